# Optimizing an MI355X kernel written in HIP

```python
import math
import jax, jax.numpy as jnp
from jax import lax
import numpy as np


D_MODEL = 1024
BATCH = 8
SEQ = 2048
DEPTH = 2

CHUNK = 64
EPS = 1e-6

GM_WIDTH = 1024
GM_GROUPS = 4
GM_BLOCK = 128

MLA_HEADS = 8
MLA_NOPE = 128
MLA_ROPE = 64
MLA_VDIM = 128
MLA_QK_DIM = MLA_NOPE + MLA_ROPE
MLA_Q_RANK = 384
MLA_KV_RANK = 256
MLA_WIDTH = MLA_HEADS * MLA_VDIM
ROPE_THETA = 10000.0
Q_BLOCK = 128

LRU_WIDTH = 1280
LRU_BLOCKS = 16
LRU_BW = LRU_WIDTH // LRU_BLOCKS
LRU_C = 8.0
CONV_W = 4

IN_SIZES = (GM_WIDTH, GM_WIDTH, GM_WIDTH, MLA_Q_RANK, MLA_KV_RANK, MLA_ROPE, MLA_WIDTH,
            LRU_WIDTH, LRU_WIDTH, D_MODEL, D_MODEL, D_MODEL)
N_IN = sum(IN_SIZES)

kernel_name = "hybrid_gmlp_mla_rglru_chunk_causal"


def _split_points():
    return [int(s) for s in np.cumsum(IN_SIZES)[:-1]]


def rmsnorm(x, g):
    xf = x.astype(jnp.float32)
    y = xf * lax.rsqrt(jnp.mean(xf * xf, axis=-1, keepdims=True) + EPS)
    return (y * g.astype(jnp.float32)).astype(x.dtype)


def layernorm(x, g, b):
    xf = x.astype(jnp.float32)
    mu = jnp.mean(xf, axis=-1, keepdims=True)
    var = jnp.mean(jnp.square(xf - mu), axis=-1, keepdims=True)
    y = (xf - mu) * lax.rsqrt(var + EPS)
    return (y * g.astype(jnp.float32) + b.astype(jnp.float32)).astype(x.dtype)


def rope(t, cos, sin):
    half = t.shape[-1] // 2
    t1, t2 = t[..., :half], t[..., half:]
    return jnp.concatenate([t1 * cos - t2 * sin, t2 * cos + t1 * sin], axis=-1)


def gmlp_spatial(u, v, ln_g, ln_b, ws, bs):
    B, S, _ = v.shape
    v = layernorm(v, ln_g, ln_b)
    vb = v.reshape(B, S // GM_BLOCK, GM_BLOCK, GM_GROUPS, GM_WIDTH // GM_GROUPS)
    idx = jnp.arange(GM_BLOCK)
    mask = (idx[None, :] // CHUNK) <= (idx[:, None] // CHUNK)
    ws_m = jnp.where(mask[None], ws, jnp.zeros_like(ws))
    sv = jnp.einsum('gij,bnjgc->bnigc', ws_m, vb) + bs.T[None, None, :, :, None]
    return u * sv.reshape(B, S, GM_WIDTH)


def mla_attention(c_q, c_kv, k_rope_in, q_norm_g, w_uq, kv_norm_g, w_ukv):
    B, S, _ = c_q.shape
    H = MLA_HEADS
    q = (rmsnorm(c_q, q_norm_g) @ w_uq).reshape(B, S, H, MLA_QK_DIM)
    kv = (rmsnorm(c_kv, kv_norm_g) @ w_ukv).reshape(B, S, H, MLA_NOPE + MLA_VDIM)
    q_nope, q_rope = q[..., :MLA_NOPE], q[..., MLA_NOPE:]
    k_nope, v = kv[..., :MLA_NOPE], kv[..., MLA_NOPE:]

    pos = jnp.arange(S, dtype=jnp.float32)
    inv_freq = ROPE_THETA ** (-jnp.arange(0, MLA_ROPE, 2, dtype=jnp.float32) / MLA_ROPE)
    ang = pos[:, None] * inv_freq[None, :]
    cos = jnp.cos(ang).astype(q.dtype)
    sin = jnp.sin(ang).astype(q.dtype)
    q_rope = rope(q_rope, cos[None, :, None, :], sin[None, :, None, :])
    k_rope = rope(k_rope_in, cos[None], sin[None])

    q = jnp.concatenate([q_nope, q_rope], axis=-1)
    k = jnp.concatenate([k_nope, jnp.broadcast_to(k_rope[:, :, None, :], (B, S, H, MLA_ROPE))], axis=-1)
    scale = 1.0 / math.sqrt(MLA_QK_DIM)
    nb = S // Q_BLOCK
    qb = q.reshape(B, nb, Q_BLOCK, H, MLA_QK_DIM).transpose(1, 0, 2, 3, 4)
    key_chunk = jnp.arange(S) // CHUNK

    def one_block(args):
        qi, bi = args
        s = jnp.einsum('bqhd,bkhd->bhqk', qi, k).astype(jnp.float32) * scale
        q_chunk = (bi * Q_BLOCK + jnp.arange(Q_BLOCK)) // CHUNK
        mask = key_chunk[None, :] <= q_chunk[:, None]
        s = jnp.where(mask[None, None], s, -1e30)
        p = jax.nn.softmax(s, axis=-1).astype(v.dtype)
        return jnp.einsum('bhqk,bkhd->bqhd', p, v)

    o = lax.map(one_block, (qb, jnp.arange(nb)))
    return o.transpose(1, 0, 2, 3, 4).reshape(B, S, MLA_WIDTH)


def rg_lru(x_c, conv_w, conv_b, w_a, b_a, w_x, b_x, lam):
    B, S, C = x_c.shape
    xc = lax.conv_general_dilated(
        x_c, conv_w[:, None, :].astype(x_c.dtype), window_strides=(1,), padding=[(CONV_W - 1, 0)],
        dimension_numbers=('NWC', 'WIO', 'NWC'), feature_group_count=C) + conv_b
    xb = xc.reshape(B, S, LRU_BLOCKS, LRU_BW)
    r = jax.nn.sigmoid(jnp.einsum('bshi,hij->bshj', xb, w_a).reshape(B, S, C) + b_a)
    i = jax.nn.sigmoid(jnp.einsum('bshi,hij->bshj', xb, w_x).reshape(B, S, C) + b_x)
    rf = r.astype(jnp.float32)
    log_a = -LRU_C * rf * jax.nn.softplus(-lam.astype(jnp.float32))
    a = jnp.exp(log_a)
    mult = jnp.sqrt(jnp.maximum(1.0 - jnp.exp(2.0 * log_a), 0.0))
    bterm = mult * (i.astype(jnp.float32) * xc.astype(jnp.float32))

    def combine(e1, e2):
        a1, b1 = e1
        a2, b2 = e2
        return a1 * a2, a2 * b1 + b2

    _, h = lax.associative_scan(combine, (a, bterm), axis=1)
    return h.astype(x_c.dtype)


def setup_inputs(seed: int = 0) -> dict:
    key = jax.random.key(seed)
    ks = iter(jax.random.split(key, 32))
    L, D = DEPTH, D_MODEL

    def nrm(shape, scale):
        return jax.random.normal(next(ks), shape, jnp.float32) * scale

    def gain(shape):
        return 1.0 + nrm(shape, 0.02)

    a_init = jax.random.uniform(next(ks), (L, LRU_WIDTH), jnp.float32, 0.9, 0.999)
    s = a_init ** (1.0 / LRU_C)
    lam = jnp.log(s) - jnp.log1p(-s)

    return {
        "x": nrm((BATCH, SEQ, D), 1.0),
        "pre_norm_g": gain((L, D)),
        "w_in": nrm((L, D, N_IN), D ** -0.5),
        "gm_ln_g": gain((L, GM_WIDTH)),
        "gm_ln_b": nrm((L, GM_WIDTH), 0.02),
        "gm_ws": nrm((L, GM_GROUPS, GM_BLOCK, GM_BLOCK), GM_BLOCK ** -0.5),
        "gm_bs": 1.0 + nrm((L, GM_GROUPS, GM_BLOCK), 0.02),
        "mla_q_norm_g": gain((L, MLA_Q_RANK)),
        "mla_w_uq": nrm((L, MLA_Q_RANK, MLA_HEADS * MLA_QK_DIM), MLA_Q_RANK ** -0.5),
        "mla_kv_norm_g": gain((L, MLA_KV_RANK)),
        "mla_w_ukv": nrm((L, MLA_KV_RANK, MLA_HEADS * (MLA_NOPE + MLA_VDIM)), MLA_KV_RANK ** -0.5),
        "lru_conv_w": nrm((L, CONV_W, LRU_WIDTH), CONV_W ** -0.5),
        "lru_conv_b": nrm((L, LRU_WIDTH), 0.01),
        "lru_w_a": nrm((L, LRU_BLOCKS, LRU_BW, LRU_BW), LRU_BW ** -0.5),
        "lru_b_a": nrm((L, LRU_WIDTH), 0.01),
        "lru_w_x": nrm((L, LRU_BLOCKS, LRU_BW, LRU_BW), LRU_BW ** -0.5),
        "lru_b_x": nrm((L, LRU_WIDTH), 0.01),
        "lru_lambda": lam,
        "w_proj_a": nrm((L, GM_WIDTH, D), GM_WIDTH ** -0.5),
        "w_proj_b": nrm((L, MLA_WIDTH, D), MLA_WIDTH ** -0.5),
        "w_proj_c": nrm((L, LRU_WIDTH, D), LRU_WIDTH ** -0.5),
        "w_out": nrm((L, D, D), D ** -0.5),
        "post_norm_g": gain((L, D)),
    }


def reference(x, pre_norm_g, w_in, gm_ln_g, gm_ln_b, gm_ws, gm_bs, mla_q_norm_g, mla_w_uq,
              mla_kv_norm_g, mla_w_ukv, lru_conv_w, lru_conv_b, lru_w_a, lru_b_a, lru_w_x,
              lru_b_x, lru_lambda, w_proj_a, w_proj_b, w_proj_c, w_out, post_norm_g):
    cuts = _split_points()
    for l in range(DEPTH):
        h = rmsnorm(x, pre_norm_g[l])
        proj = h @ w_in[l]
        (u, v, z_a, c_q, c_kv, k_rope, z_b, x_c, z_c,
         g_a, g_b, g_c) = jnp.split(proj, cuts, axis=-1)

        y_a = gmlp_spatial(u, v, gm_ln_g[l], gm_ln_b[l], gm_ws[l], gm_bs[l]) * jax.nn.silu(z_a)
        y_b = mla_attention(c_q, c_kv, k_rope, mla_q_norm_g[l], mla_w_uq[l],
                            mla_kv_norm_g[l], mla_w_ukv[l]) * jax.nn.silu(z_b)
        y_c = rg_lru(x_c, lru_conv_w[l], lru_conv_b[l], lru_w_a[l], lru_b_a[l],
                     lru_w_x[l], lru_b_x[l], lru_lambda[l]) * jax.nn.silu(z_c)

        merged = (jax.nn.sigmoid(g_a) * (y_a @ w_proj_a[l])
                  + jax.nn.sigmoid(g_b) * (y_b @ w_proj_b[l])
                  + jax.nn.sigmoid(g_c) * (y_c @ w_proj_c[l]))
        x = x + rmsnorm(merged @ w_out[l], post_norm_g[l])
    return x
```

```cpp
#include <hip/hip_runtime.h>
#include <cstdio>
#include <cstdint>

#define LAS __attribute__((address_space(3)))
#define GAS __attribute__((address_space(1)))
typedef unsigned short bf16_t;
typedef short bf16x8 __attribute__((ext_vector_type(8)));
typedef short s16x4 __attribute__((ext_vector_type(4)));
typedef float f32x2 __attribute__((ext_vector_type(2)));
typedef float f32x4 __attribute__((ext_vector_type(4)));
typedef float f32x16 __attribute__((ext_vector_type(16)));
typedef unsigned u32x2 __attribute__((ext_vector_type(2)));
typedef unsigned u32x4 __attribute__((ext_vector_type(4)));
typedef __bf16 bf16x2_t __attribute__((ext_vector_type(2)));

__device__ __forceinline__ unsigned pk_bf16(float lo, float hi) { f32x2 v = {lo, hi}; bf16x2_t b = __builtin_convertvector(v, bf16x2_t); return __builtin_bit_cast(unsigned, b); }
__device__ __forceinline__ float bf_lo(unsigned w) { return __uint_as_float(w << 16); }
__device__ __forceinline__ float bf_hi(unsigned w) { return __uint_as_float(w & 0xffff0000u); }
__device__ __forceinline__ float bf1(bf16_t h) { return __uint_as_float(((unsigned)h) << 16); }
__device__ __forceinline__ bf16_t f2bf(float f) { return (bf16_t)(pk_bf16(f, 0.f) & 0xffffu); }
__device__ __forceinline__ float fsigmoid(float x) { return __builtin_amdgcn_rcpf(1.f + __expf(-x)); }
__device__ __forceinline__ float fsilu(float x) { return x * __builtin_amdgcn_rcpf(1.f + __expf(-x)); }
__device__ __forceinline__ float wave_sum(float v) {
#pragma unroll
    for (int o = 1; o < 64; o <<= 1) v += __shfl_xor(v, o);
    return v;
}
#define LDS_WAIT() asm volatile("s_waitcnt lgkmcnt(0)" ::: "memory")
#define VM_WAIT() asm volatile("s_waitcnt vmcnt(0)" ::: "memory")

namespace g8 {
constexpr int BM = 256, BK = 64, HALF = 128, HTB = HALF * BK * 2, STAGE_BYTES = 8 * HTB, NXCD = 8, WGM = 8;
__host__ __device__ __forceinline__ int lds_byte(int r, int c) { const int st = (r >> 4) * 2 + (c >> 5), rr = r & 15, cc = c & 31, ob = rr * 64 + cc * 2; return st * 1024 + (ob ^ (((ob >> 9) & 1) << 5)); }
__host__ __device__ __forceinline__ void stage_rc(int b, int& R, int& C) { const int st = b / 1024, sb = b % 1024, swz = sb ^ (((sb >> 9) & 1) << 5); R = (st >> 1) * 16 + swz / 64; C = (st & 1) * 32 + (swz % 64) / 2; }
__host__ __device__ __forceinline__ int perm32(int rho) { const int n = rho >> 4, i = rho & 15; return 8 * (i >> 2) + 4 * n + (i & 3); }

struct UnitD { const char* A; const char* B; int nt, pm, pn, kind; };
constexpr int KEEP_ACC = 0x100;

struct TileOrder {
    int nM, nN, nwg, G, c;
    __device__ void init(int nM_, int nN_, int G_, int c_) { nM = nM_; nN = nN_; nwg = nM * nN; G = G_; c = c_; }
    __device__ bool tile(int i, int& pm, int& pn) const {
        const long L = (long)i * G + c; if (L >= nwg) return false;
        int wgid = (int)L; { const int q = nwg / NXCD, r = nwg % NXCD, xcd = wgid % NXCD, off = wgid / NXCD; wgid = (xcd < r ? xcd * (q + 1) : r * (q + 1) + (xcd - r) * q) + off; }
        const int nig = WGM * nN, gid = wgid / nig, fm = gid * WGM, gsz = (nM - fm) < WGM ? (nM - fm) : WGM;
        pm = fm + ((wgid % nig) % gsz); pn = (wgid % nig) / gsz; return true;
    }
};

template <class Sched, class Epi>
__device__ __forceinline__ void gemm_stream(LAS unsigned char* lds, int tid_in, const unsigned lda, const unsigned ldb, const Sched& S, const Epi& E) {
    int tid_ = tid_in; asm volatile("" : "+v"(tid_));
    const int tid = tid_, wid = __builtin_amdgcn_readfirstlane(tid >> 6), lane = tid & 63, wr = wid >> 2, wc = wid & 3, fr = lane & 15, fq = lane >> 4;
    unsigned voffA[2], voffB[2];
#pragma unroll
    for (int i = 0; i < 2; ++i) { int R, C; stage_rc(tid * 16 + i * 8192, R, C); const int Rb = (R & ~31) + perm32(R & 31);
        voffA[i] = (unsigned)R * lda + (unsigned)C * 2u; voffB[i] = (unsigned)Rb * ldb + (unsigned)C * 2u; }
    const size_t kstep = (size_t)(BK * 2);
    const size_t hstepA = (size_t)HALF * lda, hstepB = (size_t)HALF * ldb;
    const unsigned ldsw = (unsigned)wid * 1024u;
    const int aoff = lds_byte(wr * 64 + fr, fq * 8), boff = lds_byte(wc * 32 + fr, fq * 8);
#define G8_SA(b, h) (((b) * 2 + (h)) * HTB)
#define G8_SB(b, h) ((4 + (b) * 2 + (h)) * HTB)
#define G8_STAGE(bufoff, gbase, voff) do { _Pragma("unroll") for (int _i = 0; _i < 2; ++_i) \
        __builtin_amdgcn_global_load_lds((const unsigned*)((const char*)(gbase) + (voff)[_i]), (LAS unsigned*)(lds + (bufoff) + ldsw + _i * 8192), 16, 0, 0); } while (0)
#define G8_LDA(dst, b, h) do { _Pragma("unroll") for (int m = 0; m < 4; ++m) _Pragma("unroll") for (int k = 0; k < 2; ++k) dst[m][k] = *(const LAS bf16x8*)(lds + G8_SA(b, h) + aoff + m * 2048 + k * 1024); } while (0)
#define G8_LDB(dst, b, h) do { _Pragma("unroll") for (int n = 0; n < 2; ++n) _Pragma("unroll") for (int k = 0; k < 2; ++k) dst[n][k] = *(const LAS bf16x8*)(lds + G8_SB(b, h) + boff + n * 2048 + k * 1024); } while (0)
#define G8_MMA(ai, bj, At, Bt) do { __builtin_amdgcn_s_setprio(1); _Pragma("unroll") for (int m = 0; m < 4; ++m) _Pragma("unroll") for (int n = 0; n < 2; ++n) _Pragma("unroll") for (int k = 0; k < 2; ++k) \
        acc[ai][bj][m][n] = __builtin_amdgcn_mfma_f32_16x16x32_bf16(Bt[n][k], At[m][k], acc[ai][bj][m][n], 0, 0, 0); __builtin_amdgcn_s_setprio(0); } while (0)
#define G8_WAIT_V(n) asm volatile("s_waitcnt vmcnt(" #n ")" ::: "memory")
#define G8_WAIT_L(n) asm volatile("s_waitcnt lgkmcnt(" #n ")" ::: "memory")
#define G8_BAR __builtin_amdgcn_s_barrier()
#define G8_SCHED __builtin_amdgcn_sched_barrier(0)
    UnitD cur, nxt; int ui = 0;
    if (!S.next(0, cur)) return;
    f32x4 acc[2][2][4][2];
#pragma unroll
    for (int a = 0; a < 2; ++a)
#pragma unroll
        for (int b = 0; b < 2; ++b)
#pragma unroll
            for (int m = 0; m < 4; ++m)
#pragma unroll
                for (int n = 0; n < 2; ++n) acc[a][b][m][n] = (f32x4){0.f, 0.f, 0.f, 0.f};
    bf16x8 At[4][2], B0[2][2], B1[2][2];
    const char* cA = cur.A; const char* cB = cur.B;
    G8_STAGE(G8_SB(0, 0), cB, voffB); G8_STAGE(G8_SB(0, 1), cB + hstepB, voffB); G8_STAGE(G8_SA(0, 0), cA, voffA); G8_STAGE(G8_SA(0, 1), cA + hstepA, voffA);
    if (wr == 1) G8_BAR;
    G8_WAIT_V(2); G8_BAR;
    G8_STAGE(G8_SB(1, 0), cB + kstep, voffB); G8_STAGE(G8_SA(1, 0), cA + kstep, voffA); G8_STAGE(G8_SB(1, 1), cB + hstepB + kstep, voffB);
    G8_WAIT_V(6); G8_BAR;
    for (;;) {
        const bool has_next = S.next(ui + 1, nxt);
        const char* nA = has_next ? nxt.A : cA; const char* nB = has_next ? nxt.B : cB;
        const int nt = cur.nt;
        for (int t = 0; t < nt; t += 2) {
            const bool last = (t == nt - 2);
            const char* a1 = cA + (size_t)(t + 1) * kstep;
            const char* a2 = last ? nA : cA + (size_t)(t + 2) * kstep; const char* b2 = last ? nB : cB + (size_t)(t + 2) * kstep;
            const char* a3 = a2 + kstep; const char* b3 = b2 + kstep;
            G8_LDB(B0, 0, 0); G8_LDB(B1, 0, 1); G8_SCHED; G8_LDA(At, 0, 0); G8_STAGE(G8_SA(1, 1), a1 + hstepA, voffA);
            G8_WAIT_V(8); G8_WAIT_L(0); G8_BAR; G8_MMA(0, 0, At, B0); G8_MMA(0, 1, At, B1); G8_BAR; G8_SCHED;
            G8_LDA(At, 0, 1); G8_STAGE(G8_SB(0, 0), b2, voffB); G8_STAGE(G8_SB(0, 1), b2 + hstepB, voffB); G8_STAGE(G8_SA(0, 0), a2, voffA);
            G8_WAIT_V(8); G8_WAIT_L(0); G8_BAR; G8_MMA(1, 0, At, B0); G8_MMA(1, 1, At, B1); G8_BAR; G8_SCHED;
            G8_LDB(B0, 1, 0); G8_LDB(B1, 1, 1); G8_SCHED; G8_LDA(At, 1, 0); G8_STAGE(G8_SA(0, 1), a2 + hstepA, voffA);
            G8_WAIT_V(8); G8_WAIT_L(0); G8_BAR; G8_MMA(0, 0, At, B0); G8_MMA(0, 1, At, B1); G8_BAR; G8_SCHED;
            G8_LDA(At, 1, 1); G8_STAGE(G8_SB(1, 0), b3, voffB); G8_STAGE(G8_SB(1, 1), b3 + hstepB, voffB); G8_STAGE(G8_SA(1, 0), a3, voffA);
            G8_WAIT_V(8); G8_WAIT_L(0); G8_BAR; G8_MMA(1, 0, At, B0); G8_MMA(1, 1, At, B1); G8_BAR; G8_SCHED;
        }
        if (wr == 0) G8_BAR;
        { UnitD eu = cur; int fr_ = fr, fq_ = fq; asm volatile("" : "+s"(eu.pm), "+s"(eu.pn), "+v"(fr_), "+v"(fq_)); E(acc, eu, wr, wc, fr_, fq_); }
        if (!has_next) break;
        if (!(cur.kind & KEEP_ACC)) {
#pragma unroll
            for (int a = 0; a < 2; ++a)
#pragma unroll
                for (int b = 0; b < 2; ++b)
#pragma unroll
                    for (int m = 0; m < 4; ++m)
#pragma unroll
                        for (int n = 0; n < 2; ++n) acc[a][b][m][n] = (f32x4){0.f, 0.f, 0.f, 0.f};
        }
        cur = nxt; cA = nA; cB = nB; ++ui;
        if (wr == 1) G8_BAR;
    }
    G8_WAIT_V(0);
    G8_BAR;
#undef G8_SA
#undef G8_SB
#undef G8_STAGE
#undef G8_LDA
#undef G8_LDB
#undef G8_MMA
#undef G8_WAIT_V
#undef G8_WAIT_L
#undef G8_BAR
#undef G8_SCHED
}
}

#define XB_TMO      128
#define XB_XCNT(j)  (256  + 64 * (j))
#define XB_XSUB(j)  (1280 + 64 * (j))
#define XB_XGEN(j)  (2304 + 64 * (j))
#define XB_TOP      3328
#define XB_TOPGEN   3392
#define XCD_BAR_WORDS 3456
#define XB_SPIN_CAP (1u << 18)
__device__ __forceinline__ unsigned xb_ld(unsigned* p)              { return __hip_atomic_load(p, __ATOMIC_RELAXED, __HIP_MEMORY_SCOPE_AGENT); }
__device__ __forceinline__ unsigned xb_add(unsigned* p, unsigned v) { return __hip_atomic_fetch_add(p, v, __ATOMIC_RELAXED, __HIP_MEMORY_SCOPE_AGENT); }
__device__ __forceinline__ unsigned xb_xcc_id() { return (unsigned)__builtin_amdgcn_s_getreg((3 << 11) | 20) & 0xFu; }
#define XB_SPIN(cond, bar) do { unsigned _sp = 0; while (cond) { __builtin_amdgcn_s_sleep(1); \
    if ((++_sp & 255u) == 0u) { if (xb_ld(&(bar)[XB_TMO])) break; if (_sp > XB_SPIN_CAP) { atomicAdd(&(bar)[XB_TMO], 1u); break; } } } } while (0)
struct XcdBarrier { unsigned* bar; unsigned x; volatile LAS unsigned* st; };
__device__ __forceinline__ XcdBarrier xcd_barrier_post(unsigned* bar, volatile LAS unsigned* st) {
    XcdBarrier b; b.bar = bar; b.x = xb_xcc_id(); b.st = st;
    if (threadIdx.x == 0) (void)xb_add(&bar[XB_XCNT(b.x)], 1u);
    return b;
}
__device__ __forceinline__ void xcd_barrier_complete(unsigned* bar, unsigned x, unsigned& nloc, unsigned& nx) {
    const unsigned G = gridDim.x * gridDim.y * gridDim.z;
    unsigned sum, cnt, mine, sp = 0u;
    for (;;) {
        sum = 0u; cnt = 0u; mine = 0u;
#pragma unroll
        for (unsigned j = 0; j < 16; ++j) { const unsigned c = xb_ld(&bar[XB_XCNT(j)]); sum += c; cnt += (c > 0u) ? 1u : 0u; mine = (j == x) ? c : mine; }
        if (sum == G) break;
        __builtin_amdgcn_s_sleep(1);
        if ((++sp & 255u) == 0u) { if (xb_ld(&bar[XB_TMO])) break; if (sp > XB_SPIN_CAP) { atomicAdd(&bar[XB_TMO], 1u); break; } }
    }
    nloc = mine > 0u ? mine : 1u; nx = cnt > 0u ? cnt : 1u;
}
__device__ __forceinline__ void xcd_barrier(const XcdBarrier& b) {
    asm volatile("s_waitcnt vmcnt(0)" ::: "memory");
    __syncthreads();
    if (threadIdx.x == 0) {
        unsigned* bar = b.bar;
        __builtin_amdgcn_s_waitcnt(0);
        unsigned nloc = b.st[0], nx = b.st[1];
        if (nloc == 0u) { xcd_barrier_complete(bar, b.x, nloc, nx); b.st[0] = nloc; b.st[1] = nx; }
        const unsigned old = xb_add(&bar[XB_XSUB(b.x)], 1u);
        const unsigned gen = old / nloc;
        if (old + 1u == (gen + 1u) * nloc) {
            __builtin_amdgcn_fence(__ATOMIC_RELEASE, "agent");
            asm volatile("s_waitcnt vmcnt(0)" ::: "memory");
            const unsigned og = xb_add(&bar[XB_TOP], 1u);
            const unsigned tg = og / nx;
            if (og + 1u == (tg + 1u) * nx) xb_add(&bar[XB_TOPGEN], 1u);
            else XB_SPIN(xb_ld(&bar[XB_TOPGEN]) == tg, bar);
            __builtin_amdgcn_fence(__ATOMIC_ACQUIRE, "agent");
            xb_add(&bar[XB_XGEN(b.x)], 1u);
            asm volatile("s_waitcnt vmcnt(0)" ::: "memory");
        } else {
            XB_SPIN(xb_ld(&bar[XB_XGEN(b.x)]) == gen, bar);
            __builtin_amdgcn_fence(__ATOMIC_ACQUIRE, "agent");
            asm volatile("s_waitcnt vmcnt(0)" ::: "memory");
        }
    }
    __syncthreads();
}
constexpr int T = 16384, DM = 1024, SEQ = 2048, NBATCH = 8, DEPTH = 2, N_IN = 10432;
constexpr int NWAVES = 8;
constexpr float EPS = 1e-6f;
constexpr size_t MiB = 1u << 20;
constexpr size_t WS_CTL = 0, CTL_ZERO_BYTES = 64 * 1024;
constexpr size_t WS_WB = 1 * MiB;
constexpr size_t WB_W1T = 0;
constexpr size_t WB_W2T = WB_W1T + (size_t)4352 * 1024 * 2;
constexpr size_t WB_WQT = WB_W2T + (size_t)6144 * 1024 * 2;
constexpr size_t WB_WKVT = WB_WQT + (size_t)1536 * 384 * 2;
constexpr size_t WB_WPT = WB_WKVT + (size_t)2048 * 384 * 2;
constexpr size_t WB_WOT = WB_WPT + (size_t)1024 * 3328 * 2;
constexpr size_t WB_END = WB_WOT + (size_t)1024 * 1024 * 2;
static_assert(WB_END <= 32 * MiB, "weights region");
constexpr size_t WS_H = 33 * MiB;
constexpr size_t WS_Y = 65 * MiB;
constexpr int YLD = 3328;
constexpr size_t WS_BIG = 169 * MiB;
constexpr size_t WS_MISC = WS_BIG;
constexpr size_t WS_XC = WS_MISC + 24 * MiB;
constexpr size_t WS_Q = WS_XC + 40 * MiB;
constexpr size_t WS_VV = WS_Q + 48 * MiB;
constexpr size_t WS_KR = WS_VV + 32 * MiB;
constexpr size_t WS_V1 = WS_BIG;
constexpr size_t WS_G = WS_V1 + 32 * MiB;
constexpr size_t WS_O = WS_BIG;
constexpr size_t WS_SMALL = 315 * MiB;
constexpr size_t WS_SLAB = WS_SMALL;
constexpr size_t WS_AGG = WS_SLAB + 1536 * 1024;
constexpr size_t WS_ROPE = WS_AGG + 2560 * 1024;
constexpr size_t WS_LW = WS_ROPE + 512 * 1024;
constexpr size_t WS_GMW = WS_LW + 480 * 1024;
constexpr size_t WS_END = WS_GMW + 128 * 1024;
static_assert(WS_KR + 2 * MiB <= WS_SMALL && WS_G + 96 * MiB <= WS_SMALL && WS_END <= 326 * MiB, "d_ws map");
constexpr int CW_BAR = 1024;
static_assert((CW_BAR + XCD_BAR_WORDS) * 4 <= (int)CTL_ZERO_BYTES, "ctl");
constexpr int RING_BYTES = 131072, MISC_OFF = RING_BYTES + 320, LDS_BYTES = 147456;

enum { I_X = 0, I_PRE_G, I_W_IN, I_GM_LN_G, I_GM_LN_B, I_GM_WS, I_GM_BS, I_QN_G, I_W_UQ, I_KVN_G, I_W_UKV, I_CONV_W, I_CONV_B, I_W_A, I_B_A, I_W_X, I_B_X, I_LAM,
       I_W_PA, I_W_PB, I_W_PC, I_W_OUT, I_POST_G, N_INPUTS };
struct Args { const float* in[N_INPUTS]; float* out; unsigned char* ws; int ph_lo, ph_hi; };

struct Frame { LAS unsigned char* lds; int tid, lane, wave, vcu, G; };

struct MapW1 { __device__ __forceinline__ int operator()(int j) const {
    if (j < 384) return 3072 + j; if (j < 640) return 3456 + (j - 384); if (j < 704) return 3712 + (j - 640); if (j < 768) return -1;
    if (j < 2048) return 4800 + (j - 768); if (j < 3328) return 6080 + (j - 2048); return 3776 + (j - 3328); } };
struct MapW2 { __device__ __forceinline__ int operator()(int j) const {
    if (j < 2048) { const int tl = j >> 8, lc = j & 255; return (lc < 128) ? (128 * tl + lc) : (2048 + 128 * tl + (lc - 128)); }
    if (j < 3072) return 1024 + (j - 2048); return 7360 + (j - 3072); } };
struct MapQ { __device__ __forceinline__ int operator()(int j) const {
    if (j < 1024) { const int hd = j >> 7, d = j & 127; return hd * 192 + d; }
    const int jj = j - 1024, hh = jj >> 6, w = jj & 63, g = w >> 3, e = w & 7; return hh * 192 + (e < 4 ? 128 + 4 * g + e : 160 + 4 * g + (e - 4)); } };
struct MapId { __device__ __forceinline__ int operator()(int j) const { return j; } };

template <class Map>
__device__ __forceinline__ void tr_item(const float* W, int ldw, int nkb  , bf16_t* WT, int ldt, const Map map, const float* kscale, LAS float* scr, int item, int lane) {
    const int kb = item % nkb, nb = item / nkb, k0 = 64 * kb, n0 = 32 * nb;
    const int nn = lane & 31; const int sc = map(n0 + nn);
#pragma unroll 8
    for (int i = 0; i < 32; ++i) { const int kk = 2 * i + (lane >> 5); float v = (sc >= 0) ? W[(size_t)(k0 + kk) * ldw + sc] : 0.f; if (kscale) v *= kscale[k0 + kk]; scr[kk * 33 + nn] = v; }
    LDS_WAIT(); asm volatile("" ::: "memory");
    const int c = lane & 7;
#pragma unroll
    for (int j = 0; j < 4; ++j) { const int n = (lane >> 3) + 8 * j; const LAS float* s = scr + (8 * c) * 33 + n;
        u32x4 o; o.x = pk_bf16(s[0 * 33], s[1 * 33]); o.y = pk_bf16(s[2 * 33], s[3 * 33]); o.z = pk_bf16(s[4 * 33], s[5 * 33]); o.w = pk_bf16(s[6 * 33], s[7 * 33]);
        *(u32x4*)(WT + (size_t)(n0 + n) * ldt + k0 + 8 * c) = o; }
    LDS_WAIT(); asm volatile("" ::: "memory");
}

__device__ __forceinline__ void convert_weights(const Frame& F, const Args& a, unsigned char* ws, int l) {
    LAS float* scr = (LAS float*)(F.lds + F.wave * 16384);
    const int gw = F.vcu * NWAVES + F.wave, NGW = F.G * NWAVES;
    unsigned char* wb = ws + WS_WB;
    constexpr int I1 = 16 * (4352 / 32), I2 = 16 * (6144 / 32), IQ = 6 * (1536 / 32), IKV = 4 * (2048 / 32), IPA = 16 * 32, IPB = 16 * 32, IPC = 20 * 32, IO = 16 * 32;
    constexpr int NITEMS = I1 + I2 + IQ + IKV + IPA + IPB + IPC + IO;
    const float* w_in = a.in[I_W_IN] + (size_t)l * 1024 * N_IN;
    for (int it = gw; it < NITEMS; it += NGW) {
        int r = it;
        if (r < I1) { tr_item(w_in, N_IN, 16, (bf16_t*)(wb + WB_W1T), 1024, MapW1(), nullptr, scr, r, F.lane); continue; } r -= I1;
        if (r < I2) { tr_item(w_in, N_IN, 16, (bf16_t*)(wb + WB_W2T), 1024, MapW2(), nullptr, scr, r, F.lane); continue; } r -= I2;
        if (r < IQ) { tr_item(a.in[I_W_UQ] + (size_t)l * 384 * 1536, 1536, 6, (bf16_t*)(wb + WB_WQT), 384, MapQ(), a.in[I_QN_G] + l * 384, scr, r, F.lane); continue; } r -= IQ;
        if (r < IKV) { tr_item(a.in[I_W_UKV] + (size_t)l * 256 * 2048, 2048, 4, (bf16_t*)(wb + WB_WKVT), 384, MapId(), a.in[I_KVN_G] + l * 256, scr, r, F.lane); continue; } r -= IKV;
        if (r < IPA) { tr_item(a.in[I_W_PA] + (size_t)l * 1024 * 1024, 1024, 16, (bf16_t*)(wb + WB_WPT), 3328, MapId(), nullptr, scr, r, F.lane); continue; } r -= IPA;
        if (r < IPB) { tr_item(a.in[I_W_PB] + (size_t)l * 1024 * 1024, 1024, 16, (bf16_t*)(wb + WB_WPT) + 1024, 3328, MapId(), nullptr, scr, r, F.lane); continue; } r -= IPB;
        if (r < IPC) { tr_item(a.in[I_W_PC] + (size_t)l * 1280 * 1024, 1024, 20, (bf16_t*)(wb + WB_WPT) + 2048, 3328, MapId(), nullptr, scr, r, F.lane); continue; } r -= IPC;
        tr_item(a.in[I_W_OUT] + (size_t)l * 1024 * 1024, 1024, 16, (bf16_t*)(wb + WB_WOT), 1024, MapId(), nullptr, scr, r, F.lane);
    }
    const int gt = (F.vcu * NWAVES + F.wave) * 64 + F.lane, NGT = F.G * NWAVES * 64;
    bf16_t* lwa = (bf16_t*)(ws + WS_LW); bf16_t* lwx = lwa + 16 * 80 * 96;
    const float* w_a = a.in[I_W_A] + (size_t)l * 16 * 80 * 80; const float* w_x = a.in[I_W_X] + (size_t)l * 16 * 80 * 80;
    for (int i = gt; i < 16 * 80 * 96; i += NGT) { const int k = i % 96, j = (i / 96) % 80, blk = i / (96 * 80);
        const float va = (k < 80) ? w_a[((size_t)blk * 80 + k) * 80 + j] : 0.f, vx = (k < 80) ? w_x[((size_t)blk * 80 + k) * 80 + j] : 0.f;
        lwa[i] = f2bf(va); lwx[i] = f2bf(vx); }
    bf16_t* gmw = (bf16_t*)(ws + WS_GMW); const float* gws = a.in[I_GM_WS] + (size_t)l * 4 * 128 * 128;
    for (int i = gt; i < 4 * 128 * 128; i += NGT) { const int j = i & 127, ii = (i >> 7) & 127; gmw[i] = f2bf(((j >> 6) <= (ii >> 6)) ? gws[i] : 0.f); }
}
__device__ __forceinline__ void rope_table(const Frame& F, unsigned char* ws) {
    const int gt = (F.vcu * NWAVES + F.wave) * 64 + F.lane, NGT = F.G * NWAVES * 64;
    float* cs = (float*)(ws + WS_ROPE); float* sn = cs + 2048 * 32;
    for (int i = gt; i < 2048 * 32; i += NGT) { const int s = i >> 5, fi = i & 31; const float inv_freq = powf(10000.f, -(float)(2 * fi) / 64.f); const float ang = (float)s * inv_freq;
        cs[i] = cosf(ang); sn[i] = sinf(ang); }
}
__device__ __forceinline__ void norm_rows(const Frame& F, const float* xin, const float* o, const float* g_post, float* xout, const float* g_pre, bf16_t* h) {
    const int gw = F.vcu * NWAVES + F.wave, NGW = F.G * NWAVES;
    for (int m = gw; m < T; m += NGW) {
        const f32x4* xr = (const f32x4*)(xin + (size_t)m * DM) + F.lane;
        f32x4 v[4];
#pragma unroll
        for (int j = 0; j < 4; ++j) v[j] = xr[64 * j];
        if (o) {
            const f32x4* orow = (const f32x4*)(o + (size_t)m * DM) + F.lane; f32x4 ov[4]; float s = 0.f;
#pragma unroll
            for (int j = 0; j < 4; ++j) { ov[j] = orow[64 * j]; s += (ov[j].x * ov[j].x + ov[j].y * ov[j].y) + (ov[j].z * ov[j].z + ov[j].w * ov[j].w); }
            const float r = rsqrtf(wave_sum(s) * (1.f / DM) + EPS);
            f32x4* xo = (f32x4*)(xout + (size_t)m * DM) + F.lane;
#pragma unroll
            for (int j = 0; j < 4; ++j) { const f32x4 gp = *((const f32x4*)g_post + F.lane + 64 * j); v[j] = v[j] + ov[j] * r * gp; xo[64 * j] = v[j]; }
        }
        if (g_pre) {
            float s = 0.f;
#pragma unroll
            for (int j = 0; j < 4; ++j) s += (v[j].x * v[j].x + v[j].y * v[j].y) + (v[j].z * v[j].z + v[j].w * v[j].w);
            const float r = rsqrtf(wave_sum(s) * (1.f / DM) + EPS);
            u32x2* ho = (u32x2*)(h + (size_t)m * DM) + F.lane;
#pragma unroll
            for (int j = 0; j < 4; ++j) { const f32x4 gp = *((const f32x4*)g_pre + F.lane + 64 * j); const f32x4 y = v[j] * r * gp; u32x2 w; w.x = pk_bf16(y.x, y.y); w.y = pk_bf16(y.z, y.w); ho[64 * j] = w; }
        }
    }
}
using g8::UnitD;
constexpr float QSCALE = 0.07216878364870322f * 1.4426950408889634f;

struct SchedA {
    g8::TileOrder ord; const char* A; const char* B;
    __device__ __forceinline__ bool next(int i, UnitD& u) const { int pm, pn; if (!ord.tile(i, pm, pn)) return false;
        u.A = A + (size_t)pm * 256 * 2048; u.B = B + (size_t)pn * 256 * 2048; u.nt = 16; u.pm = pm; u.pn = pn; u.kind = 0; return true; }
};
struct EpiA {
    bf16_t* misc; bf16_t* xc; bf16_t* y; float* slab;
    __device__ __forceinline__ void operator()(f32x4 (&acc)[2][2][4][2], const UnitD& u, int wr, int wc, int fr, int fq) const {
        const int pn = u.pn, rowp = wr * 64 + fr, lc = wc * 32 + 8 * fq;
        bf16_t* dst; int ld; bool act;
        if (pn < 3) { dst = misc + 256 * pn; ld = 768; act = false; }
        else if (pn < 8) { dst = xc + 256 * (pn - 3); ld = 1280; act = false; }
        else if (pn < 13) { dst = y + 2048 + 256 * (pn - 8); ld = YLD; act = true; }
        else { dst = y + 1024 + 256 * (pn - 13); ld = YLD; act = true; }
#pragma unroll
        for (int ai = 0; ai < 2; ++ai)
#pragma unroll
            for (int m = 0; m < 4; ++m) { const int rp = rowp + ai * 128 + m * 16; bf16_t* p = dst + ((size_t)u.pm * 256 + rp) * ld + lc;
#pragma unroll
                for (int bj = 0; bj < 2; ++bj) { f32x4 v0 = acc[ai][bj][m][0], v1 = acc[ai][bj][m][1];
                    if (pn < 3) { float ss = (v0.x * v0.x + v0.y * v0.y) + (v0.z * v0.z + v0.w * v0.w) + (v1.x * v1.x + v1.y * v1.y) + (v1.z * v1.z + v1.w * v1.w);
                        ss += __shfl_xor(ss, 16); ss += __shfl_xor(ss, 32);
                        if (fq == 0) slab[(((size_t)u.pm * 6 + pn * 2 + bj) * 4 + wc) * 256 + rp] = ss; }
                    if (act) { v0.x = fsilu(v0.x); v0.y = fsilu(v0.y); v0.z = fsilu(v0.z); v0.w = fsilu(v0.w); v1.x = fsilu(v1.x); v1.y = fsilu(v1.y); v1.z = fsilu(v1.z); v1.w = fsilu(v1.w); }
                    u32x4 w; w.x = pk_bf16(v0.x, v0.y); w.y = pk_bf16(v0.z, v0.w); w.z = pk_bf16(v1.x, v1.y); w.w = pk_bf16(v1.z, v1.w);
                    *(u32x4*)(p + bj * 128) = w; } }
    }
};

struct SchedQKV {
    g8::TileOrder ord; const char* misc; const char* wq; const char* wkv;
    __device__ __forceinline__ bool next(int i, UnitD& u) const { int pm, pn; if (!ord.tile(i, pm, pn)) return false;
        u.pm = pm; u.pn = pn; u.kind = 0;
        if (pn < 6) { u.A = misc + (size_t)pm * 256 * 1536; u.B = wq + (size_t)pn * 256 * 768; u.nt = 6; }
        else { u.A = misc + (size_t)pm * 256 * 1536 + 384 * 2; u.B = wkv + (size_t)(pn - 6) * 256 * 768; u.nt = 4; }
        return true; }
};
struct EpiQKV {
    bf16_t* q; bf16_t* y; bf16_t* vv; const float* slab; const float* cs; const float* sn;
    __device__ __forceinline__ void operator()(f32x4 (&acc)[2][2][4][2], const UnitD& u, int wr, int wc, int fr, int fq) const {
        const int pn = u.pn, rowp = wr * 64 + fr, lc = wc * 32 + 8 * fq; const bool isq = pn < 6;
#pragma unroll
        for (int ai = 0; ai < 2; ++ai)
#pragma unroll
            for (int m = 0; m < 4; ++m) { const int rp = rowp + ai * 128 + m * 16; const size_t r = (size_t)u.pm * 256 + rp;
                float s = 0.f; const float* sl = slab + (size_t)u.pm * 6 * 4 * 256 + rp;
                if (isq) {
#pragma unroll
                    for (int e = 0; e < 3; ++e) { const int j = fq * 3 + e; s += sl[(size_t)((j >> 2) * 4 + (j & 3)) * 256]; }
                } else {
#pragma unroll
                    for (int e = 0; e < 2; ++e) { const int j = fq * 2 + e; s += sl[(size_t)((3 + (j >> 2)) * 4 + (j & 3)) * 256]; }
                }
                s += __shfl_xor(s, 16); s += __shfl_xor(s, 32);
                float rs = rsqrtf(s * (isq ? (1.f / 384.f) : (1.f / 256.f)) + EPS); if (isq) rs *= QSCALE;
#pragma unroll
                for (int bj = 0; bj < 2; ++bj) { f32x4 v0 = acc[ai][bj][m][0] * rs, v1 = acc[ai][bj][m][1] * rs;
                    if (pn < 4) { const int j0 = 256 * pn + 128 * bj + lc; bf16_t* p = q + r * 1536 + (j0 >> 7) * 192 + (j0 & 127);
                        u32x4 w; w.x = pk_bf16(v0.x, v0.y); w.y = pk_bf16(v0.z, v0.w); w.z = pk_bf16(v1.x, v1.y); w.w = pk_bf16(v1.z, v1.w); *(u32x4*)p = w; }
                    else if (pn < 6) { const int jj = 256 * (pn - 4) + 128 * bj + lc, hh = jj >> 6, g = (jj & 63) >> 3; const int pos = (int)(r & 2047);
                        const f32x4 c4 = *(const f32x4*)(cs + pos * 32 + 4 * g), s4 = *(const f32x4*)(sn + pos * 32 + 4 * g);
                        const f32x4 o1 = v0 * c4 - v1 * s4, o2 = v1 * c4 + v0 * s4; bf16_t* p = q + r * 1536 + hh * 192 + 128 + 4 * g;
                        u32x2 w1, w2; w1.x = pk_bf16(o1.x, o1.y); w1.y = pk_bf16(o1.z, o1.w); w2.x = pk_bf16(o2.x, o2.y); w2.y = pk_bf16(o2.z, o2.w);
                        *(u32x2*)p = w1; *(u32x2*)(p + 32) = w2; }
                    else { const int hd = pn - 6; bf16_t* p = (bj == 0) ? (y + r * YLD + hd * 128 + lc) : (vv + r * 1024 + hd * 128 + lc);
                        u32x4 w; w.x = pk_bf16(v0.x, v0.y); w.y = pk_bf16(v0.z, v0.w); w.z = pk_bf16(v1.x, v1.y); w.w = pk_bf16(v1.z, v1.w); *(u32x4*)p = w; } } }
    }
};

struct SchedD {
    g8::TileOrder ord; const char* A; const char* B;
    __device__ __forceinline__ bool next(int i, UnitD& u) const { int pm, pn; if (!ord.tile(i, pm, pn)) return false;
        u.A = A + (size_t)pm * 256 * 2048; u.B = B + (size_t)pn * 256 * 2048; u.nt = 16; u.pm = pm; u.pn = pn; u.kind = 0; return true; }
};
struct EpiD {
    bf16_t* y; bf16_t* v1; bf16_t* g;
    __device__ __forceinline__ void operator()(f32x4 (&acc)[2][2][4][2], const UnitD& u, int wr, int wc, int fr, int fq) const {
        const int pn = u.pn, rowp = wr * 64 + fr, lc = wc * 32 + 8 * fq;
#pragma unroll
        for (int ai = 0; ai < 2; ++ai)
#pragma unroll
            for (int m = 0; m < 4; ++m) { const size_t r = (size_t)u.pm * 256 + rowp + ai * 128 + m * 16;
                if (pn < 8) { const f32x4 u0 = acc[ai][0][m][0], u1 = acc[ai][0][m][1], z0 = acc[ai][1][m][0], z1 = acc[ai][1][m][1];
                    u32x4 w; w.x = pk_bf16(u0.x * fsilu(z0.x), u0.y * fsilu(z0.y)); w.y = pk_bf16(u0.z * fsilu(z0.z), u0.w * fsilu(z0.w));
                    w.z = pk_bf16(u1.x * fsilu(z1.x), u1.y * fsilu(z1.y)); w.w = pk_bf16(u1.z * fsilu(z1.z), u1.w * fsilu(z1.w));
                    *(u32x4*)(y + r * YLD + 128 * pn + lc) = w; }
                else {
#pragma unroll
                    for (int bj = 0; bj < 2; ++bj) { f32x4 v0 = acc[ai][bj][m][0], v1_ = acc[ai][bj][m][1]; bf16_t* p;
                        if (pn < 12) p = v1 + r * 1024 + 256 * (pn - 8) + 128 * bj + lc;
                        else { p = g + r * 3072 + 256 * (pn - 12) + 128 * bj + lc;
                            v0.x = fsigmoid(v0.x); v0.y = fsigmoid(v0.y); v0.z = fsigmoid(v0.z); v0.w = fsigmoid(v0.w); v1_.x = fsigmoid(v1_.x); v1_.y = fsigmoid(v1_.y); v1_.z = fsigmoid(v1_.z); v1_.w = fsigmoid(v1_.w); }
                        u32x4 w; w.x = pk_bf16(v0.x, v0.y); w.y = pk_bf16(v0.z, v0.w); w.z = pk_bf16(v1_.x, v1_.y); w.w = pk_bf16(v1_.z, v1_.w); *(u32x4*)p = w; } } }
    }
};

struct SchedF {
    g8::TileOrder ord; const char* A; const char* B;
    __device__ __forceinline__ bool next(int i, UnitD& u) const { if (i >= 3) return false; int pm, pn; if (!ord.tile(0, pm, pn)) return false;
        const size_t ko = (i == 0) ? 0 : (i == 1 ? 1024 * 2 : 2048 * 2);
        u.A = A + (size_t)pm * 256 * (YLD * 2) + ko; u.B = B + (size_t)pn * 256 * (YLD * 2) + ko; u.nt = (i == 2) ? 20 : 16; u.pm = pm; u.pn = pn; u.kind = (i < 2) ? (i | g8::KEEP_ACC) : i; return true; }
};
struct EpiF {
    const bf16_t* g; bf16_t* merged;
    __device__ __forceinline__ void operator()(f32x4 (&acc)[2][2][4][2], const UnitD& u, int wr, int wc, int fr, int fq) const {
        const int seg = u.kind & 3, rowp = wr * 64 + fr, lc = wc * 32 + 8 * fq;
#pragma unroll
        for (int ai = 0; ai < 2; ++ai)
#pragma unroll
            for (int m = 0; m < 4; ++m) { const size_t r = (size_t)u.pm * 256 + rowp + ai * 128 + m * 16;
#pragma unroll
                for (int bj = 0; bj < 2; ++bj) { const int col = 256 * u.pn + 128 * bj + lc; const bf16_t* gp = g + r * 3072 + seg * 1024 + col;
                    const u32x4 a = *(const u32x4*)gp; f32x4 f0, f1;
                    f0.x = bf_lo(a.x); f0.y = bf_hi(a.x); f0.z = bf_lo(a.y); f0.w = bf_hi(a.y); f1.x = bf_lo(a.z); f1.y = bf_hi(a.z); f1.z = bf_lo(a.w); f1.w = bf_hi(a.w);
                    if (seg < 2) { const u32x4 b = *(const u32x4*)(gp + 1024);
                        f0.x *= __builtin_amdgcn_rcpf(bf_lo(b.x)); f0.y *= __builtin_amdgcn_rcpf(bf_hi(b.x)); f0.z *= __builtin_amdgcn_rcpf(bf_lo(b.y)); f0.w *= __builtin_amdgcn_rcpf(bf_hi(b.y));
                        f1.x *= __builtin_amdgcn_rcpf(bf_lo(b.z)); f1.y *= __builtin_amdgcn_rcpf(bf_hi(b.z)); f1.z *= __builtin_amdgcn_rcpf(bf_lo(b.w)); f1.w *= __builtin_amdgcn_rcpf(bf_hi(b.w));
                        acc[ai][bj][m][0] *= f0; acc[ai][bj][m][1] *= f1; }
                    else { const f32x4 v0 = acc[ai][bj][m][0] * f0, v1 = acc[ai][bj][m][1] * f1;
                        u32x4 w; w.x = pk_bf16(v0.x, v0.y); w.y = pk_bf16(v0.z, v0.w); w.z = pk_bf16(v1.x, v1.y); w.w = pk_bf16(v1.z, v1.w);
                        *(u32x4*)(merged + r * 1024 + col) = w; } } }
    }
};

struct SchedG {
    g8::TileOrder ord; const char* A; const char* B;
    __device__ __forceinline__ bool next(int i, UnitD& u) const { int pm, pn; if (!ord.tile(i, pm, pn)) return false;
        u.A = A + (size_t)pm * 256 * 2048; u.B = B + (size_t)pn * 256 * 2048; u.nt = 16; u.pm = pm; u.pn = pn; u.kind = 0; return true; }
};
struct EpiG {
    float* o;
    __device__ __forceinline__ void operator()(f32x4 (&acc)[2][2][4][2], const UnitD& u, int wr, int wc, int fr, int fq) const {
        const int rowp = wr * 64 + fr, lc = wc * 32 + 8 * fq;
#pragma unroll
        for (int ai = 0; ai < 2; ++ai)
#pragma unroll
            for (int m = 0; m < 4; ++m) { float* p = o + ((size_t)u.pm * 256 + rowp + ai * 128 + m * 16) * 1024 + 256 * u.pn + lc;
#pragma unroll
                for (int bj = 0; bj < 2; ++bj) { *(f32x4*)(p + bj * 128) = acc[ai][bj][m][0]; *(f32x4*)(p + bj * 128 + 4) = acc[ai][bj][m][1]; } }
    }
};
typedef float f32x2v __attribute__((ext_vector_type(2)));

template <int PASS>
__device__ __forceinline__ void lru_item(const Frame& F, const Args& a, const unsigned char* ws, int l, int item, const bf16_t* xcb, bf16_t* y, float* agg) {
    const int b = item >> 5, k = item & 31; const size_t r0 = (size_t)b * SEQ + (size_t)k * 64;
    int lane_ = F.lane; asm volatile("" : "+v"(lane_));
    const int lane = lane_, cl = lane & 15, kg = lane >> 4;
    LAS unsigned char* xt = F.lds + F.wave * 16384;
    const bf16_t* lwa = (const bf16_t*)(ws + WS_LW); const bf16_t* lwx = lwa + 16 * 80 * 96;
    const float* conv_w = a.in[I_CONV_W] + (size_t)l * 4 * 1280; const float* conv_b = a.in[I_CONV_B] + l * 1280;
    const float* b_a = a.in[I_B_A] + l * 1280; const float* b_x = a.in[I_B_X] + l * 1280; const float* lam = a.in[I_LAM] + l * 1280;
#pragma unroll 1
    for (int bi = 0; bi < 2; ++bi) {
        const int blk = 2 * F.wave + bi;
        { LAS u32x4* z = (LAS u32x4*)(xt + lane * 208 + 160); z[0] = (u32x4){0u, 0u, 0u, 0u}; z[1] = (u32x4){0u, 0u, 0u, 0u}; }
#pragma unroll 1
        for (int ct = 0; ct < 5; ++ct) { const int c = blk * 80 + 16 * ct + cl;
            const float w0 = conv_w[c], w1 = conv_w[1280 + c], w2 = conv_w[2560 + c], w3 = conv_w[3840 + c], cb = conv_b[c];
#pragma unroll
            for (int rt = 0; rt < 4; ++rt) { const int t0 = 16 * rt + 4 * kg; float xv[7];
#pragma unroll
                for (int j = 0; j < 7; ++j) { const int tt = t0 - 3 + j; xv[j] = (k == 0 && tt < 0) ? 0.f : bf1(xcb[(r0 + tt) * 1280 + c]); }
#pragma unroll
                for (int e = 0; e < 4; ++e) { const float v = cb + w0 * xv[e] + w1 * xv[e + 1] + w2 * xv[e + 2] + w3 * xv[e + 3];
                    *(LAS bf16_t*)(xt + (t0 + e) * 208 + (16 * ct + cl) * 2) = f2bf(v); } } }
        LDS_WAIT(); asm volatile("" ::: "memory");
        bf16x8 af[4][3];
#pragma unroll
        for (int rt = 0; rt < 4; ++rt)
#pragma unroll
            for (int ks = 0; ks < 3; ++ks) af[rt][ks] = *(const LAS bf16x8*)(xt + (16 * rt + cl) * 208 + (32 * ks + 8 * kg) * 2);
        float totA = 1.f, totB = 0.f;
#pragma unroll 1
        for (int ct = 0; ct < 5; ++ct) { const int c = blk * 80 + 16 * ct + cl;
            f32x4 ra[4], rx[4];
#pragma unroll
            for (int rt = 0; rt < 4; ++rt) { ra[rt] = (f32x4){0.f, 0.f, 0.f, 0.f}; rx[rt] = (f32x4){0.f, 0.f, 0.f, 0.f}; }
#pragma unroll
            for (int ks = 0; ks < 3; ++ks) { const size_t wo = ((size_t)blk * 80 + 16 * ct + cl) * 96 + 32 * ks + 8 * kg;
                const bf16x8 ba = *(const bf16x8*)(lwa + wo), bx = *(const bf16x8*)(lwx + wo);
#pragma unroll
                for (int rt = 0; rt < 4; ++rt) { ra[rt] = __builtin_amdgcn_mfma_f32_16x16x32_bf16(af[rt][ks], ba, ra[rt], 0, 0, 0); rx[rt] = __builtin_amdgcn_mfma_f32_16x16x32_bf16(af[rt][ks], bx, rx[rt], 0, 0, 0); } }
            const float ba_c = b_a[c], bx_c = b_x[c]; const float sp8 = -8.f * log1pf(__expf(-lam[c]));
            float hin = 0.f;
            if (PASS == 2) { const float* ag = agg + ((size_t)b * 32 * 1280 + c) * 2;
                for (int j = 0; j < k; ++j) { const f32x2v ab = *(const f32x2v*)(ag + (size_t)j * 1280 * 2); hin = ab.x * hin + ab.y; } }
#pragma unroll
            for (int rt = 0; rt < 4; ++rt) { float av[4], bv[4];
#pragma unroll
                for (int e = 0; e < 4; ++e) { const float r = fsigmoid(ra[rt][e] + ba_c), ig = fsigmoid(rx[rt][e] + bx_c);
                    const float aa = __expf(sp8 * r); const float mult = sqrtf(fmaxf(1.f - aa * aa, 0.f));
                    const float xcv = bf1(*(const LAS bf16_t*)(xt + (16 * rt + 4 * kg + e) * 208 + (16 * ct + cl) * 2));
                    av[e] = aa; bv[e] = mult * ig * xcv; }
                float sA = av[0], sB = bv[0];
#pragma unroll
                for (int e = 1; e < 4; ++e) { sB = av[e] * sB + bv[e]; sA *= av[e]; }
                float iA = sA, iB = sB;
                { const float pA = __shfl(iA, lane - 16), pB = __shfl(iB, lane - 16); if (kg >= 1) { iB = iA * pB + iB; iA = iA * pA; } }
                { const float pA = __shfl(iA, lane - 32), pB = __shfl(iB, lane - 32); if (kg >= 2) { iB = iA * pB + iB; iA = iA * pA; } }
                const float tA = __shfl(iA, 48 + cl), tB = __shfl(iB, 48 + cl);
                if (PASS == 1) { totB = tA * totB + tB; totA *= tA; }
                else {
                    float eA = __shfl(iA, lane - 16), eB = __shfl(iB, lane - 16); if (kg == 0) { eA = 1.f; eB = 0.f; }
                    float h = eA * hin + eB;
                    bf16_t* yp = y + (r0 + 16 * rt + 4 * kg) * YLD + 2048 + c;
#pragma unroll
                    for (int e = 0; e < 4; ++e) { h = av[e] * h + bv[e]; const float z = bf1(yp[(size_t)e * YLD]); yp[(size_t)e * YLD] = f2bf(h * z); }
                    hin = tA * hin + tB;
                }
            }
            if (PASS == 1) { if (kg == 0) { *(f32x2v*)(agg + (((size_t)b * 32 + k) * 1280 + c) * 2) = (f32x2v){totA, totB}; } totA = 1.f; totB = 0.f; }
        }
        LDS_WAIT(); asm volatile("" ::: "memory");
    }
}

__device__ __forceinline__ void phaseB_extra(const Frame& F, const Args& a, const unsigned char* ws, int l, const bf16_t* misc, bf16_t* kr, const bf16_t* xc, float* agg, const float* cs, const float* sn) {
    for (int item = F.vcu; item < NBATCH * 32; item += F.G) lru_item<1>(F, a, ws, l, item, xc, nullptr, agg);
    const int gt = (F.vcu * NWAVES + F.wave) * 64 + F.lane, NGT = F.G * NWAVES * 64;
    for (int i = gt; i < T * 32; i += NGT) { const int t = i >> 5, fi = i & 31, pos = t & 2047; const float c = cs[pos * 32 + fi], s = sn[pos * 32 + fi];
        const float t1 = bf1(misc[(size_t)t * 768 + 640 + fi]), t2 = bf1(misc[(size_t)t * 768 + 672 + fi]);
        kr[(size_t)t * 64 + fi] = f2bf(t1 * c - t2 * s); kr[(size_t)t * 64 + 32 + fi] = f2bf(t2 * c + t1 * s); }
}

namespace att {
constexpr int SHM_V = 64 * 128 * 2, SHM_K = 64 * 192 * 2, OFF_K = 2 * SHM_V, OFF_WS = OFF_K + 2 * SHM_K, LDS_TOTAL = OFF_WS + 8 * 64 * 4;
constexpr float THR = 8.f;
constexpr float NEGBIG = -1e30f;
constexpr int KVBLK_ = 64;
#define ATT_SBAR() __builtin_amdgcn_sched_barrier(0)
__device__ __forceinline__ int crow(int r, int hi) { return (r & 3) + 8 * (r >> 2) + 4 * hi; }
__device__ __forceinline__ int koff(int row, int sub, int chunk) { return sub * 8192 + row * 128 + ((chunk ^ ((row >> 1) & 7)) << 4); }
__device__ __forceinline__ void partialSM(f32x16& p0, f32x16& p1, float& m_reg, float& alpha) {
    float pmax = p0[0];
#pragma unroll
    for (int r = 1; r < 16; ++r) pmax = fmaxf(pmax, p0[r]);
#pragma unroll
    for (int r = 0; r < 16; ++r) pmax = fmaxf(pmax, p1[r]);
    { auto rr = __builtin_amdgcn_permlane32_swap(__float_as_uint(pmax), __float_as_uint(pmax), false, false); pmax = fmaxf(__uint_as_float(rr[0]), __uint_as_float(rr[1])); }
    float mn;
    if (__builtin_expect(__all(pmax - m_reg <= THR), 1)) { mn = m_reg; alpha = 1.f; }
    else { mn = fmaxf(m_reg, pmax); alpha = __builtin_amdgcn_exp2f(m_reg - mn); m_reg = mn; }
#pragma unroll
    for (int r = 0; r < 16; ++r) p0[r] = __builtin_amdgcn_exp2f(p0[r] - mn);
#pragma unroll
    for (int r = 0; r < 16; ++r) p1[r] = p1[r] - mn;
}
__device__ __forceinline__ void finishSM(f32x16& p0, f32x16& p1, float alpha, float& l_reg, bf16x8& pa0, bf16x8& pa1, bf16x8& pa2, bf16x8& pa3) {
#pragma unroll
    for (int r = 0; r < 16; ++r) p1[r] = __builtin_amdgcn_exp2f(p1[r]);
    float ps = 0.f;
#pragma unroll
    for (int r = 0; r < 16; ++r) ps += p0[r];
#pragma unroll
    for (int r = 0; r < 16; ++r) ps += p1[r];
    { auto rr = __builtin_amdgcn_permlane32_swap(__float_as_uint(ps), __float_as_uint(ps), false, false); ps = __uint_as_float(rr[0]) + __uint_as_float(rr[1]); }
    l_reg = l_reg * alpha + ps;
#define ATT_PK4(P, BASE, OUT) do { unsigned a0 = pk_bf16(P[BASE + 0], P[BASE + 1]), a1 = pk_bf16(P[BASE + 2], P[BASE + 3]);   \
    unsigned b0 = pk_bf16(P[BASE + 4], P[BASE + 5]), b1 = pk_bf16(P[BASE + 6], P[BASE + 7]);                              \
    auto r0 = __builtin_amdgcn_permlane32_swap(a0, b0, false, false); auto r1 = __builtin_amdgcn_permlane32_swap(a1, b1, false, false); \
    u32x4 w = {r0[0], r1[0], r0[1], r1[1]}; OUT = __builtin_bit_cast(bf16x8, w); } while (0)
    ATT_PK4(p0, 0, pa0); ATT_PK4(p0, 8, pa1); ATT_PK4(p1, 0, pa2); ATT_PK4(p1, 8, pa3);
#undef ATT_PK4
}
__device__ __forceinline__ void qkt(f32x16& p0, f32x16& p1, const LAS unsigned char* Ks, const bf16x8* qr, int r32, int hi) {
    p0 = f32x16{}; p1 = f32x16{};
#pragma unroll
    for (int d0 = 0; d0 < 12; ++d0) { const int sub = d0 >> 2, chunk = (d0 & 3) * 2 + hi;
        const bf16x8 b0 = *(const LAS bf16x8*)(Ks + koff(r32, sub, chunk));
        const bf16x8 b1 = *(const LAS bf16x8*)(Ks + koff(32 + r32, sub, chunk));
        p0 = __builtin_amdgcn_mfma_f32_32x32x16_bf16(b0, qr[d0], p0, 0, 0, 0);
        p1 = __builtin_amdgcn_mfma_f32_32x32x16_bf16(b1, qr[d0], p1, 0, 0, 0);
        if ((d0 & 3) == 3) ATT_SBAR(); }
}
__device__ __forceinline__ int v_st(int k, int c) { const int kk = (k & ~0xC) | ((k & 4) << 1) | ((k & 8) >> 1); return ((kk >> 3) * 4 + (c >> 5)) * 512 + ((kk & 7) * 32 + (c & 31)) * 2; }
__device__ __forceinline__ int v_rd_base(int lane) { return ((lane & 3) << 3) | (((lane >> 2) & 3) << 6) | (((lane >> 4) & 1) << 5) | (((lane >> 5) & 1) << 8); }
constexpr int v_rd_off(int d0, int ks, int half) { return d0 * 512 + ks * 4096 + half * 2048; }
template <int OFF> __device__ __forceinline__ s16x4 tr_read(int vb) { s16x4 r; asm volatile("ds_read_b64_tr_b16 %0, %1 offset:%2" : "=&v"(r) : "v"(vb), "i"(OFF) : "memory"); return r; }
template <int D0> __device__ __forceinline__ void pv_one(f32x16& od, int vb, bf16x8 pa0, bf16x8 pa1, bf16x8 pa2, bf16x8 pa3) {
    const s16x4 l0 = tr_read<v_rd_off(D0, 0, 0)>(vb), h0 = tr_read<v_rd_off(D0, 0, 1)>(vb), l1 = tr_read<v_rd_off(D0, 1, 0)>(vb), h1 = tr_read<v_rd_off(D0, 1, 1)>(vb);
    const s16x4 l2 = tr_read<v_rd_off(D0, 2, 0)>(vb), h2 = tr_read<v_rd_off(D0, 2, 1)>(vb), l3 = tr_read<v_rd_off(D0, 3, 0)>(vb), h3 = tr_read<v_rd_off(D0, 3, 1)>(vb);
    asm volatile("s_waitcnt lgkmcnt(0)" ::: "memory"); ATT_SBAR();
#define ATT_PK(L, H) (bf16x8){L[0], L[1], L[2], L[3], H[0], H[1], H[2], H[3]}
    od = __builtin_amdgcn_mfma_f32_32x32x16_bf16(pa0, ATT_PK(l0, h0), od, 0, 0, 0);
    od = __builtin_amdgcn_mfma_f32_32x32x16_bf16(pa1, ATT_PK(l1, h1), od, 0, 0, 0);
    od = __builtin_amdgcn_mfma_f32_32x32x16_bf16(pa2, ATT_PK(l2, h2), od, 0, 0, 0);
    od = __builtin_amdgcn_mfma_f32_32x32x16_bf16(pa3, ATT_PK(l3, h3), od, 0, 0, 0);
#undef ATT_PK
}
__device__ __forceinline__ void pv_d0(f32x16* o, int vb, bf16x8 pa0, bf16x8 pa1, bf16x8 pa2, bf16x8 pa3) {
    pv_one<0>(o[0], vb, pa0, pa1, pa2, pa3); pv_one<1>(o[1], vb, pa0, pa1, pa2, pa3); pv_one<2>(o[2], vb, pa0, pa1, pa2, pa3); pv_one<3>(o[3], vb, pa0, pa1, pa2, pa3);
}

__device__ __forceinline__ void unit(const Frame& F, int b, int hd, int qb, const bf16_t* __restrict__ Q, bf16_t* Y, const bf16_t* __restrict__ VV, const bf16_t* __restrict__ KR) {
    int tid_ = F.tid; asm volatile("" : "+v"(tid_));
    const int tid = tid_, wid = F.wave, lane = tid & 63, r32 = lane & 31, hi = lane >> 5;
    LAS unsigned char* lds = F.lds;
    LAS unsigned char* V_lds = lds; LAS unsigned char* K_lds = lds + OFF_K;
    LAS float* wsf = (LAS float*)(lds + OFF_WS) + wid * 64; LAS float* li_l = wsf; LAS float* al_l = wsf + 32;
    const size_t rowbase = (size_t)b * SEQ; const int q0 = qb * 256; const int qc = 4 * qb + (wid >> 1); const int NT = 4 * qb + 4;
    float m_reg = NEGBIG, l_reg = 0.f; f32x16 o[4] = {}; bf16x8 qr[12];
    { const bf16_t* Qw = Q + (rowbase + q0 + wid * 32 + r32) * 1536 + hd * 192 + hi * 8;
#pragma unroll
      for (int d0 = 0; d0 < 12; ++d0) qr[d0] = *(const bf16x8*)(Qw + d0 * 16); }
    const bf16_t* Kn = Y + rowbase * YLD + hd * 128; const bf16_t* Vh = VV + rowbase * 1024 + hd * 128; const bf16_t* Kr = KR + rowbase * 64;
    const int sr = tid >> 4, sc = (tid & 15) * 8; const int vst0 = v_st(sr, sc), vst1 = v_st(32 + sr, sc);
    const int kst0 = koff(sr, sc >> 6, (sc & 63) >> 3), kst1 = koff(32 + sr, sc >> 6, (sc & 63) >> 3), kst2 = koff(tid >> 3, 2, tid & 7);
    const int vb0 = (int)(uintptr_t)V_lds + v_rd_base(lane);
    bf16x8 vs0, vs1, ks0, ks1, ks2;
#define ATT_SLOAD(k0) do { vs0 = *(const bf16x8*)(Vh + (size_t)((k0) + sr) * 1024 + sc); vs1 = *(const bf16x8*)(Vh + (size_t)((k0) + 32 + sr) * 1024 + sc); \
    ks0 = *(const bf16x8*)(Kn + (size_t)((k0) + sr) * YLD + sc); ks1 = *(const bf16x8*)(Kn + (size_t)((k0) + 32 + sr) * YLD + sc); \
    ks2 = *(const bf16x8*)(Kr + (size_t)((k0) + (tid >> 3)) * 64 + (tid & 7) * 8); } while (0)
#define ATT_SWRITE(bf) do { *(LAS bf16x8*)(V_lds + (bf) * SHM_V + vst0) = vs0; *(LAS bf16x8*)(V_lds + (bf) * SHM_V + vst1) = vs1; \
    *(LAS bf16x8*)(K_lds + (bf) * SHM_K + kst0) = ks0; *(LAS bf16x8*)(K_lds + (bf) * SHM_K + kst1) = ks1; *(LAS bf16x8*)(K_lds + (bf) * SHM_K + kst2) = ks2; } while (0)
#define ATT_RESC(al) do { if (__any((al) < 1.f)) { if (hi == 0) al_l[r32] = (al); asm volatile("s_waitcnt lgkmcnt(0)" ::: "memory"); \
    _Pragma("unroll") for (int d = 0; d < 4; ++d) _Pragma("unroll") for (int r = 0; r < 16; ++r) o[d][r] *= al_l[crow(r, hi)]; } } while (0)
#define ATT_QKT(P0, P1, bf, jt) do { if ((jt) <= qc) qkt(P0, P1, K_lds + (bf) * SHM_K, qr, r32, hi); else { _Pragma("unroll") for (int r = 0; r < 16; ++r) { P0[r] = NEGBIG; P1[r] = NEGBIG; } } } while (0)
    f32x16 pA0, pA1, pB0, pB1; float alA, alB; bf16x8 pa0, pa1, pa2, pa3;
    ATT_SLOAD(0); asm volatile("s_waitcnt vmcnt(0)" ::: "memory"); ATT_SWRITE(0); __syncthreads();
    ATT_QKT(pA0, pA1, 0, 0); partialSM(pA0, pA1, m_reg, alA);
    ATT_SLOAD(KVBLK_); asm volatile("s_waitcnt vmcnt(0)" ::: "memory"); ATT_SWRITE(1); __syncthreads();
    for (int j = 1; j + 1 < NT; j += 2) {
        ATT_SBAR(); ATT_QKT(pB0, pB1, 1, j);
        finishSM(pA0, pA1, alA, l_reg, pa0, pa1, pa2, pa3); ATT_SBAR();
        ATT_SLOAD((j + 1) * KVBLK_); ATT_SBAR();
        pv_d0(o, vb0, pa0, pa1, pa2, pa3); partialSM(pB0, pB1, m_reg, alB);
        __syncthreads(); asm volatile("s_waitcnt vmcnt(0)" ::: "memory"); ATT_SWRITE(0);
        ATT_RESC(alB); __syncthreads();
        ATT_SBAR(); ATT_QKT(pA0, pA1, 0, j + 1);
        finishSM(pB0, pB1, alB, l_reg, pa0, pa1, pa2, pa3); ATT_SBAR();
        ATT_SLOAD((j + 2) * KVBLK_); ATT_SBAR();
        pv_d0(o, vb0 + SHM_V, pa0, pa1, pa2, pa3); partialSM(pA0, pA1, m_reg, alA);
        __syncthreads(); asm volatile("s_waitcnt vmcnt(0)" ::: "memory"); ATT_SWRITE(1);
        ATT_RESC(alA); __syncthreads();
    }
    ATT_SBAR(); ATT_QKT(pB0, pB1, 1, NT - 1);
    finishSM(pA0, pA1, alA, l_reg, pa0, pa1, pa2, pa3); ATT_SBAR();
    pv_d0(o, vb0, pa0, pa1, pa2, pa3); partialSM(pB0, pB1, m_reg, alB);
    __syncthreads(); ATT_RESC(alB);
    finishSM(pB0, pB1, alB, l_reg, pa0, pa1, pa2, pa3); ATT_SBAR();
    pv_d0(o, vb0 + SHM_V, pa0, pa1, pa2, pa3);
    if (hi == 0) li_l[r32] = l_reg; asm volatile("s_waitcnt lgkmcnt(0)" ::: "memory");
    float rli[16];
#pragma unroll
    for (int r = 0; r < 16; ++r) rli[r] = __builtin_amdgcn_rcpf(li_l[crow(r, hi)]);
    bf16_t* Ow = Y + (rowbase + q0 + wid * 32) * YLD + 1024 + hd * 128;
    int hi2 = hi, r32b = r32; asm volatile("" : "+v"(hi2), "+v"(r32b));
    const unsigned eoff = (unsigned)(4 * hi2 * YLD + r32b);
#pragma unroll
    for (int r = 0; r < 16; ++r) { const unsigned ro = eoff + (unsigned)(((r & 3) + 8 * (r >> 2)) * YLD);
#pragma unroll
        for (int d0 = 0; d0 < 4; ++d0) { bf16_t* p = Ow + (ro + d0 * 32); *p = f2bf(o[d0][r] * rli[r] * bf1(*p)); } }
    __syncthreads();
#undef ATT_SLOAD
#undef ATT_SWRITE
#undef ATT_RESC
#undef ATT_QKT
}
}

__device__ __forceinline__ void phaseC(const Frame& F, const Args& a, const unsigned char* ws, int l, const bf16_t* q, bf16_t* y, const bf16_t* vv, const bf16_t* kr, const bf16_t* xc, const float* agg) {
    for (int v = F.vcu; v < 256; v += F.G) { const int bh = v >> 2, s = v & 3;
        att::unit(F, bh >> 3, bh & 7, 7 - s, q, y, vv, kr);
        att::unit(F, bh >> 3, bh & 7, s, q, y, vv, kr); }
    for (int item = F.vcu; item < NBATCH * 32; item += F.G) lru_item<2>(F, a, ws, l, item, xc, y, const_cast<float*>(agg));
}

__device__ __forceinline__ void gmlp_item(const Frame& F, const Args& a, const unsigned char* ws, int l, int item, const bf16_t* v1, bf16_t* y) {
    const int nb = item >> 2, g = item & 3; const size_t t0 = (size_t)nb * 128;
    int lane_ = F.lane; asm volatile("" : "+v"(lane_));
    const int lane = lane_, w = F.wave, cl = lane & 15, kg = lane >> 4;
    LAS f32x2v* stat = (LAS f32x2v*)F.lds; LAS unsigned char* vnT = F.lds + 1024;
#pragma unroll 1
    for (int i = 0; i < 16; ++i) { const int tok = 16 * w + i; const u32x4* p = (const u32x4*)(v1 + (t0 + tok) * 1024 + lane * 16);
        const u32x4 x0 = p[0], x1 = p[1]; float s = 0.f, ss = 0.f;
#define GM_ACC(wd) do { const float f0 = bf_lo(wd), f1 = bf_hi(wd); s += f0 + f1; ss += f0 * f0 + f1 * f1; } while (0)
        GM_ACC(x0.x); GM_ACC(x0.y); GM_ACC(x0.z); GM_ACC(x0.w); GM_ACC(x1.x); GM_ACC(x1.y); GM_ACC(x1.z); GM_ACC(x1.w);
#undef GM_ACC
        s = wave_sum(s); ss = wave_sum(ss);
        const float mu = s * (1.f / 1024.f); const float var = fmaxf(ss * (1.f / 1024.f) - mu * mu, 0.f);
        if (lane == 0) stat[tok] = (f32x2v){mu, rsqrtf(var + EPS)}; }
    LDS_WAIT(); __syncthreads();
    { const f32x2v st0 = stat[2 * lane], st1 = stat[2 * lane + 1];
      const float* lg = a.in[I_GM_LN_G] + l * 1024 + g * 256; const float* lb = a.in[I_GM_LN_B] + l * 1024 + g * 256;
#pragma unroll 1
      for (int i = 0; i < 4; ++i) { const int c8 = 4 * w + i;
          const u32x4 xa = *(const u32x4*)(v1 + (t0 + 2 * lane) * 1024 + g * 256 + c8 * 8), xb = *(const u32x4*)(v1 + (t0 + 2 * lane + 1) * 1024 + g * 256 + c8 * 8);
          const unsigned wa[4] = {xa.x, xa.y, xa.z, xa.w}, wb[4] = {xb.x, xb.y, xb.z, xb.w};
#pragma unroll
          for (int e = 0; e < 8; ++e) { const float ga = lg[c8 * 8 + e], be = lb[c8 * 8 + e];
              const float fa = (e & 1) ? bf_hi(wa[e >> 1]) : bf_lo(wa[e >> 1]), fb = (e & 1) ? bf_hi(wb[e >> 1]) : bf_lo(wb[e >> 1]);
              const float na = (fa - st0.x) * st0.y * ga + be, nbv = (fb - st1.x) * st1.y * ga + be;
              *(LAS unsigned*)(vnT + (c8 * 8 + e) * 272 + lane * 4) = pk_bf16(na, nbv); } } }
    LDS_WAIT(); __syncthreads();
    bf16x8 af[2][4];
#pragma unroll
    for (int r = 0; r < 2; ++r)
#pragma unroll
        for (int ks = 0; ks < 4; ++ks) af[r][ks] = *(const LAS bf16x8*)(vnT + (16 * (2 * w + r) + cl) * 272 + (32 * ks + 8 * kg) * 2);
    const bf16_t* gmw = (const bf16_t*)(ws + WS_GMW) + (size_t)g * 128 * 128;
    const float* bs = a.in[I_GM_BS] + l * 512 + g * 128;
#pragma unroll 1
    for (int ct = 0; ct < 8; ++ct) {
        f32x4 acc[2] = {(f32x4){0.f, 0.f, 0.f, 0.f}, (f32x4){0.f, 0.f, 0.f, 0.f}};
        const int nks = (ct < 4) ? 2 : 4;
#pragma unroll
        for (int ks = 0; ks < 4; ++ks) if (ks < nks) { const bf16x8 bfr = *(const bf16x8*)(gmw + (size_t)(16 * ct + cl) * 128 + 32 * ks + 8 * kg);
            acc[0] = __builtin_amdgcn_mfma_f32_16x16x32_bf16(af[0][ks], bfr, acc[0], 0, 0, 0); acc[1] = __builtin_amdgcn_mfma_f32_16x16x32_bf16(af[1][ks], bfr, acc[1], 0, 0, 0); }
        const float bsv = bs[16 * ct + cl];
#pragma unroll
        for (int r = 0; r < 2; ++r) { bf16_t* p = y + (t0 + 16 * ct + cl) * YLD + g * 256 + 16 * (2 * w + r) + 4 * kg;
            const u32x2 pa = *(const u32x2*)p; u32x2 o;
            o.x = pk_bf16(bf_lo(pa.x) * (acc[r][0] + bsv), bf_hi(pa.x) * (acc[r][1] + bsv)); o.y = pk_bf16(bf_lo(pa.y) * (acc[r][2] + bsv), bf_hi(pa.y) * (acc[r][3] + bsv));
            *(u32x2*)p = o; }
    }
    __syncthreads();
}
__device__ __forceinline__ void phaseE(const Frame& F, const Args& a, const unsigned char* ws, int l, const bf16_t* v1, bf16_t* y) {
    for (int item = F.vcu; item < 512; item += F.G) gmlp_item(F, a, ws, l, item, v1, y);
}
constexpr int N_PHASES = 1 + 8 * DEPTH;
#ifndef MK_MAX_PHASE
#define MK_MAX_PHASE N_PHASES
#endif

__global__ void __launch_bounds__(NWAVES * 64, 2) mk_fwd(Args args) {
    extern __shared__ __attribute__((aligned(16))) unsigned char lds_raw[];
    Frame F;
    F.lds = (LAS unsigned char*)lds_raw;
    F.tid = threadIdx.x; F.lane = F.tid & 63; F.wave = __builtin_amdgcn_readfirstlane((int)threadIdx.x >> 6);
    F.G = gridDim.x; { const int bx = blockIdx.x; F.vcu = (F.G % 8 == 0) ? (bx % 8) * (F.G / 8) + bx / 8 : bx; }
    volatile LAS unsigned* MISCW = (volatile LAS unsigned*)(F.lds + MISC_OFF);
    for (int u = F.tid; u < (LDS_BYTES - RING_BYTES) / 4; u += NWAVES * 64) ((LAS unsigned*)(F.lds + RING_BYTES))[u] = 0u;
    __syncthreads();
    unsigned* ctl = (unsigned*)(args.ws + WS_CTL); F.tid = 0; F.lane = 0;
    const int lo = args.ph_lo, hi = args.ph_hi;
    const bool multi = (hi - lo) > 1;
    XcdBarrier bar; bar.bar = ctl + CW_BAR; bar.x = 0; bar.st = nullptr;
    if (multi) bar = xcd_barrier_post(ctl + CW_BAR, MISCW + 8);
#define IN(k) (lo <= (k) && (k) < hi)
#define SEAM(k) do { if (IN((k) + 1)) xcd_barrier(bar); } while (0)

typedef const __attribute__((address_space(4))) Args* KArgP;
#define PHASE_PTRS \
    KArgP kp = (KArgP)__builtin_amdgcn_kernarg_segment_ptr(); asm volatile("" : "+s"(kp)); Args la; \
    _Pragma("unroll") for (int i_ = 0; i_ < N_INPUTS; ++i_) la.in[i_] = kp->in[i_]; la.out = kp->out; la.ws = kp->ws; la.ph_lo = 0; la.ph_hi = 0; \
    unsigned char* ws = la.ws; asm volatile("" : "+s"(ws)); Frame Fp = F; asm volatile("" : "+s"(Fp.wave), "+s"(Fp.vcu)); \
    Fp.lane = (int)__builtin_amdgcn_mbcnt_hi(~0u, __builtin_amdgcn_mbcnt_lo(~0u, 0u)); Fp.tid = Fp.wave * 64 + Fp.lane; \
    bf16_t* Hb = (bf16_t*)(ws + WS_H); bf16_t* Yb = (bf16_t*)(ws + WS_Y); \
    bf16_t* MISCb = (bf16_t*)(ws + WS_MISC); bf16_t* XCb = (bf16_t*)(ws + WS_XC); bf16_t* Qb = (bf16_t*)(ws + WS_Q); bf16_t* VVb = (bf16_t*)(ws + WS_VV); bf16_t* KRb = (bf16_t*)(ws + WS_KR); \
    bf16_t* V1b = (bf16_t*)(ws + WS_V1); bf16_t* Gb = (bf16_t*)(ws + WS_G); float* Ob = (float*)(ws + WS_O); \
    float* SLAB = (float*)(ws + WS_SLAB); float* AGG = (float*)(ws + WS_AGG); const float* CS = (const float*)(ws + WS_ROPE); const float* SN = CS + 2048 * 32; \
    const unsigned char* wb = ws + WS_WB; (void)Hb; (void)Yb; (void)MISCb; (void)XCb; (void)Qb; (void)VVb; (void)KRb; (void)V1b; (void)Gb; (void)Ob; (void)SLAB; (void)AGG; (void)CS; (void)SN; (void)wb;
    if (IN(0)) { PHASE_PTRS
        convert_weights(Fp, la, ws, 0);
        rope_table(Fp, ws);
        norm_rows(Fp, la.in[I_X], nullptr, nullptr, nullptr, la.in[I_PRE_G], Hb);
        SEAM(0);
    }
#pragma nounroll
    for (int l = 0; l < DEPTH; ++l) {
        const int pb = 1 + 8 * l;
        if (IN(pb + 0) && pb + 0 < MK_MAX_PHASE) {
            PHASE_PTRS
            SchedA S; S.ord.init(64, 17, Fp.G, (int)blockIdx.x); S.A = (const char*)Hb; S.B = (const char*)(wb + WB_W1T);
            EpiA E{MISCb, XCb, Yb, SLAB};
            g8::gemm_stream(Fp.lds, Fp.tid, 2048u, 2048u, S, E);
            SEAM(pb + 0);
        }
        if (IN(pb + 1) && pb + 1 < MK_MAX_PHASE) {
            PHASE_PTRS
            SchedQKV S; S.ord.init(64, 14, Fp.G, (int)blockIdx.x); S.misc = (const char*)MISCb; S.wq = (const char*)(wb + WB_WQT); S.wkv = (const char*)(wb + WB_WKVT);
            EpiQKV E{Qb, Yb, VVb, SLAB, CS, SN};
            g8::gemm_stream(Fp.lds, Fp.tid, 1536u, 768u, S, E);
            phaseB_extra(Fp, la, ws, l, MISCb, KRb, XCb, AGG, CS, SN);
            SEAM(pb + 1);
        }
        if (IN(pb + 2) && pb + 2 < MK_MAX_PHASE) {
            PHASE_PTRS
            phaseC(Fp, la, ws, l, Qb, Yb, VVb, KRb, XCb, AGG);
            SEAM(pb + 2);
        }
        if (IN(pb + 3) && pb + 3 < MK_MAX_PHASE) {
            PHASE_PTRS
            SchedD S; S.ord.init(64, 24, Fp.G, (int)blockIdx.x); S.A = (const char*)Hb; S.B = (const char*)(wb + WB_W2T);
            EpiD E{Yb, V1b, Gb};
            g8::gemm_stream(Fp.lds, Fp.tid, 2048u, 2048u, S, E);
            SEAM(pb + 3);
        }
        if (IN(pb + 4) && pb + 4 < MK_MAX_PHASE) {
            PHASE_PTRS
            phaseE(Fp, la, ws, l, V1b, Yb);
            SEAM(pb + 4);
        }
        if (IN(pb + 5) && pb + 5 < MK_MAX_PHASE) {
            PHASE_PTRS
            SchedF S; S.ord.init(64, 4, Fp.G, (int)blockIdx.x); S.A = (const char*)Yb; S.B = (const char*)(wb + WB_WPT);
            EpiF E{Gb, Hb};
            g8::gemm_stream(Fp.lds, Fp.tid, (unsigned)(YLD * 2), (unsigned)(YLD * 2), S, E);
            SEAM(pb + 5);
        }
        if (IN(pb + 6) && pb + 6 < MK_MAX_PHASE) {
            PHASE_PTRS
            SchedG S; S.ord.init(64, 4, Fp.G, (int)blockIdx.x); S.A = (const char*)Hb; S.B = (const char*)(wb + WB_WOT);
            EpiG E{Ob};
            g8::gemm_stream(Fp.lds, Fp.tid, 2048u, 2048u, S, E);
            SEAM(pb + 6);
        }
        if (IN(pb + 7) && pb + 7 < MK_MAX_PHASE) {
            PHASE_PTRS
            const float* xin = (l == 0) ? la.in[I_X] : la.out;
            norm_rows(Fp, xin, Ob, la.in[I_POST_G] + l * DM, la.out, (l + 1 < DEPTH) ? la.in[I_PRE_G] + (l + 1) * DM : nullptr, Hb);
            if (l + 1 < DEPTH) convert_weights(Fp, la, ws, l + 1);
            SEAM(pb + 7);
        }
    }
#undef IN
#undef SEAM
}

#ifndef MK_PER_PHASE
#define MK_PER_PHASE 0
#endif
static int mk_setup(size_t ws_size) {
    static int grid = 0;
    if (grid == 0) {
        if (ws_size < WS_END) { fprintf(stderr, "kernel_launch: workspace too small: %zu < %zu\n", ws_size, (size_t)WS_END); grid = -1; return grid; }
        int dev = 0, cus = 0, per_cu = 0;
        if (hipGetDevice(&dev) != hipSuccess || hipDeviceGetAttribute(&cus, hipDeviceAttributeMultiprocessorCount, dev) != hipSuccess) { grid = -1; return grid; }
        if (hipFuncSetAttribute((const void*)mk_fwd, hipFuncAttributeMaxDynamicSharedMemorySize, LDS_BYTES) != hipSuccess) { fprintf(stderr, "kernel_launch: hipFuncSetAttribute failed\n"); grid = -1; return grid; }
        if (hipOccupancyMaxActiveBlocksPerMultiprocessor(&per_cu, (const void*)mk_fwd, NWAVES * 64, LDS_BYTES) != hipSuccess || per_cu < 1)
            fprintf(stderr, "kernel_launch: occupancy query reports %d blocks/CU\n", per_cu);
        (void)hipGetLastError();
        grid = cus;
        if (grid != 256) fprintf(stderr, "kernel_launch: note: %d CUs (tile schedules assume 256)\n", grid);
    }
    return grid;
}
static void mk_launch(void* const* d_in, void* d_out, void* d_ws, hipStream_t stream, int grid, int lo, int hi) {
    Args a{};
    for (int i = 0; i < N_INPUTS; ++i) a.in[i] = (const float*)d_in[i];
    a.out = (float*)d_out; a.ws = (unsigned char*)d_ws; a.ph_lo = lo; a.ph_hi = hi;
    hipLaunchKernelGGL(mk_fwd, dim3(grid), dim3(NWAVES * 64), LDS_BYTES, stream, a);
}
extern "C" void kernel_launch(void* const* d_in, const int* in_sizes, int n_in, void* d_out, int out_size, void* d_ws, size_t ws_size, hipStream_t stream) {
    const int grid = mk_setup(ws_size); if (grid < 0) return;
    hipMemsetAsync((char*)d_ws + WS_CTL, 0, CTL_ZERO_BYTES, stream);
#if MK_PER_PHASE
    for (int ph = 0; ph < N_PHASES; ++ph) mk_launch(d_in, d_out, d_ws, stream, grid, ph, ph + 1);
#else
    mk_launch(d_in, d_out, d_ws, stream, grid, 0, N_PHASES);
#endif
}
```

```cpp
#define MK_PROBE 0
#include <hip/hip_runtime.h>
#include <cstdio>
#include <cstdint>

#define LAS __attribute__((address_space(3)))
#define GAS __attribute__((address_space(1)))
typedef unsigned short bf16_t;
typedef short bf16x8 __attribute__((ext_vector_type(8)));
typedef short s16x4 __attribute__((ext_vector_type(4)));
typedef float f32x2 __attribute__((ext_vector_type(2)));
typedef float f32x4 __attribute__((ext_vector_type(4)));
typedef float f32x16 __attribute__((ext_vector_type(16)));
typedef unsigned u32x2 __attribute__((ext_vector_type(2)));
typedef unsigned u32x4 __attribute__((ext_vector_type(4)));
typedef __bf16 bf16x2_t __attribute__((ext_vector_type(2)));

__device__ __forceinline__ unsigned pk_bf16(float lo, float hi) { f32x2 v = {lo, hi}; bf16x2_t b = __builtin_convertvector(v, bf16x2_t); return __builtin_bit_cast(unsigned, b); }
__device__ __forceinline__ float bf_lo(unsigned w) { return __uint_as_float(w << 16); }
__device__ __forceinline__ float bf_hi(unsigned w) { return __uint_as_float(w & 0xffff0000u); }
__device__ __forceinline__ float bf1(bf16_t h) { return __uint_as_float(((unsigned)h) << 16); }
__device__ __forceinline__ bf16_t f2bf(float f) { return (bf16_t)(pk_bf16(f, 0.f) & 0xffffu); }
__device__ __forceinline__ float fsigmoid(float x) { return __builtin_amdgcn_rcpf(1.f + __expf(-x)); }
__device__ __forceinline__ float fsilu(float x) { return x * __builtin_amdgcn_rcpf(1.f + __expf(-x)); }
template <int XM> __device__ __forceinline__ float sx(float v) { return __int_as_float(__builtin_amdgcn_ds_swizzle(__float_as_int(v), (XM << 10) | 0x1f)); }
__device__ __forceinline__ float xsum32(float v) { auto rr = __builtin_amdgcn_permlane32_swap(__float_as_uint(v), __float_as_uint(v), false, false); return __uint_as_float(rr[0]) + __uint_as_float(rr[1]); }
__device__ __forceinline__ float wave_sum(float v) { v += sx<1>(v); v += sx<2>(v); v += sx<4>(v); v += sx<8>(v); v += sx<16>(v); return xsum32(v); }
#define LDS_WAIT() asm volatile("s_waitcnt lgkmcnt(0)" ::: "memory")
#define VM_WAIT() asm volatile("s_waitcnt vmcnt(0)" ::: "memory")

namespace g8 {
constexpr int BM = 256, BK = 64, HALF = 128, HTB = HALF * BK * 2, STAGE_BYTES = 8 * HTB, NXCD = 8, WGM = 8;
__host__ __device__ __forceinline__ int lds_byte(int r, int c) { const int st = (r >> 4) * 2 + (c >> 5), rr = r & 15, cc = c & 31, ob = rr * 64 + cc * 2; return st * 1024 + (ob ^ (((ob >> 9) & 1) << 5)); }
__host__ __device__ __forceinline__ void stage_rc(int b, int& R, int& C) { const int st = b / 1024, sb = b % 1024, swz = sb ^ (((sb >> 9) & 1) << 5); R = (st >> 1) * 16 + swz / 64; C = (st & 1) * 32 + (swz % 64) / 2; }
__host__ __device__ __forceinline__ int perm32(int rho) { const int n = rho >> 4, i = rho & 15; return 8 * (i >> 2) + 4 * n + (i & 3); }

struct UnitD { const char* A; const char* B; int nt, pm, pn, kind; };
constexpr int KEEP_ACC = 0x100;

struct TileOrder {
    int nM, nN, nwg, G, c;
    __device__ void init(int nM_, int nN_, int G_, int c_) { nM = nM_; nN = nN_; nwg = nM * nN; G = G_; c = c_; }
    __device__ bool tile(int i, int& pm, int& pn) const {
        const long L = (long)i * G + c; if (L >= nwg) return false;
        int wgid = (int)L; { const int q = nwg / NXCD, r = nwg % NXCD, xcd = wgid % NXCD, off = wgid / NXCD; wgid = (xcd < r ? xcd * (q + 1) : r * (q + 1) + (xcd - r) * q) + off; }
        const int nig = WGM * nN, gid = wgid / nig, fm = gid * WGM, gsz = (nM - fm) < WGM ? (nM - fm) : WGM;
        pm = fm + ((wgid % nig) % gsz); pn = (wgid % nig) / gsz; return true;
    }
};

template <class Sched, class Epi>
__device__ __forceinline__ void gemm_stream(LAS unsigned char* lds, int tid_in, const unsigned lda, const unsigned ldb, const Sched& S, const Epi& E) {
    int tid_ = tid_in; asm volatile("" : "+v"(tid_));
    const int tid = tid_, wid = __builtin_amdgcn_readfirstlane(tid >> 6), lane = tid & 63, wr = wid >> 2, wc = wid & 3, fr = lane & 15, fq = lane >> 4;
    unsigned voffA[2], voffB[2];
#pragma unroll
    for (int i = 0; i < 2; ++i) { int R, C; stage_rc(tid * 16 + i * 8192, R, C); const int Rb = (R & ~31) + perm32(R & 31);
        voffA[i] = (unsigned)R * lda + (unsigned)C * 2u; voffB[i] = (unsigned)Rb * ldb + (unsigned)C * 2u; }
    const size_t kstep = (size_t)(BK * 2);
    const size_t hstepA = (size_t)HALF * lda, hstepB = (size_t)HALF * ldb;
    const unsigned ldsw = (unsigned)wid * 1024u;
    const int aoff = lds_byte(wr * 64 + fr, fq * 8), boff = lds_byte(wc * 32 + fr, fq * 8);
#define G8_SA(b, h) (((b) * 2 + (h)) * HTB)
#define G8_SB(b, h) ((4 + (b) * 2 + (h)) * HTB)
#define G8_STAGE(bufoff, gbase, voff) do { _Pragma("unroll") for (int _i = 0; _i < 2; ++_i) \
        __builtin_amdgcn_global_load_lds((const unsigned*)((const char*)(gbase) + (voff)[_i]), (LAS unsigned*)(lds + (bufoff) + ldsw + _i * 8192), 16, 0, 0); } while (0)
#define G8_LDA(dst, b, h) do { _Pragma("unroll") for (int m = 0; m < 4; ++m) _Pragma("unroll") for (int k = 0; k < 2; ++k) dst[m][k] = *(const LAS bf16x8*)(lds + G8_SA(b, h) + aoff + m * 2048 + k * 1024); } while (0)
#define G8_LDB(dst, b, h) do { _Pragma("unroll") for (int n = 0; n < 2; ++n) _Pragma("unroll") for (int k = 0; k < 2; ++k) dst[n][k] = *(const LAS bf16x8*)(lds + G8_SB(b, h) + boff + n * 2048 + k * 1024); } while (0)
#define G8_MMA(ai, bj, At, Bt) do { __builtin_amdgcn_s_setprio(1); _Pragma("unroll") for (int m = 0; m < 4; ++m) _Pragma("unroll") for (int n = 0; n < 2; ++n) _Pragma("unroll") for (int k = 0; k < 2; ++k) \
        acc[ai][bj][m][n] = __builtin_amdgcn_mfma_f32_16x16x32_bf16(Bt[n][k], At[m][k], acc[ai][bj][m][n], 0, 0, 0); __builtin_amdgcn_s_setprio(0); } while (0)
#define G8_WAIT_V(n) asm volatile("s_waitcnt vmcnt(" #n ")" ::: "memory")
#define G8_WAIT_L(n) asm volatile("s_waitcnt lgkmcnt(" #n ")" ::: "memory")
#define G8_BAR __builtin_amdgcn_s_barrier()
#define G8_SCHED __builtin_amdgcn_sched_barrier(0)
    UnitD cur, nxt; int ui = 0;
    if (!S.next(0, cur)) return;
    f32x4 acc[2][2][4][2];
#pragma unroll
    for (int a = 0; a < 2; ++a)
#pragma unroll
        for (int b = 0; b < 2; ++b)
#pragma unroll
            for (int m = 0; m < 4; ++m)
#pragma unroll
                for (int n = 0; n < 2; ++n) acc[a][b][m][n] = (f32x4){0.f, 0.f, 0.f, 0.f};
    bf16x8 At[4][2], B0[2][2], B1[2][2];
    const char* cA = cur.A; const char* cB = cur.B;
    G8_STAGE(G8_SB(0, 0), cB, voffB); G8_STAGE(G8_SB(0, 1), cB + hstepB, voffB); G8_STAGE(G8_SA(0, 0), cA, voffA); G8_STAGE(G8_SA(0, 1), cA + hstepA, voffA);
    if (wr == 1) G8_BAR;
    G8_WAIT_V(2); G8_BAR;
    G8_STAGE(G8_SB(1, 0), cB + kstep, voffB); G8_STAGE(G8_SA(1, 0), cA + kstep, voffA); G8_STAGE(G8_SB(1, 1), cB + hstepB + kstep, voffB);
    G8_WAIT_V(6); G8_BAR;
    for (;;) {
        const bool has_next = S.next(ui + 1, nxt);
        const char* nA = has_next ? nxt.A : cA; const char* nB = has_next ? nxt.B : cB;
        const int nt = cur.nt;
        for (int t = 0; t < nt; t += 2) {
            const bool last = (t == nt - 2);
            const char* a1 = cA + (size_t)(t + 1) * kstep;
            const char* a2 = last ? nA : cA + (size_t)(t + 2) * kstep; const char* b2 = last ? nB : cB + (size_t)(t + 2) * kstep;
            const char* a3 = a2 + kstep; const char* b3 = b2 + kstep;
            G8_LDB(B0, 0, 0); G8_LDB(B1, 0, 1); G8_SCHED; G8_LDA(At, 0, 0); G8_STAGE(G8_SA(1, 1), a1 + hstepA, voffA);
            G8_WAIT_V(8); G8_WAIT_L(0); G8_BAR; G8_MMA(0, 0, At, B0); G8_MMA(0, 1, At, B1); G8_BAR; G8_SCHED;
            G8_LDA(At, 0, 1); G8_STAGE(G8_SB(0, 0), b2, voffB); G8_STAGE(G8_SB(0, 1), b2 + hstepB, voffB); G8_STAGE(G8_SA(0, 0), a2, voffA);
            G8_WAIT_V(8); G8_WAIT_L(0); G8_BAR; G8_MMA(1, 0, At, B0); G8_MMA(1, 1, At, B1); G8_BAR; G8_SCHED;
            G8_LDB(B0, 1, 0); G8_LDB(B1, 1, 1); G8_SCHED; G8_LDA(At, 1, 0); G8_STAGE(G8_SA(0, 1), a2 + hstepA, voffA);
            G8_WAIT_V(8); G8_WAIT_L(0); G8_BAR; G8_MMA(0, 0, At, B0); G8_MMA(0, 1, At, B1); G8_BAR; G8_SCHED;
            G8_LDA(At, 1, 1); G8_STAGE(G8_SB(1, 0), b3, voffB); G8_STAGE(G8_SB(1, 1), b3 + hstepB, voffB); G8_STAGE(G8_SA(1, 0), a3, voffA);
            G8_WAIT_V(8); G8_WAIT_L(0); G8_BAR; G8_MMA(1, 0, At, B0); G8_MMA(1, 1, At, B1); G8_BAR; G8_SCHED;
        }
        if (wr == 0) G8_BAR;
        { UnitD eu = cur; int fr_ = fr, fq_ = fq; asm volatile("" : "+s"(eu.pm), "+s"(eu.pn), "+v"(fr_), "+v"(fq_)); E(acc, eu, wr, wc, fr_, fq_); }
        if (!has_next) break;
        if (!(cur.kind & KEEP_ACC)) {
#pragma unroll
            for (int a = 0; a < 2; ++a)
#pragma unroll
                for (int b = 0; b < 2; ++b)
#pragma unroll
                    for (int m = 0; m < 4; ++m)
#pragma unroll
                        for (int n = 0; n < 2; ++n) acc[a][b][m][n] = (f32x4){0.f, 0.f, 0.f, 0.f};
        }
        cur = nxt; cA = nA; cB = nB; ++ui;
        if (wr == 1) G8_BAR;
    }
    G8_WAIT_V(0);
    G8_BAR;
#undef G8_SA
#undef G8_SB
#undef G8_STAGE
#undef G8_LDA
#undef G8_LDB
#undef G8_MMA
#undef G8_WAIT_V
#undef G8_WAIT_L
#undef G8_BAR
#undef G8_SCHED
}
}

#define XB_TMO      128
#define XB_XCNT(j)  (256  + 64 * (j))
#define XB_XSUB(j)  (1280 + 64 * (j))
#define XB_XGEN(j)  (2304 + 64 * (j))
#define XB_TOP      3328
#define XB_TOPGEN   3392
#define XCD_BAR_WORDS 3456
#define XB_SPIN_CAP (1u << 18)
__device__ __forceinline__ unsigned xb_ld(unsigned* p)              { return __hip_atomic_load(p, __ATOMIC_RELAXED, __HIP_MEMORY_SCOPE_AGENT); }
__device__ __forceinline__ unsigned xb_add(unsigned* p, unsigned v) { return __hip_atomic_fetch_add(p, v, __ATOMIC_RELAXED, __HIP_MEMORY_SCOPE_AGENT); }
__device__ __forceinline__ unsigned xb_xcc_id() { return (unsigned)__builtin_amdgcn_s_getreg((3 << 11) | 20) & 0xFu; }
#define XB_SPIN(cond, bar) do { unsigned _sp = 0; while (cond) { __builtin_amdgcn_s_sleep(1); \
    if ((++_sp & 255u) == 0u) { if (xb_ld(&(bar)[XB_TMO])) break; if (_sp > XB_SPIN_CAP) { atomicAdd(&(bar)[XB_TMO], 1u); break; } } } } while (0)
struct XcdBarrier { unsigned* bar; unsigned x; volatile LAS unsigned* st; };
__device__ __forceinline__ XcdBarrier xcd_barrier_post(unsigned* bar, volatile LAS unsigned* st) {
    XcdBarrier b; b.bar = bar; b.x = xb_xcc_id(); b.st = st;
    if (threadIdx.x == 0) (void)xb_add(&bar[XB_XCNT(b.x)], 1u);
    return b;
}
__device__ __forceinline__ void xcd_barrier_complete(unsigned* bar, unsigned x, unsigned& nloc, unsigned& nx) {
    const unsigned G = gridDim.x * gridDim.y * gridDim.z;
    unsigned sum, cnt, mine, sp = 0u;
    for (;;) {
        sum = 0u; cnt = 0u; mine = 0u;
#pragma unroll
        for (unsigned j = 0; j < 16; ++j) { const unsigned c = xb_ld(&bar[XB_XCNT(j)]); sum += c; cnt += (c > 0u) ? 1u : 0u; mine = (j == x) ? c : mine; }
        if (sum == G) break;
        __builtin_amdgcn_s_sleep(1);
        if ((++sp & 255u) == 0u) { if (xb_ld(&bar[XB_TMO])) break; if (sp > XB_SPIN_CAP) { atomicAdd(&bar[XB_TMO], 1u); break; } }
    }
    nloc = mine > 0u ? mine : 1u; nx = cnt > 0u ? cnt : 1u;
}
__device__ __forceinline__ void xcd_barrier(const XcdBarrier& b) {
    asm volatile("s_waitcnt vmcnt(0)" ::: "memory");
    __syncthreads();
    if (threadIdx.x == 0) {
        unsigned* bar = b.bar;
        __builtin_amdgcn_s_waitcnt(0);
        unsigned nloc = b.st[0], nx = b.st[1];
        if (nloc == 0u) { xcd_barrier_complete(bar, b.x, nloc, nx); b.st[0] = nloc; b.st[1] = nx; }
        const unsigned old = xb_add(&bar[XB_XSUB(b.x)], 1u);
        const unsigned gen = old / nloc;
        if (old + 1u == (gen + 1u) * nloc) {
            __builtin_amdgcn_fence(__ATOMIC_RELEASE, "agent");
            asm volatile("s_waitcnt vmcnt(0)" ::: "memory");
            const unsigned og = xb_add(&bar[XB_TOP], 1u);
            const unsigned tg = og / nx;
            if (og + 1u == (tg + 1u) * nx) xb_add(&bar[XB_TOPGEN], 1u);
            else XB_SPIN(xb_ld(&bar[XB_TOPGEN]) == tg, bar);
            __builtin_amdgcn_fence(__ATOMIC_ACQUIRE, "agent");
            xb_add(&bar[XB_XGEN(b.x)], 1u);
            asm volatile("s_waitcnt vmcnt(0)" ::: "memory");
        } else {
            XB_SPIN(xb_ld(&bar[XB_XGEN(b.x)]) == gen, bar);
            __builtin_amdgcn_fence(__ATOMIC_ACQUIRE, "agent");
            asm volatile("s_waitcnt vmcnt(0)" ::: "memory");
        }
    }
    __syncthreads();
}
constexpr int T = 16384, DM = 1024, SEQ = 2048, NBATCH = 8, DEPTH = 2, N_IN = 10432;
constexpr int NWAVES = 8;
constexpr float EPS = 1e-6f;
constexpr size_t MiB = 1u << 20;
constexpr size_t WS_CTL = 0, CTL_ZERO_BYTES = 64 * 1024;
constexpr size_t WS_WB = 1 * MiB;
constexpr size_t WB_W1T = 0;
constexpr size_t WB_W2T = WB_W1T + (size_t)4352 * 1024 * 2;
constexpr size_t WB_WQT = WB_W2T + (size_t)6144 * 1024 * 2;
constexpr size_t WB_WKVT = WB_WQT + (size_t)1536 * 384 * 2;
constexpr size_t WB_WPT = WB_WKVT + (size_t)2048 * 384 * 2;
constexpr size_t WB_WOT = WB_WPT + (size_t)1024 * 3328 * 2;
constexpr size_t WB_END = WB_WOT + (size_t)1024 * 1024 * 2;
static_assert(WB_END <= 32 * MiB, "weights region");
constexpr size_t WS_H = 33 * MiB;
constexpr size_t WS_Y = 65 * MiB;
constexpr int YLD = 3328;
constexpr size_t WS_BIG = 169 * MiB;
constexpr size_t WS_MISC = WS_BIG;
constexpr size_t WS_XC = WS_MISC + 24 * MiB;
constexpr size_t WS_Q = WS_XC + 40 * MiB;
constexpr size_t WS_VV = WS_Q + 48 * MiB;
constexpr size_t WS_KR = WS_VV + 32 * MiB;
constexpr size_t WS_V1 = WS_BIG;
constexpr size_t WS_G = WS_V1 + 32 * MiB;
constexpr size_t WS_O = WS_BIG;
constexpr size_t WS_SMALL = 315 * MiB;
constexpr size_t WS_SLAB = WS_SMALL;
constexpr size_t WS_AGG = WS_SLAB + 1536 * 1024;
constexpr size_t WS_ROPE = WS_AGG + 2560 * 1024;
constexpr size_t WS_LW = WS_ROPE + 512 * 1024;
constexpr size_t WS_GMW = WS_LW + 480 * 1024;
constexpr size_t WS_LCT = WS_GMW + 128 * 1024;
constexpr size_t WS_END = WS_LCT + 64 * 1024;
static_assert(WS_KR + 2 * MiB <= WS_SMALL && WS_G + 96 * MiB <= WS_SMALL && WS_END <= 326 * MiB, "d_ws map");
constexpr int CW_BAR = 1024;
static_assert((CW_BAR + XCD_BAR_WORDS) * 4 <= (int)CTL_ZERO_BYTES, "ctl");
constexpr int RING_BYTES = 131072, MISC_OFF = RING_BYTES + 320, LDS_BYTES = 147456;

enum { I_X = 0, I_PRE_G, I_W_IN, I_GM_LN_G, I_GM_LN_B, I_GM_WS, I_GM_BS, I_QN_G, I_W_UQ, I_KVN_G, I_W_UKV, I_CONV_W, I_CONV_B, I_W_A, I_B_A, I_W_X, I_B_X, I_LAM,
       I_W_PA, I_W_PB, I_W_PC, I_W_OUT, I_POST_G, N_INPUTS };
struct Args { const float* in[N_INPUTS]; float* out; unsigned char* ws; int ph_lo, ph_hi, probe, pad; };

struct Frame { LAS unsigned char* lds; int wave, vcu, G; };
__device__ __forceinline__ int lane_id() { int l; asm volatile("v_mbcnt_lo_u32_b32 %0, -1, 0\n\tv_mbcnt_hi_u32_b32 %0, -1, %0" : "=v"(l)); return l; }

struct MapW1 { __device__ __forceinline__ int operator()(int j) const {
    if (j < 384) return 3072 + j; if (j < 640) return 3456 + (j - 384); if (j < 704) return 3712 + (j - 640); if (j < 768) return -1;
    if (j < 2048) return 4800 + (j - 768); if (j < 3328) return 6080 + (j - 2048); return 3776 + (j - 3328); } };
struct MapW2 { __device__ __forceinline__ int operator()(int j) const {
    if (j < 2048) { const int tl = j >> 8, lc = j & 255; return (lc < 128) ? (128 * tl + lc) : (2048 + 128 * tl + (lc - 128)); }
    if (j < 3072) return 1024 + (j - 2048); return 7360 + (j - 3072); } };
struct MapQ { __device__ __forceinline__ int operator()(int j) const {
    if (j < 1024) { const int hd = j >> 7, d = j & 127; return hd * 192 + d; }
    const int jj = j - 1024, hh = jj >> 6, w = jj & 63, g = w >> 3, e = w & 7; return hh * 192 + (e < 4 ? 128 + 4 * g + e : 160 + 4 * g + (e - 4)); } };
struct MapId { __device__ __forceinline__ int operator()(int j) const { return j; } };

template <class Map>
__device__ __forceinline__ void tr_item(const float* W, int ldw, int nkb  , bf16_t* WT, int ldt, const Map map, const float* kscale, LAS float* scr, int item, int lane) {
    const int kb = item % nkb, nb = item / nkb, k0 = 64 * kb, n0 = 32 * nb;
    const int nn = lane & 31; const int sc = map(n0 + nn);
#pragma unroll 8
    for (int i = 0; i < 32; ++i) { const int kk = 2 * i + (lane >> 5); float v = (sc >= 0) ? W[(size_t)(k0 + kk) * ldw + sc] : 0.f; if (kscale) v *= kscale[k0 + kk]; scr[kk * 33 + nn] = v; }
    LDS_WAIT(); asm volatile("" ::: "memory");
    const int c = lane & 7;
#pragma unroll
    for (int j = 0; j < 4; ++j) { const int n = (lane >> 3) + 8 * j; const LAS float* s = scr + (8 * c) * 33 + n;
        u32x4 o; o.x = pk_bf16(s[0 * 33], s[1 * 33]); o.y = pk_bf16(s[2 * 33], s[3 * 33]); o.z = pk_bf16(s[4 * 33], s[5 * 33]); o.w = pk_bf16(s[6 * 33], s[7 * 33]);
        *(u32x4*)(WT + (size_t)(n0 + n) * ldt + k0 + 8 * c) = o; }
    LDS_WAIT(); asm volatile("" ::: "memory");
}

__device__ __forceinline__ void convert_weights(const Frame& F, const Args& a, unsigned char* ws, int l) {
    const int lane = lane_id();
    LAS float* scr = (LAS float*)(F.lds + F.wave * 16384);
    const int gw = F.vcu * NWAVES + F.wave, NGW = F.G * NWAVES;
    unsigned char* wb = ws + WS_WB;
    constexpr int I1 = 16 * (4352 / 32), I2 = 16 * (6144 / 32), IQ = 6 * (1536 / 32), IKV = 4 * (2048 / 32), IPA = 16 * 32, IPB = 16 * 32, IPC = 20 * 32, IO = 16 * 32;
    constexpr int NITEMS = I1 + I2 + IQ + IKV + IPA + IPB + IPC + IO;
    const float* w_in = a.in[I_W_IN] + (size_t)l * 1024 * N_IN;
    for (int it = gw; it < NITEMS; it += NGW) {
        int r = it;
        if (r < I1) { tr_item(w_in, N_IN, 16, (bf16_t*)(wb + WB_W1T), 1024, MapW1(), nullptr, scr, r, lane); continue; } r -= I1;
        if (r < I2) { tr_item(w_in, N_IN, 16, (bf16_t*)(wb + WB_W2T), 1024, MapW2(), nullptr, scr, r, lane); continue; } r -= I2;
        if (r < IQ) { tr_item(a.in[I_W_UQ] + (size_t)l * 384 * 1536, 1536, 6, (bf16_t*)(wb + WB_WQT), 384, MapQ(), a.in[I_QN_G] + l * 384, scr, r, lane); continue; } r -= IQ;
        if (r < IKV) { tr_item(a.in[I_W_UKV] + (size_t)l * 256 * 2048, 2048, 4, (bf16_t*)(wb + WB_WKVT), 384, MapId(), a.in[I_KVN_G] + l * 256, scr, r, lane); continue; } r -= IKV;
        if (r < IPA) { tr_item(a.in[I_W_PA] + (size_t)l * 1024 * 1024, 1024, 16, (bf16_t*)(wb + WB_WPT), 3328, MapId(), nullptr, scr, r, lane); continue; } r -= IPA;
        if (r < IPB) { tr_item(a.in[I_W_PB] + (size_t)l * 1024 * 1024, 1024, 16, (bf16_t*)(wb + WB_WPT) + 1024, 3328, MapId(), nullptr, scr, r, lane); continue; } r -= IPB;
        if (r < IPC) { tr_item(a.in[I_W_PC] + (size_t)l * 1280 * 1024, 1024, 20, (bf16_t*)(wb + WB_WPT) + 2048, 3328, MapId(), nullptr, scr, r, lane); continue; } r -= IPC;
        tr_item(a.in[I_W_OUT] + (size_t)l * 1024 * 1024, 1024, 16, (bf16_t*)(wb + WB_WOT), 1024, MapId(), nullptr, scr, r, lane);
    }
    const int gt = (F.vcu * NWAVES + F.wave) * 64 + lane, NGT = F.G * NWAVES * 64;
    bf16_t* lwa = (bf16_t*)(ws + WS_LW); bf16_t* lwx = lwa + 16 * 80 * 96;
    const float* w_a = a.in[I_W_A] + (size_t)l * 16 * 80 * 80; const float* w_x = a.in[I_W_X] + (size_t)l * 16 * 80 * 80;
    for (int i = gt; i < 16 * 80 * 96; i += NGT) { const int k = i % 96, j = (i / 96) % 80, blk = i / (96 * 80);
        const float va = (k < 80) ? w_a[((size_t)blk * 80 + k) * 80 + j] : 0.f, vx = (k < 80) ? w_x[((size_t)blk * 80 + k) * 80 + j] : 0.f;
        lwa[i] = f2bf(va); lwx[i] = f2bf(vx); }
    { float* lct = (float*)(ws + WS_LCT); const float* cw = a.in[I_CONV_W] + (size_t)l * 4 * 1280;
      for (int c = gt; c < 1280; c += NGT) { f32x4 v0 = {cw[c], cw[1280 + c], cw[2560 + c], cw[3840 + c]};
          f32x4 v1 = {a.in[I_CONV_B][l * 1280 + c], a.in[I_B_A][l * 1280 + c], a.in[I_B_X][l * 1280 + c], -8.f * log1pf(expf(-a.in[I_LAM][l * 1280 + c]))};
          *(f32x4*)(lct + c * 8) = v0; *(f32x4*)(lct + c * 8 + 4) = v1; } }
    bf16_t* gmw = (bf16_t*)(ws + WS_GMW); const float* gws = a.in[I_GM_WS] + (size_t)l * 4 * 128 * 128;
    for (int i = gt; i < 4 * 128 * 128; i += NGT) { const int j = i & 127, ii = (i >> 7) & 127; gmw[i] = f2bf(((j >> 6) <= (ii >> 6)) ? gws[i] : 0.f); }
}
__device__ __forceinline__ void rope_table(const Frame& F, unsigned char* ws) {
    const int gt = (F.vcu * NWAVES + F.wave) * 64 + lane_id(), NGT = F.G * NWAVES * 64;
    float* cs = (float*)(ws + WS_ROPE); float* sn = cs + 2048 * 32;
    for (int i = gt; i < 2048 * 32; i += NGT) { const int s = i >> 5, fi = i & 31; const float inv_freq = powf(10000.f, -(float)(2 * fi) / 64.f); const float ang = (float)s * inv_freq;
        cs[i] = cosf(ang); sn[i] = sinf(ang); }
}
__device__ __forceinline__ void norm_rows(const Frame& F, const bool nostore, const float* xin, const float* o, const float* g_post, float* xout, const float* g_pre, bf16_t* h) {
    const int gw = F.vcu * NWAVES + F.wave, NGW = F.G * NWAVES; const int lane = lane_id();
    for (int m = gw; m < T; m += NGW) {
        const f32x4* xr = (const f32x4*)(xin + (size_t)m * DM) + lane;
        f32x4 v[4];
#pragma unroll
        for (int j = 0; j < 4; ++j) v[j] = xr[64 * j];
        if (o) {
            const f32x4* orow = (const f32x4*)(o + (size_t)m * DM) + lane; f32x4 ov[4]; float s = 0.f;
#pragma unroll
            for (int j = 0; j < 4; ++j) { ov[j] = orow[64 * j]; s += (ov[j].x * ov[j].x + ov[j].y * ov[j].y) + (ov[j].z * ov[j].z + ov[j].w * ov[j].w); }
            const float r = rsqrtf(wave_sum(s) * (1.f / DM) + EPS);
            f32x4* xo = (f32x4*)(xout + (size_t)m * DM) + lane;
#pragma unroll
            for (int j = 0; j < 4; ++j) { const f32x4 gp = *((const f32x4*)g_post + lane + 64 * j); v[j] = v[j] + ov[j] * r * gp; if (!nostore) xo[64 * j] = v[j]; }
        }
        if (g_pre) {
            float s = 0.f;
#pragma unroll
            for (int j = 0; j < 4; ++j) s += (v[j].x * v[j].x + v[j].y * v[j].y) + (v[j].z * v[j].z + v[j].w * v[j].w);
            const float r = rsqrtf(wave_sum(s) * (1.f / DM) + EPS);
            u32x2* ho = (u32x2*)(h + (size_t)m * DM) + lane;
#pragma unroll
            for (int j = 0; j < 4; ++j) { const f32x4 gp = *((const f32x4*)g_pre + lane + 64 * j); const f32x4 y = v[j] * r * gp; u32x2 w; w.x = pk_bf16(y.x, y.y); w.y = pk_bf16(y.z, y.w); if (!nostore) ho[64 * j] = w; }
        }
    }
}
using g8::UnitD;
constexpr float QSCALE = 0.07216878364870322f * 1.4426950408889634f;

struct SchedA {
    g8::TileOrder ord; const char* A; const char* B;
    __device__ __forceinline__ bool next(int i, UnitD& u) const { int pm, pn; if (!ord.tile(i, pm, pn)) return false;
        u.A = A + (size_t)pm * 256 * 2048; u.B = B + (size_t)pn * 256 * 2048; u.nt = 16; u.pm = pm; u.pn = pn; u.kind = 0; return true; }
};
struct EpiA {
    bf16_t* misc; bf16_t* xc; bf16_t* y; float* slab;
    __device__ __forceinline__ void operator()(f32x4 (&acc)[2][2][4][2], const UnitD& u, int wr, int wc, int fr, int fq) const {
        const int pn = u.pn, rowp = wr * 64 + fr, lc = wc * 32 + 8 * fq;
        bf16_t* dst; int ld; bool act;
        if (pn < 3) { dst = misc + 256 * pn; ld = 768; act = false; }
        else if (pn < 8) { dst = xc + 256 * (pn - 3); ld = 1280; act = false; }
        else if (pn < 13) { dst = y + 2048 + 256 * (pn - 8); ld = YLD; act = true; }
        else { dst = y + 1024 + 256 * (pn - 13); ld = YLD; act = true; }
#pragma unroll
        for (int ai = 0; ai < 2; ++ai)
#pragma unroll
            for (int m = 0; m < 4; ++m) { const int rp = rowp + ai * 128 + m * 16; bf16_t* p = dst + ((size_t)u.pm * 256 + rp) * ld + lc;
#pragma unroll
                for (int bj = 0; bj < 2; ++bj) { f32x4 v0 = acc[ai][bj][m][0], v1 = acc[ai][bj][m][1];
                    if (pn < 3) { float ss = (v0.x * v0.x + v0.y * v0.y) + (v0.z * v0.z + v0.w * v0.w) + (v1.x * v1.x + v1.y * v1.y) + (v1.z * v1.z + v1.w * v1.w);
                        ss += sx<16>(ss); ss = xsum32(ss);
                        if (fq == 0) slab[(((size_t)u.pm * 6 + pn * 2 + bj) * 4 + wc) * 256 + rp] = ss; }
                    if (act) { v0.x = fsilu(v0.x); v0.y = fsilu(v0.y); v0.z = fsilu(v0.z); v0.w = fsilu(v0.w); v1.x = fsilu(v1.x); v1.y = fsilu(v1.y); v1.z = fsilu(v1.z); v1.w = fsilu(v1.w); }
                    u32x4 w; w.x = pk_bf16(v0.x, v0.y); w.y = pk_bf16(v0.z, v0.w); w.z = pk_bf16(v1.x, v1.y); w.w = pk_bf16(v1.z, v1.w);
                    *(u32x4*)(p + bj * 128) = w; } }
    }
};

struct SchedQKV {
    g8::TileOrder ord; const char* misc; const char* wq; const char* wkv;
    __device__ __forceinline__ bool next(int i, UnitD& u) const { int pm, pn; if (!ord.tile(i, pm, pn)) return false;
        u.pm = pm; u.pn = pn; u.kind = 0;
        if (pn < 6) { u.A = misc + (size_t)pm * 256 * 1536; u.B = wq + (size_t)pn * 256 * 768; u.nt = 6; }
        else { u.A = misc + (size_t)pm * 256 * 1536 + 384 * 2; u.B = wkv + (size_t)(pn - 6) * 256 * 768; u.nt = 4; }
        return true; }
};
struct EpiQKV {
    bf16_t* q; bf16_t* y; bf16_t* vv; const float* slab; const float* cs; const float* sn;
    __device__ __forceinline__ void operator()(f32x4 (&acc)[2][2][4][2], const UnitD& u, int wr, int wc, int fr, int fq) const {
        const int pn = u.pn, rowp = wr * 64 + fr, lc = wc * 32 + 8 * fq; const bool isq = pn < 6;
#pragma unroll
        for (int ai = 0; ai < 2; ++ai)
#pragma unroll
            for (int m = 0; m < 4; ++m) { const int rp = rowp + ai * 128 + m * 16; const size_t r = (size_t)u.pm * 256 + rp;
                float s = 0.f; const float* sl = slab + (size_t)u.pm * 6 * 4 * 256 + rp;
                if (isq) {
#pragma unroll
                    for (int e = 0; e < 3; ++e) { const int j = fq * 3 + e; s += sl[(size_t)((j >> 2) * 4 + (j & 3)) * 256]; }
                } else {
#pragma unroll
                    for (int e = 0; e < 2; ++e) { const int j = fq * 2 + e; s += sl[(size_t)((3 + (j >> 2)) * 4 + (j & 3)) * 256]; }
                }
                s += sx<16>(s); s = xsum32(s);
                float rs = rsqrtf(s * (isq ? (1.f / 384.f) : (1.f / 256.f)) + EPS); if (isq) rs *= QSCALE;
#pragma unroll
                for (int bj = 0; bj < 2; ++bj) { f32x4 v0 = acc[ai][bj][m][0] * rs, v1 = acc[ai][bj][m][1] * rs;
                    if (pn < 4) { const int j0 = 256 * pn + 128 * bj + lc; bf16_t* p = q + r * 1536 + (j0 >> 7) * 192 + (j0 & 127);
                        u32x4 w; w.x = pk_bf16(v0.x, v0.y); w.y = pk_bf16(v0.z, v0.w); w.z = pk_bf16(v1.x, v1.y); w.w = pk_bf16(v1.z, v1.w); *(u32x4*)p = w; }
                    else if (pn < 6) { const int jj = 256 * (pn - 4) + 128 * bj + lc, hh = jj >> 6, g = (jj & 63) >> 3; const int pos = (int)(r & 2047);
                        const f32x4 c4 = *(const f32x4*)(cs + pos * 32 + 4 * g), s4 = *(const f32x4*)(sn + pos * 32 + 4 * g);
                        const f32x4 o1 = v0 * c4 - v1 * s4, o2 = v1 * c4 + v0 * s4; bf16_t* p = q + r * 1536 + hh * 192 + 128 + 4 * g;
                        u32x2 w1, w2; w1.x = pk_bf16(o1.x, o1.y); w1.y = pk_bf16(o1.z, o1.w); w2.x = pk_bf16(o2.x, o2.y); w2.y = pk_bf16(o2.z, o2.w);
                        *(u32x2*)p = w1; *(u32x2*)(p + 32) = w2; }
                    else { const int hd = pn - 6; bf16_t* p = (bj == 0) ? (y + r * YLD + hd * 128 + lc) : (vv + r * 1024 + hd * 128 + lc);
                        u32x4 w; w.x = pk_bf16(v0.x, v0.y); w.y = pk_bf16(v0.z, v0.w); w.z = pk_bf16(v1.x, v1.y); w.w = pk_bf16(v1.z, v1.w); *(u32x4*)p = w; } } }
    }
};

struct SchedD {
    g8::TileOrder ord; const char* A; const char* B;
    __device__ __forceinline__ bool next(int i, UnitD& u) const { int pm, pn; if (!ord.tile(i, pm, pn)) return false;
        u.A = A + (size_t)pm * 256 * 2048; u.B = B + (size_t)pn * 256 * 2048; u.nt = 16; u.pm = pm; u.pn = pn; u.kind = 0; return true; }
};
struct EpiD {
    bf16_t* y; bf16_t* v1; bf16_t* g;
    __device__ __forceinline__ void operator()(f32x4 (&acc)[2][2][4][2], const UnitD& u, int wr, int wc, int fr, int fq) const {
        const int pn = u.pn, rowp = wr * 64 + fr, lc = wc * 32 + 8 * fq;
#pragma unroll
        for (int ai = 0; ai < 2; ++ai)
#pragma unroll
            for (int m = 0; m < 4; ++m) { const size_t r = (size_t)u.pm * 256 + rowp + ai * 128 + m * 16;
                if (pn < 8) { const f32x4 u0 = acc[ai][0][m][0], u1 = acc[ai][0][m][1], z0 = acc[ai][1][m][0], z1 = acc[ai][1][m][1];
                    u32x4 w; w.x = pk_bf16(u0.x * fsilu(z0.x), u0.y * fsilu(z0.y)); w.y = pk_bf16(u0.z * fsilu(z0.z), u0.w * fsilu(z0.w));
                    w.z = pk_bf16(u1.x * fsilu(z1.x), u1.y * fsilu(z1.y)); w.w = pk_bf16(u1.z * fsilu(z1.z), u1.w * fsilu(z1.w));
                    *(u32x4*)(y + r * YLD + 128 * pn + lc) = w; }
                else {
#pragma unroll
                    for (int bj = 0; bj < 2; ++bj) { f32x4 v0 = acc[ai][bj][m][0], v1_ = acc[ai][bj][m][1]; bf16_t* p;
                        if (pn < 12) p = v1 + r * 1024 + 256 * (pn - 8) + 128 * bj + lc;
                        else { p = g + r * 3072 + 256 * (pn - 12) + 128 * bj + lc;
                            v0.x = fsigmoid(v0.x); v0.y = fsigmoid(v0.y); v0.z = fsigmoid(v0.z); v0.w = fsigmoid(v0.w); v1_.x = fsigmoid(v1_.x); v1_.y = fsigmoid(v1_.y); v1_.z = fsigmoid(v1_.z); v1_.w = fsigmoid(v1_.w); }
                        u32x4 w; w.x = pk_bf16(v0.x, v0.y); w.y = pk_bf16(v0.z, v0.w); w.z = pk_bf16(v1_.x, v1_.y); w.w = pk_bf16(v1_.z, v1_.w); *(u32x4*)p = w; } } }
    }
};

struct SchedF {
    g8::TileOrder ord; const char* A; const char* B;
    __device__ __forceinline__ bool next(int i, UnitD& u) const { if (i >= 3) return false; int pm, pn; if (!ord.tile(0, pm, pn)) return false;
        const size_t ko = (i == 0) ? 0 : (i == 1 ? 1024 * 2 : 2048 * 2);
        u.A = A + (size_t)pm * 256 * (YLD * 2) + ko; u.B = B + (size_t)pn * 256 * (YLD * 2) + ko; u.nt = (i == 2) ? 20 : 16; u.pm = pm; u.pn = pn; u.kind = (i < 2) ? (i | g8::KEEP_ACC) : i; return true; }
};
struct EpiF {
    const bf16_t* g; bf16_t* merged;
    __device__ __forceinline__ void operator()(f32x4 (&acc)[2][2][4][2], const UnitD& u, int wr, int wc, int fr, int fq) const {
        const int seg = u.kind & 3, rowp = wr * 64 + fr, lc = wc * 32 + 8 * fq;
#pragma unroll
        for (int ai = 0; ai < 2; ++ai)
#pragma unroll
            for (int m = 0; m < 4; ++m) { const size_t r = (size_t)u.pm * 256 + rowp + ai * 128 + m * 16;
#pragma unroll
                for (int bj = 0; bj < 2; ++bj) { const int col = 256 * u.pn + 128 * bj + lc; const bf16_t* gp = g + r * 3072 + seg * 1024 + col;
                    const u32x4 a = *(const u32x4*)gp; f32x4 f0, f1;
                    f0.x = bf_lo(a.x); f0.y = bf_hi(a.x); f0.z = bf_lo(a.y); f0.w = bf_hi(a.y); f1.x = bf_lo(a.z); f1.y = bf_hi(a.z); f1.z = bf_lo(a.w); f1.w = bf_hi(a.w);
                    if (seg < 2) { const u32x4 b = *(const u32x4*)(gp + 1024);
                        f0.x *= __builtin_amdgcn_rcpf(bf_lo(b.x)); f0.y *= __builtin_amdgcn_rcpf(bf_hi(b.x)); f0.z *= __builtin_amdgcn_rcpf(bf_lo(b.y)); f0.w *= __builtin_amdgcn_rcpf(bf_hi(b.y));
                        f1.x *= __builtin_amdgcn_rcpf(bf_lo(b.z)); f1.y *= __builtin_amdgcn_rcpf(bf_hi(b.z)); f1.z *= __builtin_amdgcn_rcpf(bf_lo(b.w)); f1.w *= __builtin_amdgcn_rcpf(bf_hi(b.w));
                        acc[ai][bj][m][0] *= f0; acc[ai][bj][m][1] *= f1; }
                    else { const f32x4 v0 = acc[ai][bj][m][0] * f0, v1 = acc[ai][bj][m][1] * f1;
                        u32x4 w; w.x = pk_bf16(v0.x, v0.y); w.y = pk_bf16(v0.z, v0.w); w.z = pk_bf16(v1.x, v1.y); w.w = pk_bf16(v1.z, v1.w);
                        *(u32x4*)(merged + r * 1024 + col) = w; } } }
    }
};

struct SchedG {
    g8::TileOrder ord; const char* A; const char* B;
    __device__ __forceinline__ bool next(int i, UnitD& u) const { int pm, pn; if (!ord.tile(i, pm, pn)) return false;
        u.A = A + (size_t)pm * 256 * 2048; u.B = B + (size_t)pn * 256 * 2048; u.nt = 16; u.pm = pm; u.pn = pn; u.kind = 0; return true; }
};
struct EpiG {
    float* o;
    __device__ __forceinline__ void operator()(f32x4 (&acc)[2][2][4][2], const UnitD& u, int wr, int wc, int fr, int fq) const {
        const int rowp = wr * 64 + fr, lc = wc * 32 + 8 * fq;
#pragma unroll
        for (int ai = 0; ai < 2; ++ai)
#pragma unroll
            for (int m = 0; m < 4; ++m) { float* p = o + ((size_t)u.pm * 256 + rowp + ai * 128 + m * 16) * 1024 + 256 * u.pn + lc;
#pragma unroll
                for (int bj = 0; bj < 2; ++bj) { *(f32x4*)(p + bj * 128) = acc[ai][bj][m][0]; *(f32x4*)(p + bj * 128 + 4) = acc[ai][bj][m][1]; } }
    }
};
typedef float f32x2v __attribute__((ext_vector_type(2)));

constexpr int LRU_HIN_OFF = RING_BYTES + 1024;
template <int PASS>
__device__ __forceinline__ void lru_item(const Frame& F, const Args& a, const unsigned char* ws, const bool nostore, int l, int item, const bf16_t* xcb, bf16_t* y, float* agg) {
    const int b = item >> 5, k = item & 31; const size_t r0 = (size_t)b * SEQ + (size_t)k * 64;
    int lane_ = lane_id(); asm volatile("" : "+v"(lane_));
    const int lane = lane_, cl = lane & 15, kg = lane >> 4;
    LAS unsigned char* xt = F.lds + F.wave * 16384;
    const bf16_t* lwa = (const bf16_t*)(ws + WS_LW); const bf16_t* lwx = lwa + 16 * 80 * 96;
    const float* lct = (const float*)(ws + WS_LCT);
    LAS float* hin_l = (LAS float*)(F.lds + LRU_HIN_OFF);
    if (PASS == 2) {
        for (int c = F.wave * 64 + lane; c < 1280; c += 512) { const float* ag = agg + ((size_t)b * 32 * 1280 + c) * 2; float h = 0.f;
#pragma unroll 8
            for (int j = 0; j < k; ++j) { const f32x2v ab = *(const f32x2v*)(ag + (size_t)j * 2560); h = ab.x * h + ab.y; }
            hin_l[c] = h; }
        LDS_WAIT(); __syncthreads();
    }
#pragma unroll 1
    for (int bi = 0; bi < 2; ++bi) {
        const int blk = 2 * F.wave + bi;
        {
            u32x4 xch[11]; int ln = lane; asm volatile("" : "+v"(ln));
            const bf16_t* xbase = xcb + (r0 - 3) * 1280 + blk * 80;
#pragma unroll
            for (int i = 0; i < 11; ++i) { const int idx = ln + 64 * i; const int row = idx / 10, ch = idx - row * 10; xch[i] = (u32x4){0u, 0u, 0u, 0u};
                if (idx < 670 && !(k == 0 && row < 3)) xch[i] = *(const u32x4*)(xbase + (unsigned)(row * 1280 + ch * 8)); }
#pragma unroll
            for (int i = 0; i < 11; ++i) { const int idx = ln + 64 * i; const int row = idx / 10, ch = idx - row * 10; if (idx < 670) *(LAS u32x4*)(xt + row * 208 + ch * 16) = xch[i]; }
            LAS u32x4* z = (LAS u32x4*)(xt + (lane + 3) * 208 + 160); z[0] = (u32x4){0u, 0u, 0u, 0u}; z[1] = (u32x4){0u, 0u, 0u, 0u};
        }
        LDS_WAIT(); asm volatile("" ::: "memory");
#pragma unroll
        for (int ct = 0; ct < 5; ++ct) { const int c = blk * 80 + 16 * ct + cl; const f32x4 cw = *(const f32x4*)(lct + c * 8); const float cb = lct[c * 8 + 4];
            float xv[4][7];
#pragma unroll
            for (int rt = 0; rt < 4; ++rt)
#pragma unroll
                for (int j = 0; j < 7; ++j) xv[rt][j] = bf1(*(const LAS bf16_t*)(xt + (16 * rt + 4 * kg + j) * 208 + (16 * ct + cl) * 2));
            asm volatile("" ::: "memory");
#pragma unroll
            for (int rt = 0; rt < 4; ++rt)
#pragma unroll
                for (int e = 0; e < 4; ++e) { const float v = cb + cw.x * xv[rt][e] + cw.y * xv[rt][e + 1] + cw.z * xv[rt][e + 2] + cw.w * xv[rt][e + 3];
                    *(LAS bf16_t*)(xt + (16 * rt + 4 * kg + e + 3) * 208 + (16 * ct + cl) * 2) = f2bf(v); }
            asm volatile("" ::: "memory"); }
        LDS_WAIT(); asm volatile("" ::: "memory");
        bf16x8 af[4][3];
#pragma unroll
        for (int rt = 0; rt < 4; ++rt)
#pragma unroll
            for (int ks = 0; ks < 3; ++ks) af[rt][ks] = *(const LAS bf16x8*)(xt + (16 * rt + cl + 3) * 208 + (32 * ks + 8 * kg) * 2);
        bf16x8 wA[2][3], wX[2][3];
#pragma unroll
        for (int ks = 0; ks < 3; ++ks) { const size_t wo = ((size_t)blk * 80 + cl) * 96 + 32 * ks + 8 * kg; wA[0][ks] = *(const bf16x8*)(lwa + wo); wX[0][ks] = *(const bf16x8*)(lwx + wo); }
#pragma unroll
        for (int ct = 0; ct < 5; ++ct) { const int c = blk * 80 + 16 * ct + cl; const int cur = ct & 1;
            if (ct + 1 < 5) {
#pragma unroll
                for (int ks = 0; ks < 3; ++ks) { const size_t wo = ((size_t)blk * 80 + 16 * (ct + 1) + cl) * 96 + 32 * ks + 8 * kg; wA[cur ^ 1][ks] = *(const bf16x8*)(lwa + wo); wX[cur ^ 1][ks] = *(const bf16x8*)(lwx + wo); } }
            const f32x4 c1 = *(const f32x4*)(lct + c * 8 + 4); const float ba_c = c1.y, bx_c = c1.z, sp8 = c1.w;
            float zv[4][4];
            if (PASS == 2) {
#pragma unroll
                for (int rt = 0; rt < 4; ++rt)
#pragma unroll
                    for (int e = 0; e < 4; ++e) zv[rt][e] = bf1(y[(r0 + 16 * rt + 4 * kg + e) * YLD + 2048 + c]); }
            f32x4 ra[4], rx[4];
#pragma unroll
            for (int rt = 0; rt < 4; ++rt) { ra[rt] = (f32x4){0.f, 0.f, 0.f, 0.f}; rx[rt] = (f32x4){0.f, 0.f, 0.f, 0.f}; }
#pragma unroll
            for (int ks = 0; ks < 3; ++ks)
#pragma unroll
                for (int rt = 0; rt < 4; ++rt) { ra[rt] = __builtin_amdgcn_mfma_f32_16x16x32_bf16(af[rt][ks], wA[cur][ks], ra[rt], 0, 0, 0); rx[rt] = __builtin_amdgcn_mfma_f32_16x16x32_bf16(af[rt][ks], wX[cur][ks], rx[rt], 0, 0, 0); }
            float hin = (PASS == 2) ? hin_l[c] : 0.f; float totA = 1.f, totB = 0.f;
#pragma unroll
            for (int rt = 0; rt < 4; ++rt) { float av[4], bv[4];
#pragma unroll
                for (int e = 0; e < 4; ++e) { const float r = fsigmoid(ra[rt][e] + ba_c), ig = fsigmoid(rx[rt][e] + bx_c);
                    const float aa = __expf(sp8 * r); const float mult = sqrtf(fmaxf(1.f - aa * aa, 0.f));
                    const float xcv = bf1(*(const LAS bf16_t*)(xt + (16 * rt + 4 * kg + e + 3) * 208 + (16 * ct + cl) * 2));
                    av[e] = aa; bv[e] = mult * ig * xcv; }
                float sA = av[0], sB = bv[0];
#pragma unroll
                for (int e = 1; e < 4; ++e) { sB = av[e] * sB + bv[e]; sA *= av[e]; }
                float iA = sA, iB = sB;
                { const float pA = __shfl(iA, lane - 16), pB = __shfl(iB, lane - 16); if (kg >= 1) { iB = iA * pB + iB; iA = iA * pA; } }
                { const float pA = __shfl(iA, lane - 32), pB = __shfl(iB, lane - 32); if (kg >= 2) { iB = iA * pB + iB; iA = iA * pA; } }
                const float tA = __shfl(iA, 48 + cl), tB = __shfl(iB, 48 + cl);
                if (PASS == 1) { totB = tA * totB + tB; totA *= tA; }
                else {
                    float eA = __shfl(iA, lane - 16), eB = __shfl(iB, lane - 16); if (kg == 0) { eA = 1.f; eB = 0.f; }
                    float h = eA * hin + eB;
                    bf16_t* yp = y + (r0 + 16 * rt + 4 * kg) * YLD + 2048 + c;
#pragma unroll
                    for (int e = 0; e < 4; ++e) { h = av[e] * h + bv[e]; if (!nostore) yp[(size_t)e * YLD] = f2bf(h * zv[rt][e]); }
                    hin = tA * hin + tB;
                }
            }
            if (PASS == 1) { if (kg == 0) *(f32x2v*)(agg + (((size_t)b * 32 + k) * 1280 + c) * 2) = (f32x2v){totA, totB}; }
        }
        LDS_WAIT(); asm volatile("" ::: "memory");
    }
    if (PASS == 2) __syncthreads();
}

__device__ __forceinline__ void phaseB_extra(const Frame& F, const Args& a, const unsigned char* ws, int l, const bf16_t* misc, bf16_t* kr, const bf16_t* xc, float* agg, const float* cs, const float* sn) {
    for (int item = F.vcu; item < NBATCH * 32; item += F.G) lru_item<1>(F, a, ws, false, l, item, xc, nullptr, agg);
    const int gt = (F.vcu * NWAVES + F.wave) * 64 + lane_id(), NGT = F.G * NWAVES * 64;
    for (int i = gt; i < T * 32; i += NGT) { const int t = i >> 5, fi = i & 31, pos = t & 2047; const float c = cs[pos * 32 + fi], s = sn[pos * 32 + fi];
        const float t1 = bf1(misc[(size_t)t * 768 + 640 + fi]), t2 = bf1(misc[(size_t)t * 768 + 672 + fi]);
        kr[(size_t)t * 64 + fi] = f2bf(t1 * c - t2 * s); kr[(size_t)t * 64 + 32 + fi] = f2bf(t2 * c + t1 * s); }
}

namespace att {
constexpr int SHM_V = 64 * 128 * 2, SHM_K = 64 * 192 * 2, OFF_K = 2 * SHM_V, OFF_WS = OFF_K + 2 * SHM_K, LDS_TOTAL = OFF_WS + 8 * 64 * 4;
constexpr float THR = 8.f;
constexpr float NEGBIG = -1e30f;
constexpr int KVBLK_ = 64;
#define ATT_SBAR() __builtin_amdgcn_sched_barrier(0)
__device__ __forceinline__ int crow(int r, int hi) { return (r & 3) + 8 * (r >> 2) + 4 * hi; }
__device__ __forceinline__ int koff(int row, int sub, int chunk) { return sub * 8192 + row * 128 + ((chunk ^ ((row >> 1) & 7)) << 4); }
__device__ __forceinline__ void partialSM(f32x16& p0, f32x16& p1, float& m_reg, float& alpha) {
    float pmax = p0[0];
#pragma unroll
    for (int r = 1; r < 16; ++r) pmax = fmaxf(pmax, p0[r]);
#pragma unroll
    for (int r = 0; r < 16; ++r) pmax = fmaxf(pmax, p1[r]);
    { auto rr = __builtin_amdgcn_permlane32_swap(__float_as_uint(pmax), __float_as_uint(pmax), false, false); pmax = fmaxf(__uint_as_float(rr[0]), __uint_as_float(rr[1])); }
    float mn;
    if (__builtin_expect(__all(pmax - m_reg <= THR), 1)) { mn = m_reg; alpha = 1.f; }
    else { mn = fmaxf(m_reg, pmax); alpha = __builtin_amdgcn_exp2f(m_reg - mn); m_reg = mn; }
#pragma unroll
    for (int r = 0; r < 16; ++r) p0[r] = __builtin_amdgcn_exp2f(p0[r] - mn);
#pragma unroll
    for (int r = 0; r < 16; ++r) p1[r] = p1[r] - mn;
}
__device__ __forceinline__ void finishSM(f32x16& p0, f32x16& p1, float alpha, float& l_reg, bf16x8& pa0, bf16x8& pa1, bf16x8& pa2, bf16x8& pa3) {
#pragma unroll
    for (int r = 0; r < 16; ++r) p1[r] = __builtin_amdgcn_exp2f(p1[r]);
    float ps = 0.f;
#pragma unroll
    for (int r = 0; r < 16; ++r) ps += p0[r];
#pragma unroll
    for (int r = 0; r < 16; ++r) ps += p1[r];
    { auto rr = __builtin_amdgcn_permlane32_swap(__float_as_uint(ps), __float_as_uint(ps), false, false); ps = __uint_as_float(rr[0]) + __uint_as_float(rr[1]); }
    l_reg = l_reg * alpha + ps;
#define ATT_PK4(P, BASE, OUT) do { unsigned a0 = pk_bf16(P[BASE + 0], P[BASE + 1]), a1 = pk_bf16(P[BASE + 2], P[BASE + 3]);   \
    unsigned b0 = pk_bf16(P[BASE + 4], P[BASE + 5]), b1 = pk_bf16(P[BASE + 6], P[BASE + 7]);                              \
    auto r0 = __builtin_amdgcn_permlane32_swap(a0, b0, false, false); auto r1 = __builtin_amdgcn_permlane32_swap(a1, b1, false, false); \
    u32x4 w = {r0[0], r1[0], r0[1], r1[1]}; OUT = __builtin_bit_cast(bf16x8, w); } while (0)
    ATT_PK4(p0, 0, pa0); ATT_PK4(p0, 8, pa1); ATT_PK4(p1, 0, pa2); ATT_PK4(p1, 8, pa3);
#undef ATT_PK4
}
__device__ __forceinline__ void qkt(f32x16& p0, f32x16& p1, const LAS unsigned char* Ks, const bf16x8* qr, int r32, int hi) {
    p0 = f32x16{}; p1 = f32x16{};
#pragma unroll
    for (int d0 = 0; d0 < 12; ++d0) { const int sub = d0 >> 2, chunk = (d0 & 3) * 2 + hi;
        const bf16x8 b0 = *(const LAS bf16x8*)(Ks + koff(r32, sub, chunk));
        const bf16x8 b1 = *(const LAS bf16x8*)(Ks + koff(32 + r32, sub, chunk));
        p0 = __builtin_amdgcn_mfma_f32_32x32x16_bf16(b0, qr[d0], p0, 0, 0, 0);
        p1 = __builtin_amdgcn_mfma_f32_32x32x16_bf16(b1, qr[d0], p1, 0, 0, 0);
        if ((d0 & 3) == 3) ATT_SBAR(); }
}
__device__ __forceinline__ int v_st(int k, int c) { const int kk = (k & ~0xC) | ((k & 4) << 1) | ((k & 8) >> 1); return ((kk >> 3) * 4 + (c >> 5)) * 512 + ((kk & 7) * 32 + (c & 31)) * 2; }
__device__ __forceinline__ int v_rd_base(int lane) { return ((lane & 3) << 3) | (((lane >> 2) & 3) << 6) | (((lane >> 4) & 1) << 5) | (((lane >> 5) & 1) << 8); }
constexpr int v_rd_off(int d0, int ks, int half) { return d0 * 512 + ks * 4096 + half * 2048; }
template <int OFF> __device__ __forceinline__ s16x4 tr_read(int vb) { s16x4 r; asm volatile("ds_read_b64_tr_b16 %0, %1 offset:%2" : "=&v"(r) : "v"(vb), "i"(OFF) : "memory"); return r; }
template <int D0> __device__ __forceinline__ void pv_one(f32x16& od, int vb, bf16x8 pa0, bf16x8 pa1, bf16x8 pa2, bf16x8 pa3) {
    const s16x4 l0 = tr_read<v_rd_off(D0, 0, 0)>(vb), h0 = tr_read<v_rd_off(D0, 0, 1)>(vb), l1 = tr_read<v_rd_off(D0, 1, 0)>(vb), h1 = tr_read<v_rd_off(D0, 1, 1)>(vb);
    const s16x4 l2 = tr_read<v_rd_off(D0, 2, 0)>(vb), h2 = tr_read<v_rd_off(D0, 2, 1)>(vb), l3 = tr_read<v_rd_off(D0, 3, 0)>(vb), h3 = tr_read<v_rd_off(D0, 3, 1)>(vb);
    asm volatile("s_waitcnt lgkmcnt(0)" ::: "memory"); ATT_SBAR();
#define ATT_PK(L, H) (bf16x8){L[0], L[1], L[2], L[3], H[0], H[1], H[2], H[3]}
    od = __builtin_amdgcn_mfma_f32_32x32x16_bf16(pa0, ATT_PK(l0, h0), od, 0, 0, 0);
    od = __builtin_amdgcn_mfma_f32_32x32x16_bf16(pa1, ATT_PK(l1, h1), od, 0, 0, 0);
    od = __builtin_amdgcn_mfma_f32_32x32x16_bf16(pa2, ATT_PK(l2, h2), od, 0, 0, 0);
    od = __builtin_amdgcn_mfma_f32_32x32x16_bf16(pa3, ATT_PK(l3, h3), od, 0, 0, 0);
#undef ATT_PK
}
__device__ __forceinline__ void pv_d0(f32x16* o, int vb, bf16x8 pa0, bf16x8 pa1, bf16x8 pa2, bf16x8 pa3) {
    pv_one<0>(o[0], vb, pa0, pa1, pa2, pa3); pv_one<1>(o[1], vb, pa0, pa1, pa2, pa3); pv_one<2>(o[2], vb, pa0, pa1, pa2, pa3); pv_one<3>(o[3], vb, pa0, pa1, pa2, pa3);
}

__device__ __forceinline__ void unit(const Frame& F, const bool nostore, int b, int hd, int qb, const bf16_t* __restrict__ Q, bf16_t* Y, const bf16_t* __restrict__ VV, const bf16_t* __restrict__ KR) {
    int tid_ = F.wave * 64 + lane_id(); asm volatile("" : "+v"(tid_));
    const int tid = tid_, wid = F.wave, lane = tid & 63, r32 = lane & 31, hi = lane >> 5;
    LAS unsigned char* lds = F.lds;
    LAS unsigned char* V_lds = lds; LAS unsigned char* K_lds = lds + OFF_K;
    LAS float* wsf = (LAS float*)(lds + OFF_WS) + wid * 64; LAS float* li_l = wsf; LAS float* al_l = wsf + 32;
    const size_t rowbase = (size_t)b * SEQ; const int q0 = qb * 256; const int qc = 4 * qb + (wid >> 1); const int NT = 4 * qb + 4;
    float m_reg = NEGBIG, l_reg = 0.f; f32x16 o[4] = {}; bf16x8 qr[12];
    { const bf16_t* Qw = Q + (rowbase + q0 + wid * 32 + r32) * 1536 + hd * 192 + hi * 8;
#pragma unroll
      for (int d0 = 0; d0 < 12; ++d0) qr[d0] = *(const bf16x8*)(Qw + d0 * 16); }
    const bf16_t* Kn = Y + rowbase * YLD + hd * 128; const bf16_t* Vh = VV + rowbase * 1024 + hd * 128; const bf16_t* Kr = KR + rowbase * 64;
    const int sr = tid >> 4, sc = (tid & 15) * 8; const int vst0 = v_st(sr, sc), vst1 = v_st(32 + sr, sc);
    const int kst0 = koff(sr, sc >> 6, (sc & 63) >> 3), kst1 = koff(32 + sr, sc >> 6, (sc & 63) >> 3), kst2 = koff(tid >> 3, 2, tid & 7);
    const int vb0 = (int)(uintptr_t)V_lds + v_rd_base(lane);
    bf16x8 vs0, vs1, ks0, ks1, ks2;
#define ATT_SLOAD(k0) do { vs0 = *(const bf16x8*)(Vh + (size_t)((k0) + sr) * 1024 + sc); vs1 = *(const bf16x8*)(Vh + (size_t)((k0) + 32 + sr) * 1024 + sc); \
    ks0 = *(const bf16x8*)(Kn + (size_t)((k0) + sr) * YLD + sc); ks1 = *(const bf16x8*)(Kn + (size_t)((k0) + 32 + sr) * YLD + sc); \
    ks2 = *(const bf16x8*)(Kr + (size_t)((k0) + (tid >> 3)) * 64 + (tid & 7) * 8); } while (0)
#define ATT_SWRITE(bf) do { *(LAS bf16x8*)(V_lds + (bf) * SHM_V + vst0) = vs0; *(LAS bf16x8*)(V_lds + (bf) * SHM_V + vst1) = vs1; \
    *(LAS bf16x8*)(K_lds + (bf) * SHM_K + kst0) = ks0; *(LAS bf16x8*)(K_lds + (bf) * SHM_K + kst1) = ks1; *(LAS bf16x8*)(K_lds + (bf) * SHM_K + kst2) = ks2; } while (0)
#define ATT_RESC(al) do { if (__any((al) < 1.f)) { if (hi == 0) al_l[r32] = (al); asm volatile("s_waitcnt lgkmcnt(0)" ::: "memory"); \
    _Pragma("unroll") for (int d = 0; d < 4; ++d) _Pragma("unroll") for (int r = 0; r < 16; ++r) o[d][r] *= al_l[crow(r, hi)]; } } while (0)
#define ATT_QKT(P0, P1, bf, jt) do { if ((jt) <= qc) qkt(P0, P1, K_lds + (bf) * SHM_K, qr, r32, hi); else { _Pragma("unroll") for (int r = 0; r < 16; ++r) { P0[r] = NEGBIG; P1[r] = NEGBIG; } } } while (0)
    f32x16 pA0, pA1, pB0, pB1; float alA, alB; bf16x8 pa0, pa1, pa2, pa3;
    ATT_SLOAD(0); asm volatile("s_waitcnt vmcnt(0)" ::: "memory"); ATT_SWRITE(0); __syncthreads();
    ATT_QKT(pA0, pA1, 0, 0); partialSM(pA0, pA1, m_reg, alA);
    ATT_SLOAD(KVBLK_); asm volatile("s_waitcnt vmcnt(0)" ::: "memory"); ATT_SWRITE(1); __syncthreads();
    for (int j = 1; j + 1 < NT; j += 2) {
        ATT_SBAR(); ATT_QKT(pB0, pB1, 1, j);
        finishSM(pA0, pA1, alA, l_reg, pa0, pa1, pa2, pa3); ATT_SBAR();
        ATT_SLOAD((j + 1) * KVBLK_); ATT_SBAR();
        pv_d0(o, vb0, pa0, pa1, pa2, pa3); partialSM(pB0, pB1, m_reg, alB);
        __syncthreads(); asm volatile("s_waitcnt vmcnt(0)" ::: "memory"); ATT_SWRITE(0);
        ATT_RESC(alB); __syncthreads();
        ATT_SBAR(); ATT_QKT(pA0, pA1, 0, j + 1);
        finishSM(pB0, pB1, alB, l_reg, pa0, pa1, pa2, pa3); ATT_SBAR();
        ATT_SLOAD((j + 2) * KVBLK_); ATT_SBAR();
        pv_d0(o, vb0 + SHM_V, pa0, pa1, pa2, pa3); partialSM(pA0, pA1, m_reg, alA);
        __syncthreads(); asm volatile("s_waitcnt vmcnt(0)" ::: "memory"); ATT_SWRITE(1);
        ATT_RESC(alA); __syncthreads();
    }
    ATT_SBAR(); ATT_QKT(pB0, pB1, 1, NT - 1);
    finishSM(pA0, pA1, alA, l_reg, pa0, pa1, pa2, pa3); ATT_SBAR();
    pv_d0(o, vb0, pa0, pa1, pa2, pa3); partialSM(pB0, pB1, m_reg, alB);
    __syncthreads(); ATT_RESC(alB);
    finishSM(pB0, pB1, alB, l_reg, pa0, pa1, pa2, pa3); ATT_SBAR();
    pv_d0(o, vb0 + SHM_V, pa0, pa1, pa2, pa3);
    if (hi == 0) li_l[r32] = l_reg; asm volatile("s_waitcnt lgkmcnt(0)" ::: "memory");
    float rli[16];
#pragma unroll
    for (int r = 0; r < 16; ++r) rli[r] = __builtin_amdgcn_rcpf(li_l[crow(r, hi)]);
    bf16_t* Ow = Y + (rowbase + q0 + wid * 32) * YLD + 1024 + hd * 128;
    int hi2 = hi, r32b = r32; asm volatile("" : "+v"(hi2), "+v"(r32b));
    const unsigned eoff = (unsigned)(4 * hi2 * YLD + r32b);
#pragma unroll
    for (int r = 0; r < 16; ++r) { const unsigned ro = eoff + (unsigned)(((r & 3) + 8 * (r >> 2)) * YLD);
#pragma unroll
        for (int d0 = 0; d0 < 4; ++d0) { bf16_t* p = Ow + (ro + d0 * 32); const bf16_t ov = f2bf(o[d0][r] * rli[r] * bf1(*p)); if (!nostore) *p = ov; } }
    __syncthreads();
#undef ATT_SLOAD
#undef ATT_SWRITE
#undef ATT_RESC
#undef ATT_QKT
}
}

__device__ __forceinline__ void phaseC(const Frame& F, const Args& a, const unsigned char* ws, const bool nostore, int l, const bf16_t* q, bf16_t* y, const bf16_t* vv, const bf16_t* kr, const bf16_t* xc, const float* agg) {
    for (int v = F.vcu; v < 256; v += F.G) { const int bh = v >> 2, s = v & 3;
        att::unit(F, nostore, bh >> 3, bh & 7, 7 - s, q, y, vv, kr);
        att::unit(F, nostore, bh >> 3, bh & 7, s, q, y, vv, kr); }
    for (int item = F.vcu; item < NBATCH * 32; item += F.G) lru_item<2>(F, a, ws, nostore, l, item, xc, y, const_cast<float*>(agg));
}

__device__ __forceinline__ void gmlp_item(const Frame& F, const Args& a, const unsigned char* ws, const bool nostore, int l, int item, const bf16_t* v1, bf16_t* y) {
    const int nb = item >> 2, g = item & 3; const size_t t0 = (size_t)nb * 128;
    int lane_ = lane_id(); asm volatile("" : "+v"(lane_));
    const int lane = lane_, w = F.wave, cl = lane & 15, kg = lane >> 4;
    LAS f32x2v* stat = (LAS f32x2v*)F.lds; LAS unsigned char* vnT = F.lds + 1024;
#pragma unroll 1
    for (int i = 0; i < 16; ++i) { const int tok = 16 * w + i; const u32x4* p = (const u32x4*)(v1 + (t0 + tok) * 1024 + lane * 16);
        const u32x4 x0 = p[0], x1 = p[1]; float s = 0.f, ss = 0.f;
#define GM_ACC(wd) do { const float f0 = bf_lo(wd), f1 = bf_hi(wd); s += f0 + f1; ss += f0 * f0 + f1 * f1; } while (0)
        GM_ACC(x0.x); GM_ACC(x0.y); GM_ACC(x0.z); GM_ACC(x0.w); GM_ACC(x1.x); GM_ACC(x1.y); GM_ACC(x1.z); GM_ACC(x1.w);
#undef GM_ACC
        s = wave_sum(s); ss = wave_sum(ss);
        const float mu = s * (1.f / 1024.f); const float var = fmaxf(ss * (1.f / 1024.f) - mu * mu, 0.f);
        if (lane == 0) stat[tok] = (f32x2v){mu, rsqrtf(var + EPS)}; }
    LDS_WAIT(); __syncthreads();
    { const f32x2v st0 = stat[2 * lane], st1 = stat[2 * lane + 1];
      const float* lg = a.in[I_GM_LN_G] + l * 1024 + g * 256; const float* lb = a.in[I_GM_LN_B] + l * 1024 + g * 256;
#pragma unroll 1
      for (int i = 0; i < 4; ++i) { const int c8 = 4 * w + i;
          const u32x4 xa = *(const u32x4*)(v1 + (t0 + 2 * lane) * 1024 + g * 256 + c8 * 8), xb = *(const u32x4*)(v1 + (t0 + 2 * lane + 1) * 1024 + g * 256 + c8 * 8);
          const unsigned wa[4] = {xa.x, xa.y, xa.z, xa.w}, wb[4] = {xb.x, xb.y, xb.z, xb.w};
#pragma unroll
          for (int e = 0; e < 8; ++e) { const float ga = lg[c8 * 8 + e], be = lb[c8 * 8 + e];
              const float fa = (e & 1) ? bf_hi(wa[e >> 1]) : bf_lo(wa[e >> 1]), fb = (e & 1) ? bf_hi(wb[e >> 1]) : bf_lo(wb[e >> 1]);
              const float na = (fa - st0.x) * st0.y * ga + be, nbv = (fb - st1.x) * st1.y * ga + be;
              *(LAS unsigned*)(vnT + (c8 * 8 + e) * 272 + lane * 4) = pk_bf16(na, nbv); } } }
    LDS_WAIT(); __syncthreads();
    bf16x8 af[2][4];
#pragma unroll
    for (int r = 0; r < 2; ++r)
#pragma unroll
        for (int ks = 0; ks < 4; ++ks) af[r][ks] = *(const LAS bf16x8*)(vnT + (16 * (2 * w + r) + cl) * 272 + (32 * ks + 8 * kg) * 2);
    const bf16_t* gmw = (const bf16_t*)(ws + WS_GMW) + (size_t)g * 128 * 128;
    const float* bs = a.in[I_GM_BS] + l * 512 + g * 128;
#pragma unroll 1
    for (int ct = 0; ct < 8; ++ct) {
        f32x4 acc[2] = {(f32x4){0.f, 0.f, 0.f, 0.f}, (f32x4){0.f, 0.f, 0.f, 0.f}};
        const int nks = (ct < 4) ? 2 : 4;
#pragma unroll
        for (int ks = 0; ks < 4; ++ks) if (ks < nks) { const bf16x8 bfr = *(const bf16x8*)(gmw + (size_t)(16 * ct + cl) * 128 + 32 * ks + 8 * kg);
            acc[0] = __builtin_amdgcn_mfma_f32_16x16x32_bf16(af[0][ks], bfr, acc[0], 0, 0, 0); acc[1] = __builtin_amdgcn_mfma_f32_16x16x32_bf16(af[1][ks], bfr, acc[1], 0, 0, 0); }
        const float bsv = bs[16 * ct + cl];
#pragma unroll
        for (int r = 0; r < 2; ++r) { bf16_t* p = y + (t0 + 16 * ct + cl) * YLD + g * 256 + 16 * (2 * w + r) + 4 * kg;
            const u32x2 pa = *(const u32x2*)p; u32x2 o;
            o.x = pk_bf16(bf_lo(pa.x) * (acc[r][0] + bsv), bf_hi(pa.x) * (acc[r][1] + bsv)); o.y = pk_bf16(bf_lo(pa.y) * (acc[r][2] + bsv), bf_hi(pa.y) * (acc[r][3] + bsv));
            if (!nostore) *(u32x2*)p = o; }
    }
    __syncthreads();
}
__device__ __forceinline__ void phaseE(const Frame& F, const Args& a, const unsigned char* ws, const bool nostore, int l, const bf16_t* v1, bf16_t* y) {
    for (int item = F.vcu; item < 512; item += F.G) gmlp_item(F, a, ws, nostore, l, item, v1, y);
}
constexpr int N_PHASES = 1 + 8 * DEPTH;
#ifndef MK_MAX_PHASE
#define MK_MAX_PHASE N_PHASES
#endif

__global__ void __launch_bounds__(NWAVES * 64, 2) mk_fwd(Args args) {
    extern __shared__ __attribute__((aligned(16))) unsigned char lds_raw[];
    Frame F;
    F.lds = (LAS unsigned char*)lds_raw;
    F.wave = __builtin_amdgcn_readfirstlane((int)threadIdx.x >> 6);
    F.G = gridDim.x; { const int bx = blockIdx.x; F.vcu = (F.G % 8 == 0) ? (bx % 8) * (F.G / 8) + bx / 8 : bx; }
    volatile LAS unsigned* MISCW = (volatile LAS unsigned*)(F.lds + MISC_OFF);
    for (int u = threadIdx.x; u < (LDS_BYTES - RING_BYTES) / 4; u += NWAVES * 64) ((LAS unsigned*)(F.lds + RING_BYTES))[u] = 0u;
    __syncthreads();
    unsigned* ctl = (unsigned*)(args.ws + WS_CTL);
    const int lo = args.ph_lo, hi = args.ph_hi, probe = args.probe;
    const bool multi = (hi - lo) > 1;
    XcdBarrier bar; bar.bar = ctl + CW_BAR; bar.x = 0; bar.st = nullptr;
    if (multi) bar = xcd_barrier_post(ctl + CW_BAR, MISCW + 8);
#define IN(k) (lo <= (k) && (k) < hi)
#define SEAM(k) do { if (IN((k) + 1)) { xcd_barrier(bar); if (probe & 256) xcd_barrier(bar); } } while (0)
#define xcd_barrier_if(c, b) do { if (c) xcd_barrier(b); } while (0)

typedef const __attribute__((address_space(4))) Args* KArgP;
#define PHASE_PTRS \
    KArgP kp = (KArgP)__builtin_amdgcn_kernarg_segment_ptr(); asm volatile("" : "+s"(kp)); Args la; \
    _Pragma("unroll") for (int i_ = 0; i_ < N_INPUTS; ++i_) la.in[i_] = kp->in[i_]; la.out = kp->out; la.ws = kp->ws; la.ph_lo = 0; la.ph_hi = 0; \
    unsigned char* ws = la.ws; asm volatile("" : "+s"(ws)); Frame Fp = F; int bid = (int)blockIdx.x; asm volatile("" : "+s"(Fp.wave), "+s"(Fp.vcu), "+s"(Fp.G), "+s"(bid)); (void)bid; \
    bf16_t* Hb = (bf16_t*)(ws + WS_H); bf16_t* Yb = (bf16_t*)(ws + WS_Y); \
    bf16_t* MISCb = (bf16_t*)(ws + WS_MISC); bf16_t* XCb = (bf16_t*)(ws + WS_XC); bf16_t* Qb = (bf16_t*)(ws + WS_Q); bf16_t* VVb = (bf16_t*)(ws + WS_VV); bf16_t* KRb = (bf16_t*)(ws + WS_KR); \
    bf16_t* V1b = (bf16_t*)(ws + WS_V1); bf16_t* Gb = (bf16_t*)(ws + WS_G); float* Ob = (float*)(ws + WS_O); \
    float* SLAB = (float*)(ws + WS_SLAB); float* AGG = (float*)(ws + WS_AGG); const float* CS = (const float*)(ws + WS_ROPE); const float* SN = CS + 2048 * 32; \
    const unsigned char* wb = ws + WS_WB; (void)Hb; (void)Yb; (void)MISCb; (void)XCb; (void)Qb; (void)VVb; (void)KRb; (void)V1b; (void)Gb; (void)Ob; (void)SLAB; (void)AGG; (void)CS; (void)SN; (void)wb;
    if (IN(0)) {
#pragma nounroll
        for (int rep = (probe & 512) ? 0 : 1; rep < 2; ++rep) { PHASE_PTRS
        convert_weights(Fp, la, ws, 0);
        rope_table(Fp, ws);
        norm_rows(Fp, false, la.in[I_X], nullptr, nullptr, nullptr, la.in[I_PRE_G], Hb);
        if (rep == 0) xcd_barrier_if(multi, bar);
        }
        SEAM(0);
    }
#pragma nounroll
    for (int l = 0; l < DEPTH; ++l) {
        const int pb = 1 + 8 * l;
        if (IN(pb + 0)) {
#pragma nounroll
            for (int rep = ((probe >> ((pb + 0 - 1) & 7)) & 1) ? 0 : 1; rep < 2; ++rep) {
            const bool nostore = (rep == 0); (void)nostore;
            PHASE_PTRS
            SchedA S; S.ord.init(64, 17, Fp.G, bid); S.A = (const char*)Hb; S.B = (const char*)(wb + WB_W1T);
            EpiA E{MISCb, XCb, Yb, SLAB};
            g8::gemm_stream(Fp.lds, Fp.wave * 64 + lane_id(), 2048u, 2048u, S, E);
            if (rep == 0) xcd_barrier_if(multi, bar);
            }
            SEAM(pb + 0);
        }
        if (IN(pb + 1)) {
#pragma nounroll
            for (int rep = ((probe >> ((pb + 1 - 1) & 7)) & 1) ? 0 : 1; rep < 2; ++rep) {
            const bool nostore = (rep == 0); (void)nostore;
            PHASE_PTRS
            SchedQKV S; S.ord.init(64, 14, Fp.G, bid); S.misc = (const char*)MISCb; S.wq = (const char*)(wb + WB_WQT); S.wkv = (const char*)(wb + WB_WKVT);
            EpiQKV E{Qb, Yb, VVb, SLAB, CS, SN};
            g8::gemm_stream(Fp.lds, Fp.wave * 64 + lane_id(), 1536u, 768u, S, E);
            phaseB_extra(Fp, la, ws, l, MISCb, KRb, XCb, AGG, CS, SN);
            if (rep == 0) xcd_barrier_if(multi, bar);
            }
            SEAM(pb + 1);
        }
        if (IN(pb + 2)) {
#pragma nounroll
            for (int rep = ((probe >> ((pb + 2 - 1) & 7)) & 1) ? 0 : 1; rep < 2; ++rep) {
            const bool nostore = (rep == 0); (void)nostore;
            PHASE_PTRS
            phaseC(Fp, la, ws, nostore, l, Qb, Yb, VVb, KRb, XCb, AGG);
            if (rep == 0) xcd_barrier_if(multi, bar);
            }
            SEAM(pb + 2);
        }
        if (IN(pb + 3)) {
#pragma nounroll
            for (int rep = ((probe >> ((pb + 3 - 1) & 7)) & 1) ? 0 : 1; rep < 2; ++rep) {
            const bool nostore = (rep == 0); (void)nostore;
            PHASE_PTRS
            SchedD S; S.ord.init(64, 24, Fp.G, bid); S.A = (const char*)Hb; S.B = (const char*)(wb + WB_W2T);
            EpiD E{Yb, V1b, Gb};
            g8::gemm_stream(Fp.lds, Fp.wave * 64 + lane_id(), 2048u, 2048u, S, E);
            if (rep == 0) xcd_barrier_if(multi, bar);
            }
            SEAM(pb + 3);
        }
        if (IN(pb + 4)) {
#pragma nounroll
            for (int rep = ((probe >> ((pb + 4 - 1) & 7)) & 1) ? 0 : 1; rep < 2; ++rep) {
            const bool nostore = (rep == 0); (void)nostore;
            PHASE_PTRS
            phaseE(Fp, la, ws, nostore, l, V1b, Yb);
            if (rep == 0) xcd_barrier_if(multi, bar);
            }
            SEAM(pb + 4);
        }
        if (IN(pb + 5)) {
#pragma nounroll
            for (int rep = ((probe >> ((pb + 5 - 1) & 7)) & 1) ? 0 : 1; rep < 2; ++rep) {
            const bool nostore = (rep == 0); (void)nostore;
            PHASE_PTRS
            SchedF S; S.ord.init(64, 4, Fp.G, bid); S.A = (const char*)Yb; S.B = (const char*)(wb + WB_WPT);
            EpiF E{Gb, Hb};
            g8::gemm_stream(Fp.lds, Fp.wave * 64 + lane_id(), (unsigned)(YLD * 2), (unsigned)(YLD * 2), S, E);
            if (rep == 0) xcd_barrier_if(multi, bar);
            }
            SEAM(pb + 5);
        }
        if (IN(pb + 6)) {
#pragma nounroll
            for (int rep = ((probe >> ((pb + 6 - 1) & 7)) & 1) ? 0 : 1; rep < 2; ++rep) {
            const bool nostore = (rep == 0); (void)nostore;
            PHASE_PTRS
            SchedG S; S.ord.init(64, 4, Fp.G, bid); S.A = (const char*)Hb; S.B = (const char*)(wb + WB_WOT);
            EpiG E{Ob};
            g8::gemm_stream(Fp.lds, Fp.wave * 64 + lane_id(), 2048u, 2048u, S, E);
            if (rep == 0) xcd_barrier_if(multi, bar);
            }
            SEAM(pb + 6);
        }
        if (IN(pb + 7)) {
#pragma nounroll
            for (int rep = ((probe >> ((pb + 7 - 1) & 7)) & 1) ? 0 : 1; rep < 2; ++rep) {
            const bool nostore = (rep == 0); (void)nostore;
            PHASE_PTRS
            const float* xin = (l == 0) ? la.in[I_X] : la.out;
            norm_rows(Fp, nostore, xin, Ob, la.in[I_POST_G] + l * DM, la.out, (l + 1 < DEPTH) ? la.in[I_PRE_G] + (l + 1) * DM : nullptr, Hb);
            if (l + 1 < DEPTH) convert_weights(Fp, la, ws, l + 1);
            if (rep == 0) xcd_barrier_if(multi, bar);
            }
            SEAM(pb + 7);
        }
    }
#undef IN
#undef SEAM
}

#ifndef MK_PROBE
#define MK_PROBE 0
#endif
#ifndef MK_PER_PHASE
#define MK_PER_PHASE 0
#endif
static int mk_setup(size_t ws_size) {
    static int grid = 0;
    if (grid == 0) {
        if (ws_size < WS_END) { fprintf(stderr, "kernel_launch: workspace too small: %zu < %zu\n", ws_size, (size_t)WS_END); grid = -1; return grid; }
        int dev = 0, cus = 0, per_cu = 0;
        if (hipGetDevice(&dev) != hipSuccess || hipDeviceGetAttribute(&cus, hipDeviceAttributeMultiprocessorCount, dev) != hipSuccess) { grid = -1; return grid; }
        if (hipFuncSetAttribute((const void*)mk_fwd, hipFuncAttributeMaxDynamicSharedMemorySize, LDS_BYTES) != hipSuccess) { fprintf(stderr, "kernel_launch: hipFuncSetAttribute failed\n"); grid = -1; return grid; }
        if (hipOccupancyMaxActiveBlocksPerMultiprocessor(&per_cu, (const void*)mk_fwd, NWAVES * 64, LDS_BYTES) != hipSuccess || per_cu < 1)
            fprintf(stderr, "kernel_launch: occupancy query reports %d blocks/CU\n", per_cu);
        (void)hipGetLastError();
        grid = cus;
        if (grid != 256) fprintf(stderr, "kernel_launch: note: %d CUs (tile schedules assume 256)\n", grid);
    }
    return grid;
}
static void mk_launch(void* const* d_in, void* d_out, void* d_ws, hipStream_t stream, int grid, int lo, int hi) {
    Args a{};
    for (int i = 0; i < N_INPUTS; ++i) a.in[i] = (const float*)d_in[i];
    a.out = (float*)d_out; a.ws = (unsigned char*)d_ws; a.ph_lo = lo; a.ph_hi = hi; a.probe = MK_PROBE; a.pad = 0;
    hipLaunchKernelGGL(mk_fwd, dim3(grid), dim3(NWAVES * 64), LDS_BYTES, stream, a);
}
extern "C" void kernel_launch(void* const* d_in, const int* in_sizes, int n_in, void* d_out, int out_size, void* d_ws, size_t ws_size, hipStream_t stream) {
    const int grid = mk_setup(ws_size); if (grid < 0) return;
    hipMemsetAsync((char*)d_ws + WS_CTL, 0, CTL_ZERO_BYTES, stream);
#if MK_PER_PHASE
    for (int ph = 0; ph < N_PHASES; ++ph) mk_launch(d_in, d_out, d_ws, stream, grid, ph, ph + 1);
#else
    mk_launch(d_in, d_out, d_ws, stream, grid, 0, N_PHASES);
#endif
}
```

```cpp
#define MK_PROBE 0
#include <hip/hip_runtime.h>
#include <cstdio>
#include <cstdint>

#define LAS __attribute__((address_space(3)))
#define GAS __attribute__((address_space(1)))
typedef unsigned short bf16_t;
typedef short bf16x8 __attribute__((ext_vector_type(8)));
typedef short s16x4 __attribute__((ext_vector_type(4)));
typedef float f32x2 __attribute__((ext_vector_type(2)));
typedef float f32x4 __attribute__((ext_vector_type(4)));
typedef float f32x16 __attribute__((ext_vector_type(16)));
typedef unsigned u32x2 __attribute__((ext_vector_type(2)));
typedef unsigned u32x4 __attribute__((ext_vector_type(4)));
typedef __bf16 bf16x2_t __attribute__((ext_vector_type(2)));

__device__ __forceinline__ unsigned pk_bf16(float lo, float hi) { f32x2 v = {lo, hi}; bf16x2_t b = __builtin_convertvector(v, bf16x2_t); return __builtin_bit_cast(unsigned, b); }
__device__ __forceinline__ float bf_lo(unsigned w) { return __uint_as_float(w << 16); }
__device__ __forceinline__ float bf_hi(unsigned w) { return __uint_as_float(w & 0xffff0000u); }
__device__ __forceinline__ float bf1(bf16_t h) { return __uint_as_float(((unsigned)h) << 16); }
__device__ __forceinline__ bf16_t f2bf(float f) { return (bf16_t)(pk_bf16(f, 0.f) & 0xffffu); }
__device__ __forceinline__ float fsigmoid(float x) { return __builtin_amdgcn_rcpf(1.f + __expf(-x)); }
__device__ __forceinline__ float fsilu(float x) { return x * __builtin_amdgcn_rcpf(1.f + __expf(-x)); }
template <int XM> __device__ __forceinline__ float sx(float v) { return __int_as_float(__builtin_amdgcn_ds_swizzle(__float_as_int(v), (XM << 10) | 0x1f)); }
__device__ __forceinline__ float xsum32(float v) { auto rr = __builtin_amdgcn_permlane32_swap(__float_as_uint(v), __float_as_uint(v), false, false); return __uint_as_float(rr[0]) + __uint_as_float(rr[1]); }
__device__ __forceinline__ float wave_sum(float v) { v += sx<1>(v); v += sx<2>(v); v += sx<4>(v); v += sx<8>(v); v += sx<16>(v); return xsum32(v); }
#define LDS_WAIT() asm volatile("s_waitcnt lgkmcnt(0)" ::: "memory")
#define VM_WAIT() asm volatile("s_waitcnt vmcnt(0)" ::: "memory")

namespace g8 {
constexpr int BM = 256, BK = 64, HALF = 128, HTB = HALF * BK * 2, STAGE_BYTES = 8 * HTB, NXCD = 8, WGM = 8;
__host__ __device__ __forceinline__ int lds_byte(int r, int c) { const int st = (r >> 4) * 2 + (c >> 5), rr = r & 15, cc = c & 31, ob = rr * 64 + cc * 2; return st * 1024 + (ob ^ (((ob >> 9) & 1) << 5)); }
__host__ __device__ __forceinline__ void stage_rc(int b, int& R, int& C) { const int st = b / 1024, sb = b % 1024, swz = sb ^ (((sb >> 9) & 1) << 5); R = (st >> 1) * 16 + swz / 64; C = (st & 1) * 32 + (swz % 64) / 2; }
__host__ __device__ __forceinline__ int perm32(int rho) { const int n = rho >> 4, i = rho & 15; return 8 * (i >> 2) + 4 * n + (i & 3); }

struct UnitD { const char* A; const char* B; int nt, pm, pn, kind; };
constexpr int KEEP_ACC = 0x100;

struct TileOrder {
    int nM, nN, nwg, G, c;
    __device__ void init(int nM_, int nN_, int G_, int c_) { nM = nM_; nN = nN_; nwg = nM * nN; G = G_; c = c_; }
    __device__ bool tile(int i, int& pm, int& pn) const {
        const long L = (long)i * G + c; if (L >= nwg) return false;
        int wgid = (int)L; { const int q = nwg / NXCD, r = nwg % NXCD, xcd = wgid % NXCD, off = wgid / NXCD; wgid = (xcd < r ? xcd * (q + 1) : r * (q + 1) + (xcd - r) * q) + off; }
        const int nig = WGM * nN, gid = wgid / nig, fm = gid * WGM, gsz = (nM - fm) < WGM ? (nM - fm) : WGM;
        pm = fm + ((wgid % nig) % gsz); pn = (wgid % nig) / gsz; return true;
    }
};

template <class Sched, class Epi>
__device__ __forceinline__ void gemm_stream(LAS unsigned char* lds, int tid_in, const unsigned lda, const unsigned ldb, const Sched& S, const Epi& E) {
    int tid_ = tid_in; asm volatile("" : "+v"(tid_));
    const int tid = tid_, wid = __builtin_amdgcn_readfirstlane(tid >> 6), lane = tid & 63, wr = wid >> 2, wc = wid & 3, fr = lane & 15, fq = lane >> 4;
    unsigned voffA[2], voffB[2];
#pragma unroll
    for (int i = 0; i < 2; ++i) { int R, C; stage_rc(tid * 16 + i * 8192, R, C); const int Rb = (R & ~31) + perm32(R & 31);
        voffA[i] = (unsigned)R * lda + (unsigned)C * 2u; voffB[i] = (unsigned)Rb * ldb + (unsigned)C * 2u; }
    const size_t kstep = (size_t)(BK * 2);
    const size_t hstepA = (size_t)HALF * lda, hstepB = (size_t)HALF * ldb;
    const unsigned ldsw = (unsigned)wid * 1024u;
    const int aoff = lds_byte(wr * 64 + fr, fq * 8), boff = lds_byte(wc * 32 + fr, fq * 8);
#define G8_SA(b, h) (((b) * 2 + (h)) * HTB)
#define G8_SB(b, h) ((4 + (b) * 2 + (h)) * HTB)
#define G8_STAGE(bufoff, gbase, voff) do { _Pragma("unroll") for (int _i = 0; _i < 2; ++_i) \
        __builtin_amdgcn_global_load_lds((const unsigned*)((const char*)(gbase) + (voff)[_i]), (LAS unsigned*)(lds + (bufoff) + ldsw + _i * 8192), 16, 0, 0); } while (0)
#define G8_LDA(dst, b, h) do { _Pragma("unroll") for (int m = 0; m < 4; ++m) _Pragma("unroll") for (int k = 0; k < 2; ++k) dst[m][k] = *(const LAS bf16x8*)(lds + G8_SA(b, h) + aoff + m * 2048 + k * 1024); } while (0)
#define G8_LDB(dst, b, h) do { _Pragma("unroll") for (int n = 0; n < 2; ++n) _Pragma("unroll") for (int k = 0; k < 2; ++k) dst[n][k] = *(const LAS bf16x8*)(lds + G8_SB(b, h) + boff + n * 2048 + k * 1024); } while (0)
#define G8_MMA(ai, bj, At, Bt) do { __builtin_amdgcn_s_setprio(1); _Pragma("unroll") for (int m = 0; m < 4; ++m) _Pragma("unroll") for (int n = 0; n < 2; ++n) _Pragma("unroll") for (int k = 0; k < 2; ++k) \
        acc[ai][bj][m][n] = __builtin_amdgcn_mfma_f32_16x16x32_bf16(Bt[n][k], At[m][k], acc[ai][bj][m][n], 0, 0, 0); __builtin_amdgcn_s_setprio(0); } while (0)
#define G8_WAIT_V(n) asm volatile("s_waitcnt vmcnt(" #n ")" ::: "memory")
#define G8_WAIT_L(n) asm volatile("s_waitcnt lgkmcnt(" #n ")" ::: "memory")
#define G8_BAR __builtin_amdgcn_s_barrier()
#define G8_SCHED __builtin_amdgcn_sched_barrier(0)
    UnitD cur, nxt; int ui = 0;
    if (!S.next(0, cur)) return;
    f32x4 acc[2][2][4][2];
#pragma unroll
    for (int a = 0; a < 2; ++a)
#pragma unroll
        for (int b = 0; b < 2; ++b)
#pragma unroll
            for (int m = 0; m < 4; ++m)
#pragma unroll
                for (int n = 0; n < 2; ++n) acc[a][b][m][n] = (f32x4){0.f, 0.f, 0.f, 0.f};
    bf16x8 At[4][2], B0[2][2], B1[2][2];
    const char* cA = cur.A; const char* cB = cur.B;
    G8_STAGE(G8_SB(0, 0), cB, voffB); G8_STAGE(G8_SB(0, 1), cB + hstepB, voffB); G8_STAGE(G8_SA(0, 0), cA, voffA); G8_STAGE(G8_SA(0, 1), cA + hstepA, voffA);
    if (wr == 1) G8_BAR;
    G8_WAIT_V(2); G8_BAR;
    G8_STAGE(G8_SB(1, 0), cB + kstep, voffB); G8_STAGE(G8_SA(1, 0), cA + kstep, voffA); G8_STAGE(G8_SB(1, 1), cB + hstepB + kstep, voffB);
    G8_WAIT_V(6); G8_BAR;
    for (;;) {
        const bool has_next = S.next(ui + 1, nxt);
        const char* nA = has_next ? nxt.A : cA; const char* nB = has_next ? nxt.B : cB;
        const int nt = cur.nt;
        for (int t = 0; t < nt; t += 2) {
            const bool last = (t == nt - 2);
            const char* a1 = cA + (size_t)(t + 1) * kstep;
            const char* a2 = last ? nA : cA + (size_t)(t + 2) * kstep; const char* b2 = last ? nB : cB + (size_t)(t + 2) * kstep;
            const char* a3 = a2 + kstep; const char* b3 = b2 + kstep;
            G8_LDB(B0, 0, 0); G8_LDB(B1, 0, 1); G8_SCHED; G8_LDA(At, 0, 0); G8_STAGE(G8_SA(1, 1), a1 + hstepA, voffA);
            G8_WAIT_V(8); G8_WAIT_L(0); G8_BAR; G8_MMA(0, 0, At, B0); G8_MMA(0, 1, At, B1); G8_BAR; G8_SCHED;
            G8_LDA(At, 0, 1); G8_STAGE(G8_SB(0, 0), b2, voffB); G8_STAGE(G8_SB(0, 1), b2 + hstepB, voffB); G8_STAGE(G8_SA(0, 0), a2, voffA);
            G8_WAIT_V(8); G8_WAIT_L(0); G8_BAR; G8_MMA(1, 0, At, B0); G8_MMA(1, 1, At, B1); G8_BAR; G8_SCHED;
            G8_LDB(B0, 1, 0); G8_LDB(B1, 1, 1); G8_SCHED; G8_LDA(At, 1, 0); G8_STAGE(G8_SA(0, 1), a2 + hstepA, voffA);
            G8_WAIT_V(8); G8_WAIT_L(0); G8_BAR; G8_MMA(0, 0, At, B0); G8_MMA(0, 1, At, B1); G8_BAR; G8_SCHED;
            G8_LDA(At, 1, 1); G8_STAGE(G8_SB(1, 0), b3, voffB); G8_STAGE(G8_SB(1, 1), b3 + hstepB, voffB); G8_STAGE(G8_SA(1, 0), a3, voffA);
            G8_WAIT_V(8); G8_WAIT_L(0); G8_BAR; G8_MMA(1, 0, At, B0); G8_MMA(1, 1, At, B1); G8_BAR; G8_SCHED;
        }
        if (wr == 0) G8_BAR;
        { UnitD eu = cur; int fr_ = fr, fq_ = fq; asm volatile("" : "+s"(eu.pm), "+s"(eu.pn), "+v"(fr_), "+v"(fq_)); E(acc, eu, wr, wc, fr_, fq_); }
        if (!has_next) break;
        if (!(cur.kind & KEEP_ACC)) {
#pragma unroll
            for (int a = 0; a < 2; ++a)
#pragma unroll
                for (int b = 0; b < 2; ++b)
#pragma unroll
                    for (int m = 0; m < 4; ++m)
#pragma unroll
                        for (int n = 0; n < 2; ++n) acc[a][b][m][n] = (f32x4){0.f, 0.f, 0.f, 0.f};
        }
        cur = nxt; cA = nA; cB = nB; ++ui;
        if (wr == 1) G8_BAR;
    }
    G8_WAIT_V(0);
    G8_BAR;
#undef G8_SA
#undef G8_SB
#undef G8_STAGE
#undef G8_LDA
#undef G8_LDB
#undef G8_MMA
#undef G8_WAIT_V
#undef G8_WAIT_L
#undef G8_BAR
#undef G8_SCHED
}
}

#define XB_TMO      128
#define XB_XCNT(j)  (256  + 64 * (j))
#define XB_XSUB(j)  (1280 + 64 * (j))
#define XB_XGEN(j)  (2304 + 64 * (j))
#define XB_TOP      3328
#define XB_TOPGEN   3392
#define XCD_BAR_WORDS 3456
#define XB_SPIN_CAP (1u << 18)
__device__ __forceinline__ unsigned xb_ld(unsigned* p)              { return __hip_atomic_load(p, __ATOMIC_RELAXED, __HIP_MEMORY_SCOPE_AGENT); }
__device__ __forceinline__ unsigned xb_add(unsigned* p, unsigned v) { return __hip_atomic_fetch_add(p, v, __ATOMIC_RELAXED, __HIP_MEMORY_SCOPE_AGENT); }
__device__ __forceinline__ unsigned xb_xcc_id() { return (unsigned)__builtin_amdgcn_s_getreg((3 << 11) | 20) & 0xFu; }
#define XB_SPIN(cond, bar) do { unsigned _sp = 0; while (cond) { __builtin_amdgcn_s_sleep(1); \
    if ((++_sp & 255u) == 0u) { if (xb_ld(&(bar)[XB_TMO])) break; if (_sp > XB_SPIN_CAP) { atomicAdd(&(bar)[XB_TMO], 1u); break; } } } } while (0)
struct XcdBarrier { unsigned* bar; unsigned x; volatile LAS unsigned* st; };
__device__ __forceinline__ XcdBarrier xcd_barrier_post(unsigned* bar, volatile LAS unsigned* st) {
    XcdBarrier b; b.bar = bar; b.x = xb_xcc_id(); b.st = st;
    if (threadIdx.x == 0) (void)xb_add(&bar[XB_XCNT(b.x)], 1u);
    return b;
}
__device__ __forceinline__ void xcd_barrier_complete(unsigned* bar, unsigned x, unsigned& nloc, unsigned& nx) {
    const unsigned G = gridDim.x * gridDim.y * gridDim.z;
    unsigned sum, cnt, mine, sp = 0u;
    for (;;) {
        sum = 0u; cnt = 0u; mine = 0u;
#pragma unroll
        for (unsigned j = 0; j < 16; ++j) { const unsigned c = xb_ld(&bar[XB_XCNT(j)]); sum += c; cnt += (c > 0u) ? 1u : 0u; mine = (j == x) ? c : mine; }
        if (sum == G) break;
        __builtin_amdgcn_s_sleep(1);
        if ((++sp & 255u) == 0u) { if (xb_ld(&bar[XB_TMO])) break; if (sp > XB_SPIN_CAP) { atomicAdd(&bar[XB_TMO], 1u); break; } }
    }
    nloc = mine > 0u ? mine : 1u; nx = cnt > 0u ? cnt : 1u;
}
__device__ __forceinline__ void xcd_barrier(const XcdBarrier& b) {
    asm volatile("s_waitcnt vmcnt(0)" ::: "memory");
    __syncthreads();
    if (threadIdx.x == 0) {
        unsigned* bar = b.bar;
        __builtin_amdgcn_s_waitcnt(0);
        unsigned nloc = b.st[0], nx = b.st[1];
        if (nloc == 0u) { xcd_barrier_complete(bar, b.x, nloc, nx); b.st[0] = nloc; b.st[1] = nx; }
        const unsigned old = xb_add(&bar[XB_XSUB(b.x)], 1u);
        const unsigned gen = old / nloc;
        if (old + 1u == (gen + 1u) * nloc) {
            __builtin_amdgcn_fence(__ATOMIC_RELEASE, "agent");
            asm volatile("s_waitcnt vmcnt(0)" ::: "memory");
            const unsigned og = xb_add(&bar[XB_TOP], 1u);
            const unsigned tg = og / nx;
            if (og + 1u == (tg + 1u) * nx) xb_add(&bar[XB_TOPGEN], 1u);
            else XB_SPIN(xb_ld(&bar[XB_TOPGEN]) == tg, bar);
            __builtin_amdgcn_fence(__ATOMIC_ACQUIRE, "agent");
            xb_add(&bar[XB_XGEN(b.x)], 1u);
            asm volatile("s_waitcnt vmcnt(0)" ::: "memory");
        } else {
            XB_SPIN(xb_ld(&bar[XB_XGEN(b.x)]) == gen, bar);
            __builtin_amdgcn_fence(__ATOMIC_ACQUIRE, "agent");
            asm volatile("s_waitcnt vmcnt(0)" ::: "memory");
        }
    }
    __syncthreads();
}
constexpr int T = 16384, DM = 1024, SEQ = 2048, NBATCH = 8, DEPTH = 2, N_IN = 10432;
constexpr int NWAVES = 8;
constexpr float EPS = 1e-6f;
constexpr size_t MiB = 1u << 20;
constexpr size_t WS_CTL = 0, CTL_ZERO_BYTES = 64 * 1024;
constexpr size_t WS_WB = 1 * MiB;
constexpr size_t WB_W1T = 0;
constexpr size_t WB_W2T = WB_W1T + (size_t)4352 * 1024 * 2;
constexpr size_t WB_WQT = WB_W2T + (size_t)6144 * 1024 * 2;
constexpr size_t WB_WKVT = WB_WQT + (size_t)1536 * 384 * 2;
constexpr size_t WB_WPT = WB_WKVT + (size_t)2048 * 384 * 2;
constexpr size_t WB_WOT = WB_WPT + (size_t)1024 * 3328 * 2;
constexpr size_t WB_END = WB_WOT + (size_t)1024 * 1024 * 2;
static_assert(WB_END <= 32 * MiB, "weights region");
constexpr size_t WS_H = 33 * MiB;
constexpr size_t WS_Y = 65 * MiB;
constexpr int YLD = 3328;
constexpr size_t WS_BIG = 169 * MiB;
constexpr size_t WS_MISC = WS_BIG;
constexpr size_t WS_XC = WS_MISC + 24 * MiB;
constexpr size_t WS_Q = WS_XC + 40 * MiB;
constexpr size_t WS_VV = WS_Q + 48 * MiB;
constexpr size_t WS_KR = WS_VV + 32 * MiB;
constexpr size_t WS_V1 = WS_BIG;
constexpr size_t WS_G = WS_V1 + 32 * MiB;
constexpr size_t WS_O = WS_BIG;
constexpr size_t WS_SMALL = 315 * MiB;
constexpr size_t WS_SLAB = WS_SMALL;
constexpr size_t WS_AGG = WS_SLAB + 1536 * 1024;
constexpr size_t WS_ROPE = WS_AGG + 2560 * 1024;
constexpr size_t WS_LW = WS_ROPE + 512 * 1024;
constexpr size_t WS_GMW = WS_LW + 480 * 1024;
constexpr size_t WS_LCT = WS_GMW + 128 * 1024;
constexpr size_t WS_END = WS_LCT + 64 * 1024;
static_assert(WS_KR + 2 * MiB <= WS_SMALL && WS_G + 96 * MiB <= WS_SMALL && WS_END <= 326 * MiB, "d_ws map");
constexpr int CW_BAR = 1024;
static_assert((CW_BAR + XCD_BAR_WORDS) * 4 <= (int)CTL_ZERO_BYTES, "ctl");
constexpr int RING_BYTES = 131072, MISC_OFF = RING_BYTES + 320, LDS_BYTES = 147456;

enum { I_X = 0, I_PRE_G, I_W_IN, I_GM_LN_G, I_GM_LN_B, I_GM_WS, I_GM_BS, I_QN_G, I_W_UQ, I_KVN_G, I_W_UKV, I_CONV_W, I_CONV_B, I_W_A, I_B_A, I_W_X, I_B_X, I_LAM,
       I_W_PA, I_W_PB, I_W_PC, I_W_OUT, I_POST_G, N_INPUTS };
struct Args { const float* in[N_INPUTS]; float* out; unsigned char* ws; int ph_lo, ph_hi, probe, pad; };

struct Frame { LAS unsigned char* lds; int wave, vcu, G; };
__device__ __forceinline__ int lane_id() { int l; asm volatile("v_mbcnt_lo_u32_b32 %0, -1, 0\n\tv_mbcnt_hi_u32_b32 %0, -1, %0" : "=v"(l)); return l; }

struct MapW1 { __device__ __forceinline__ int operator()(int j) const {
    if (j < 384) return 3072 + j; if (j < 640) return 3456 + (j - 384); if (j < 704) { const int jj = j - 640, g = jj >> 3, e = jj & 7; return 3712 + (e < 4 ? 4 * g + e : 32 + 4 * g + (e - 4)); } if (j < 768) return -1;
    if (j < 2048) return 4800 + (j - 768); if (j < 3328) return 6080 + (j - 2048); return 3776 + (j - 3328); } };
struct MapW2 { __device__ __forceinline__ int operator()(int j) const {
    if (j < 2048) { const int tl = j >> 8, lc = j & 255; return (lc < 128) ? (128 * tl + lc) : (2048 + 128 * tl + (lc - 128)); }
    if (j < 3072) return 1024 + (j - 2048); return 7360 + (j - 3072); } };
struct MapQ { __device__ __forceinline__ int operator()(int j) const {
    if (j < 1024) { const int hd = j >> 7, d = j & 127; return hd * 192 + d; }
    const int jj = j - 1024, hh = jj >> 6, w = jj & 63, g = w >> 3, e = w & 7; return hh * 192 + (e < 4 ? 128 + 4 * g + e : 160 + 4 * g + (e - 4)); } };
struct MapId { __device__ __forceinline__ int operator()(int j) const { return j; } };

template <class Map>
__device__ __forceinline__ void tr_item(const float* W, int ldw, int nkb  , bf16_t* WT, int ldt, const Map map, const float* kscale, LAS float* scr, int item, int lane) {
    const int kb = item % nkb, nb = item / nkb, k0 = 64 * kb, n0 = 32 * nb;
    const int nn = lane & 31; const int sc = map(n0 + nn);
#pragma unroll 8
    for (int i = 0; i < 32; ++i) { const int kk = 2 * i + (lane >> 5); float v = (sc >= 0) ? W[(size_t)(k0 + kk) * ldw + sc] : 0.f; if (kscale) v *= kscale[k0 + kk]; scr[kk * 33 + nn] = v; }
    LDS_WAIT(); asm volatile("" ::: "memory");
    const int c = lane & 7;
#pragma unroll
    for (int j = 0; j < 4; ++j) { const int n = (lane >> 3) + 8 * j; const LAS float* s = scr + (8 * c) * 33 + n;
        u32x4 o; o.x = pk_bf16(s[0 * 33], s[1 * 33]); o.y = pk_bf16(s[2 * 33], s[3 * 33]); o.z = pk_bf16(s[4 * 33], s[5 * 33]); o.w = pk_bf16(s[6 * 33], s[7 * 33]);
        *(u32x4*)(WT + (size_t)(n0 + n) * ldt + k0 + 8 * c) = o; }
    LDS_WAIT(); asm volatile("" ::: "memory");
}

__device__ __forceinline__ void convert_weights(const Frame& F, const Args& a, unsigned char* ws, int l) {
    const int lane = lane_id();
    LAS float* scr = (LAS float*)(F.lds + F.wave * 16384);
    const int gw = F.vcu * NWAVES + F.wave, NGW = F.G * NWAVES;
    unsigned char* wb = ws + WS_WB;
    constexpr int I1 = 16 * (4352 / 32), I2 = 16 * (6144 / 32), IQ = 6 * (1536 / 32), IKV = 4 * (2048 / 32), IPA = 16 * 32, IPB = 16 * 32, IPC = 20 * 32, IO = 16 * 32;
    constexpr int NITEMS = I1 + I2 + IQ + IKV + IPA + IPB + IPC + IO;
    const float* w_in = a.in[I_W_IN] + (size_t)l * 1024 * N_IN;
    for (int it = gw; it < NITEMS; it += NGW) {
        int r = it;
        if (r < I1) { tr_item(w_in, N_IN, 16, (bf16_t*)(wb + WB_W1T), 1024, MapW1(), nullptr, scr, r, lane); continue; } r -= I1;
        if (r < I2) { tr_item(w_in, N_IN, 16, (bf16_t*)(wb + WB_W2T), 1024, MapW2(), nullptr, scr, r, lane); continue; } r -= I2;
        if (r < IQ) { tr_item(a.in[I_W_UQ] + (size_t)l * 384 * 1536, 1536, 6, (bf16_t*)(wb + WB_WQT), 384, MapQ(), a.in[I_QN_G] + l * 384, scr, r, lane); continue; } r -= IQ;
        if (r < IKV) { tr_item(a.in[I_W_UKV] + (size_t)l * 256 * 2048, 2048, 4, (bf16_t*)(wb + WB_WKVT), 384, MapId(), a.in[I_KVN_G] + l * 256, scr, r, lane); continue; } r -= IKV;
        if (r < IPA) { tr_item(a.in[I_W_PA] + (size_t)l * 1024 * 1024, 1024, 16, (bf16_t*)(wb + WB_WPT), 3328, MapId(), nullptr, scr, r, lane); continue; } r -= IPA;
        if (r < IPB) { tr_item(a.in[I_W_PB] + (size_t)l * 1024 * 1024, 1024, 16, (bf16_t*)(wb + WB_WPT) + 1024, 3328, MapId(), nullptr, scr, r, lane); continue; } r -= IPB;
        if (r < IPC) { tr_item(a.in[I_W_PC] + (size_t)l * 1280 * 1024, 1024, 20, (bf16_t*)(wb + WB_WPT) + 2048, 3328, MapId(), nullptr, scr, r, lane); continue; } r -= IPC;
        tr_item(a.in[I_W_OUT] + (size_t)l * 1024 * 1024, 1024, 16, (bf16_t*)(wb + WB_WOT), 1024, MapId(), nullptr, scr, r, lane);
    }
    const int gt = (F.vcu * NWAVES + F.wave) * 64 + lane, NGT = F.G * NWAVES * 64;
    bf16_t* lwa = (bf16_t*)(ws + WS_LW); bf16_t* lwx = lwa + 16 * 80 * 96;
    const float* w_a = a.in[I_W_A] + (size_t)l * 16 * 80 * 80; const float* w_x = a.in[I_W_X] + (size_t)l * 16 * 80 * 80;
    for (int i = gt; i < 16 * 80 * 96; i += NGT) { const int k = i % 96, j = (i / 96) % 80, blk = i / (96 * 80);
        const float va = (k < 80) ? w_a[((size_t)blk * 80 + k) * 80 + j] : 0.f, vx = (k < 80) ? w_x[((size_t)blk * 80 + k) * 80 + j] : 0.f;
        lwa[i] = f2bf(va); lwx[i] = f2bf(vx); }
    { float* lct = (float*)(ws + WS_LCT); const float* cw = a.in[I_CONV_W] + (size_t)l * 4 * 1280;
      for (int c = gt; c < 1280; c += NGT) { f32x4 v0 = {cw[c], cw[1280 + c], cw[2560 + c], cw[3840 + c]};
          f32x4 v1 = {a.in[I_CONV_B][l * 1280 + c], a.in[I_B_A][l * 1280 + c], a.in[I_B_X][l * 1280 + c], -8.f * log1pf(expf(-a.in[I_LAM][l * 1280 + c]))};
          *(f32x4*)(lct + c * 8) = v0; *(f32x4*)(lct + c * 8 + 4) = v1; } }
    bf16_t* gmw = (bf16_t*)(ws + WS_GMW); const float* gws = a.in[I_GM_WS] + (size_t)l * 4 * 128 * 128;
    for (int i = gt; i < 4 * 128 * 128; i += NGT) { const int j = i & 127, ii = (i >> 7) & 127; gmw[i] = f2bf(((j >> 6) <= (ii >> 6)) ? gws[i] : 0.f); }
}
__device__ __forceinline__ void rope_table(const Frame& F, unsigned char* ws) {
    const int gt = (F.vcu * NWAVES + F.wave) * 64 + lane_id(), NGT = F.G * NWAVES * 64;
    float* cs = (float*)(ws + WS_ROPE); float* sn = cs + 2048 * 32;
    for (int i = gt; i < 2048 * 32; i += NGT) { const int s = i >> 5, fi = i & 31; const float inv_freq = powf(10000.f, -(float)(2 * fi) / 64.f); const float ang = (float)s * inv_freq;
        cs[i] = cosf(ang); sn[i] = sinf(ang); }
}
__device__ __forceinline__ void norm_rows(const Frame& F, const bool nostore, const float* xin, const float* o, const float* g_post, float* xout, const float* g_pre, bf16_t* h) {
    const int gw = F.vcu * NWAVES + F.wave, NGW = F.G * NWAVES; const int lane = lane_id();
    for (int m = gw; m < T; m += NGW) {
        const f32x4* xr = (const f32x4*)(xin + (size_t)m * DM) + lane;
        f32x4 v[4];
#pragma unroll
        for (int j = 0; j < 4; ++j) v[j] = xr[64 * j];
        if (o) {
            const f32x4* orow = (const f32x4*)(o + (size_t)m * DM) + lane; f32x4 ov[4]; float s = 0.f;
#pragma unroll
            for (int j = 0; j < 4; ++j) { ov[j] = orow[64 * j]; s += (ov[j].x * ov[j].x + ov[j].y * ov[j].y) + (ov[j].z * ov[j].z + ov[j].w * ov[j].w); }
            const float r = rsqrtf(wave_sum(s) * (1.f / DM) + EPS);
            f32x4* xo = (f32x4*)(xout + (size_t)m * DM) + lane;
#pragma unroll
            for (int j = 0; j < 4; ++j) { const f32x4 gp = *((const f32x4*)g_post + lane + 64 * j); v[j] = v[j] + ov[j] * r * gp; if (!nostore) xo[64 * j] = v[j]; }
        }
        if (g_pre) {
            float s = 0.f;
#pragma unroll
            for (int j = 0; j < 4; ++j) s += (v[j].x * v[j].x + v[j].y * v[j].y) + (v[j].z * v[j].z + v[j].w * v[j].w);
            const float r = rsqrtf(wave_sum(s) * (1.f / DM) + EPS);
            u32x2* ho = (u32x2*)(h + (size_t)m * DM) + lane;
#pragma unroll
            for (int j = 0; j < 4; ++j) { const f32x4 gp = *((const f32x4*)g_pre + lane + 64 * j); const f32x4 y = v[j] * r * gp; u32x2 w; w.x = pk_bf16(y.x, y.y); w.y = pk_bf16(y.z, y.w); if (!nostore) ho[64 * j] = w; }
        }
    }
}
using g8::UnitD;
constexpr float QSCALE = 0.07216878364870322f * 1.4426950408889634f;

struct SchedA {
    g8::TileOrder ord; const char* A; const char* B;
    __device__ __forceinline__ bool next(int i, UnitD& u) const { int pm, pn; if (!ord.tile(i, pm, pn)) return false;
        u.A = A + (size_t)pm * 256 * 2048; u.B = B + (size_t)pn * 256 * 2048; u.nt = 16; u.pm = pm; u.pn = pn; u.kind = 0; return true; }
};
struct EpiA {
    bf16_t* misc; bf16_t* xc; bf16_t* y; float* slab; bf16_t* kr; const float* cs; const float* sn;
    __device__ __forceinline__ void operator()(f32x4 (&acc)[2][2][4][2], const UnitD& u, int wr, int wc, int fr, int fq) const {
        const int pn = u.pn, rowp = wr * 64 + fr, lc = wc * 32 + 8 * fq;
        bf16_t* dst; int ld; bool act;
        if (pn < 3) { dst = misc + 256 * pn; ld = 768; act = false; }
        else if (pn < 8) { dst = xc + 256 * (pn - 3); ld = 1280; act = false; }
        else if (pn < 13) { dst = y + 2048 + 256 * (pn - 8); ld = YLD; act = true; }
        else { dst = y + 1024 + 256 * (pn - 13); ld = YLD; act = true; }
#pragma unroll
        for (int ai = 0; ai < 2; ++ai)
#pragma unroll
            for (int m = 0; m < 4; ++m) { const int rp = rowp + ai * 128 + m * 16; bf16_t* p = dst + ((size_t)u.pm * 256 + rp) * ld + lc;
#pragma unroll
                for (int bj = 0; bj < 2; ++bj) { f32x4 v0 = acc[ai][bj][m][0], v1 = acc[ai][bj][m][1];
                    if (pn == 2 && bj == 1) { if (wc < 2) { const int g = 4 * wc + fq; const size_t r = (size_t)u.pm * 256 + rp; const int pos = (int)(r & 2047);
                            const f32x4 c4 = *(const f32x4*)(cs + pos * 32 + 4 * g), s4 = *(const f32x4*)(sn + pos * 32 + 4 * g);
                            const f32x4 o1 = v0 * c4 - v1 * s4, o2 = v1 * c4 + v0 * s4; bf16_t* kp = kr + r * 64 + 4 * g;
                            u32x2 w1, w2; w1.x = pk_bf16(o1.x, o1.y); w1.y = pk_bf16(o1.z, o1.w); w2.x = pk_bf16(o2.x, o2.y); w2.y = pk_bf16(o2.z, o2.w);
                            *(u32x2*)kp = w1; *(u32x2*)(kp + 32) = w2; }
                        continue; }
                    if (pn < 3) { float ss = (v0.x * v0.x + v0.y * v0.y) + (v0.z * v0.z + v0.w * v0.w) + (v1.x * v1.x + v1.y * v1.y) + (v1.z * v1.z + v1.w * v1.w);
                        ss += sx<16>(ss); ss = xsum32(ss);
                        if (fq == 0) slab[(((size_t)u.pm * 6 + pn * 2 + bj) * 4 + wc) * 256 + rp] = ss; }
                    if (act) { v0.x = fsilu(v0.x); v0.y = fsilu(v0.y); v0.z = fsilu(v0.z); v0.w = fsilu(v0.w); v1.x = fsilu(v1.x); v1.y = fsilu(v1.y); v1.z = fsilu(v1.z); v1.w = fsilu(v1.w); }
                    u32x4 w; w.x = pk_bf16(v0.x, v0.y); w.y = pk_bf16(v0.z, v0.w); w.z = pk_bf16(v1.x, v1.y); w.w = pk_bf16(v1.z, v1.w);
                    *(u32x4*)(p + bj * 128) = w; } }
    }
};

struct SchedQKV {
    g8::TileOrder ord; const char* misc; const char* wq; const char* wkv;
    __device__ __forceinline__ bool next(int i, UnitD& u) const { int pm, pn; if (!ord.tile(i, pm, pn)) return false;
        u.pm = pm; u.pn = pn; u.kind = 0;
        if (pn < 6) { u.A = misc + (size_t)pm * 256 * 1536; u.B = wq + (size_t)pn * 256 * 768; u.nt = 6; }
        else { u.A = misc + (size_t)pm * 256 * 1536 + 384 * 2; u.B = wkv + (size_t)(pn - 6) * 256 * 768; u.nt = 4; }
        return true; }
};
struct EpiQKV {
    bf16_t* q; bf16_t* y; bf16_t* vv; const float* slab; const float* cs; const float* sn;
    __device__ __forceinline__ void operator()(f32x4 (&acc)[2][2][4][2], const UnitD& u, int wr, int wc, int fr, int fq) const {
        const int pn = u.pn, rowp = wr * 64 + fr, lc = wc * 32 + 8 * fq; const bool isq = pn < 6;
#pragma unroll
        for (int ai = 0; ai < 2; ++ai)
#pragma unroll
            for (int m = 0; m < 4; ++m) { const int rp = rowp + ai * 128 + m * 16; const size_t r = (size_t)u.pm * 256 + rp;
                float s = 0.f; const float* sl = slab + (size_t)u.pm * 6 * 4 * 256 + rp;
                if (isq) {
#pragma unroll
                    for (int e = 0; e < 3; ++e) { const int j = fq * 3 + e; s += sl[(size_t)((j >> 2) * 4 + (j & 3)) * 256]; }
                } else {
#pragma unroll
                    for (int e = 0; e < 2; ++e) { const int j = fq * 2 + e; s += sl[(size_t)((3 + (j >> 2)) * 4 + (j & 3)) * 256]; }
                }
                s += sx<16>(s); s = xsum32(s);
                float rs = rsqrtf(s * (isq ? (1.f / 384.f) : (1.f / 256.f)) + EPS); if (isq) rs *= QSCALE;
#pragma unroll
                for (int bj = 0; bj < 2; ++bj) { f32x4 v0 = acc[ai][bj][m][0] * rs, v1 = acc[ai][bj][m][1] * rs;
                    if (pn < 4) { const int j0 = 256 * pn + 128 * bj + lc; bf16_t* p = q + r * 1536 + (j0 >> 7) * 192 + (j0 & 127);
                        u32x4 w; w.x = pk_bf16(v0.x, v0.y); w.y = pk_bf16(v0.z, v0.w); w.z = pk_bf16(v1.x, v1.y); w.w = pk_bf16(v1.z, v1.w); *(u32x4*)p = w; }
                    else if (pn < 6) { const int jj = 256 * (pn - 4) + 128 * bj + lc, hh = jj >> 6, g = (jj & 63) >> 3; const int pos = (int)(r & 2047);
                        const f32x4 c4 = *(const f32x4*)(cs + pos * 32 + 4 * g), s4 = *(const f32x4*)(sn + pos * 32 + 4 * g);
                        const f32x4 o1 = v0 * c4 - v1 * s4, o2 = v1 * c4 + v0 * s4; bf16_t* p = q + r * 1536 + hh * 192 + 128 + 4 * g;
                        u32x2 w1, w2; w1.x = pk_bf16(o1.x, o1.y); w1.y = pk_bf16(o1.z, o1.w); w2.x = pk_bf16(o2.x, o2.y); w2.y = pk_bf16(o2.z, o2.w);
                        *(u32x2*)p = w1; *(u32x2*)(p + 32) = w2; }
                    else { const int hd = pn - 6; bf16_t* p = (bj == 0) ? (y + r * YLD + hd * 128 + lc) : (vv + r * 1024 + hd * 128 + lc);
                        u32x4 w; w.x = pk_bf16(v0.x, v0.y); w.y = pk_bf16(v0.z, v0.w); w.z = pk_bf16(v1.x, v1.y); w.w = pk_bf16(v1.z, v1.w); *(u32x4*)p = w; } } }
    }
};

struct SchedD {
    g8::TileOrder ord; const char* A; const char* B;
    __device__ __forceinline__ bool next(int i, UnitD& u) const { int pm, pn; if (!ord.tile(i, pm, pn)) return false;
        u.A = A + (size_t)pm * 256 * 2048; u.B = B + (size_t)pn * 256 * 2048; u.nt = 16; u.pm = pm; u.pn = pn; u.kind = 0; return true; }
};
struct EpiD {
    bf16_t* y; bf16_t* v1; bf16_t* g; float* vslab;
    __device__ __forceinline__ void operator()(f32x4 (&acc)[2][2][4][2], const UnitD& u, int wr, int wc, int fr, int fq) const {
        const int pn = u.pn, rowp = wr * 64 + fr, lc = wc * 32 + 8 * fq;
#pragma unroll
        for (int ai = 0; ai < 2; ++ai)
#pragma unroll
            for (int m = 0; m < 4; ++m) { const size_t r = (size_t)u.pm * 256 + rowp + ai * 128 + m * 16;
                if (pn < 8) { const f32x4 u0 = acc[ai][0][m][0], u1 = acc[ai][0][m][1], z0 = acc[ai][1][m][0], z1 = acc[ai][1][m][1];
                    u32x4 w; w.x = pk_bf16(u0.x * fsilu(z0.x), u0.y * fsilu(z0.y)); w.y = pk_bf16(u0.z * fsilu(z0.z), u0.w * fsilu(z0.w));
                    w.z = pk_bf16(u1.x * fsilu(z1.x), u1.y * fsilu(z1.y)); w.w = pk_bf16(u1.z * fsilu(z1.z), u1.w * fsilu(z1.w));
                    *(u32x4*)(y + r * YLD + 128 * pn + lc) = w; }
                else {
#pragma unroll
                    for (int bj = 0; bj < 2; ++bj) { f32x4 v0 = acc[ai][bj][m][0], v1_ = acc[ai][bj][m][1]; bf16_t* p;
                        if (pn < 12) { p = v1 + r * 1024 + 256 * (pn - 8) + 128 * bj + lc;
                            float s1 = (v0.x + v0.y) + (v0.z + v0.w) + (v1_.x + v1_.y) + (v1_.z + v1_.w);
                            float s2 = (v0.x * v0.x + v0.y * v0.y) + (v0.z * v0.z + v0.w * v0.w) + (v1_.x * v1_.x + v1_.y * v1_.y) + (v1_.z * v1_.z + v1_.w * v1_.w);
                            s1 += sx<16>(s1); s1 = xsum32(s1); s2 += sx<16>(s2); s2 = xsum32(s2);
                            if (fq == 0) *(f32x2*)(vslab + r * 64 + (((pn - 8) * 2 + bj) * 4 + wc) * 2) = (f32x2){s1, s2}; }
                        else { p = g + r * 3072 + 256 * (pn - 12) + 128 * bj + lc;
                            v0.x = fsigmoid(v0.x); v0.y = fsigmoid(v0.y); v0.z = fsigmoid(v0.z); v0.w = fsigmoid(v0.w); v1_.x = fsigmoid(v1_.x); v1_.y = fsigmoid(v1_.y); v1_.z = fsigmoid(v1_.z); v1_.w = fsigmoid(v1_.w); }
                        u32x4 w; w.x = pk_bf16(v0.x, v0.y); w.y = pk_bf16(v0.z, v0.w); w.z = pk_bf16(v1_.x, v1_.y); w.w = pk_bf16(v1_.z, v1_.w); *(u32x4*)p = w; } } }
    }
};

struct SchedF {
    g8::TileOrder ord; const char* A; const char* B;
    __device__ __forceinline__ bool next(int i, UnitD& u) const { if (i >= 3) return false; int pm, pn; if (!ord.tile(0, pm, pn)) return false;
        const size_t ko = (i == 0) ? 0 : (i == 1 ? 1024 * 2 : 2048 * 2);
        u.A = A + (size_t)pm * 256 * (YLD * 2) + ko; u.B = B + (size_t)pn * 256 * (YLD * 2) + ko; u.nt = (i == 2) ? 20 : 16; u.pm = pm; u.pn = pn; u.kind = (i < 2) ? (i | g8::KEEP_ACC) : i; return true; }
};
struct EpiF {
    const bf16_t* g; bf16_t* merged;
    __device__ __forceinline__ void operator()(f32x4 (&acc)[2][2][4][2], const UnitD& u, int wr, int wc, int fr, int fq) const {
        const int seg = u.kind & 3, rowp = wr * 64 + fr, lc = wc * 32 + 8 * fq;
#pragma unroll
        for (int ai = 0; ai < 2; ++ai)
#pragma unroll
            for (int m = 0; m < 4; ++m) { const size_t r = (size_t)u.pm * 256 + rowp + ai * 128 + m * 16;
#pragma unroll
                for (int bj = 0; bj < 2; ++bj) { const int col = 256 * u.pn + 128 * bj + lc; const bf16_t* gp = g + r * 3072 + seg * 1024 + col;
                    const u32x4 a = *(const u32x4*)gp; f32x4 f0, f1;
                    f0.x = bf_lo(a.x); f0.y = bf_hi(a.x); f0.z = bf_lo(a.y); f0.w = bf_hi(a.y); f1.x = bf_lo(a.z); f1.y = bf_hi(a.z); f1.z = bf_lo(a.w); f1.w = bf_hi(a.w);
                    if (seg < 2) { const u32x4 b = *(const u32x4*)(gp + 1024);
                        f0.x *= __builtin_amdgcn_rcpf(bf_lo(b.x)); f0.y *= __builtin_amdgcn_rcpf(bf_hi(b.x)); f0.z *= __builtin_amdgcn_rcpf(bf_lo(b.y)); f0.w *= __builtin_amdgcn_rcpf(bf_hi(b.y));
                        f1.x *= __builtin_amdgcn_rcpf(bf_lo(b.z)); f1.y *= __builtin_amdgcn_rcpf(bf_hi(b.z)); f1.z *= __builtin_amdgcn_rcpf(bf_lo(b.w)); f1.w *= __builtin_amdgcn_rcpf(bf_hi(b.w));
                        acc[ai][bj][m][0] *= f0; acc[ai][bj][m][1] *= f1; }
                    else { const f32x4 v0 = acc[ai][bj][m][0] * f0, v1 = acc[ai][bj][m][1] * f1;
                        u32x4 w; w.x = pk_bf16(v0.x, v0.y); w.y = pk_bf16(v0.z, v0.w); w.z = pk_bf16(v1.x, v1.y); w.w = pk_bf16(v1.z, v1.w);
                        *(u32x4*)(merged + r * 1024 + col) = w; } } }
    }
};

struct SchedG {
    g8::TileOrder ord; const char* A; const char* B;
    __device__ __forceinline__ bool next(int i, UnitD& u) const { int pm, pn; if (!ord.tile(i, pm, pn)) return false;
        u.A = A + (size_t)pm * 256 * 2048; u.B = B + (size_t)pn * 256 * 2048; u.nt = 16; u.pm = pm; u.pn = pn; u.kind = 0; return true; }
};
struct EpiG {
    float* o;
    __device__ __forceinline__ void operator()(f32x4 (&acc)[2][2][4][2], const UnitD& u, int wr, int wc, int fr, int fq) const {
        const int rowp = wr * 64 + fr, lc = wc * 32 + 8 * fq;
#pragma unroll
        for (int ai = 0; ai < 2; ++ai)
#pragma unroll
            for (int m = 0; m < 4; ++m) { float* p = o + ((size_t)u.pm * 256 + rowp + ai * 128 + m * 16) * 1024 + 256 * u.pn + lc;
#pragma unroll
                for (int bj = 0; bj < 2; ++bj) { *(f32x4*)(p + bj * 128) = acc[ai][bj][m][0]; *(f32x4*)(p + bj * 128 + 4) = acc[ai][bj][m][1]; } }
    }
};
typedef float f32x2v __attribute__((ext_vector_type(2)));

constexpr int LRU_HIN_OFF = RING_BYTES + 1024;
template <int PASS>
__device__ __forceinline__ void lru_item(const Frame& F, const Args& a, const unsigned char* ws, const bool nostore, int l, int item, const bf16_t* xcb, bf16_t* y, float* agg) {
    const int b = item >> 5, k = item & 31; const size_t r0 = (size_t)b * SEQ + (size_t)k * 64;
    int lane_ = lane_id(); asm volatile("" : "+v"(lane_));
    const int lane = lane_, cl = lane & 15, kg = lane >> 4;
    LAS unsigned char* xt = F.lds + F.wave * 16384;
    const bf16_t* lwa = (const bf16_t*)(ws + WS_LW); const bf16_t* lwx = lwa + 16 * 80 * 96;
    const float* lct = (const float*)(ws + WS_LCT);
    LAS float* hin_l = (LAS float*)(F.lds + LRU_HIN_OFF);
    if (PASS == 2) {
        for (int c = F.wave * 64 + lane; c < 1280; c += 512) { const float* ag = agg + ((size_t)b * 32 * 1280 + c) * 2; float h = 0.f;
#pragma unroll 8
            for (int j = 0; j < k; ++j) { const f32x2v ab = *(const f32x2v*)(ag + (size_t)j * 2560); h = ab.x * h + ab.y; }
            hin_l[c] = h; }
        LDS_WAIT(); __syncthreads();
    }
#pragma unroll 1
    for (int bi = 0; bi < 2; ++bi) {
        const int blk = 2 * F.wave + bi;
        {
            u32x4 xch[11]; int ln = lane; asm volatile("" : "+v"(ln));
            const bf16_t* xbase = xcb + (r0 - 3) * 1280 + blk * 80;
#pragma unroll
            for (int i = 0; i < 11; ++i) { const int idx = ln + 64 * i; const int row = idx / 10, ch = idx - row * 10; xch[i] = (u32x4){0u, 0u, 0u, 0u};
                if (idx < 670 && !(k == 0 && row < 3)) xch[i] = *(const u32x4*)(xbase + (unsigned)(row * 1280 + ch * 8)); }
#pragma unroll
            for (int i = 0; i < 11; ++i) { const int idx = ln + 64 * i; const int row = idx / 10, ch = idx - row * 10; if (idx < 670) *(LAS u32x4*)(xt + row * 208 + ch * 16) = xch[i]; }
            LAS u32x4* z = (LAS u32x4*)(xt + (lane + 3) * 208 + 160); z[0] = (u32x4){0u, 0u, 0u, 0u}; z[1] = (u32x4){0u, 0u, 0u, 0u};
        }
        LDS_WAIT(); asm volatile("" ::: "memory");
#pragma unroll
        for (int ct = 0; ct < 5; ++ct) { const int c = blk * 80 + 16 * ct + cl; const f32x4 cw = *(const f32x4*)(lct + c * 8); const float cb = lct[c * 8 + 4];
            float xv[4][7];
#pragma unroll
            for (int rt = 0; rt < 4; ++rt)
#pragma unroll
                for (int j = 0; j < 7; ++j) xv[rt][j] = bf1(*(const LAS bf16_t*)(xt + (16 * rt + 4 * kg + j) * 208 + (16 * ct + cl) * 2));
            asm volatile("" ::: "memory");
#pragma unroll
            for (int rt = 0; rt < 4; ++rt)
#pragma unroll
                for (int e = 0; e < 4; ++e) { const float v = cb + cw.x * xv[rt][e] + cw.y * xv[rt][e + 1] + cw.z * xv[rt][e + 2] + cw.w * xv[rt][e + 3];
                    *(LAS bf16_t*)(xt + (16 * rt + 4 * kg + e + 3) * 208 + (16 * ct + cl) * 2) = f2bf(v); }
            asm volatile("" ::: "memory"); }
        LDS_WAIT(); asm volatile("" ::: "memory");
        bf16x8 af[4][3];
#pragma unroll
        for (int rt = 0; rt < 4; ++rt)
#pragma unroll
            for (int ks = 0; ks < 3; ++ks) af[rt][ks] = *(const LAS bf16x8*)(xt + (16 * rt + cl + 3) * 208 + (32 * ks + 8 * kg) * 2);
        bf16x8 wA[2][3], wX[2][3];
#pragma unroll
        for (int ks = 0; ks < 3; ++ks) { const size_t wo = ((size_t)blk * 80 + cl) * 96 + 32 * ks + 8 * kg; wA[0][ks] = *(const bf16x8*)(lwa + wo); wX[0][ks] = *(const bf16x8*)(lwx + wo); }
#pragma unroll
        for (int ct = 0; ct < 5; ++ct) { const int c = blk * 80 + 16 * ct + cl; const int cur = ct & 1;
            if (ct + 1 < 5) {
#pragma unroll
                for (int ks = 0; ks < 3; ++ks) { const size_t wo = ((size_t)blk * 80 + 16 * (ct + 1) + cl) * 96 + 32 * ks + 8 * kg; wA[cur ^ 1][ks] = *(const bf16x8*)(lwa + wo); wX[cur ^ 1][ks] = *(const bf16x8*)(lwx + wo); } }
            const f32x4 c1 = *(const f32x4*)(lct + c * 8 + 4); const float ba_c = c1.y, bx_c = c1.z, sp8 = c1.w;
            float zv[4][4];
            if (PASS == 2) {
#pragma unroll
                for (int rt = 0; rt < 4; ++rt)
#pragma unroll
                    for (int e = 0; e < 4; ++e) zv[rt][e] = bf1(y[(r0 + 16 * rt + 4 * kg + e) * YLD + 2048 + c]); }
            f32x4 ra[4], rx[4];
#pragma unroll
            for (int rt = 0; rt < 4; ++rt) { ra[rt] = (f32x4){0.f, 0.f, 0.f, 0.f}; rx[rt] = (f32x4){0.f, 0.f, 0.f, 0.f}; }
#pragma unroll
            for (int ks = 0; ks < 3; ++ks)
#pragma unroll
                for (int rt = 0; rt < 4; ++rt) { ra[rt] = __builtin_amdgcn_mfma_f32_16x16x32_bf16(af[rt][ks], wA[cur][ks], ra[rt], 0, 0, 0); rx[rt] = __builtin_amdgcn_mfma_f32_16x16x32_bf16(af[rt][ks], wX[cur][ks], rx[rt], 0, 0, 0); }
            float hin = (PASS == 2) ? hin_l[c] : 0.f; float totA = 1.f, totB = 0.f;
#pragma unroll
            for (int rt = 0; rt < 4; ++rt) { float av[4], bv[4];
#pragma unroll
                for (int e = 0; e < 4; ++e) { const float r = fsigmoid(ra[rt][e] + ba_c), ig = fsigmoid(rx[rt][e] + bx_c);
                    const float aa = __expf(sp8 * r); const float mult = sqrtf(fmaxf(1.f - aa * aa, 0.f));
                    const float xcv = bf1(*(const LAS bf16_t*)(xt + (16 * rt + 4 * kg + e + 3) * 208 + (16 * ct + cl) * 2));
                    av[e] = aa; bv[e] = mult * ig * xcv; }
                float sA = av[0], sB = bv[0];
#pragma unroll
                for (int e = 1; e < 4; ++e) { sB = av[e] * sB + bv[e]; sA *= av[e]; }
                float iA = sA, iB = sB;
                { const float pA = __shfl(iA, lane - 16), pB = __shfl(iB, lane - 16); if (kg >= 1) { iB = iA * pB + iB; iA = iA * pA; } }
                { const float pA = __shfl(iA, lane - 32), pB = __shfl(iB, lane - 32); if (kg >= 2) { iB = iA * pB + iB; iA = iA * pA; } }
                const float tA = __shfl(iA, 48 + cl), tB = __shfl(iB, 48 + cl);
                if (PASS == 1) { totB = tA * totB + tB; totA *= tA; }
                else {
                    float eA = __shfl(iA, lane - 16), eB = __shfl(iB, lane - 16); if (kg == 0) { eA = 1.f; eB = 0.f; }
                    float h = eA * hin + eB;
                    bf16_t* yp = y + (r0 + 16 * rt + 4 * kg) * YLD + 2048 + c;
#pragma unroll
                    for (int e = 0; e < 4; ++e) { h = av[e] * h + bv[e]; if (!nostore) yp[(size_t)e * YLD] = f2bf(h * zv[rt][e]); }
                    hin = tA * hin + tB;
                }
            }
            if (PASS == 1) { if (kg == 0) *(f32x2v*)(agg + (((size_t)b * 32 + k) * 1280 + c) * 2) = (f32x2v){totA, totB}; }
        }
        LDS_WAIT(); asm volatile("" ::: "memory");
    }
    if (PASS == 2) __syncthreads();
}

__device__ __forceinline__ void phaseB_extra(const Frame& F, const Args& a, const unsigned char* ws, int l, const bf16_t* misc, bf16_t* kr, const bf16_t* xc, float* agg, const float* cs, const float* sn) {
    for (int item = F.vcu; item < NBATCH * 32; item += F.G) lru_item<1>(F, a, ws, false, l, item, xc, nullptr, agg);
}

namespace att {
constexpr int SHM_V = 64 * 128 * 2, SHM_K = 64 * 192 * 2, OFF_K = 2 * SHM_V, OFF_WS = OFF_K + 2 * SHM_K, LDS_TOTAL = OFF_WS + 8 * 64 * 4;
constexpr float THR = 8.f;
constexpr float NEGBIG = -1e30f;
constexpr int KVBLK_ = 64;
#define ATT_SBAR() __builtin_amdgcn_sched_barrier(0)
__device__ __forceinline__ int crow(int r, int hi) { return (r & 3) + 8 * (r >> 2) + 4 * hi; }
__device__ __forceinline__ int koff(int row, int sub, int chunk) { return sub * 8192 + row * 128 + ((chunk ^ ((row >> 1) & 7)) << 4); }
__device__ __forceinline__ void partialSM(f32x16& p0, f32x16& p1, float& m_reg, float& alpha) {
    float pmax = p0[0];
#pragma unroll
    for (int r = 1; r < 16; ++r) pmax = fmaxf(pmax, p0[r]);
#pragma unroll
    for (int r = 0; r < 16; ++r) pmax = fmaxf(pmax, p1[r]);
    { auto rr = __builtin_amdgcn_permlane32_swap(__float_as_uint(pmax), __float_as_uint(pmax), false, false); pmax = fmaxf(__uint_as_float(rr[0]), __uint_as_float(rr[1])); }
    float mn;
    if (__builtin_expect(__all(pmax - m_reg <= THR), 1)) { mn = m_reg; alpha = 1.f; }
    else { mn = fmaxf(m_reg, pmax); alpha = __builtin_amdgcn_exp2f(m_reg - mn); m_reg = mn; }
#pragma unroll
    for (int r = 0; r < 16; ++r) p0[r] = __builtin_amdgcn_exp2f(p0[r] - mn);
#pragma unroll
    for (int r = 0; r < 16; ++r) p1[r] = p1[r] - mn;
}
__device__ __forceinline__ void finishSM(f32x16& p0, f32x16& p1, float alpha, float& l_reg, bf16x8& pa0, bf16x8& pa1, bf16x8& pa2, bf16x8& pa3) {
#pragma unroll
    for (int r = 0; r < 16; ++r) p1[r] = __builtin_amdgcn_exp2f(p1[r]);
    float ps = 0.f;
#pragma unroll
    for (int r = 0; r < 16; ++r) ps += p0[r];
#pragma unroll
    for (int r = 0; r < 16; ++r) ps += p1[r];
    { auto rr = __builtin_amdgcn_permlane32_swap(__float_as_uint(ps), __float_as_uint(ps), false, false); ps = __uint_as_float(rr[0]) + __uint_as_float(rr[1]); }
    l_reg = l_reg * alpha + ps;
#define ATT_PK4(P, BASE, OUT) do { unsigned a0 = pk_bf16(P[BASE + 0], P[BASE + 1]), a1 = pk_bf16(P[BASE + 2], P[BASE + 3]);   \
    unsigned b0 = pk_bf16(P[BASE + 4], P[BASE + 5]), b1 = pk_bf16(P[BASE + 6], P[BASE + 7]);                              \
    auto r0 = __builtin_amdgcn_permlane32_swap(a0, b0, false, false); auto r1 = __builtin_amdgcn_permlane32_swap(a1, b1, false, false); \
    u32x4 w = {r0[0], r1[0], r0[1], r1[1]}; OUT = __builtin_bit_cast(bf16x8, w); } while (0)
    ATT_PK4(p0, 0, pa0); ATT_PK4(p0, 8, pa1); ATT_PK4(p1, 0, pa2); ATT_PK4(p1, 8, pa3);
#undef ATT_PK4
}
__device__ __forceinline__ void qkt(f32x16& p0, f32x16& p1, const LAS unsigned char* Ks, const bf16x8* qr, int r32, int hi) {
    p0 = f32x16{}; p1 = f32x16{};
#pragma unroll
    for (int d0 = 0; d0 < 12; ++d0) { const int sub = d0 >> 2, chunk = (d0 & 3) * 2 + hi;
        const bf16x8 b0 = *(const LAS bf16x8*)(Ks + koff(r32, sub, chunk));
        const bf16x8 b1 = *(const LAS bf16x8*)(Ks + koff(32 + r32, sub, chunk));
        p0 = __builtin_amdgcn_mfma_f32_32x32x16_bf16(b0, qr[d0], p0, 0, 0, 0);
        p1 = __builtin_amdgcn_mfma_f32_32x32x16_bf16(b1, qr[d0], p1, 0, 0, 0);
        if ((d0 & 3) == 3) ATT_SBAR(); }
}
__device__ __forceinline__ int v_st(int k, int c) { const int kk = (k & ~0xC) | ((k & 4) << 1) | ((k & 8) >> 1); return ((kk >> 3) * 4 + (c >> 5)) * 512 + ((kk & 7) * 32 + (c & 31)) * 2; }
__device__ __forceinline__ int v_rd_base(int lane) { return ((lane & 3) << 3) | (((lane >> 2) & 3) << 6) | (((lane >> 4) & 1) << 5) | (((lane >> 5) & 1) << 8); }
constexpr int v_rd_off(int d0, int ks, int half) { return d0 * 512 + ks * 4096 + half * 2048; }
template <int OFF> __device__ __forceinline__ s16x4 tr_read(int vb) { s16x4 r; asm volatile("ds_read_b64_tr_b16 %0, %1 offset:%2" : "=&v"(r) : "v"(vb), "i"(OFF) : "memory"); return r; }
template <int D0> __device__ __forceinline__ void pv_one(f32x16& od, int vb, bf16x8 pa0, bf16x8 pa1, bf16x8 pa2, bf16x8 pa3) {
    const s16x4 l0 = tr_read<v_rd_off(D0, 0, 0)>(vb), h0 = tr_read<v_rd_off(D0, 0, 1)>(vb), l1 = tr_read<v_rd_off(D0, 1, 0)>(vb), h1 = tr_read<v_rd_off(D0, 1, 1)>(vb);
    const s16x4 l2 = tr_read<v_rd_off(D0, 2, 0)>(vb), h2 = tr_read<v_rd_off(D0, 2, 1)>(vb), l3 = tr_read<v_rd_off(D0, 3, 0)>(vb), h3 = tr_read<v_rd_off(D0, 3, 1)>(vb);
    asm volatile("s_waitcnt lgkmcnt(0)" ::: "memory"); ATT_SBAR();
#define ATT_PK(L, H) (bf16x8){L[0], L[1], L[2], L[3], H[0], H[1], H[2], H[3]}
    od = __builtin_amdgcn_mfma_f32_32x32x16_bf16(pa0, ATT_PK(l0, h0), od, 0, 0, 0);
    od = __builtin_amdgcn_mfma_f32_32x32x16_bf16(pa1, ATT_PK(l1, h1), od, 0, 0, 0);
    od = __builtin_amdgcn_mfma_f32_32x32x16_bf16(pa2, ATT_PK(l2, h2), od, 0, 0, 0);
    od = __builtin_amdgcn_mfma_f32_32x32x16_bf16(pa3, ATT_PK(l3, h3), od, 0, 0, 0);
#undef ATT_PK
}
__device__ __forceinline__ void pv_d0(f32x16* o, int vb, bf16x8 pa0, bf16x8 pa1, bf16x8 pa2, bf16x8 pa3) {
    pv_one<0>(o[0], vb, pa0, pa1, pa2, pa3); pv_one<1>(o[1], vb, pa0, pa1, pa2, pa3); pv_one<2>(o[2], vb, pa0, pa1, pa2, pa3); pv_one<3>(o[3], vb, pa0, pa1, pa2, pa3);
}

__device__ __forceinline__ void unit(const Frame& F, const bool nostore, int b, int hd, int qb, const bf16_t* __restrict__ Q, bf16_t* Y, const bf16_t* __restrict__ VV, const bf16_t* __restrict__ KR) {
    int tid_ = F.wave * 64 + lane_id(); asm volatile("" : "+v"(tid_));
    const int tid = tid_, wid = F.wave, lane = tid & 63, r32 = lane & 31, hi = lane >> 5;
    LAS unsigned char* lds = F.lds;
    LAS unsigned char* V_lds = lds; LAS unsigned char* K_lds = lds + OFF_K;
    LAS float* wsf = (LAS float*)(lds + OFF_WS) + wid * 64; LAS float* li_l = wsf; LAS float* al_l = wsf + 32;
    const size_t rowbase = (size_t)b * SEQ; const int q0 = qb * 256; const int qc = 4 * qb + (wid >> 1); const int NT = 4 * qb + 4;
    float m_reg = NEGBIG, l_reg = 0.f; f32x16 o[4] = {}; bf16x8 qr[12];
    { const bf16_t* Qw = Q + (rowbase + q0 + wid * 32 + r32) * 1536 + hd * 192 + hi * 8;
#pragma unroll
      for (int d0 = 0; d0 < 12; ++d0) qr[d0] = *(const bf16x8*)(Qw + d0 * 16); }
    const bf16_t* Kn = Y + rowbase * YLD + hd * 128; const bf16_t* Vh = VV + rowbase * 1024 + hd * 128; const bf16_t* Kr = KR + rowbase * 64;
    const int sr = tid >> 4, sc = (tid & 15) * 8; const int vst0 = v_st(sr, sc), vst1 = v_st(32 + sr, sc);
    const int kst0 = koff(sr, sc >> 6, (sc & 63) >> 3), kst1 = koff(32 + sr, sc >> 6, (sc & 63) >> 3), kst2 = koff(tid >> 3, 2, tid & 7);
    const int vb0 = (int)(uintptr_t)V_lds + v_rd_base(lane);
    bf16x8 vs0, vs1, ks0, ks1, ks2;
#define ATT_SLOAD(k0) do { vs0 = *(const bf16x8*)(Vh + (size_t)((k0) + sr) * 1024 + sc); vs1 = *(const bf16x8*)(Vh + (size_t)((k0) + 32 + sr) * 1024 + sc); \
    ks0 = *(const bf16x8*)(Kn + (size_t)((k0) + sr) * YLD + sc); ks1 = *(const bf16x8*)(Kn + (size_t)((k0) + 32 + sr) * YLD + sc); \
    ks2 = *(const bf16x8*)(Kr + (size_t)((k0) + (tid >> 3)) * 64 + (tid & 7) * 8); } while (0)
#define ATT_SWRITE(bf) do { *(LAS bf16x8*)(V_lds + (bf) * SHM_V + vst0) = vs0; *(LAS bf16x8*)(V_lds + (bf) * SHM_V + vst1) = vs1; \
    *(LAS bf16x8*)(K_lds + (bf) * SHM_K + kst0) = ks0; *(LAS bf16x8*)(K_lds + (bf) * SHM_K + kst1) = ks1; *(LAS bf16x8*)(K_lds + (bf) * SHM_K + kst2) = ks2; } while (0)
#define ATT_RESC(al) do { if (__any((al) < 1.f)) { if (hi == 0) al_l[r32] = (al); asm volatile("s_waitcnt lgkmcnt(0)" ::: "memory"); \
    _Pragma("unroll") for (int d = 0; d < 4; ++d) _Pragma("unroll") for (int r = 0; r < 16; ++r) o[d][r] *= al_l[crow(r, hi)]; } } while (0)
#define ATT_QKT(P0, P1, bf, jt) do { if ((jt) <= qc) qkt(P0, P1, K_lds + (bf) * SHM_K, qr, r32, hi); else { _Pragma("unroll") for (int r = 0; r < 16; ++r) { P0[r] = NEGBIG; P1[r] = NEGBIG; } } } while (0)
    f32x16 pA0, pA1, pB0, pB1; float alA, alB; bf16x8 pa0, pa1, pa2, pa3;
    ATT_SLOAD(0); asm volatile("s_waitcnt vmcnt(0)" ::: "memory"); ATT_SWRITE(0); __syncthreads();
    ATT_QKT(pA0, pA1, 0, 0); partialSM(pA0, pA1, m_reg, alA);
    ATT_SLOAD(KVBLK_); asm volatile("s_waitcnt vmcnt(0)" ::: "memory"); ATT_SWRITE(1); __syncthreads();
    for (int j = 1; j + 1 < NT; j += 2) {
        ATT_SBAR(); ATT_QKT(pB0, pB1, 1, j);
        finishSM(pA0, pA1, alA, l_reg, pa0, pa1, pa2, pa3); ATT_SBAR();
        ATT_SLOAD((j + 1) * KVBLK_); ATT_SBAR();
        pv_d0(o, vb0, pa0, pa1, pa2, pa3); partialSM(pB0, pB1, m_reg, alB);
        __syncthreads(); asm volatile("s_waitcnt vmcnt(0)" ::: "memory"); ATT_SWRITE(0);
        ATT_RESC(alB); __syncthreads();
        ATT_SBAR(); ATT_QKT(pA0, pA1, 0, j + 1);
        finishSM(pB0, pB1, alB, l_reg, pa0, pa1, pa2, pa3); ATT_SBAR();
        ATT_SLOAD((j + 2) * KVBLK_); ATT_SBAR();
        pv_d0(o, vb0 + SHM_V, pa0, pa1, pa2, pa3); partialSM(pA0, pA1, m_reg, alA);
        __syncthreads(); asm volatile("s_waitcnt vmcnt(0)" ::: "memory"); ATT_SWRITE(1);
        ATT_RESC(alA); __syncthreads();
    }
    ATT_SBAR(); ATT_QKT(pB0, pB1, 1, NT - 1);
    finishSM(pA0, pA1, alA, l_reg, pa0, pa1, pa2, pa3); ATT_SBAR();
    pv_d0(o, vb0, pa0, pa1, pa2, pa3); partialSM(pB0, pB1, m_reg, alB);
    __syncthreads(); ATT_RESC(alB);
    finishSM(pB0, pB1, alB, l_reg, pa0, pa1, pa2, pa3); ATT_SBAR();
    pv_d0(o, vb0 + SHM_V, pa0, pa1, pa2, pa3);
    if (hi == 0) li_l[r32] = l_reg; asm volatile("s_waitcnt lgkmcnt(0)" ::: "memory");
    float rli[16];
#pragma unroll
    for (int r = 0; r < 16; ++r) rli[r] = __builtin_amdgcn_rcpf(li_l[crow(r, hi)]);
    bf16_t* Ow = Y + (rowbase + q0 + wid * 32) * YLD + 1024 + hd * 128;
    int hi2 = hi, r32b = r32; asm volatile("" : "+v"(hi2), "+v"(r32b));
    const unsigned eoff = (unsigned)(4 * hi2 * YLD + r32b);
#pragma unroll
    for (int r = 0; r < 16; ++r) { const unsigned ro = eoff + (unsigned)(((r & 3) + 8 * (r >> 2)) * YLD);
#pragma unroll
        for (int d0 = 0; d0 < 4; ++d0) { bf16_t* p = Ow + (ro + d0 * 32); const bf16_t ov = f2bf(o[d0][r] * rli[r] * bf1(*p)); if (!nostore) *p = ov; } }
    __syncthreads();
#undef ATT_SLOAD
#undef ATT_SWRITE
#undef ATT_RESC
#undef ATT_QKT
}
}

__device__ __forceinline__ void phaseC_att(const Frame& F, const bool nostore, const bf16_t* q, bf16_t* y, const bf16_t* vv, const bf16_t* kr) {
    for (int v = F.vcu; v < 256; v += F.G) { const int bh = v >> 2, s = v & 3;
        att::unit(F, nostore, bh >> 3, bh & 7, 7 - s, q, y, vv, kr);
        att::unit(F, nostore, bh >> 3, bh & 7, s, q, y, vv, kr); }
}
__device__ __forceinline__ void phaseC_lru(const Frame& F, const Args& a, const unsigned char* ws, const bool nostore, int l, bf16_t* y, const bf16_t* xc, const float* agg) {
    for (int item = F.vcu; item < NBATCH * 32; item += F.G) lru_item<2>(F, a, ws, nostore, l, item, xc, y, const_cast<float*>(agg));
}

__device__ __forceinline__ void gmlp_item(const Frame& F, const Args& a, const unsigned char* ws, const bool nostore, int l, int item, const bf16_t* v1, bf16_t* y, const float* vslab) {
    const int nb = item >> 2, g = item & 3; const size_t t0 = (size_t)nb * 128;
    int lane_ = lane_id(); asm volatile("" : "+v"(lane_));
    const int lane = lane_, w = F.wave, cl = lane & 15, kg = lane >> 4;
    LAS f32x2v* stat = (LAS f32x2v*)F.lds; LAS unsigned char* vnT = F.lds + 1024;
    { float pv[16];
#pragma unroll
      for (int i = 0; i < 16; ++i) pv[i] = vslab[(t0 + 16 * w + i) * 64 + lane];
#pragma unroll
      for (int i = 0; i < 16; ++i) { float v = pv[i]; v += sx<2>(v); v += sx<4>(v); v += sx<8>(v); v += sx<16>(v); v = xsum32(v);
          const float o = sx<1>(v);
          const float mu = v * (1.f / 1024.f); const float var = fmaxf(o * (1.f / 1024.f) - mu * mu, 0.f);
          if (lane == 0) stat[16 * w + i] = (f32x2v){mu, rsqrtf(var + EPS)}; } }
    LDS_WAIT(); __syncthreads();
    { const f32x2v st0 = stat[2 * lane], st1 = stat[2 * lane + 1];
      const float* lg = a.in[I_GM_LN_G] + l * 1024 + g * 256; const float* lb = a.in[I_GM_LN_B] + l * 1024 + g * 256;
      u32x4 xa[4], xb[4];
#pragma unroll
      for (int i = 0; i < 4; ++i) { const int c8 = 4 * w + i; xa[i] = *(const u32x4*)(v1 + (t0 + 2 * lane) * 1024 + g * 256 + c8 * 8); xb[i] = *(const u32x4*)(v1 + (t0 + 2 * lane + 1) * 1024 + g * 256 + c8 * 8); }
#pragma unroll
      for (int i = 0; i < 4; ++i) { const int c8 = 4 * w + i;
          const f32x4 g0 = *(const f32x4*)(lg + c8 * 8), g1 = *(const f32x4*)(lg + c8 * 8 + 4), b0 = *(const f32x4*)(lb + c8 * 8), b1 = *(const f32x4*)(lb + c8 * 8 + 4);
          const float ga[8] = {g0.x, g0.y, g0.z, g0.w, g1.x, g1.y, g1.z, g1.w}, be[8] = {b0.x, b0.y, b0.z, b0.w, b1.x, b1.y, b1.z, b1.w};
          const unsigned wa[4] = {xa[i].x, xa[i].y, xa[i].z, xa[i].w}, wb[4] = {xb[i].x, xb[i].y, xb[i].z, xb[i].w};
#pragma unroll
          for (int e = 0; e < 8; ++e) {
              const float fa = (e & 1) ? bf_hi(wa[e >> 1]) : bf_lo(wa[e >> 1]), fb = (e & 1) ? bf_hi(wb[e >> 1]) : bf_lo(wb[e >> 1]);
              const float na = (fa - st0.x) * st0.y * ga[e] + be[e], nbv = (fb - st1.x) * st1.y * ga[e] + be[e];
              *(LAS unsigned*)(vnT + (c8 * 8 + e) * 272 + lane * 4) = pk_bf16(na, nbv); } } }
    const bf16_t* gmw = (const bf16_t*)(ws + WS_GMW) + (size_t)g * 128 * 128;
    const float* bs = a.in[I_GM_BS] + l * 512 + g * 128;
    bf16_t* ybase = y + t0 * YLD + g * 256 + 16 * (2 * w) + 4 * kg;
    u32x2 pa[8][2]; float bsv[8];
#pragma unroll
    for (int ct = 0; ct < 8; ++ct) { bsv[ct] = bs[16 * ct + cl];
#pragma unroll
        for (int r = 0; r < 2; ++r) pa[ct][r] = *(const u32x2*)(ybase + (unsigned)((16 * ct + cl) * YLD + 16 * r)); }
    bf16x8 wf[2][4];
#pragma unroll
    for (int ks = 0; ks < 2; ++ks) wf[0][ks] = *(const bf16x8*)(gmw + (size_t)cl * 128 + 32 * ks + 8 * kg);
    LDS_WAIT(); __syncthreads();
    bf16x8 af[2][4];
#pragma unroll
    for (int r = 0; r < 2; ++r)
#pragma unroll
        for (int ks = 0; ks < 4; ++ks) af[r][ks] = *(const LAS bf16x8*)(vnT + (16 * (2 * w + r) + cl) * 272 + (32 * ks + 8 * kg) * 2);
#pragma unroll
    for (int ct = 0; ct < 8; ++ct) { const int cur = ct & 1;
        if (ct + 1 < 8) {
#pragma unroll
            for (int ks = 0; ks < 4; ++ks) if (ks < ((ct + 1 < 4) ? 2 : 4)) wf[cur ^ 1][ks] = *(const bf16x8*)(gmw + (size_t)(16 * (ct + 1) + cl) * 128 + 32 * ks + 8 * kg); }
        f32x4 acc[2] = {(f32x4){0.f, 0.f, 0.f, 0.f}, (f32x4){0.f, 0.f, 0.f, 0.f}};
#pragma unroll
        for (int ks = 0; ks < 4; ++ks) if (ks < ((ct < 4) ? 2 : 4)) {
            acc[0] = __builtin_amdgcn_mfma_f32_16x16x32_bf16(af[0][ks], wf[cur][ks], acc[0], 0, 0, 0); acc[1] = __builtin_amdgcn_mfma_f32_16x16x32_bf16(af[1][ks], wf[cur][ks], acc[1], 0, 0, 0); }
#pragma unroll
        for (int r = 0; r < 2; ++r) { u32x2 o; const u32x2 p_ = pa[ct][r];
            o.x = pk_bf16(bf_lo(p_.x) * (acc[r][0] + bsv[ct]), bf_hi(p_.x) * (acc[r][1] + bsv[ct])); o.y = pk_bf16(bf_lo(p_.y) * (acc[r][2] + bsv[ct]), bf_hi(p_.y) * (acc[r][3] + bsv[ct]));
            if (!nostore) *(u32x2*)(ybase + (unsigned)((16 * ct + cl) * YLD + 16 * r)) = o; }
    }
    __syncthreads();
}
__device__ __forceinline__ void phaseE(const Frame& F, const Args& a, const unsigned char* ws, const bool nostore, int l, const bf16_t* v1, bf16_t* y, const float* vslab) {
    for (int item = F.vcu; item < 512; item += F.G) gmlp_item(F, a, ws, nostore, l, item, v1, y, vslab);
}
constexpr int N_PHASES = 1 + 8 * DEPTH;
#ifndef MK_MAX_PHASE
#define MK_MAX_PHASE N_PHASES
#endif

__global__ void __launch_bounds__(NWAVES * 64, 2) mk_fwd(Args args) {
    extern __shared__ __attribute__((aligned(16))) unsigned char lds_raw[];
    Frame F;
    F.lds = (LAS unsigned char*)lds_raw;
    F.wave = __builtin_amdgcn_readfirstlane((int)threadIdx.x >> 6);
    F.G = gridDim.x; { const int bx = blockIdx.x; F.vcu = (F.G % 8 == 0) ? (bx % 8) * (F.G / 8) + bx / 8 : bx; }
    volatile LAS unsigned* MISCW = (volatile LAS unsigned*)(F.lds + MISC_OFF);
    for (int u = threadIdx.x; u < (LDS_BYTES - RING_BYTES) / 4; u += NWAVES * 64) ((LAS unsigned*)(F.lds + RING_BYTES))[u] = 0u;
    __syncthreads();
    unsigned* ctl = (unsigned*)(args.ws + WS_CTL);
    const int lo = args.ph_lo, hi = args.ph_hi, probe = args.probe;
    const bool multi = (hi - lo) > 1;
    XcdBarrier bar; bar.bar = ctl + CW_BAR; bar.x = 0; bar.st = nullptr;
    if (multi) bar = xcd_barrier_post(ctl + CW_BAR, MISCW + 8);
#define IN(k) (lo <= (k) && (k) < hi)
#define SEAM(k) do { if (IN((k) + 1)) { xcd_barrier(bar); if (probe & 256) xcd_barrier(bar); } } while (0)
#define xcd_barrier_if(c, b) do { if (c) xcd_barrier(b); } while (0)

typedef const __attribute__((address_space(4))) Args* KArgP;
#define PHASE_PTRS \
    KArgP kp = (KArgP)__builtin_amdgcn_kernarg_segment_ptr(); asm volatile("" : "+s"(kp)); Args la; \
    _Pragma("unroll") for (int i_ = 0; i_ < N_INPUTS; ++i_) la.in[i_] = kp->in[i_]; la.out = kp->out; la.ws = kp->ws; la.ph_lo = 0; la.ph_hi = 0; \
    unsigned char* ws = la.ws; asm volatile("" : "+s"(ws)); Frame Fp = F; int bid = (int)blockIdx.x; asm volatile("" : "+s"(Fp.wave), "+s"(Fp.vcu), "+s"(Fp.G), "+s"(bid)); (void)bid; \
    bf16_t* Hb = (bf16_t*)(ws + WS_H); bf16_t* Yb = (bf16_t*)(ws + WS_Y); \
    bf16_t* MISCb = (bf16_t*)(ws + WS_MISC); bf16_t* XCb = (bf16_t*)(ws + WS_XC); bf16_t* Qb = (bf16_t*)(ws + WS_Q); bf16_t* VVb = (bf16_t*)(ws + WS_VV); bf16_t* KRb = (bf16_t*)(ws + WS_KR); \
    bf16_t* V1b = (bf16_t*)(ws + WS_V1); bf16_t* Gb = (bf16_t*)(ws + WS_G); float* Ob = (float*)(ws + WS_O); \
    float* SLAB = (float*)(ws + WS_SLAB); float* AGG = (float*)(ws + WS_AGG); const float* CS = (const float*)(ws + WS_ROPE); const float* SN = CS + 2048 * 32; \
    const unsigned char* wb = ws + WS_WB; (void)Hb; (void)Yb; (void)MISCb; (void)XCb; (void)Qb; (void)VVb; (void)KRb; (void)V1b; (void)Gb; (void)Ob; (void)SLAB; (void)AGG; (void)CS; (void)SN; (void)wb;
    if (IN(0)) {
#pragma nounroll
        for (int rep = (probe & 512) ? 0 : 1; rep < 2; ++rep) { PHASE_PTRS
        convert_weights(Fp, la, ws, 0);
        rope_table(Fp, ws);
        norm_rows(Fp, false, la.in[I_X], nullptr, nullptr, nullptr, la.in[I_PRE_G], Hb);
        if (rep == 0) xcd_barrier_if(multi, bar);
        }
        SEAM(0);
    }
#pragma nounroll
    for (int l = 0; l < DEPTH; ++l) {
        const int pb = 1 + 8 * l;
        if (IN(pb + 0)) {
#pragma nounroll
            for (int rep = ((probe >> ((pb + 0 - 1) & 7)) & 1) ? 0 : 1; rep < 2; ++rep) {
            const bool nostore = (rep == 0); (void)nostore;
            PHASE_PTRS
            SchedA S; S.ord.init(64, 17, Fp.G, bid); S.A = (const char*)Hb; S.B = (const char*)(wb + WB_W1T);
            EpiA E{MISCb, XCb, Yb, SLAB, KRb, CS, SN};
            g8::gemm_stream(Fp.lds, Fp.wave * 64 + lane_id(), 2048u, 2048u, S, E);
            if (rep == 0) xcd_barrier_if(multi, bar);
            }
            SEAM(pb + 0);
        }
        if (IN(pb + 1)) {
#pragma nounroll
            for (int rep = ((probe >> ((pb + 1 - 1) & 7)) & 1) ? 0 : 1; rep < 2; ++rep) {
            const bool nostore = (rep == 0); (void)nostore;
            PHASE_PTRS
            SchedQKV S; S.ord.init(64, 14, Fp.G, bid); S.misc = (const char*)MISCb; S.wq = (const char*)(wb + WB_WQT); S.wkv = (const char*)(wb + WB_WKVT);
            EpiQKV E{Qb, Yb, VVb, SLAB, CS, SN};
            g8::gemm_stream(Fp.lds, Fp.wave * 64 + lane_id(), 1536u, 768u, S, E);
            if (probe & 1024) { xcd_barrier_if(multi, bar); g8::gemm_stream(Fp.lds, Fp.wave * 64 + lane_id(), 1536u, 768u, S, E); }
            phaseB_extra(Fp, la, ws, l, MISCb, KRb, XCb, AGG, CS, SN);
            if (probe & 2048) { xcd_barrier_if(multi, bar); phaseB_extra(Fp, la, ws, l, MISCb, KRb, XCb, AGG, CS, SN); }
            if (rep == 0) xcd_barrier_if(multi, bar);
            }
            SEAM(pb + 1);
        }
        if (IN(pb + 2)) {
#pragma nounroll
            for (int rep = ((probe >> ((pb + 2 - 1) & 7)) & 1) ? 0 : 1; rep < 2; ++rep) {
            const bool nostore = (rep == 0); (void)nostore;
            PHASE_PTRS
            if (probe & 4096) { phaseC_att(Fp, true, Qb, Yb, VVb, KRb); xcd_barrier_if(multi, bar); }
            if (probe & 8192) { phaseC_lru(Fp, la, ws, true, l, Yb, XCb, AGG); xcd_barrier_if(multi, bar); }
            phaseC_att(Fp, nostore, Qb, Yb, VVb, KRb);
            phaseC_lru(Fp, la, ws, nostore, l, Yb, XCb, AGG);
            if (rep == 0) xcd_barrier_if(multi, bar);
            }
            SEAM(pb + 2);
        }
        if (IN(pb + 3)) {
#pragma nounroll
            for (int rep = ((probe >> ((pb + 3 - 1) & 7)) & 1) ? 0 : 1; rep < 2; ++rep) {
            const bool nostore = (rep == 0); (void)nostore;
            PHASE_PTRS
            SchedD S; S.ord.init(64, 24, Fp.G, bid); S.A = (const char*)Hb; S.B = (const char*)(wb + WB_W2T);
            EpiD E{Yb, V1b, Gb, SLAB};
            g8::gemm_stream(Fp.lds, Fp.wave * 64 + lane_id(), 2048u, 2048u, S, E);
            if (rep == 0) xcd_barrier_if(multi, bar);
            }
            SEAM(pb + 3);
        }
        if (IN(pb + 4)) {
#pragma nounroll
            for (int rep = ((probe >> ((pb + 4 - 1) & 7)) & 1) ? 0 : 1; rep < 2; ++rep) {
            const bool nostore = (rep == 0); (void)nostore;
            PHASE_PTRS
            phaseE(Fp, la, ws, nostore, l, V1b, Yb, SLAB);
            if (rep == 0) xcd_barrier_if(multi, bar);
            }
            SEAM(pb + 4);
        }
        if (IN(pb + 5)) {
#pragma nounroll
            for (int rep = ((probe >> ((pb + 5 - 1) & 7)) & 1) ? 0 : 1; rep < 2; ++rep) {
            const bool nostore = (rep == 0); (void)nostore;
            PHASE_PTRS
            SchedF S; S.ord.init(64, 4, Fp.G, bid); S.A = (const char*)Yb; S.B = (const char*)(wb + WB_WPT);
            EpiF E{Gb, Hb};
            g8::gemm_stream(Fp.lds, Fp.wave * 64 + lane_id(), (unsigned)(YLD * 2), (unsigned)(YLD * 2), S, E);
            if (rep == 0) xcd_barrier_if(multi, bar);
            }
            SEAM(pb + 5);
        }
        if (IN(pb + 6)) {
#pragma nounroll
            for (int rep = ((probe >> ((pb + 6 - 1) & 7)) & 1) ? 0 : 1; rep < 2; ++rep) {
            const bool nostore = (rep == 0); (void)nostore;
            PHASE_PTRS
            SchedG S; S.ord.init(64, 4, Fp.G, bid); S.A = (const char*)Hb; S.B = (const char*)(wb + WB_WOT);
            EpiG E{Ob};
            g8::gemm_stream(Fp.lds, Fp.wave * 64 + lane_id(), 2048u, 2048u, S, E);
            if (rep == 0) xcd_barrier_if(multi, bar);
            }
            SEAM(pb + 6);
        }
        if (IN(pb + 7)) {
#pragma nounroll
            for (int rep = ((probe >> ((pb + 7 - 1) & 7)) & 1) ? 0 : 1; rep < 2; ++rep) {
            const bool nostore = (rep == 0); (void)nostore;
            PHASE_PTRS
            const float* xin = (l == 0) ? la.in[I_X] : la.out;
            norm_rows(Fp, nostore, xin, Ob, la.in[I_POST_G] + l * DM, la.out, (l + 1 < DEPTH) ? la.in[I_PRE_G] + (l + 1) * DM : nullptr, Hb);
            if (l + 1 < DEPTH) convert_weights(Fp, la, ws, l + 1);
            if (rep == 0) xcd_barrier_if(multi, bar);
            }
            SEAM(pb + 7);
        }
    }
#undef IN
#undef SEAM
}

#ifndef MK_PROBE
#define MK_PROBE 0
#endif
#ifndef MK_PER_PHASE
#define MK_PER_PHASE 0
#endif
static int mk_setup(size_t ws_size) {
    static int grid = 0;
    if (grid == 0) {
        if (ws_size < WS_END) { fprintf(stderr, "kernel_launch: workspace too small: %zu < %zu\n", ws_size, (size_t)WS_END); grid = -1; return grid; }
        int dev = 0, cus = 0, per_cu = 0;
        if (hipGetDevice(&dev) != hipSuccess || hipDeviceGetAttribute(&cus, hipDeviceAttributeMultiprocessorCount, dev) != hipSuccess) { grid = -1; return grid; }
        if (hipFuncSetAttribute((const void*)mk_fwd, hipFuncAttributeMaxDynamicSharedMemorySize, LDS_BYTES) != hipSuccess) { fprintf(stderr, "kernel_launch: hipFuncSetAttribute failed\n"); grid = -1; return grid; }
        if (hipOccupancyMaxActiveBlocksPerMultiprocessor(&per_cu, (const void*)mk_fwd, NWAVES * 64, LDS_BYTES) != hipSuccess || per_cu < 1)
            fprintf(stderr, "kernel_launch: occupancy query reports %d blocks/CU\n", per_cu);
        (void)hipGetLastError();
        grid = cus;
        if (grid != 256) fprintf(stderr, "kernel_launch: note: %d CUs (tile schedules assume 256)\n", grid);
    }
    return grid;
}
static void mk_launch(void* const* d_in, void* d_out, void* d_ws, hipStream_t stream, int grid, int lo, int hi) {
    Args a{};
    for (int i = 0; i < N_INPUTS; ++i) a.in[i] = (const float*)d_in[i];
    a.out = (float*)d_out; a.ws = (unsigned char*)d_ws; a.ph_lo = lo; a.ph_hi = hi; a.probe = MK_PROBE; a.pad = 0;
    hipLaunchKernelGGL(mk_fwd, dim3(grid), dim3(NWAVES * 64), LDS_BYTES, stream, a);
}
extern "C" void kernel_launch(void* const* d_in, const int* in_sizes, int n_in, void* d_out, int out_size, void* d_ws, size_t ws_size, hipStream_t stream) {
    const int grid = mk_setup(ws_size); if (grid < 0) return;
    hipMemsetAsync((char*)d_ws + WS_CTL, 0, CTL_ZERO_BYTES, stream);
#if MK_PER_PHASE
    for (int ph = 0; ph < N_PHASES; ++ph) mk_launch(d_in, d_out, d_ws, stream, grid, ph, ph + 1);
#else
    mk_launch(d_in, d_out, d_ws, stream, grid, 0, N_PHASES);
#endif
}
```

```cpp
#define MK_PROBE 0
#include <hip/hip_runtime.h>
#include <cstdio>
#include <cstdint>

#define LAS __attribute__((address_space(3)))
#define GAS __attribute__((address_space(1)))
typedef unsigned short bf16_t;
typedef short bf16x8 __attribute__((ext_vector_type(8)));
typedef short s16x4 __attribute__((ext_vector_type(4)));
typedef float f32x2 __attribute__((ext_vector_type(2)));
typedef float f32x4 __attribute__((ext_vector_type(4)));
typedef float f32x16 __attribute__((ext_vector_type(16)));
typedef unsigned u32x2 __attribute__((ext_vector_type(2)));
typedef unsigned u32x4 __attribute__((ext_vector_type(4)));
typedef __bf16 bf16x2_t __attribute__((ext_vector_type(2)));

__device__ __forceinline__ unsigned pk_bf16(float lo, float hi) { f32x2 v = {lo, hi}; bf16x2_t b = __builtin_convertvector(v, bf16x2_t); return __builtin_bit_cast(unsigned, b); }
__device__ __forceinline__ float bf_lo(unsigned w) { return __uint_as_float(w << 16); }
__device__ __forceinline__ float bf_hi(unsigned w) { return __uint_as_float(w & 0xffff0000u); }
__device__ __forceinline__ float bf1(bf16_t h) { return __uint_as_float(((unsigned)h) << 16); }
__device__ __forceinline__ bf16_t f2bf(float f) { return (bf16_t)(pk_bf16(f, 0.f) & 0xffffu); }
__device__ __forceinline__ float fsigmoid(float x) { return __builtin_amdgcn_rcpf(1.f + __expf(-x)); }
__device__ __forceinline__ float fsilu(float x) { return x * __builtin_amdgcn_rcpf(1.f + __expf(-x)); }
template <int XM> __device__ __forceinline__ float sx(float v) { return __int_as_float(__builtin_amdgcn_ds_swizzle(__float_as_int(v), (XM << 10) | 0x1f)); }
__device__ __forceinline__ float xsum32(float v) { auto rr = __builtin_amdgcn_permlane32_swap(__float_as_uint(v), __float_as_uint(v), false, false); return __uint_as_float(rr[0]) + __uint_as_float(rr[1]); }
__device__ __forceinline__ float wave_sum(float v) { v += sx<1>(v); v += sx<2>(v); v += sx<4>(v); v += sx<8>(v); v += sx<16>(v); return xsum32(v); }
#define LDS_WAIT() asm volatile("s_waitcnt lgkmcnt(0)" ::: "memory")
#define VM_WAIT() asm volatile("s_waitcnt vmcnt(0)" ::: "memory")

namespace g8 {
constexpr int BM = 256, BK = 64, HALF = 128, HTB = HALF * BK * 2, STAGE_BYTES = 8 * HTB, NXCD = 8, WGM = 8;
__host__ __device__ __forceinline__ int lds_byte(int r, int c) { const int st = (r >> 4) * 2 + (c >> 5), rr = r & 15, cc = c & 31, ob = rr * 64 + cc * 2; return st * 1024 + (ob ^ (((ob >> 9) & 1) << 5)); }
__host__ __device__ __forceinline__ void stage_rc(int b, int& R, int& C) { const int st = b / 1024, sb = b % 1024, swz = sb ^ (((sb >> 9) & 1) << 5); R = (st >> 1) * 16 + swz / 64; C = (st & 1) * 32 + (swz % 64) / 2; }
__host__ __device__ __forceinline__ int perm32(int rho) { const int n = rho >> 4, i = rho & 15; return 8 * (i >> 2) + 4 * n + (i & 3); }

struct UnitD { const char* A; const char* B; int nt, pm, pn, kind; };
constexpr int KEEP_ACC = 0x100;

struct TileOrder {
    int nM, nN, nwg, G, c;
    __device__ void init(int nM_, int nN_, int G_, int c_) { nM = nM_; nN = nN_; nwg = nM * nN; G = G_; c = c_; }
    __device__ bool tile(int i, int& pm, int& pn) const {
        const long L = (long)i * G + c; if (L >= nwg) return false;
        int wgid = (int)L; { const int q = nwg / NXCD, r = nwg % NXCD, xcd = wgid % NXCD, off = wgid / NXCD; wgid = (xcd < r ? xcd * (q + 1) : r * (q + 1) + (xcd - r) * q) + off; }
        const int nig = WGM * nN, gid = wgid / nig, fm = gid * WGM, gsz = (nM - fm) < WGM ? (nM - fm) : WGM;
        pm = fm + ((wgid % nig) % gsz); pn = (wgid % nig) / gsz; return true;
    }
};

template <class Sched, class Epi>
__device__ __forceinline__ void gemm_stream(LAS unsigned char* lds, int tid_in, const unsigned lda, const unsigned ldb, const Sched& S, const Epi& E) {
    int tid_ = tid_in; asm volatile("" : "+v"(tid_));
    const int tid = tid_, wid = __builtin_amdgcn_readfirstlane(tid >> 6), lane = tid & 63, wr = wid >> 2, wc = wid & 3, fr = lane & 15, fq = lane >> 4;
    unsigned voffA[2], voffB[2];
#pragma unroll
    for (int i = 0; i < 2; ++i) { int R, C; stage_rc(tid * 16 + i * 8192, R, C); const int Rb = (R & ~31) + perm32(R & 31);
        voffA[i] = (unsigned)R * lda + (unsigned)C * 2u; voffB[i] = (unsigned)Rb * ldb + (unsigned)C * 2u; }
    const size_t kstep = (size_t)(BK * 2);
    const size_t hstepA = (size_t)HALF * lda, hstepB = (size_t)HALF * ldb;
    const unsigned ldsw = (unsigned)wid * 1024u;
    const int aoff = lds_byte(wr * 64 + fr, fq * 8), boff = lds_byte(wc * 32 + fr, fq * 8);
#define G8_SA(b, h) (((b) * 2 + (h)) * HTB)
#define G8_SB(b, h) ((4 + (b) * 2 + (h)) * HTB)
#define G8_STAGE(bufoff, gbase, voff) do { _Pragma("unroll") for (int _i = 0; _i < 2; ++_i) \
        __builtin_amdgcn_global_load_lds((const unsigned*)((const char*)(gbase) + (voff)[_i]), (LAS unsigned*)(lds + (bufoff) + ldsw + _i * 8192), 16, 0, 0); } while (0)
#define G8_LDA(dst, b, h) do { _Pragma("unroll") for (int m = 0; m < 4; ++m) _Pragma("unroll") for (int k = 0; k < 2; ++k) dst[m][k] = *(const LAS bf16x8*)(lds + G8_SA(b, h) + aoff + m * 2048 + k * 1024); } while (0)
#define G8_LDB(dst, b, h) do { _Pragma("unroll") for (int n = 0; n < 2; ++n) _Pragma("unroll") for (int k = 0; k < 2; ++k) dst[n][k] = *(const LAS bf16x8*)(lds + G8_SB(b, h) + boff + n * 2048 + k * 1024); } while (0)
#define G8_MMA(ai, bj, At, Bt) do { __builtin_amdgcn_s_setprio(1); _Pragma("unroll") for (int m = 0; m < 4; ++m) _Pragma("unroll") for (int n = 0; n < 2; ++n) _Pragma("unroll") for (int k = 0; k < 2; ++k) \
        acc[ai][bj][m][n] = __builtin_amdgcn_mfma_f32_16x16x32_bf16(Bt[n][k], At[m][k], acc[ai][bj][m][n], 0, 0, 0); __builtin_amdgcn_s_setprio(0); } while (0)
#define G8_WAIT_V(n) asm volatile("s_waitcnt vmcnt(" #n ")" ::: "memory")
#define G8_WAIT_L(n) asm volatile("s_waitcnt lgkmcnt(" #n ")" ::: "memory")
#define G8_BAR __builtin_amdgcn_s_barrier()
#define G8_SCHED __builtin_amdgcn_sched_barrier(0)
    UnitD cur, nxt; int ui = 0;
    if (!S.next(0, cur)) return;
    f32x4 acc[2][2][4][2];
#pragma unroll
    for (int a = 0; a < 2; ++a)
#pragma unroll
        for (int b = 0; b < 2; ++b)
#pragma unroll
            for (int m = 0; m < 4; ++m)
#pragma unroll
                for (int n = 0; n < 2; ++n) acc[a][b][m][n] = (f32x4){0.f, 0.f, 0.f, 0.f};
    bf16x8 At[4][2], B0[2][2], B1[2][2];
    const char* cA = cur.A; const char* cB = cur.B;
    G8_STAGE(G8_SB(0, 0), cB, voffB); G8_STAGE(G8_SB(0, 1), cB + hstepB, voffB); G8_STAGE(G8_SA(0, 0), cA, voffA); G8_STAGE(G8_SA(0, 1), cA + hstepA, voffA);
    if (wr == 1) G8_BAR;
    G8_WAIT_V(2); G8_BAR;
    G8_STAGE(G8_SB(1, 0), cB + kstep, voffB); G8_STAGE(G8_SA(1, 0), cA + kstep, voffA); G8_STAGE(G8_SB(1, 1), cB + hstepB + kstep, voffB);
    G8_WAIT_V(6); G8_BAR;
    for (;;) {
        const bool has_next = S.next(ui + 1, nxt);
        const char* nA = has_next ? nxt.A : cA; const char* nB = has_next ? nxt.B : cB;
        const int nt = cur.nt;
        for (int t = 0; t < nt; t += 2) {
            const bool last = (t == nt - 2);
            const char* a1 = cA + (size_t)(t + 1) * kstep;
            const char* a2 = last ? nA : cA + (size_t)(t + 2) * kstep; const char* b2 = last ? nB : cB + (size_t)(t + 2) * kstep;
            const char* a3 = a2 + kstep; const char* b3 = b2 + kstep;
            G8_LDB(B0, 0, 0); G8_LDB(B1, 0, 1); G8_SCHED; G8_LDA(At, 0, 0); G8_STAGE(G8_SA(1, 1), a1 + hstepA, voffA);
            G8_WAIT_V(8); G8_WAIT_L(0); G8_BAR; G8_MMA(0, 0, At, B0); G8_MMA(0, 1, At, B1); G8_BAR; G8_SCHED;
            G8_LDA(At, 0, 1); G8_STAGE(G8_SB(0, 0), b2, voffB); G8_STAGE(G8_SB(0, 1), b2 + hstepB, voffB); G8_STAGE(G8_SA(0, 0), a2, voffA);
            G8_WAIT_V(8); G8_WAIT_L(0); G8_BAR; G8_MMA(1, 0, At, B0); G8_MMA(1, 1, At, B1); G8_BAR; G8_SCHED;
            G8_LDB(B0, 1, 0); G8_LDB(B1, 1, 1); G8_SCHED; G8_LDA(At, 1, 0); G8_STAGE(G8_SA(0, 1), a2 + hstepA, voffA);
            G8_WAIT_V(8); G8_WAIT_L(0); G8_BAR; G8_MMA(0, 0, At, B0); G8_MMA(0, 1, At, B1); G8_BAR; G8_SCHED;
            G8_LDA(At, 1, 1); G8_STAGE(G8_SB(1, 0), b3, voffB); G8_STAGE(G8_SB(1, 1), b3 + hstepB, voffB); G8_STAGE(G8_SA(1, 0), a3, voffA);
            G8_WAIT_V(8); G8_WAIT_L(0); G8_BAR; G8_MMA(1, 0, At, B0); G8_MMA(1, 1, At, B1); G8_BAR; G8_SCHED;
        }
        if (wr == 0) G8_BAR;
        { UnitD eu = cur; int fr_ = fr, fq_ = fq; asm volatile("" : "+s"(eu.pm), "+s"(eu.pn), "+v"(fr_), "+v"(fq_)); E(acc, eu, wr, wc, fr_, fq_); }
        if (!has_next) break;
        if (!(cur.kind & KEEP_ACC)) {
#pragma unroll
            for (int a = 0; a < 2; ++a)
#pragma unroll
                for (int b = 0; b < 2; ++b)
#pragma unroll
                    for (int m = 0; m < 4; ++m)
#pragma unroll
                        for (int n = 0; n < 2; ++n) acc[a][b][m][n] = (f32x4){0.f, 0.f, 0.f, 0.f};
        }
        cur = nxt; cA = nA; cB = nB; ++ui;
        if (wr == 1) G8_BAR;
    }
    G8_WAIT_V(0);
    G8_BAR;
#undef G8_SA
#undef G8_SB
#undef G8_STAGE
#undef G8_LDA
#undef G8_LDB
#undef G8_MMA
#undef G8_WAIT_V
#undef G8_WAIT_L
#undef G8_BAR
#undef G8_SCHED
}
}

#define XB_TMO      128
#define XB_XCNT(j)  (256  + 64 * (j))
#define XB_XSUB(j)  (1280 + 64 * (j))
#define XB_XGEN(j)  (2304 + 64 * (j))
#define XB_TOP      3328
#define XB_TOPGEN   3392
#define XCD_BAR_WORDS 3456
#define XB_SPIN_CAP (1u << 18)
__device__ __forceinline__ unsigned xb_ld(unsigned* p)              { return __hip_atomic_load(p, __ATOMIC_RELAXED, __HIP_MEMORY_SCOPE_AGENT); }
__device__ __forceinline__ unsigned xb_add(unsigned* p, unsigned v) { return __hip_atomic_fetch_add(p, v, __ATOMIC_RELAXED, __HIP_MEMORY_SCOPE_AGENT); }
__device__ __forceinline__ unsigned xb_xcc_id() { return (unsigned)__builtin_amdgcn_s_getreg((3 << 11) | 20) & 0xFu; }
#define XB_SPIN(cond, bar) do { unsigned _sp = 0; while (cond) { __builtin_amdgcn_s_sleep(1); \
    if ((++_sp & 255u) == 0u) { if (xb_ld(&(bar)[XB_TMO])) break; if (_sp > XB_SPIN_CAP) { atomicAdd(&(bar)[XB_TMO], 1u); break; } } } } while (0)
struct XcdBarrier { unsigned* bar; unsigned x; volatile LAS unsigned* st; };
__device__ __forceinline__ XcdBarrier xcd_barrier_post(unsigned* bar, volatile LAS unsigned* st) {
    XcdBarrier b; b.bar = bar; b.x = xb_xcc_id(); b.st = st;
    if (threadIdx.x == 0) (void)xb_add(&bar[XB_XCNT(b.x)], 1u);
    return b;
}
__device__ __forceinline__ void xcd_barrier_complete(unsigned* bar, unsigned x, unsigned& nloc, unsigned& nx) {
    const unsigned G = gridDim.x * gridDim.y * gridDim.z;
    unsigned sum, cnt, mine, sp = 0u;
    for (;;) {
        sum = 0u; cnt = 0u; mine = 0u;
#pragma unroll
        for (unsigned j = 0; j < 16; ++j) { const unsigned c = xb_ld(&bar[XB_XCNT(j)]); sum += c; cnt += (c > 0u) ? 1u : 0u; mine = (j == x) ? c : mine; }
        if (sum == G) break;
        __builtin_amdgcn_s_sleep(1);
        if ((++sp & 255u) == 0u) { if (xb_ld(&bar[XB_TMO])) break; if (sp > XB_SPIN_CAP) { atomicAdd(&bar[XB_TMO], 1u); break; } }
    }
    nloc = mine > 0u ? mine : 1u; nx = cnt > 0u ? cnt : 1u;
}
__device__ __forceinline__ void xcd_barrier(const XcdBarrier& b) {
    asm volatile("s_waitcnt vmcnt(0)" ::: "memory");
    __syncthreads();
    if (threadIdx.x == 0) {
        unsigned* bar = b.bar; unsigned bx = b.x; asm volatile("" : "+s"(bar), "+s"(bx));
        __builtin_amdgcn_s_waitcnt(0);
        unsigned nloc = b.st[0], nx = b.st[1];
        if (nloc == 0u) { xcd_barrier_complete(bar, bx, nloc, nx); b.st[0] = nloc; b.st[1] = nx; }
        const unsigned old = xb_add(&bar[XB_XSUB(bx)], 1u);
        const unsigned gen = old / nloc;
        if (old + 1u == (gen + 1u) * nloc) {
            __builtin_amdgcn_fence(__ATOMIC_RELEASE, "agent");
            asm volatile("s_waitcnt vmcnt(0)" ::: "memory");
            const unsigned og = xb_add(&bar[XB_TOP], 1u);
            const unsigned tg = og / nx;
            if (og + 1u == (tg + 1u) * nx) xb_add(&bar[XB_TOPGEN], 1u);
            else XB_SPIN(xb_ld(&bar[XB_TOPGEN]) == tg, bar);
            __builtin_amdgcn_fence(__ATOMIC_ACQUIRE, "agent");
            xb_add(&bar[XB_XGEN(bx)], 1u);
            asm volatile("s_waitcnt vmcnt(0)" ::: "memory");
        } else {
            XB_SPIN(xb_ld(&bar[XB_XGEN(bx)]) == gen, bar);
            __builtin_amdgcn_fence(__ATOMIC_ACQUIRE, "agent");
            asm volatile("s_waitcnt vmcnt(0)" ::: "memory");
        }
    }
    __syncthreads();
}
constexpr int T = 16384, DM = 1024, SEQ = 2048, NBATCH = 8, DEPTH = 2, N_IN = 10432;
constexpr int NWAVES = 8;
constexpr float EPS = 1e-6f;
constexpr size_t MiB = 1u << 20;
constexpr size_t WS_CTL = 0, CTL_ZERO_BYTES = 64 * 1024;
constexpr size_t WS_WB = 1 * MiB;
constexpr size_t WB_W1T = 0;
constexpr size_t WB_W2T = WB_W1T + (size_t)4352 * 1024 * 2;
constexpr size_t WB_WQT = WB_W2T + (size_t)6144 * 1024 * 2;
constexpr size_t WB_WKVT = WB_WQT + (size_t)1536 * 384 * 2;
constexpr size_t WB_WPT = WB_WKVT + (size_t)2048 * 384 * 2;
constexpr size_t WB_WOT = WB_WPT + (size_t)1024 * 3328 * 2;
constexpr size_t WB_END = WB_WOT + (size_t)1024 * 1024 * 2;
static_assert(WB_END <= 32 * MiB, "weights region");
constexpr size_t WS_H = 33 * MiB;
constexpr size_t WS_Y = 65 * MiB;
constexpr int YLD = 3328;
constexpr size_t WS_BIG = 169 * MiB;
constexpr size_t WS_MISC = WS_BIG;
constexpr size_t WS_XC = WS_MISC + 24 * MiB;
constexpr size_t WS_Q = WS_XC + 40 * MiB;
constexpr size_t WS_VV = WS_Q + 48 * MiB;
constexpr size_t WS_KR = WS_VV + 32 * MiB;
constexpr size_t WS_V1 = WS_BIG;
constexpr size_t WS_G = WS_V1 + 32 * MiB;
constexpr size_t WS_O = WS_BIG;
constexpr size_t WS_SMALL = 315 * MiB;
constexpr size_t WS_SLAB = WS_SMALL;
constexpr size_t WS_AGG = WS_SLAB + 1536 * 1024;
constexpr size_t WS_ROPE = WS_AGG + 2560 * 1024;
constexpr size_t WS_LW = WS_ROPE + 512 * 1024;
constexpr size_t WS_GMW = WS_LW + 480 * 1024;
constexpr size_t WS_LCT = WS_GMW + 128 * 1024;
constexpr size_t WS_END = WS_LCT + 64 * 1024;
static_assert(WS_KR + 2 * MiB <= WS_SMALL && WS_G + 96 * MiB <= WS_SMALL && WS_END <= 326 * MiB, "d_ws map");
constexpr int CW_BAR = 1024;
static_assert((CW_BAR + XCD_BAR_WORDS) * 4 <= (int)CTL_ZERO_BYTES, "ctl");
constexpr int RING_BYTES = 131072, MISC_OFF = RING_BYTES + 320, LDS_BYTES = 147456;

enum { I_X = 0, I_PRE_G, I_W_IN, I_GM_LN_G, I_GM_LN_B, I_GM_WS, I_GM_BS, I_QN_G, I_W_UQ, I_KVN_G, I_W_UKV, I_CONV_W, I_CONV_B, I_W_A, I_B_A, I_W_X, I_B_X, I_LAM,
       I_W_PA, I_W_PB, I_W_PC, I_W_OUT, I_POST_G, N_INPUTS };
struct Args { const float* in[N_INPUTS]; float* out; unsigned char* ws; int ph_lo, ph_hi, probe, pad; };

struct Frame { LAS unsigned char* lds; int wave, vcu, G; };
__device__ __forceinline__ int lane_id() { int l; asm volatile("v_mbcnt_lo_u32_b32 %0, -1, 0\n\tv_mbcnt_hi_u32_b32 %0, -1, %0" : "=v"(l)); return l; }

__device__ __forceinline__ float softplus_neg(float x) { const float e = __expf(-x);
    const float p = e * (1.f - e * (0.5f - e * (0.33333334f - e * (0.25f - e * (0.2f - e * (0.16666667f - e * (0.14285715f - e * 0.125f)))))));
    return (e < 0.2f) ? p : __logf(1.f + e); }
struct MapW1 { __device__ __forceinline__ int operator()(int j) const {
    if (j < 384) return 3072 + j; if (j < 640) return 3456 + (j - 384); if (j < 704) { const int jj = j - 640, g = jj >> 3, e = jj & 7; return 3712 + (e < 4 ? 4 * g + e : 32 + 4 * g + (e - 4)); } if (j < 768) return -1;
    if (j < 2048) return 4800 + (j - 768); if (j < 3328) return 6080 + (j - 2048); return 3776 + (j - 3328); } };
struct MapW2 { __device__ __forceinline__ int operator()(int j) const {
    if (j < 2048) { const int tl = j >> 8, lc = j & 255; return (lc < 128) ? (128 * tl + lc) : (2048 + 128 * tl + (lc - 128)); }
    if (j < 3072) return 1024 + (j - 2048); return 7360 + (j - 3072); } };
struct MapQ { __device__ __forceinline__ int operator()(int j) const {
    if (j < 1024) { const int hd = j >> 7, d = j & 127; return hd * 192 + d; }
    const int jj = j - 1024, hh = jj >> 6, w = jj & 63, g = w >> 3, e = w & 7; return hh * 192 + (e < 4 ? 128 + 4 * g + e : 160 + 4 * g + (e - 4)); } };
struct MapId { __device__ __forceinline__ int operator()(int j) const { return j; } };

template <class Map>
__device__ __forceinline__ void tr_item(const float* W, int ldw, int nkb  , bf16_t* WT, int ldt, const Map map, const float* kscale, LAS float* scr, int item, int lane) {
    const int kb = item % nkb, nb = item / nkb, k0 = 64 * kb, n0 = 32 * nb;
    const int nn = lane & 31; const int sc = map(n0 + nn);
    float wv[32];
    const float* wp = W + (size_t)(k0 + (lane >> 5)) * ldw + (sc >= 0 ? sc : 0);
#pragma unroll
    for (int i = 0; i < 32; ++i) wv[i] = (sc >= 0) ? wp[(size_t)(2 * i) * ldw] : 0.f;
#pragma unroll
    for (int i = 0; i < 32; ++i) { const int kk = 2 * i + (lane >> 5); float v = wv[i]; if (kscale) v *= kscale[k0 + kk]; scr[kk * 33 + nn] = v; }
    LDS_WAIT(); asm volatile("" ::: "memory");
    const int c = lane & 7;
#pragma unroll
    for (int j = 0; j < 4; ++j) { const int n = (lane >> 3) + 8 * j; const LAS float* s = scr + (8 * c) * 33 + n;
        u32x4 o; o.x = pk_bf16(s[0 * 33], s[1 * 33]); o.y = pk_bf16(s[2 * 33], s[3 * 33]); o.z = pk_bf16(s[4 * 33], s[5 * 33]); o.w = pk_bf16(s[6 * 33], s[7 * 33]);
        *(u32x4*)(WT + (size_t)(n0 + n) * ldt + k0 + 8 * c) = o; }
    LDS_WAIT(); asm volatile("" ::: "memory");
}

__device__ __forceinline__ void convert_weights(const Frame& F, const Args& a, unsigned char* ws, int l) {
    const int lane = lane_id();
    LAS float* scr = (LAS float*)(F.lds + F.wave * 16384);
    const int gw = F.vcu * NWAVES + F.wave, NGW = F.G * NWAVES;
    unsigned char* wb = ws + WS_WB;
    constexpr int I1 = 16 * (4352 / 32), I2 = 16 * (6144 / 32), IQ = 6 * (1536 / 32), IKV = 4 * (2048 / 32), IPA = 16 * 32, IPB = 16 * 32, IPC = 20 * 32, IO = 16 * 32;
    constexpr int NITEMS = I1 + I2 + IQ + IKV + IPA + IPB + IPC + IO;
    const float* w_in = a.in[I_W_IN] + (size_t)l * 1024 * N_IN;
    for (int it = gw; it < NITEMS; it += NGW) {
        int r = it;
        if (r < I1) { tr_item(w_in, N_IN, 16, (bf16_t*)(wb + WB_W1T), 1024, MapW1(), nullptr, scr, r, lane); continue; } r -= I1;
        if (r < I2) { tr_item(w_in, N_IN, 16, (bf16_t*)(wb + WB_W2T), 1024, MapW2(), nullptr, scr, r, lane); continue; } r -= I2;
        if (r < IQ) { tr_item(a.in[I_W_UQ] + (size_t)l * 384 * 1536, 1536, 6, (bf16_t*)(wb + WB_WQT), 384, MapQ(), a.in[I_QN_G] + l * 384, scr, r, lane); continue; } r -= IQ;
        if (r < IKV) { tr_item(a.in[I_W_UKV] + (size_t)l * 256 * 2048, 2048, 4, (bf16_t*)(wb + WB_WKVT), 384, MapId(), a.in[I_KVN_G] + l * 256, scr, r, lane); continue; } r -= IKV;
        if (r < IPA) { tr_item(a.in[I_W_PA] + (size_t)l * 1024 * 1024, 1024, 16, (bf16_t*)(wb + WB_WPT), 3328, MapId(), nullptr, scr, r, lane); continue; } r -= IPA;
        if (r < IPB) { tr_item(a.in[I_W_PB] + (size_t)l * 1024 * 1024, 1024, 16, (bf16_t*)(wb + WB_WPT) + 1024, 3328, MapId(), nullptr, scr, r, lane); continue; } r -= IPB;
        if (r < IPC) { tr_item(a.in[I_W_PC] + (size_t)l * 1280 * 1024, 1024, 20, (bf16_t*)(wb + WB_WPT) + 2048, 3328, MapId(), nullptr, scr, r, lane); continue; } r -= IPC;
        tr_item(a.in[I_W_OUT] + (size_t)l * 1024 * 1024, 1024, 16, (bf16_t*)(wb + WB_WOT), 1024, MapId(), nullptr, scr, r, lane);
    }
    const int gt = (F.vcu * NWAVES + F.wave) * 64 + lane, NGT = F.G * NWAVES * 64;
    bf16_t* lwa = (bf16_t*)(ws + WS_LW); bf16_t* lwx = lwa + 16 * 80 * 96;
    const float* w_a = a.in[I_W_A] + (size_t)l * 16 * 80 * 80; const float* w_x = a.in[I_W_X] + (size_t)l * 16 * 80 * 80;
    for (int i = gt; i < 16 * 80 * 96; i += NGT) { const int k = i % 96, j = (i / 96) % 80, blk = i / (96 * 80);
        const float va = (k < 80) ? w_a[((size_t)blk * 80 + k) * 80 + j] : 0.f, vx = (k < 80) ? w_x[((size_t)blk * 80 + k) * 80 + j] : 0.f;
        lwa[i] = f2bf(va); lwx[i] = f2bf(vx); }
    { float* lct = (float*)(ws + WS_LCT); const float* cw = a.in[I_CONV_W] + (size_t)l * 4 * 1280;
      for (int c = gt; c < 1280; c += NGT) { f32x4 v0 = {cw[c], cw[1280 + c], cw[2560 + c], cw[3840 + c]};
          f32x4 v1 = {a.in[I_CONV_B][l * 1280 + c], a.in[I_B_A][l * 1280 + c], a.in[I_B_X][l * 1280 + c], -8.f * softplus_neg(a.in[I_LAM][l * 1280 + c])};
          *(f32x4*)(lct + c * 8) = v0; *(f32x4*)(lct + c * 8 + 4) = v1; } }
    bf16_t* gmw = (bf16_t*)(ws + WS_GMW); const float* gws = a.in[I_GM_WS] + (size_t)l * 4 * 128 * 128;
    for (int i = gt; i < 4 * 128 * 128; i += NGT) { const int j = i & 127, ii = (i >> 7) & 127; gmw[i] = f2bf(((j >> 6) <= (ii >> 6)) ? gws[i] : 0.f); }
}
__device__ __forceinline__ void rope_table(const Frame& F, unsigned char* ws) {
    const int gt = (F.vcu * NWAVES + F.wave) * 64 + lane_id(), NGT = F.G * NWAVES * 64;
    float* cs = (float*)(ws + WS_ROPE); float* sn = cs + 2048 * 32;
    for (int i = gt; i < 2048 * 32; i += NGT) { const int s = i >> 5, fi = i & 31; const float inv_freq = powf(10000.f, -(float)(2 * fi) / 64.f); const float ang = (float)s * inv_freq;
        cs[i] = cosf(ang); sn[i] = sinf(ang); }
}
__device__ __forceinline__ void norm_rows(const Frame& F, const bool nostore, const float* xin, const bf16_t* o, const float* g_post, float* xout, const float* g_pre, bf16_t* h) {
    const int gw = F.vcu * NWAVES + F.wave, NGW = F.G * NWAVES; const int lane = lane_id();
    f32x4 v[4], ov[4], nv[4]; u32x2 nov[4];
    if (gw < T) {
#pragma unroll
        for (int j = 0; j < 4; ++j) { nv[j] = *((const f32x4*)(xin + (size_t)gw * DM) + lane + 64 * j); nov[j] = o ? *((const u32x2*)(o + (size_t)gw * DM) + lane + 64 * j) : (u32x2){0u, 0u}; }
    }
    for (int m = gw; m < T; m += NGW) {
#pragma unroll
        for (int j = 0; j < 4; ++j) { v[j] = nv[j]; ov[j] = (f32x4){bf_lo(nov[j].x), bf_hi(nov[j].x), bf_lo(nov[j].y), bf_hi(nov[j].y)}; }
        const int mn = m + NGW;
        if (mn < T) {
#pragma unroll
            for (int j = 0; j < 4; ++j) { nv[j] = *((const f32x4*)(xin + (size_t)mn * DM) + lane + 64 * j); if (o) nov[j] = *((const u32x2*)(o + (size_t)mn * DM) + lane + 64 * j); }
        }
        if (o) {
            float s = 0.f;
#pragma unroll
            for (int j = 0; j < 4; ++j) s += (ov[j].x * ov[j].x + ov[j].y * ov[j].y) + (ov[j].z * ov[j].z + ov[j].w * ov[j].w);
            const float r = rsqrtf(wave_sum(s) * (1.f / DM) + EPS);
            f32x4* xo = (f32x4*)(xout + (size_t)m * DM) + lane;
#pragma unroll
            for (int j = 0; j < 4; ++j) { const f32x4 gp = *((const f32x4*)g_post + lane + 64 * j); v[j] = v[j] + ov[j] * r * gp; if (!nostore) xo[64 * j] = v[j]; }
        }
        if (g_pre) {
            float s = 0.f;
#pragma unroll
            for (int j = 0; j < 4; ++j) s += (v[j].x * v[j].x + v[j].y * v[j].y) + (v[j].z * v[j].z + v[j].w * v[j].w);
            const float r = rsqrtf(wave_sum(s) * (1.f / DM) + EPS);
            u32x2* ho = (u32x2*)(h + (size_t)m * DM) + lane;
#pragma unroll
            for (int j = 0; j < 4; ++j) { const f32x4 gp = *((const f32x4*)g_pre + lane + 64 * j); const f32x4 y = v[j] * r * gp; u32x2 w; w.x = pk_bf16(y.x, y.y); w.y = pk_bf16(y.z, y.w); if (!nostore) ho[64 * j] = w; }
        }
    }
}
using g8::UnitD;
constexpr float QSCALE = 0.07216878364870322f * 1.4426950408889634f;

struct SchedA {
    g8::TileOrder ord; const char* A; const char* B;
    __device__ __forceinline__ bool next(int i, UnitD& u) const { int pm, pn; if (!ord.tile(i, pm, pn)) return false;
        u.A = A + (size_t)pm * 256 * 2048; u.B = B + (size_t)pn * 256 * 2048; u.nt = 16; u.pm = pm; u.pn = pn; u.kind = 0; return true; }
};
struct EpiA {
    bf16_t* misc; bf16_t* xc; bf16_t* y; float* slab; bf16_t* kr; const float* cs; const float* sn;
    __device__ __forceinline__ void operator()(f32x4 (&acc)[2][2][4][2], const UnitD& u, int wr, int wc, int fr, int fq) const {
        const int pn = u.pn, rowp = wr * 64 + fr, lc = wc * 32 + 8 * fq;
        bf16_t* dst; int ld; bool act;
        if (pn < 3) { dst = misc + 256 * pn; ld = 768; act = false; }
        else if (pn < 8) { dst = xc + 256 * (pn - 3); ld = 1280; act = false; }
        else if (pn < 13) { dst = y + 2048 + 256 * (pn - 8); ld = YLD; act = true; }
        else { dst = y + 1024 + 256 * (pn - 13); ld = YLD; act = true; }
#pragma unroll
        for (int ai = 0; ai < 2; ++ai)
#pragma unroll
            for (int m = 0; m < 4; ++m) { const int rp = rowp + ai * 128 + m * 16; bf16_t* p = dst + ((size_t)u.pm * 256 + rp) * ld + lc;
#pragma unroll
                for (int bj = 0; bj < 2; ++bj) { f32x4 v0 = acc[ai][bj][m][0], v1 = acc[ai][bj][m][1];
                    if (pn == 2 && bj == 1) { if (wc < 2) { const int g = 4 * wc + fq; const size_t r = (size_t)u.pm * 256 + rp; const int pos = (int)(r & 2047);
                            const f32x4 c4 = *(const f32x4*)(cs + pos * 32 + 4 * g), s4 = *(const f32x4*)(sn + pos * 32 + 4 * g);
                            const f32x4 o1 = v0 * c4 - v1 * s4, o2 = v1 * c4 + v0 * s4; bf16_t* kp = kr + r * 64 + 4 * g;
                            u32x2 w1, w2; w1.x = pk_bf16(o1.x, o1.y); w1.y = pk_bf16(o1.z, o1.w); w2.x = pk_bf16(o2.x, o2.y); w2.y = pk_bf16(o2.z, o2.w);
                            *(u32x2*)kp = w1; *(u32x2*)(kp + 32) = w2; }
                        continue; }
                    if (pn < 3) { float ss = (v0.x * v0.x + v0.y * v0.y) + (v0.z * v0.z + v0.w * v0.w) + (v1.x * v1.x + v1.y * v1.y) + (v1.z * v1.z + v1.w * v1.w);
                        ss += sx<16>(ss); ss = xsum32(ss);
                        if (fq == 0) slab[(((size_t)u.pm * 6 + pn * 2 + bj) * 4 + wc) * 256 + rp] = ss; }
                    if (act) { v0.x = fsilu(v0.x); v0.y = fsilu(v0.y); v0.z = fsilu(v0.z); v0.w = fsilu(v0.w); v1.x = fsilu(v1.x); v1.y = fsilu(v1.y); v1.z = fsilu(v1.z); v1.w = fsilu(v1.w); }
                    u32x4 w; w.x = pk_bf16(v0.x, v0.y); w.y = pk_bf16(v0.z, v0.w); w.z = pk_bf16(v1.x, v1.y); w.w = pk_bf16(v1.z, v1.w);
                    *(u32x4*)(p + bj * 128) = w; } }
    }
};

struct SchedZ {
    int v; const char* A; const char* B;
    __device__ __forceinline__ bool next(int i, UnitD& u) const { if (i > 0 || (v & 3) != 0 || v >= 256) return false; const int pm = v >> 2;
        u.A = A + (size_t)pm * 256 * 2048; u.B = B + (size_t)16 * 256 * 2048; u.nt = 16; u.pm = pm; u.pn = 16; u.kind = 0; return true; }
};
struct SchedQKV {
    int v; const char* misc; const char* wq; const char* wkv;
    __device__ __forceinline__ bool next(int i, UnitD& u) const { if (v >= 256) return false; const int role = v & 3, pm = v >> 2; int pn;
        if (role == 0) { if (i > 0) return false; pn = 0; }
        else if (role == 1) { if (i > 4) return false; pn = (i == 0) ? 1 : 5 + i; }
        else { if (i > 3) return false; pn = (i < 2) ? (2 * role - 2 + i) : (10 + 2 * (role - 2) + (i - 2)); }
        u.pm = pm; u.pn = pn; u.kind = 0;
        if (pn < 6) { u.A = misc + (size_t)pm * 256 * 1536; u.B = wq + (size_t)pn * 256 * 768; u.nt = 6; }
        else { u.A = misc + (size_t)pm * 256 * 1536 + 384 * 2; u.B = wkv + (size_t)(pn - 6) * 256 * 768; u.nt = 4; }
        return true; }
};
struct EpiQKV {
    bf16_t* q; bf16_t* y; bf16_t* vv; const float* slab; const float* cs; const float* sn;
    __device__ __forceinline__ void operator()(f32x4 (&acc)[2][2][4][2], const UnitD& u, int wr, int wc, int fr, int fq) const {
        const int pn = u.pn, rowp = wr * 64 + fr, lc = wc * 32 + 8 * fq; const bool isq = pn < 6;
#pragma unroll
        for (int ai = 0; ai < 2; ++ai)
#pragma unroll
            for (int m = 0; m < 4; ++m) { const int rp = rowp + ai * 128 + m * 16; const size_t r = (size_t)u.pm * 256 + rp;
                float s = 0.f; const float* sl = slab + (size_t)u.pm * 6 * 4 * 256 + rp;
                if (isq) {
#pragma unroll
                    for (int e = 0; e < 3; ++e) { const int j = fq * 3 + e; s += sl[(size_t)((j >> 2) * 4 + (j & 3)) * 256]; }
                } else {
#pragma unroll
                    for (int e = 0; e < 2; ++e) { const int j = fq * 2 + e; s += sl[(size_t)((3 + (j >> 2)) * 4 + (j & 3)) * 256]; }
                }
                s += sx<16>(s); s = xsum32(s);
                float rs = rsqrtf(s * (isq ? (1.f / 384.f) : (1.f / 256.f)) + EPS); if (isq) rs *= QSCALE;
#pragma unroll
                for (int bj = 0; bj < 2; ++bj) { f32x4 v0 = acc[ai][bj][m][0] * rs, v1 = acc[ai][bj][m][1] * rs;
                    if (pn < 4) { const int j0 = 256 * pn + 128 * bj + lc; bf16_t* p = q + r * 1536 + (j0 >> 7) * 192 + (j0 & 127);
                        u32x4 w; w.x = pk_bf16(v0.x, v0.y); w.y = pk_bf16(v0.z, v0.w); w.z = pk_bf16(v1.x, v1.y); w.w = pk_bf16(v1.z, v1.w); *(u32x4*)p = w; }
                    else if (pn < 6) { const int jj = 256 * (pn - 4) + 128 * bj + lc, hh = jj >> 6, g = (jj & 63) >> 3; const int pos = (int)(r & 2047);
                        const f32x4 c4 = *(const f32x4*)(cs + pos * 32 + 4 * g), s4 = *(const f32x4*)(sn + pos * 32 + 4 * g);
                        const f32x4 o1 = v0 * c4 - v1 * s4, o2 = v1 * c4 + v0 * s4; bf16_t* p = q + r * 1536 + hh * 192 + 128 + 4 * g;
                        u32x2 w1, w2; w1.x = pk_bf16(o1.x, o1.y); w1.y = pk_bf16(o1.z, o1.w); w2.x = pk_bf16(o2.x, o2.y); w2.y = pk_bf16(o2.z, o2.w);
                        *(u32x2*)p = w1; *(u32x2*)(p + 32) = w2; }
                    else { const int hd = pn - 6; bf16_t* p = (bj == 0) ? (y + r * YLD + hd * 128 + lc) : (vv + r * 1024 + hd * 128 + lc);
                        u32x4 w; w.x = pk_bf16(v0.x, v0.y); w.y = pk_bf16(v0.z, v0.w); w.z = pk_bf16(v1.x, v1.y); w.w = pk_bf16(v1.z, v1.w); *(u32x4*)p = w; } } }
    }
};

struct SchedD {
    g8::TileOrder ord; const char* A; const char* B;
    __device__ __forceinline__ bool next(int i, UnitD& u) const { int pm, pn; if (!ord.tile(i, pm, pn)) return false;
        u.A = A + (size_t)pm * 256 * 2048; u.B = B + (size_t)pn * 256 * 2048; u.nt = 16; u.pm = pm; u.pn = pn; u.kind = 0; return true; }
};
struct EpiD {
    bf16_t* y; bf16_t* v1; bf16_t* g; float* vslab;
    __device__ __forceinline__ void operator()(f32x4 (&acc)[2][2][4][2], const UnitD& u, int wr, int wc, int fr, int fq) const {
        const int pn = u.pn, rowp = wr * 64 + fr, lc = wc * 32 + 8 * fq;
#pragma unroll
        for (int ai = 0; ai < 2; ++ai)
#pragma unroll
            for (int m = 0; m < 4; ++m) { const size_t r = (size_t)u.pm * 256 + rowp + ai * 128 + m * 16;
                if (pn < 8) { const f32x4 u0 = acc[ai][0][m][0], u1 = acc[ai][0][m][1], z0 = acc[ai][1][m][0], z1 = acc[ai][1][m][1];
                    u32x4 w; w.x = pk_bf16(u0.x * fsilu(z0.x), u0.y * fsilu(z0.y)); w.y = pk_bf16(u0.z * fsilu(z0.z), u0.w * fsilu(z0.w));
                    w.z = pk_bf16(u1.x * fsilu(z1.x), u1.y * fsilu(z1.y)); w.w = pk_bf16(u1.z * fsilu(z1.z), u1.w * fsilu(z1.w));
                    *(u32x4*)(y + r * YLD + 128 * pn + lc) = w; }
                else {
#pragma unroll
                    for (int bj = 0; bj < 2; ++bj) { f32x4 v0 = acc[ai][bj][m][0], v1_ = acc[ai][bj][m][1]; bf16_t* p;
                        if (pn < 12) { p = v1 + r * 1024 + 256 * (pn - 8) + 128 * bj + lc;
                            float s1 = (v0.x + v0.y) + (v0.z + v0.w) + (v1_.x + v1_.y) + (v1_.z + v1_.w);
                            float s2 = (v0.x * v0.x + v0.y * v0.y) + (v0.z * v0.z + v0.w * v0.w) + (v1_.x * v1_.x + v1_.y * v1_.y) + (v1_.z * v1_.z + v1_.w * v1_.w);
                            s1 += sx<16>(s1); s1 = xsum32(s1); s2 += sx<16>(s2); s2 = xsum32(s2);
                            if (fq == 0) *(f32x2*)(vslab + r * 64 + (((pn - 8) * 2 + bj) * 4 + wc) * 2) = (f32x2){s1, s2}; }
                        else { p = g + r * 3072 + 256 * (pn - 12) + 128 * bj + lc;
                            v0.x = fsigmoid(v0.x); v0.y = fsigmoid(v0.y); v0.z = fsigmoid(v0.z); v0.w = fsigmoid(v0.w); v1_.x = fsigmoid(v1_.x); v1_.y = fsigmoid(v1_.y); v1_.z = fsigmoid(v1_.z); v1_.w = fsigmoid(v1_.w); }
                        u32x4 w; w.x = pk_bf16(v0.x, v0.y); w.y = pk_bf16(v0.z, v0.w); w.z = pk_bf16(v1_.x, v1_.y); w.w = pk_bf16(v1_.z, v1_.w); *(u32x4*)p = w; } } }
    }
};

struct SchedF {
    g8::TileOrder ord; const char* A; const char* B;
    __device__ __forceinline__ bool next(int i, UnitD& u) const { if (i >= 3) return false; int pm, pn; if (!ord.tile(0, pm, pn)) return false;
        const size_t ko = (i == 0) ? 0 : (i == 1 ? 1024 * 2 : 2048 * 2);
        u.A = A + (size_t)pm * 256 * (YLD * 2) + ko; u.B = B + (size_t)pn * 256 * (YLD * 2) + ko; u.nt = (i == 2) ? 20 : 16; u.pm = pm; u.pn = pn; u.kind = (i < 2) ? (i | g8::KEEP_ACC) : i; return true; }
};
struct EpiF {
    const bf16_t* g; bf16_t* merged;
    __device__ __forceinline__ void operator()(f32x4 (&acc)[2][2][4][2], const UnitD& u, int wr, int wc, int fr, int fq) const {
        const int seg = u.kind & 3, rowp = wr * 64 + fr, lc = wc * 32 + 8 * fq;
#pragma unroll
        for (int ai = 0; ai < 2; ++ai)
#pragma unroll
            for (int m = 0; m < 4; ++m) { const size_t r = (size_t)u.pm * 256 + rowp + ai * 128 + m * 16;
#pragma unroll
                for (int bj = 0; bj < 2; ++bj) { const int col = 256 * u.pn + 128 * bj + lc; const bf16_t* gp = g + r * 3072 + seg * 1024 + col;
                    const u32x4 a = *(const u32x4*)gp; f32x4 f0, f1;
                    f0.x = bf_lo(a.x); f0.y = bf_hi(a.x); f0.z = bf_lo(a.y); f0.w = bf_hi(a.y); f1.x = bf_lo(a.z); f1.y = bf_hi(a.z); f1.z = bf_lo(a.w); f1.w = bf_hi(a.w);
                    if (seg < 2) { const u32x4 b = *(const u32x4*)(gp + 1024);
                        f0.x *= __builtin_amdgcn_rcpf(bf_lo(b.x)); f0.y *= __builtin_amdgcn_rcpf(bf_hi(b.x)); f0.z *= __builtin_amdgcn_rcpf(bf_lo(b.y)); f0.w *= __builtin_amdgcn_rcpf(bf_hi(b.y));
                        f1.x *= __builtin_amdgcn_rcpf(bf_lo(b.z)); f1.y *= __builtin_amdgcn_rcpf(bf_hi(b.z)); f1.z *= __builtin_amdgcn_rcpf(bf_lo(b.w)); f1.w *= __builtin_amdgcn_rcpf(bf_hi(b.w));
                        acc[ai][bj][m][0] *= f0; acc[ai][bj][m][1] *= f1; }
                    else { const f32x4 v0 = acc[ai][bj][m][0] * f0, v1 = acc[ai][bj][m][1] * f1;
                        u32x4 w; w.x = pk_bf16(v0.x, v0.y); w.y = pk_bf16(v0.z, v0.w); w.z = pk_bf16(v1.x, v1.y); w.w = pk_bf16(v1.z, v1.w);
                        *(u32x4*)(merged + r * 1024 + col) = w; } } }
    }
};

struct SchedG {
    g8::TileOrder ord; const char* A; const char* B;
    __device__ __forceinline__ bool next(int i, UnitD& u) const { int pm, pn; if (!ord.tile(i, pm, pn)) return false;
        u.A = A + (size_t)pm * 256 * 2048; u.B = B + (size_t)pn * 256 * 2048; u.nt = 16; u.pm = pm; u.pn = pn; u.kind = 0; return true; }
};
struct EpiG {
    bf16_t* o;
    __device__ __forceinline__ void operator()(f32x4 (&acc)[2][2][4][2], const UnitD& u, int wr, int wc, int fr, int fq) const {
        const int rowp = wr * 64 + fr, lc = wc * 32 + 8 * fq;
#pragma unroll
        for (int ai = 0; ai < 2; ++ai)
#pragma unroll
            for (int m = 0; m < 4; ++m) { bf16_t* p = o + ((size_t)u.pm * 256 + rowp + ai * 128 + m * 16) * 1024 + 256 * u.pn + lc;
#pragma unroll
                for (int bj = 0; bj < 2; ++bj) { const f32x4 v0 = acc[ai][bj][m][0], v1 = acc[ai][bj][m][1];
                    u32x4 w; w.x = pk_bf16(v0.x, v0.y); w.y = pk_bf16(v0.z, v0.w); w.z = pk_bf16(v1.x, v1.y); w.w = pk_bf16(v1.z, v1.w); *(u32x4*)(p + bj * 128) = w; } }
    }
};
typedef float f32x2v __attribute__((ext_vector_type(2)));

constexpr int LRU_HIN_OFF = RING_BYTES + 1024;
template <int PASS>
__device__ __forceinline__ void lru_item(const Frame& F, const Args& a, const unsigned char* ws, const bool nostore, int l, int item, const bf16_t* xcb, bf16_t* y, float* agg) {
    const int b = item >> 5, k = item & 31; const size_t r0 = (size_t)b * SEQ + (size_t)k * 64;
    int lane_ = lane_id(); asm volatile("" : "+v"(lane_));
    const int lane = lane_, cl = lane & 15, kg = lane >> 4;
    LAS unsigned char* xt = F.lds + F.wave * 16384;
    const bf16_t* lwa = (const bf16_t*)(ws + WS_LW); const bf16_t* lwx = lwa + 16 * 80 * 96;
    const float* lct = (const float*)(ws + WS_LCT);
    LAS float* hin_l = (LAS float*)(F.lds + LRU_HIN_OFF);
    if (PASS == 2) {
        for (int c = F.wave * 64 + lane; c < 1280; c += 512) { const float* ag = agg + ((size_t)b * 32 * 1280 + c) * 2; float h = 0.f;
#pragma unroll 8
            for (int j = 0; j < k; ++j) { const f32x2v ab = *(const f32x2v*)(ag + (size_t)j * 2560); h = ab.x * h + ab.y; }
            hin_l[c] = h; }
        LDS_WAIT(); __syncthreads();
    }
#pragma unroll 1
    for (int bi = 0; bi < 2; ++bi) {
        const int blk = 2 * F.wave + bi;
        {
            u32x4 xch[11]; int ln = lane; asm volatile("" : "+v"(ln));
            const bf16_t* xbase = xcb + (r0 - 3) * 1280 + blk * 80;
#pragma unroll
            for (int i = 0; i < 11; ++i) { const int idx = ln + 64 * i; const int row = idx / 10, ch = idx - row * 10; xch[i] = (u32x4){0u, 0u, 0u, 0u};
                if (idx < 670 && !(k == 0 && row < 3)) xch[i] = *(const u32x4*)(xbase + (unsigned)(row * 1280 + ch * 8)); }
#pragma unroll
            for (int i = 0; i < 11; ++i) { const int idx = ln + 64 * i; const int row = idx / 10, ch = idx - row * 10; if (idx < 670) *(LAS u32x4*)(xt + row * 208 + ch * 16) = xch[i]; }
            LAS u32x4* z = (LAS u32x4*)(xt + (lane + 3) * 208 + 160); z[0] = (u32x4){0u, 0u, 0u, 0u}; z[1] = (u32x4){0u, 0u, 0u, 0u};
        }
        LDS_WAIT(); asm volatile("" ::: "memory");
#pragma unroll
        for (int ct = 0; ct < 5; ++ct) { const int c = blk * 80 + 16 * ct + cl; const f32x4 cw = *(const f32x4*)(lct + c * 8); const float cb = lct[c * 8 + 4];
            float xv[4][7];
#pragma unroll
            for (int rt = 0; rt < 4; ++rt)
#pragma unroll
                for (int j = 0; j < 7; ++j) xv[rt][j] = bf1(*(const LAS bf16_t*)(xt + (16 * rt + 4 * kg + j) * 208 + (16 * ct + cl) * 2));
            asm volatile("" ::: "memory");
#pragma unroll
            for (int rt = 0; rt < 4; ++rt)
#pragma unroll
                for (int e = 0; e < 4; ++e) { const float v = cb + cw.x * xv[rt][e] + cw.y * xv[rt][e + 1] + cw.z * xv[rt][e + 2] + cw.w * xv[rt][e + 3];
                    *(LAS bf16_t*)(xt + (16 * rt + 4 * kg + e + 3) * 208 + (16 * ct + cl) * 2) = f2bf(v); }
            asm volatile("" ::: "memory"); }
        LDS_WAIT(); asm volatile("" ::: "memory");
        bf16x8 af[4][3];
#pragma unroll
        for (int rt = 0; rt < 4; ++rt)
#pragma unroll
            for (int ks = 0; ks < 3; ++ks) af[rt][ks] = *(const LAS bf16x8*)(xt + (16 * rt + cl + 3) * 208 + (32 * ks + 8 * kg) * 2);
        bf16x8 wA[2][3], wX[2][3];
#pragma unroll
        for (int ks = 0; ks < 3; ++ks) { const size_t wo = ((size_t)blk * 80 + cl) * 96 + 32 * ks + 8 * kg; wA[0][ks] = *(const bf16x8*)(lwa + wo); wX[0][ks] = *(const bf16x8*)(lwx + wo); }
#pragma unroll
        for (int ct = 0; ct < 5; ++ct) { const int c = blk * 80 + 16 * ct + cl; const int cur = ct & 1;
            if (ct + 1 < 5) {
#pragma unroll
                for (int ks = 0; ks < 3; ++ks) { const size_t wo = ((size_t)blk * 80 + 16 * (ct + 1) + cl) * 96 + 32 * ks + 8 * kg; wA[cur ^ 1][ks] = *(const bf16x8*)(lwa + wo); wX[cur ^ 1][ks] = *(const bf16x8*)(lwx + wo); } }
            const f32x4 c1 = *(const f32x4*)(lct + c * 8 + 4); const float ba_c = c1.y, bx_c = c1.z, sp8 = c1.w;
            f32x4 ra[4], rx[4];
#pragma unroll
            for (int rt = 0; rt < 4; ++rt) { ra[rt] = (f32x4){0.f, 0.f, 0.f, 0.f}; rx[rt] = (f32x4){0.f, 0.f, 0.f, 0.f}; }
#pragma unroll
            for (int ks = 0; ks < 3; ++ks)
#pragma unroll
                for (int rt = 0; rt < 4; ++rt) { ra[rt] = __builtin_amdgcn_mfma_f32_16x16x32_bf16(af[rt][ks], wA[cur][ks], ra[rt], 0, 0, 0); rx[rt] = __builtin_amdgcn_mfma_f32_16x16x32_bf16(af[rt][ks], wX[cur][ks], rx[rt], 0, 0, 0); }
            float hin = (PASS == 2) ? hin_l[c] : 0.f; float totA = 1.f, totB = 0.f;
#pragma unroll
            for (int rt = 0; rt < 4; ++rt) { float av[4], bv[4];
#pragma unroll
                for (int e = 0; e < 4; ++e) { const float r = fsigmoid(ra[rt][e] + ba_c), ig = fsigmoid(rx[rt][e] + bx_c);
                    const float aa = __expf(sp8 * r); const float mult = sqrtf(fmaxf(1.f - aa * aa, 0.f));
                    const float xcv = bf1(*(const LAS bf16_t*)(xt + (16 * rt + 4 * kg + e + 3) * 208 + (16 * ct + cl) * 2));
                    av[e] = aa; bv[e] = mult * ig * xcv; }
                float sA = av[0], sB = bv[0];
#pragma unroll
                for (int e = 1; e < 4; ++e) { sB = av[e] * sB + bv[e]; sA *= av[e]; }
                float iA = sA, iB = sB;
                { const float pA = __shfl(iA, lane - 16), pB = __shfl(iB, lane - 16); if (kg >= 1) { iB = iA * pB + iB; iA = iA * pA; } }
                { const float pA = __shfl(iA, lane - 32), pB = __shfl(iB, lane - 32); if (kg >= 2) { iB = iA * pB + iB; iA = iA * pA; } }
                const float tA = __shfl(iA, 48 + cl), tB = __shfl(iB, 48 + cl);
                if (PASS == 1) { totB = tA * totB + tB; totA *= tA; }
                else {
                    float eA = __shfl(iA, lane - 16), eB = __shfl(iB, lane - 16); if (kg == 0) { eA = 1.f; eB = 0.f; }
                    float h = eA * hin + eB;
#pragma unroll
                    for (int e = 0; e < 4; ++e) { h = av[e] * h + bv[e]; *(LAS bf16_t*)(xt + (16 * rt + 4 * kg + e + 3) * 208 + (16 * ct + cl) * 2) = f2bf(h); }
                    hin = tA * hin + tB;
                }
            }
            if (PASS == 1) { if (kg == 0) *(f32x2v*)(agg + (((size_t)b * 32 + k) * 1280 + c) * 2) = (f32x2v){totA, totB}; }
        }
        LDS_WAIT(); asm volatile("" ::: "memory");
        if (PASS == 2) {
            int ln = lane; asm volatile("" : "+v"(ln));
            bf16_t* ybase = y + r0 * YLD + 2048 + blk * 80; u32x4 zc[10];
#pragma unroll
            for (int i = 0; i < 10; ++i) { const int idx = ln + 64 * i; const int row = idx / 10, ch = idx - row * 10; zc[i] = *(const u32x4*)(ybase + (unsigned)(row * YLD + ch * 8)); }
#pragma unroll
            for (int i = 0; i < 10; ++i) { const int idx = ln + 64 * i; const int row = idx / 10, ch = idx - row * 10; const u32x4 hv = *(const LAS u32x4*)(xt + (row + 3) * 208 + ch * 16); u32x4 o;
                o.x = pk_bf16(bf_lo(hv.x) * bf_lo(zc[i].x), bf_hi(hv.x) * bf_hi(zc[i].x)); o.y = pk_bf16(bf_lo(hv.y) * bf_lo(zc[i].y), bf_hi(hv.y) * bf_hi(zc[i].y));
                o.z = pk_bf16(bf_lo(hv.z) * bf_lo(zc[i].z), bf_hi(hv.z) * bf_hi(zc[i].z)); o.w = pk_bf16(bf_lo(hv.w) * bf_lo(zc[i].w), bf_hi(hv.w) * bf_hi(zc[i].w));
                if (!nostore) *(u32x4*)(ybase + (unsigned)(row * YLD + ch * 8)) = o; }
            LDS_WAIT(); asm volatile("" ::: "memory");
        }
    }
    if (PASS == 2) __syncthreads();
}

constexpr int CW_LRUF = 8192;
__device__ __forceinline__ void lru_single(const Frame& F, const unsigned char* ws, unsigned* ctl, const bool nostore, int l, int item, const bf16_t* xcb, bf16_t* y, float* agg) {
    const int b = item >> 5, k = item & 31; const size_t r0 = (size_t)b * SEQ + (size_t)k * 64;
    int lane_ = lane_id(); asm volatile("" : "+v"(lane_));
    const int lane = lane_, cl = lane & 15, kg = lane >> 4;
    LAS unsigned char* xt = F.lds + F.wave * 16384;
    const bf16_t* lwa = (const bf16_t*)(ws + WS_LW); const bf16_t* lwx = lwa + 16 * 80 * 96;
    const float* lct = (const float*)(ws + WS_LCT);
    const unsigned epoch = (unsigned)l + 1u;
    unsigned* flags = ctl + CW_LRUF + b * 32 * 16;
    unsigned long long* agg64 = (unsigned long long*)agg;
#pragma unroll 1
    for (int bi = 0; bi < 2; ++bi) {
        const int blk = 2 * F.wave + bi;
        {
            u32x4 xch[11]; int ln = lane; asm volatile("" : "+v"(ln));
            const bf16_t* xbase = xcb + (r0 - 3) * 1280 + blk * 80;
#pragma unroll
            for (int i = 0; i < 11; ++i) { const int idx = ln + 64 * i; const int row = idx / 10, ch = idx - row * 10; xch[i] = (u32x4){0u, 0u, 0u, 0u};
                if (idx < 670 && !(k == 0 && row < 3)) xch[i] = *(const u32x4*)(xbase + (unsigned)(row * 1280 + ch * 8)); }
#pragma unroll
            for (int i = 0; i < 11; ++i) { const int idx = ln + 64 * i; const int row = idx / 10, ch = idx - row * 10; if (idx < 670) *(LAS u32x4*)(xt + row * 208 + ch * 16) = xch[i]; }
            LAS u32x4* z = (LAS u32x4*)(xt + (lane + 3) * 208 + 160); z[0] = (u32x4){0u, 0u, 0u, 0u}; z[1] = (u32x4){0u, 0u, 0u, 0u};
        }
        LDS_WAIT(); asm volatile("" ::: "memory");
#pragma unroll
        for (int ct = 0; ct < 5; ++ct) { const int c = blk * 80 + 16 * ct + cl; const f32x4 cw = *(const f32x4*)(lct + c * 8); const float cb = lct[c * 8 + 4];
            float xv[4][7];
#pragma unroll
            for (int rt = 0; rt < 4; ++rt)
#pragma unroll
                for (int j = 0; j < 7; ++j) xv[rt][j] = bf1(*(const LAS bf16_t*)(xt + (16 * rt + 4 * kg + j) * 208 + (16 * ct + cl) * 2));
            asm volatile("" ::: "memory");
#pragma unroll
            for (int rt = 0; rt < 4; ++rt)
#pragma unroll
                for (int e = 0; e < 4; ++e) { const float v = cb + cw.x * xv[rt][e] + cw.y * xv[rt][e + 1] + cw.z * xv[rt][e + 2] + cw.w * xv[rt][e + 3];
                    *(LAS bf16_t*)(xt + (16 * rt + 4 * kg + e + 3) * 208 + (16 * ct + cl) * 2) = f2bf(v); }
            asm volatile("" ::: "memory"); }
        LDS_WAIT(); asm volatile("" ::: "memory");
        bf16x8 af[4][3];
#pragma unroll
        for (int rt = 0; rt < 4; ++rt)
#pragma unroll
            for (int ks = 0; ks < 3; ++ks) af[rt][ks] = *(const LAS bf16x8*)(xt + (16 * rt + cl + 3) * 208 + (32 * ks + 8 * kg) * 2);
        bf16x8 wA[2][3], wX[2][3];
#pragma unroll
        for (int ks = 0; ks < 3; ++ks) { const size_t wo = ((size_t)blk * 80 + cl) * 96 + 32 * ks + 8 * kg; wA[0][ks] = *(const bf16x8*)(lwa + wo); wX[0][ks] = *(const bf16x8*)(lwx + wo); }
        unsigned pk[5][4][2];
#pragma unroll
        for (int ct = 0; ct < 5; ++ct) { const int c = blk * 80 + 16 * ct + cl; const int cur = ct & 1;
            if (ct + 1 < 5) {
#pragma unroll
                for (int ks = 0; ks < 3; ++ks) { const size_t wo = ((size_t)blk * 80 + 16 * (ct + 1) + cl) * 96 + 32 * ks + 8 * kg; wA[cur ^ 1][ks] = *(const bf16x8*)(lwa + wo); wX[cur ^ 1][ks] = *(const bf16x8*)(lwx + wo); } }
            const f32x4 c1 = *(const f32x4*)(lct + c * 8 + 4); const float ba_c = c1.y, bx_c = c1.z, sp8 = c1.w;
            f32x4 ra[4], rx[4];
#pragma unroll
            for (int rt = 0; rt < 4; ++rt) { ra[rt] = (f32x4){0.f, 0.f, 0.f, 0.f}; rx[rt] = (f32x4){0.f, 0.f, 0.f, 0.f}; }
#pragma unroll
            for (int ks = 0; ks < 3; ++ks)
#pragma unroll
                for (int rt = 0; rt < 4; ++rt) { ra[rt] = __builtin_amdgcn_mfma_f32_16x16x32_bf16(af[rt][ks], wA[cur][ks], ra[rt], 0, 0, 0); rx[rt] = __builtin_amdgcn_mfma_f32_16x16x32_bf16(af[rt][ks], wX[cur][ks], rx[rt], 0, 0, 0); }
            float hl = 0.f, pl = 1.f;
#pragma unroll
            for (int rt = 0; rt < 4; ++rt) { float av[4], bv[4];
#pragma unroll
                for (int e = 0; e < 4; ++e) { const float r = fsigmoid(ra[rt][e] + ba_c), ig = fsigmoid(rx[rt][e] + bx_c);
                    const float aa = __expf(sp8 * r); const float mult = sqrtf(fmaxf(1.f - aa * aa, 0.f));
                    const float xcv = bf1(*(const LAS bf16_t*)(xt + (16 * rt + 4 * kg + e + 3) * 208 + (16 * ct + cl) * 2));
                    av[e] = aa; bv[e] = mult * ig * xcv; }
                float sA = av[0], sB = bv[0];
#pragma unroll
                for (int e = 1; e < 4; ++e) { sB = av[e] * sB + bv[e]; sA *= av[e]; }
                float iA = sA, iB = sB;
                { const float pA = __shfl(iA, lane - 16), pB = __shfl(iB, lane - 16); if (kg >= 1) { iB = iA * pB + iB; iA = iA * pA; } }
                { const float pA = __shfl(iA, lane - 32), pB = __shfl(iB, lane - 32); if (kg >= 2) { iB = iA * pB + iB; iA = iA * pA; } }
                const float tA = __shfl(iA, 48 + cl), tB = __shfl(iB, 48 + cl);
                float eA = __shfl(iA, lane - 16), eB = __shfl(iB, lane - 16); if (kg == 0) { eA = 1.f; eB = 0.f; }
                float h = eA * hl + eB, pp = eA * pl, P[4];
#pragma unroll
                for (int e = 0; e < 4; ++e) { h = av[e] * h + bv[e]; pp *= av[e]; P[e] = pp;
                    *(LAS bf16_t*)(xt + (16 * rt + 4 * kg + e + 3) * 208 + (16 * ct + cl) * 2) = f2bf(h); }
                pk[ct][rt][0] = pk_bf16(P[0], P[1]); pk[ct][rt][1] = pk_bf16(P[2], P[3]);
                hl = tA * hl + tB; pl *= tA;
            }
            if (kg == 0) __hip_atomic_store(agg64 + ((size_t)b * 32 + k) * 1280 + c, ((unsigned long long)__float_as_uint(hl) << 32) | (unsigned long long)__float_as_uint(pl), __ATOMIC_RELAXED, __HIP_MEMORY_SCOPE_AGENT);
        }
        asm volatile("s_waitcnt vmcnt(0)" ::: "memory");
        if (lane == 0) __hip_atomic_store(flags + k * 16 + blk, epoch, __ATOMIC_RELAXED, __HIP_MEMORY_SCOPE_AGENT);
        if (k > 0) {
            for (unsigned spins = 0; spins < (1u << 20); ++spins) {
                const unsigned f = (lane < k) ? __hip_atomic_load(flags + lane * 16 + blk, __ATOMIC_RELAXED, __HIP_MEMORY_SCOPE_AGENT) : epoch;
                if (__all(f == epoch)) break;
                __builtin_amdgcn_s_sleep(2);
            }
            float fa[5], fb[5];
#pragma unroll
            for (int ct = 0; ct < 5; ++ct) { fa[ct] = 1.f; fb[ct] = 0.f; }
            const int j0 = (k * kg) >> 2, j1 = (k * (kg + 1)) >> 2;
            const unsigned long long* ag0 = agg64 + (size_t)b * 32 * 1280 + blk * 80 + cl;
#pragma unroll 2
            for (int j = j0; j < j1; ++j) {
                unsigned long long w[5];
#pragma unroll
                for (int ct = 0; ct < 5; ++ct) w[ct] = __hip_atomic_load(ag0 + (size_t)j * 1280 + 16 * ct, __ATOMIC_RELAXED, __HIP_MEMORY_SCOPE_AGENT);
#pragma unroll
                for (int ct = 0; ct < 5; ++ct) { const float A = __uint_as_float((unsigned)w[ct]), B = __uint_as_float((unsigned)(w[ct] >> 32)); fb[ct] = A * fb[ct] + B; fa[ct] *= A; } }
#pragma unroll
            for (int ct = 0; ct < 5; ++ct) { float iA = fa[ct], iB = fb[ct];
                { const float pA = __shfl(iA, lane - 16), pB = __shfl(iB, lane - 16); if (kg >= 1) { iB = iA * pB + iB; iA = iA * pA; } }
                { const float pA = __shfl(iA, lane - 32), pB = __shfl(iB, lane - 32); if (kg >= 2) { iB = iA * pB + iB; iA = iA * pA; } }
                const float cin = __shfl(iB, 48 + cl);
#pragma unroll
                for (int rt = 0; rt < 4; ++rt) { const float P[4] = {bf_lo(pk[ct][rt][0]), bf_hi(pk[ct][rt][0]), bf_lo(pk[ct][rt][1]), bf_hi(pk[ct][rt][1])};
#pragma unroll
                    for (int e = 0; e < 4; ++e) { LAS bf16_t* hp = (LAS bf16_t*)(xt + (16 * rt + 4 * kg + e + 3) * 208 + (16 * ct + cl) * 2); *hp = f2bf(bf1(*hp) + P[e] * cin); } } }
        }
        LDS_WAIT(); asm volatile("" ::: "memory");
        {
            int ln = lane; asm volatile("" : "+v"(ln));
            bf16_t* ybase = y + r0 * YLD + 2048 + blk * 80; u32x4 zc[10];
#pragma unroll
            for (int i = 0; i < 10; ++i) { const int idx = ln + 64 * i; const int row = idx / 10, ch = idx - row * 10; zc[i] = *(const u32x4*)(ybase + (unsigned)(row * YLD + ch * 8)); }
#pragma unroll
            for (int i = 0; i < 10; ++i) { const int idx = ln + 64 * i; const int row = idx / 10, ch = idx - row * 10; const u32x4 hv = *(const LAS u32x4*)(xt + (row + 3) * 208 + ch * 16); u32x4 o;
                o.x = pk_bf16(bf_lo(hv.x) * bf_lo(zc[i].x), bf_hi(hv.x) * bf_hi(zc[i].x)); o.y = pk_bf16(bf_lo(hv.y) * bf_lo(zc[i].y), bf_hi(hv.y) * bf_hi(zc[i].y));
                o.z = pk_bf16(bf_lo(hv.z) * bf_lo(zc[i].z), bf_hi(hv.z) * bf_hi(zc[i].z)); o.w = pk_bf16(bf_lo(hv.w) * bf_lo(zc[i].w), bf_hi(hv.w) * bf_hi(zc[i].w));
                if (!nostore) *(u32x4*)(ybase + (unsigned)(row * YLD + ch * 8)) = o; }
            LDS_WAIT(); asm volatile("" ::: "memory");
        }
    }
}
__device__ __forceinline__ void phaseB_lru(const Frame& F, const unsigned char* ws, unsigned* ctl, const bool nostore, int l, const bf16_t* xc, bf16_t* y, float* agg) {
    for (int item = F.vcu; item < NBATCH * 32; item += F.G) lru_single(F, ws, ctl, nostore, l, item, xc, y, agg);
}

__device__ __forceinline__ void phaseB_extra(const Frame& F, const Args& a, const unsigned char* ws, int l, const bf16_t* misc, bf16_t* kr, const bf16_t* xc, float* agg, const float* cs, const float* sn) {
    for (int item = F.vcu; item < NBATCH * 32; item += F.G) lru_item<1>(F, a, ws, false, l, item, xc, nullptr, agg);
}

namespace att {
constexpr int SHM_V = 64 * 128 * 2, SHM_K = 64 * 192 * 2, OFF_K = 2 * SHM_V, OFF_WS = OFF_K + 2 * SHM_K, LDS_TOTAL = OFF_WS + 8 * 64 * 4;
constexpr float THR = 8.f;
constexpr float NEGBIG = -1e30f;
constexpr int KVBLK_ = 64;
#define ATT_SBAR() __builtin_amdgcn_sched_barrier(0)
__device__ __forceinline__ int crow(int r, int hi) { return (r & 3) + 8 * (r >> 2) + 4 * hi; }
__device__ __forceinline__ int koff(int row, int sub, int chunk) { return sub * 8192 + row * 128 + ((chunk ^ ((row >> 1) & 7)) << 4); }
__device__ __forceinline__ void partialSM(f32x16& p0, f32x16& p1, float& m_reg, float& alpha) {
    float pmax = p0[0];
#pragma unroll
    for (int r = 1; r < 16; ++r) pmax = fmaxf(pmax, p0[r]);
#pragma unroll
    for (int r = 0; r < 16; ++r) pmax = fmaxf(pmax, p1[r]);
    { auto rr = __builtin_amdgcn_permlane32_swap(__float_as_uint(pmax), __float_as_uint(pmax), false, false); pmax = fmaxf(__uint_as_float(rr[0]), __uint_as_float(rr[1])); }
    float mn;
    if (__builtin_expect(__all(pmax - m_reg <= THR), 1)) { mn = m_reg; alpha = 1.f; }
    else { mn = fmaxf(m_reg, pmax); alpha = __builtin_amdgcn_exp2f(m_reg - mn); m_reg = mn; }
#pragma unroll
    for (int r = 0; r < 16; ++r) p0[r] = __builtin_amdgcn_exp2f(p0[r] - mn);
#pragma unroll
    for (int r = 0; r < 16; ++r) p1[r] = p1[r] - mn;
}
__device__ __forceinline__ void finishSM(f32x16& p0, f32x16& p1, float alpha, float& l_reg, bf16x8& pa0, bf16x8& pa1, bf16x8& pa2, bf16x8& pa3) {
#pragma unroll
    for (int r = 0; r < 16; ++r) p1[r] = __builtin_amdgcn_exp2f(p1[r]);
    float ps = 0.f;
#pragma unroll
    for (int r = 0; r < 16; ++r) ps += p0[r];
#pragma unroll
    for (int r = 0; r < 16; ++r) ps += p1[r];
    { auto rr = __builtin_amdgcn_permlane32_swap(__float_as_uint(ps), __float_as_uint(ps), false, false); ps = __uint_as_float(rr[0]) + __uint_as_float(rr[1]); }
    l_reg = l_reg * alpha + ps;
#define ATT_PK4(P, BASE, OUT) do { unsigned a0 = pk_bf16(P[BASE + 0], P[BASE + 1]), a1 = pk_bf16(P[BASE + 2], P[BASE + 3]);   \
    unsigned b0 = pk_bf16(P[BASE + 4], P[BASE + 5]), b1 = pk_bf16(P[BASE + 6], P[BASE + 7]);                              \
    auto r0 = __builtin_amdgcn_permlane32_swap(a0, b0, false, false); auto r1 = __builtin_amdgcn_permlane32_swap(a1, b1, false, false); \
    u32x4 w = {r0[0], r1[0], r0[1], r1[1]}; OUT = __builtin_bit_cast(bf16x8, w); } while (0)
    ATT_PK4(p0, 0, pa0); ATT_PK4(p0, 8, pa1); ATT_PK4(p1, 0, pa2); ATT_PK4(p1, 8, pa3);
#undef ATT_PK4
}
__device__ __forceinline__ void qkt(f32x16& p0, f32x16& p1, const LAS unsigned char* Ks, const bf16x8* qr, int r32, int hi) {
    p0 = f32x16{}; p1 = f32x16{};
#pragma unroll
    for (int d0 = 0; d0 < 12; ++d0) { const int sub = d0 >> 2, chunk = (d0 & 3) * 2 + hi;
        const bf16x8 b0 = *(const LAS bf16x8*)(Ks + koff(r32, sub, chunk));
        const bf16x8 b1 = *(const LAS bf16x8*)(Ks + koff(32 + r32, sub, chunk));
        p0 = __builtin_amdgcn_mfma_f32_32x32x16_bf16(b0, qr[d0], p0, 0, 0, 0);
        p1 = __builtin_amdgcn_mfma_f32_32x32x16_bf16(b1, qr[d0], p1, 0, 0, 0);
        if ((d0 & 3) == 3) ATT_SBAR(); }
}
__device__ __forceinline__ int v_st(int k, int c) { const int kk = (k & ~0xC) | ((k & 4) << 1) | ((k & 8) >> 1); return ((kk >> 3) * 4 + (c >> 5)) * 512 + ((kk & 7) * 32 + (c & 31)) * 2; }
__device__ __forceinline__ int v_rd_base(int lane) { return ((lane & 3) << 3) | (((lane >> 2) & 3) << 6) | (((lane >> 4) & 1) << 5) | (((lane >> 5) & 1) << 8); }
constexpr int v_rd_off(int d0, int ks, int half) { return d0 * 512 + ks * 4096 + half * 2048; }
template <int OFF> __device__ __forceinline__ s16x4 tr_read(int vb) { s16x4 r; asm volatile("ds_read_b64_tr_b16 %0, %1 offset:%2" : "=&v"(r) : "v"(vb), "i"(OFF) : "memory"); return r; }
template <int D0> __device__ __forceinline__ void pv_one(f32x16& od, int vb, bf16x8 pa0, bf16x8 pa1, bf16x8 pa2, bf16x8 pa3) {
    const s16x4 l0 = tr_read<v_rd_off(D0, 0, 0)>(vb), h0 = tr_read<v_rd_off(D0, 0, 1)>(vb), l1 = tr_read<v_rd_off(D0, 1, 0)>(vb), h1 = tr_read<v_rd_off(D0, 1, 1)>(vb);
    const s16x4 l2 = tr_read<v_rd_off(D0, 2, 0)>(vb), h2 = tr_read<v_rd_off(D0, 2, 1)>(vb), l3 = tr_read<v_rd_off(D0, 3, 0)>(vb), h3 = tr_read<v_rd_off(D0, 3, 1)>(vb);
    asm volatile("s_waitcnt lgkmcnt(0)" ::: "memory"); ATT_SBAR();
#define ATT_PK(L, H) (bf16x8){L[0], L[1], L[2], L[3], H[0], H[1], H[2], H[3]}
    od = __builtin_amdgcn_mfma_f32_32x32x16_bf16(pa0, ATT_PK(l0, h0), od, 0, 0, 0);
    od = __builtin_amdgcn_mfma_f32_32x32x16_bf16(pa1, ATT_PK(l1, h1), od, 0, 0, 0);
    od = __builtin_amdgcn_mfma_f32_32x32x16_bf16(pa2, ATT_PK(l2, h2), od, 0, 0, 0);
    od = __builtin_amdgcn_mfma_f32_32x32x16_bf16(pa3, ATT_PK(l3, h3), od, 0, 0, 0);
#undef ATT_PK
}
__device__ __forceinline__ void pv_d0(f32x16* o, int vb, bf16x8 pa0, bf16x8 pa1, bf16x8 pa2, bf16x8 pa3) {
    pv_one<0>(o[0], vb, pa0, pa1, pa2, pa3); pv_one<1>(o[1], vb, pa0, pa1, pa2, pa3); pv_one<2>(o[2], vb, pa0, pa1, pa2, pa3); pv_one<3>(o[3], vb, pa0, pa1, pa2, pa3);
}

__device__ __forceinline__ void unit(const Frame& F, const bool nostore, int b, int hd, int qb, const bf16_t* __restrict__ Q, bf16_t* Y, const bf16_t* __restrict__ VV, const bf16_t* __restrict__ KR) {
    int tid_ = F.wave * 64 + lane_id(); asm volatile("" : "+v"(tid_));
    const int tid = tid_, wid = F.wave, lane = tid & 63, r32 = lane & 31, hi = lane >> 5;
    LAS unsigned char* lds = F.lds;
    LAS unsigned char* V_lds = lds; LAS unsigned char* K_lds = lds + OFF_K;
    LAS float* wsf = (LAS float*)(lds + OFF_WS) + wid * 64; LAS float* li_l = wsf; LAS float* al_l = wsf + 32;
    const size_t rowbase = (size_t)b * SEQ; const int q0 = qb * 256; const int qc = 4 * qb + (wid >> 1); const int NT = 4 * qb + 4;
    float m_reg = NEGBIG, l_reg = 0.f; f32x16 o[4] = {}; bf16x8 qr[12];
    { const bf16_t* Qw = Q + (rowbase + q0 + wid * 32 + r32) * 1536 + hd * 192 + hi * 8;
#pragma unroll
      for (int d0 = 0; d0 < 12; ++d0) qr[d0] = *(const bf16x8*)(Qw + d0 * 16); }
    const bf16_t* Kn = Y + rowbase * YLD + hd * 128; const bf16_t* Vh = VV + rowbase * 1024 + hd * 128; const bf16_t* Kr = KR + rowbase * 64;
    const int sr = tid >> 4, sc = (tid & 15) * 8; const int vst0 = v_st(sr, sc), vst1 = v_st(32 + sr, sc);
    const int kst0 = koff(sr, sc >> 6, (sc & 63) >> 3), kst1 = koff(32 + sr, sc >> 6, (sc & 63) >> 3), kst2 = koff(tid >> 3, 2, tid & 7);
    const int vb0 = (int)(uintptr_t)V_lds + v_rd_base(lane);
    bf16x8 vs0, vs1, ks0, ks1, ks2;
#define ATT_SLOAD(k0) do { vs0 = *(const bf16x8*)(Vh + (size_t)((k0) + sr) * 1024 + sc); vs1 = *(const bf16x8*)(Vh + (size_t)((k0) + 32 + sr) * 1024 + sc); \
    ks0 = *(const bf16x8*)(Kn + (size_t)((k0) + sr) * YLD + sc); ks1 = *(const bf16x8*)(Kn + (size_t)((k0) + 32 + sr) * YLD + sc); \
    ks2 = *(const bf16x8*)(Kr + (size_t)((k0) + (tid >> 3)) * 64 + (tid & 7) * 8); } while (0)
#define ATT_SWRITE(bf) do { *(LAS bf16x8*)(V_lds + (bf) * SHM_V + vst0) = vs0; *(LAS bf16x8*)(V_lds + (bf) * SHM_V + vst1) = vs1; \
    *(LAS bf16x8*)(K_lds + (bf) * SHM_K + kst0) = ks0; *(LAS bf16x8*)(K_lds + (bf) * SHM_K + kst1) = ks1; *(LAS bf16x8*)(K_lds + (bf) * SHM_K + kst2) = ks2; } while (0)
#define ATT_RESC(al) do { if (__any((al) < 1.f)) { if (hi == 0) al_l[r32] = (al); asm volatile("s_waitcnt lgkmcnt(0)" ::: "memory"); \
    _Pragma("unroll") for (int d = 0; d < 4; ++d) _Pragma("unroll") for (int r = 0; r < 16; ++r) o[d][r] *= al_l[crow(r, hi)]; } } while (0)
#define ATT_QKT(P0, P1, bf, jt) do { if ((jt) <= qc) qkt(P0, P1, K_lds + (bf) * SHM_K, qr, r32, hi); else { _Pragma("unroll") for (int r = 0; r < 16; ++r) { P0[r] = NEGBIG; P1[r] = NEGBIG; } } } while (0)
    f32x16 pA0, pA1, pB0, pB1; float alA, alB; bf16x8 pa0, pa1, pa2, pa3;
    ATT_SLOAD(0); asm volatile("s_waitcnt vmcnt(0)" ::: "memory"); ATT_SWRITE(0); __syncthreads();
    ATT_QKT(pA0, pA1, 0, 0); partialSM(pA0, pA1, m_reg, alA);
    ATT_SLOAD(KVBLK_); asm volatile("s_waitcnt vmcnt(0)" ::: "memory"); ATT_SWRITE(1); __syncthreads();
    for (int j = 1; j + 1 < NT; j += 2) {
        ATT_SBAR(); ATT_QKT(pB0, pB1, 1, j);
        finishSM(pA0, pA1, alA, l_reg, pa0, pa1, pa2, pa3); ATT_SBAR();
        ATT_SLOAD((j + 1) * KVBLK_); ATT_SBAR();
        pv_d0(o, vb0, pa0, pa1, pa2, pa3); partialSM(pB0, pB1, m_reg, alB);
        __syncthreads(); asm volatile("s_waitcnt vmcnt(0)" ::: "memory"); ATT_SWRITE(0);
        ATT_RESC(alB); __syncthreads();
        ATT_SBAR(); ATT_QKT(pA0, pA1, 0, j + 1);
        finishSM(pB0, pB1, alB, l_reg, pa0, pa1, pa2, pa3); ATT_SBAR();
        ATT_SLOAD((j + 2) * KVBLK_); ATT_SBAR();
        pv_d0(o, vb0 + SHM_V, pa0, pa1, pa2, pa3); partialSM(pA0, pA1, m_reg, alA);
        __syncthreads(); asm volatile("s_waitcnt vmcnt(0)" ::: "memory"); ATT_SWRITE(1);
        ATT_RESC(alA); __syncthreads();
    }
    ATT_SBAR(); ATT_QKT(pB0, pB1, 1, NT - 1);
    finishSM(pA0, pA1, alA, l_reg, pa0, pa1, pa2, pa3); ATT_SBAR();
    pv_d0(o, vb0, pa0, pa1, pa2, pa3); partialSM(pB0, pB1, m_reg, alB);
    __syncthreads(); ATT_RESC(alB);
    finishSM(pB0, pB1, alB, l_reg, pa0, pa1, pa2, pa3); ATT_SBAR();
    pv_d0(o, vb0 + SHM_V, pa0, pa1, pa2, pa3);
    if (hi == 0) li_l[r32] = l_reg; asm volatile("s_waitcnt lgkmcnt(0)" ::: "memory");
    float rli[16];
#pragma unroll
    for (int r = 0; r < 16; ++r) rli[r] = __builtin_amdgcn_rcpf(li_l[crow(r, hi)]);
    __syncthreads();
    int hi2 = hi, r32b = r32, ln = lane; asm volatile("" : "+v"(hi2), "+v"(r32b), "+v"(ln));
    LAS unsigned char* stg = lds + wid * 8704;
#pragma unroll
    for (int r = 0; r < 16; ++r) { const int orow = (r & 3) + 8 * (r >> 2) + 4 * hi2;
#pragma unroll
        for (int d0 = 0; d0 < 4; ++d0) *(LAS bf16_t*)(stg + orow * 272 + (d0 * 32 + r32b) * 2) = f2bf(o[d0][r] * rli[r]); }
    asm volatile("s_waitcnt lgkmcnt(0)" ::: "memory");
    bf16_t* Ow = Y + (rowbase + q0 + wid * 32) * YLD + 1024 + hd * 128;
    u32x4 zb[8];
#pragma unroll
    for (int i = 0; i < 8; ++i) { const int row = i * 4 + (ln >> 4), ch = ln & 15; zb[i] = *(const u32x4*)(Ow + (unsigned)(row * YLD + ch * 8)); }
#pragma unroll
    for (int i = 0; i < 8; ++i) { const int row = i * 4 + (ln >> 4), ch = ln & 15; const u32x4 ov = *(const LAS u32x4*)(stg + row * 272 + ch * 16); u32x4 w;
        w.x = pk_bf16(bf_lo(ov.x) * bf_lo(zb[i].x), bf_hi(ov.x) * bf_hi(zb[i].x)); w.y = pk_bf16(bf_lo(ov.y) * bf_lo(zb[i].y), bf_hi(ov.y) * bf_hi(zb[i].y));
        w.z = pk_bf16(bf_lo(ov.z) * bf_lo(zb[i].z), bf_hi(ov.z) * bf_hi(zb[i].z)); w.w = pk_bf16(bf_lo(ov.w) * bf_lo(zb[i].w), bf_hi(ov.w) * bf_hi(zb[i].w));
        if (!nostore) *(u32x4*)(Ow + (unsigned)(row * YLD + ch * 8)) = w; }
    asm volatile("s_waitcnt lgkmcnt(0)" ::: "memory");
    __syncthreads();
#undef ATT_SLOAD
#undef ATT_SWRITE
#undef ATT_RESC
#undef ATT_QKT
}
}

__device__ __forceinline__ void phaseC_att(const Frame& F, const bool nostore, const bf16_t* q, bf16_t* y, const bf16_t* vv, const bf16_t* kr) {
    for (int v = F.vcu; v < 256; v += F.G) { const int bh = v >> 2, s = v & 3;
        att::unit(F, nostore, bh >> 3, bh & 7, 7 - s, q, y, vv, kr);
        att::unit(F, nostore, bh >> 3, bh & 7, s, q, y, vv, kr); }
}
__device__ __forceinline__ void phaseC_lru(const Frame& F, const Args& a, const unsigned char* ws, const bool nostore, int l, bf16_t* y, const bf16_t* xc, const float* agg) {
    for (int item = F.vcu; item < NBATCH * 32; item += F.G) lru_item<2>(F, a, ws, nostore, l, item, xc, y, const_cast<float*>(agg));
}

__device__ __forceinline__ void gmlp_item(const Frame& F, const Args& a, const unsigned char* ws, const bool nostore, int l, int item, const bf16_t* v1, bf16_t* y, const float* vslab) {
    const int nb = item >> 2, g = item & 3; const size_t t0 = (size_t)nb * 128;
    int lane_ = lane_id(); asm volatile("" : "+v"(lane_));
    const int lane = lane_, w = F.wave, cl = lane & 15, kg = lane >> 4;
    LAS f32x2v* stat = (LAS f32x2v*)F.lds; LAS unsigned char* vnT = F.lds + 1024;
    { float pv[16];
#pragma unroll
      for (int i = 0; i < 16; ++i) pv[i] = vslab[(t0 + 16 * w + i) * 64 + lane];
#pragma unroll
      for (int i = 0; i < 16; ++i) { float v = pv[i]; v += sx<2>(v); v += sx<4>(v); v += sx<8>(v); v += sx<16>(v); v = xsum32(v);
          const float o = sx<1>(v);
          const float mu = v * (1.f / 1024.f); const float var = fmaxf(o * (1.f / 1024.f) - mu * mu, 0.f);
          if (lane == 0) stat[16 * w + i] = (f32x2v){mu, rsqrtf(var + EPS)}; } }
    LDS_WAIT(); __syncthreads();
    { const f32x2v st0 = stat[2 * lane], st1 = stat[2 * lane + 1];
      const float* lg = a.in[I_GM_LN_G] + l * 1024 + g * 256; const float* lb = a.in[I_GM_LN_B] + l * 1024 + g * 256;
      u32x4 xa[4], xb[4];
#pragma unroll
      for (int i = 0; i < 4; ++i) { const int c8 = 4 * w + i; xa[i] = *(const u32x4*)(v1 + (t0 + 2 * lane) * 1024 + g * 256 + c8 * 8); xb[i] = *(const u32x4*)(v1 + (t0 + 2 * lane + 1) * 1024 + g * 256 + c8 * 8); }
#pragma unroll
      for (int i = 0; i < 4; ++i) { const int c8 = 4 * w + i;
          const f32x4 g0 = *(const f32x4*)(lg + c8 * 8), g1 = *(const f32x4*)(lg + c8 * 8 + 4), b0 = *(const f32x4*)(lb + c8 * 8), b1 = *(const f32x4*)(lb + c8 * 8 + 4);
          const float ga[8] = {g0.x, g0.y, g0.z, g0.w, g1.x, g1.y, g1.z, g1.w}, be[8] = {b0.x, b0.y, b0.z, b0.w, b1.x, b1.y, b1.z, b1.w};
          const unsigned wa[4] = {xa[i].x, xa[i].y, xa[i].z, xa[i].w}, wb[4] = {xb[i].x, xb[i].y, xb[i].z, xb[i].w};
#pragma unroll
          for (int e = 0; e < 8; ++e) {
              const float fa = (e & 1) ? bf_hi(wa[e >> 1]) : bf_lo(wa[e >> 1]), fb = (e & 1) ? bf_hi(wb[e >> 1]) : bf_lo(wb[e >> 1]);
              const float na = (fa - st0.x) * st0.y * ga[e] + be[e], nbv = (fb - st1.x) * st1.y * ga[e] + be[e];
              *(LAS unsigned*)(vnT + (c8 * 8 + e) * 272 + lane * 4) = pk_bf16(na, nbv); } } }
    const bf16_t* gmw = (const bf16_t*)(ws + WS_GMW) + (size_t)g * 128 * 128;
    const float* bs = a.in[I_GM_BS] + l * 512 + g * 128;
    bf16_t* ybase = y + t0 * YLD + g * 256;
    const int tid = w * 64 + lane;
    u32x4 pa[8];
#pragma unroll
    for (int i = 0; i < 8; ++i) { const int idx = tid + 512 * i; pa[i] = *(const u32x4*)(ybase + (unsigned)((idx >> 5) * YLD + (idx & 31) * 8)); }
    float bsv[8];
#pragma unroll
    for (int ct = 0; ct < 8; ++ct) bsv[ct] = bs[16 * ct + cl];
    bf16x8 wf[2][4];
#pragma unroll
    for (int ks = 0; ks < 2; ++ks) wf[0][ks] = *(const bf16x8*)(gmw + (size_t)cl * 128 + 32 * ks + 8 * kg);
    LDS_WAIT(); __syncthreads();
    bf16x8 af[2][4];
#pragma unroll
    for (int r = 0; r < 2; ++r)
#pragma unroll
        for (int ks = 0; ks < 4; ++ks) af[r][ks] = *(const LAS bf16x8*)(vnT + (16 * (2 * w + r) + cl) * 272 + (32 * ks + 8 * kg) * 2);
    LDS_WAIT(); __syncthreads();
    LAS unsigned char* stg = vnT;
#pragma unroll
    for (int ct = 0; ct < 8; ++ct) { const int cur = ct & 1;
        if (ct + 1 < 8) {
#pragma unroll
            for (int ks = 0; ks < 4; ++ks) if (ks < ((ct + 1 < 4) ? 2 : 4)) wf[cur ^ 1][ks] = *(const bf16x8*)(gmw + (size_t)(16 * (ct + 1) + cl) * 128 + 32 * ks + 8 * kg); }
        f32x4 acc[2] = {(f32x4){0.f, 0.f, 0.f, 0.f}, (f32x4){0.f, 0.f, 0.f, 0.f}};
#pragma unroll
        for (int ks = 0; ks < 4; ++ks) if (ks < ((ct < 4) ? 2 : 4)) {
            acc[0] = __builtin_amdgcn_mfma_f32_16x16x32_bf16(af[0][ks], wf[cur][ks], acc[0], 0, 0, 0); acc[1] = __builtin_amdgcn_mfma_f32_16x16x32_bf16(af[1][ks], wf[cur][ks], acc[1], 0, 0, 0); }
#pragma unroll
        for (int r = 0; r < 2; ++r) { u32x2 o; o.x = pk_bf16(acc[r][0] + bsv[ct], acc[r][1] + bsv[ct]); o.y = pk_bf16(acc[r][2] + bsv[ct], acc[r][3] + bsv[ct]);
            *(LAS u32x2*)(stg + (16 * ct + cl) * 528 + (16 * (2 * w + r) + 4 * kg) * 2) = o; }
    }
    LDS_WAIT(); __syncthreads();
#pragma unroll
    for (int i = 0; i < 8; ++i) { const int idx = tid + 512 * i; const u32x4 sv = *(const LAS u32x4*)(stg + (idx >> 5) * 528 + (idx & 31) * 16); u32x4 o;
        o.x = pk_bf16(bf_lo(pa[i].x) * bf_lo(sv.x), bf_hi(pa[i].x) * bf_hi(sv.x)); o.y = pk_bf16(bf_lo(pa[i].y) * bf_lo(sv.y), bf_hi(pa[i].y) * bf_hi(sv.y));
        o.z = pk_bf16(bf_lo(pa[i].z) * bf_lo(sv.z), bf_hi(pa[i].z) * bf_hi(sv.z)); o.w = pk_bf16(bf_lo(pa[i].w) * bf_lo(sv.w), bf_hi(pa[i].w) * bf_hi(sv.w));
        if (!nostore) *(u32x4*)(ybase + (unsigned)((idx >> 5) * YLD + (idx & 31) * 8)) = o; }
    LDS_WAIT(); __syncthreads();
}
__device__ __forceinline__ void phaseE(const Frame& F, const Args& a, const unsigned char* ws, const bool nostore, int l, const bf16_t* v1, bf16_t* y, const float* vslab) {
    for (int item = F.vcu; item < 512; item += F.G) gmlp_item(F, a, ws, nostore, l, item, v1, y, vslab);
}
constexpr int N_PHASES = 1 + 8 * DEPTH;
#ifndef MK_PER_PHASE
#define MK_PER_PHASE 0
#endif
#ifndef MK_MAX_PHASE
#define MK_MAX_PHASE N_PHASES
#endif

__global__ void __launch_bounds__(NWAVES * 64, 2) mk_fwd(Args args) {
    extern __shared__ __attribute__((aligned(16))) unsigned char lds_raw[];
    Frame F;
    F.lds = (LAS unsigned char*)lds_raw;
    F.wave = __builtin_amdgcn_readfirstlane((int)threadIdx.x >> 6);
    F.G = gridDim.x; { const int bx = blockIdx.x; F.vcu = (F.G % 8 == 0) ? (bx % 8) * (F.G / 8) + bx / 8 : bx; }
    volatile LAS unsigned* MISCW = (volatile LAS unsigned*)(F.lds + MISC_OFF);
    for (int u = threadIdx.x; u < (LDS_BYTES - RING_BYTES) / 4; u += NWAVES * 64) ((LAS unsigned*)(F.lds + RING_BYTES))[u] = 0u;
    __syncthreads();
    unsigned* ctl = (unsigned*)(args.ws + WS_CTL);
#if MK_PER_PHASE
    const int lo = args.ph_lo, hi = args.ph_hi;
    const bool multi = (hi - lo) > 1;
#else
    constexpr int lo = 0, hi = N_PHASES;
    constexpr bool multi = true;
#endif
    XcdBarrier bar; bar.bar = ctl + CW_BAR; bar.x = 0; bar.st = nullptr;
    if (multi) bar = xcd_barrier_post(ctl + CW_BAR, MISCW + 8);
#define IN(k) (lo <= (k) && (k) < hi)
#define SEAM(k) do { if (IN((k) + 1)) xcd_barrier(bar); } while (0)
#define xcd_barrier_if(c, b) do { if (c) xcd_barrier(b); } while (0)

typedef const __attribute__((address_space(4))) Args* KArgP;
#define PHASE_PTRS \
    KArgP kp = (KArgP)__builtin_amdgcn_kernarg_segment_ptr(); asm volatile("" : "+s"(kp)); Args la; \
    _Pragma("unroll") for (int i_ = 0; i_ < N_INPUTS; ++i_) la.in[i_] = kp->in[i_]; la.out = kp->out; la.ws = kp->ws; la.ph_lo = 0; la.ph_hi = 0; \
    unsigned char* ws = la.ws; asm volatile("" : "+s"(ws)); Frame Fp = F; int bid = (int)blockIdx.x; asm volatile("" : "+s"(Fp.wave), "+s"(Fp.vcu), "+s"(Fp.G), "+s"(bid)); (void)bid; \
    bf16_t* Hb = (bf16_t*)(ws + WS_H); bf16_t* Yb = (bf16_t*)(ws + WS_Y); \
    bf16_t* MISCb = (bf16_t*)(ws + WS_MISC); bf16_t* XCb = (bf16_t*)(ws + WS_XC); bf16_t* Qb = (bf16_t*)(ws + WS_Q); bf16_t* VVb = (bf16_t*)(ws + WS_VV); bf16_t* KRb = (bf16_t*)(ws + WS_KR); \
    bf16_t* V1b = (bf16_t*)(ws + WS_V1); bf16_t* Gb = (bf16_t*)(ws + WS_G); bf16_t* Ob = (bf16_t*)(ws + WS_O); \
    float* SLAB = (float*)(ws + WS_SLAB); float* AGG = (float*)(ws + WS_AGG); const float* CS = (const float*)(ws + WS_ROPE); const float* SN = CS + 2048 * 32; \
    const unsigned char* wb = ws + WS_WB; (void)Hb; (void)Yb; (void)MISCb; (void)XCb; (void)Qb; (void)VVb; (void)KRb; (void)V1b; (void)Gb; (void)Ob; (void)SLAB; (void)AGG; (void)CS; (void)SN; (void)wb;
    if (IN(0)) {
        { PHASE_PTRS
        convert_weights(Fp, la, ws, 0);
        rope_table(Fp, ws);
        norm_rows(Fp, false, la.in[I_X], nullptr, nullptr, nullptr, la.in[I_PRE_G], Hb);
        }
        SEAM(0);
    }
#pragma nounroll
    for (int l = 0; l < DEPTH; ++l) {
        const int pb = 1 + 8 * l;
        if (IN(pb + 0)) {
            { const bool nostore = false; (void)nostore;
            PHASE_PTRS
            SchedA S; S.ord.init(64, 16, Fp.G, bid); S.A = (const char*)Hb; S.B = (const char*)(wb + WB_W1T);
            EpiA E{MISCb, XCb, Yb, SLAB, KRb, CS, SN};
            g8::gemm_stream(Fp.lds, Fp.wave * 64 + lane_id(), 2048u, 2048u, S, E);
            }
            SEAM(pb + 0);
        }
        if (IN(pb + 1)) {
            { const bool nostore = false; (void)nostore;
            PHASE_PTRS
            { SchedZ SZ; SZ.v = Fp.vcu; SZ.A = (const char*)Hb; SZ.B = (const char*)(wb + WB_W1T); EpiA EZ{MISCb, XCb, Yb, SLAB, KRb, CS, SN};
              g8::gemm_stream(Fp.lds, Fp.wave * 64 + lane_id(), 2048u, 2048u, SZ, EZ); }
            SchedQKV S; S.v = Fp.vcu; S.misc = (const char*)MISCb; S.wq = (const char*)(wb + WB_WQT); S.wkv = (const char*)(wb + WB_WKVT);
            EpiQKV E{Qb, Yb, VVb, SLAB, CS, SN};
            g8::gemm_stream(Fp.lds, Fp.wave * 64 + lane_id(), 1536u, 768u, S, E);
            phaseB_lru(Fp, ws, (unsigned*)(ws + WS_CTL), nostore, l, XCb, Yb, AGG);
            }
            SEAM(pb + 1);
        }
        if (IN(pb + 2)) {
            { const bool nostore = false; (void)nostore;
            PHASE_PTRS
            phaseC_att(Fp, nostore, Qb, Yb, VVb, KRb);
            }
            SEAM(pb + 2);
        }
        if (IN(pb + 3)) {
            { const bool nostore = false; (void)nostore;
            PHASE_PTRS
            SchedD S; S.ord.init(64, 24, Fp.G, bid); S.A = (const char*)Hb; S.B = (const char*)(wb + WB_W2T);
            EpiD E{Yb, V1b, Gb, SLAB};
            g8::gemm_stream(Fp.lds, Fp.wave * 64 + lane_id(), 2048u, 2048u, S, E);
            }
            SEAM(pb + 3);
        }
        if (IN(pb + 4)) {
            { const bool nostore = false; (void)nostore;
            PHASE_PTRS
            phaseE(Fp, la, ws, nostore, l, V1b, Yb, SLAB);
            }
            SEAM(pb + 4);
        }
        if (IN(pb + 5)) {
            { const bool nostore = false; (void)nostore;
            PHASE_PTRS
            SchedF S; S.ord.init(64, 4, Fp.G, bid); S.A = (const char*)Yb; S.B = (const char*)(wb + WB_WPT);
            EpiF E{Gb, Hb};
            g8::gemm_stream(Fp.lds, Fp.wave * 64 + lane_id(), (unsigned)(YLD * 2), (unsigned)(YLD * 2), S, E);
            }
            SEAM(pb + 5);
        }
        if (IN(pb + 6)) {
            { const bool nostore = false; (void)nostore;
            PHASE_PTRS
            SchedG S; S.ord.init(64, 4, Fp.G, bid); S.A = (const char*)Hb; S.B = (const char*)(wb + WB_WOT);
            EpiG E{Ob};
            g8::gemm_stream(Fp.lds, Fp.wave * 64 + lane_id(), 2048u, 2048u, S, E);
            }
            SEAM(pb + 6);
        }
        if (IN(pb + 7)) {
            { const bool nostore = false; (void)nostore;
            PHASE_PTRS
            const float* xin = (l == 0) ? la.in[I_X] : la.out;
            norm_rows(Fp, nostore, xin, Ob, la.in[I_POST_G] + l * DM, la.out, (l + 1 < DEPTH) ? la.in[I_PRE_G] + (l + 1) * DM : nullptr, Hb);
            if (l + 1 < DEPTH) convert_weights(Fp, la, ws, l + 1);
            }
            SEAM(pb + 7);
        }
    }
#undef IN
#undef SEAM
}

#ifndef MK_PROBE
#define MK_PROBE 0
#endif
static int mk_setup(size_t ws_size) {
    static int grid = 0;
    if (grid == 0) {
        if (ws_size < WS_END) { fprintf(stderr, "kernel_launch: workspace too small: %zu < %zu\n", ws_size, (size_t)WS_END); grid = -1; return grid; }
        int dev = 0, cus = 0, per_cu = 0;
        if (hipGetDevice(&dev) != hipSuccess || hipDeviceGetAttribute(&cus, hipDeviceAttributeMultiprocessorCount, dev) != hipSuccess) { grid = -1; return grid; }
        if (hipFuncSetAttribute((const void*)mk_fwd, hipFuncAttributeMaxDynamicSharedMemorySize, LDS_BYTES) != hipSuccess) { fprintf(stderr, "kernel_launch: hipFuncSetAttribute failed\n"); grid = -1; return grid; }
        if (hipOccupancyMaxActiveBlocksPerMultiprocessor(&per_cu, (const void*)mk_fwd, NWAVES * 64, LDS_BYTES) != hipSuccess || per_cu < 1)
            fprintf(stderr, "kernel_launch: occupancy query reports %d blocks/CU\n", per_cu);
        (void)hipGetLastError();
        grid = cus;
        if (grid != 256) fprintf(stderr, "kernel_launch: note: %d CUs (tile schedules assume 256)\n", grid);
    }
    return grid;
}
static void mk_launch(void* const* d_in, void* d_out, void* d_ws, hipStream_t stream, int grid, int lo, int hi) {
    Args a{};
    for (int i = 0; i < N_INPUTS; ++i) a.in[i] = (const float*)d_in[i];
    a.out = (float*)d_out; a.ws = (unsigned char*)d_ws; a.ph_lo = lo; a.ph_hi = hi; a.probe = MK_PROBE; a.pad = 0;
    hipLaunchKernelGGL(mk_fwd, dim3(grid), dim3(NWAVES * 64), LDS_BYTES, stream, a);
}
extern "C" void kernel_launch(void* const* d_in, const int* in_sizes, int n_in, void* d_out, int out_size, void* d_ws, size_t ws_size, hipStream_t stream) {
    const int grid = mk_setup(ws_size); if (grid < 0) return;
    hipMemsetAsync((char*)d_ws + WS_CTL, 0, CTL_ZERO_BYTES, stream);
#if MK_PER_PHASE
    for (int ph = 0; ph < N_PHASES; ++ph) mk_launch(d_in, d_out, d_ws, stream, grid, ph, ph + 1);
#else
    mk_launch(d_in, d_out, d_ws, stream, grid, 0, N_PHASES);
#endif
}
```

```cpp
#define MK_PROBE 0
#include <hip/hip_runtime.h>
#include <cstdio>
#include <cstdint>

#define LAS __attribute__((address_space(3)))
#define GAS __attribute__((address_space(1)))
typedef unsigned short bf16_t;
typedef short bf16x8 __attribute__((ext_vector_type(8)));
typedef short s16x4 __attribute__((ext_vector_type(4)));
typedef float f32x2 __attribute__((ext_vector_type(2)));
typedef float f32x4 __attribute__((ext_vector_type(4)));
typedef float f32x16 __attribute__((ext_vector_type(16)));
typedef unsigned u32x2 __attribute__((ext_vector_type(2)));
typedef unsigned u32x4 __attribute__((ext_vector_type(4)));
typedef __bf16 bf16x2_t __attribute__((ext_vector_type(2)));

__device__ __forceinline__ unsigned pk_bf16(float lo, float hi) { f32x2 v = {lo, hi}; bf16x2_t b = __builtin_convertvector(v, bf16x2_t); return __builtin_bit_cast(unsigned, b); }
__device__ __forceinline__ float bf_lo(unsigned w) { return __uint_as_float(w << 16); }
__device__ __forceinline__ float bf_hi(unsigned w) { return __uint_as_float(w & 0xffff0000u); }
__device__ __forceinline__ float bf1(bf16_t h) { return __uint_as_float(((unsigned)h) << 16); }
__device__ __forceinline__ bf16_t f2bf(float f) { return (bf16_t)(pk_bf16(f, 0.f) & 0xffffu); }
__device__ __forceinline__ float fsigmoid(float x) { return __builtin_amdgcn_rcpf(1.f + __expf(-x)); }
__device__ __forceinline__ float fsilu(float x) { return x * __builtin_amdgcn_rcpf(1.f + __expf(-x)); }
template <int XM> __device__ __forceinline__ float sx(float v) { return __int_as_float(__builtin_amdgcn_ds_swizzle(__float_as_int(v), (XM << 10) | 0x1f)); }
__device__ __forceinline__ float xsum32(float v) { auto rr = __builtin_amdgcn_permlane32_swap(__float_as_uint(v), __float_as_uint(v), false, false); return __uint_as_float(rr[0]) + __uint_as_float(rr[1]); }
__device__ __forceinline__ float wave_sum(float v) { v += sx<1>(v); v += sx<2>(v); v += sx<4>(v); v += sx<8>(v); v += sx<16>(v); return xsum32(v); }
#define LDS_WAIT() asm volatile("s_waitcnt lgkmcnt(0)" ::: "memory")
#define VM_WAIT() asm volatile("s_waitcnt vmcnt(0)" ::: "memory")

namespace g8 {
constexpr int BM = 256, BK = 64, HALF = 128, HTB = HALF * BK * 2, STAGE_BYTES = 8 * HTB, NXCD = 8, WGM = 8;
__host__ __device__ __forceinline__ int lds_byte(int r, int c) { const int st = (r >> 4) * 2 + (c >> 5), rr = r & 15, cc = c & 31, ob = rr * 64 + cc * 2; return st * 1024 + (ob ^ (((ob >> 9) & 1) << 5)); }
__host__ __device__ __forceinline__ void stage_rc(int b, int& R, int& C) { const int st = b / 1024, sb = b % 1024, swz = sb ^ (((sb >> 9) & 1) << 5); R = (st >> 1) * 16 + swz / 64; C = (st & 1) * 32 + (swz % 64) / 2; }
__host__ __device__ __forceinline__ int perm32(int rho) { const int n = rho >> 4, i = rho & 15; return 8 * (i >> 2) + 4 * n + (i & 3); }

struct UnitD { const char* A; const char* B; int nt, pm, pn, kind; };
constexpr int KEEP_ACC = 0x100;

struct TileOrder {
    int nM, nN, nwg, G, c;
    __device__ void init(int nM_, int nN_, int G_, int c_) { nM = nM_; nN = nN_; nwg = nM * nN; G = G_; c = c_; }
    __device__ bool tile(int i, int& pm, int& pn) const {
        const long L = (long)i * G + c; if (L >= nwg) return false;
        int wgid = (int)L; { const int q = nwg / NXCD, r = nwg % NXCD, xcd = wgid % NXCD, off = wgid / NXCD; wgid = (xcd < r ? xcd * (q + 1) : r * (q + 1) + (xcd - r) * q) + off; }
        const int nig = WGM * nN, gid = wgid / nig, fm = gid * WGM, gsz = (nM - fm) < WGM ? (nM - fm) : WGM;
        pm = fm + ((wgid % nig) % gsz); pn = (wgid % nig) / gsz; return true;
    }
};

template <bool AFTER_DRAIN = false, class Sched, class Epi>
__device__ __forceinline__ void gemm_stream(LAS unsigned char* lds, int tid_in, const unsigned lda, const unsigned ldb, const Sched& S, const Epi& E) {
    int tid_ = tid_in; asm volatile("" : "+v"(tid_));
    const int tid = tid_, wid = __builtin_amdgcn_readfirstlane(tid >> 6), lane = tid & 63, wr = wid >> 2, wc = wid & 3, fr = lane & 15, fq = lane >> 4;
    unsigned voffA[2], voffB[2];
#pragma unroll
    for (int i = 0; i < 2; ++i) { int R, C; stage_rc(tid * 16 + i * 8192, R, C); const int Rb = (R & ~31) + perm32(R & 31);
        voffA[i] = (unsigned)R * lda + (unsigned)C * 2u; voffB[i] = (unsigned)Rb * ldb + (unsigned)C * 2u; }
    const size_t kstep = (size_t)(BK * 2);
    const size_t hstepA = (size_t)HALF * lda, hstepB = (size_t)HALF * ldb;
    const unsigned ldsw = (unsigned)wid * 1024u;
    const int aoff = lds_byte(wr * 64 + fr, fq * 8), boff = lds_byte(wc * 32 + fr, fq * 8);
#define G8_SA(b, h) (((b) * 2 + (h)) * HTB)
#define G8_SB(b, h) ((4 + (b) * 2 + (h)) * HTB)
#define G8_STAGE(bufoff, gbase, voff) do { _Pragma("unroll") for (int _i = 0; _i < 2; ++_i) \
        __builtin_amdgcn_global_load_lds((const unsigned*)((const char*)(gbase) + (voff)[_i]), (LAS unsigned*)(lds + (bufoff) + ldsw + _i * 8192), 16, 0, 0); } while (0)
#define G8_LDA(dst, b, h) do { _Pragma("unroll") for (int m = 0; m < 4; ++m) _Pragma("unroll") for (int k = 0; k < 2; ++k) dst[m][k] = *(const LAS bf16x8*)(lds + G8_SA(b, h) + aoff + m * 2048 + k * 1024); } while (0)
#define G8_LDB(dst, b, h) do { _Pragma("unroll") for (int n = 0; n < 2; ++n) _Pragma("unroll") for (int k = 0; k < 2; ++k) dst[n][k] = *(const LAS bf16x8*)(lds + G8_SB(b, h) + boff + n * 2048 + k * 1024); } while (0)
#define G8_MMA(ai, bj, At, Bt) do { __builtin_amdgcn_s_setprio(1); _Pragma("unroll") for (int m = 0; m < 4; ++m) _Pragma("unroll") for (int n = 0; n < 2; ++n) _Pragma("unroll") for (int k = 0; k < 2; ++k) \
        acc[ai][bj][m][n] = __builtin_amdgcn_mfma_f32_16x16x32_bf16(Bt[n][k], At[m][k], acc[ai][bj][m][n], 0, 0, 0); __builtin_amdgcn_s_setprio(0); } while (0)
#define G8_WAIT_V(n) asm volatile("s_waitcnt vmcnt(" #n ")" ::: "memory")
#define G8_WAIT_L(n) asm volatile("s_waitcnt lgkmcnt(" #n ")" ::: "memory")
#define G8_BAR __builtin_amdgcn_s_barrier()
#define G8_SCHED __builtin_amdgcn_sched_barrier(0)
    UnitD cur, nxt; int ui = 0;
    if (!S.next(0, cur)) return;
    f32x4 acc[2][2][4][2];
#pragma unroll
    for (int a = 0; a < 2; ++a)
#pragma unroll
        for (int b = 0; b < 2; ++b)
#pragma unroll
            for (int m = 0; m < 4; ++m)
#pragma unroll
                for (int n = 0; n < 2; ++n) acc[a][b][m][n] = (f32x4){0.f, 0.f, 0.f, 0.f};
    bf16x8 At[4][2], B0[2][2], B1[2][2];
    const char* cA = cur.A; const char* cB = cur.B;
    G8_STAGE(G8_SB(0, 0), cB, voffB); G8_STAGE(G8_SB(0, 1), cB + hstepB, voffB); G8_STAGE(G8_SA(0, 0), cA, voffA); G8_STAGE(G8_SA(0, 1), cA + hstepA, voffA);
    if (wr == 1) G8_BAR;
    G8_WAIT_V(2); G8_BAR;
    G8_STAGE(G8_SB(1, 0), cB + kstep, voffB); G8_STAGE(G8_SA(1, 0), cA + kstep, voffA); G8_STAGE(G8_SB(1, 1), cB + hstepB + kstep, voffB);
    G8_WAIT_V(6); G8_BAR;
    for (;;) {
        const bool has_next = S.next(ui + 1, nxt);
        const char* nA = has_next ? nxt.A : cA; const char* nB = has_next ? nxt.B : cB;
        const int nt = cur.nt;
        for (int t = 0; t < nt; t += 2) {
            const bool last = (t == nt - 2);
            const char* a1 = cA + (size_t)(t + 1) * kstep;
            const char* a2 = last ? nA : cA + (size_t)(t + 2) * kstep; const char* b2 = last ? nB : cB + (size_t)(t + 2) * kstep;
            const char* a3 = a2 + kstep; const char* b3 = b2 + kstep;
            G8_LDB(B0, 0, 0); G8_LDB(B1, 0, 1); G8_SCHED; G8_LDA(At, 0, 0); G8_STAGE(G8_SA(1, 1), a1 + hstepA, voffA);
            G8_WAIT_V(8); G8_WAIT_L(0); G8_BAR; G8_MMA(0, 0, At, B0); G8_MMA(0, 1, At, B1); G8_BAR; G8_SCHED;
            G8_LDA(At, 0, 1); G8_STAGE(G8_SB(0, 0), b2, voffB); G8_STAGE(G8_SB(0, 1), b2 + hstepB, voffB); G8_STAGE(G8_SA(0, 0), a2, voffA);
            G8_WAIT_V(8); G8_WAIT_L(0); G8_BAR; G8_MMA(1, 0, At, B0); G8_MMA(1, 1, At, B1); G8_BAR; G8_SCHED;
            G8_LDB(B0, 1, 0); G8_LDB(B1, 1, 1); G8_SCHED; G8_LDA(At, 1, 0); G8_STAGE(G8_SA(0, 1), a2 + hstepA, voffA);
            G8_WAIT_V(8); G8_WAIT_L(0); G8_BAR; G8_MMA(0, 0, At, B0); G8_MMA(0, 1, At, B1); G8_BAR; G8_SCHED;
            G8_LDA(At, 1, 1); G8_STAGE(G8_SB(1, 0), b3, voffB); G8_STAGE(G8_SB(1, 1), b3 + hstepB, voffB); G8_STAGE(G8_SA(1, 0), a3, voffA);
            G8_WAIT_V(8); G8_WAIT_L(0); G8_BAR; G8_MMA(1, 0, At, B0); G8_MMA(1, 1, At, B1); G8_BAR; G8_SCHED;
        }
        if (wr == 0) G8_BAR;
        if constexpr (!AFTER_DRAIN) { UnitD eu = cur; int fr_ = fr, fq_ = fq; asm volatile("" : "+s"(eu.pm), "+s"(eu.pn), "+v"(fr_), "+v"(fq_)); E(acc, eu, wr, wc, fr_, fq_); }
        if (!has_next) break;
        if (!(cur.kind & KEEP_ACC)) {
#pragma unroll
            for (int a = 0; a < 2; ++a)
#pragma unroll
                for (int b = 0; b < 2; ++b)
#pragma unroll
                    for (int m = 0; m < 4; ++m)
#pragma unroll
                        for (int n = 0; n < 2; ++n) acc[a][b][m][n] = (f32x4){0.f, 0.f, 0.f, 0.f};
        }
        cur = nxt; cA = nA; cB = nB; ++ui;
        if (wr == 1) G8_BAR;
    }
    G8_WAIT_V(0);
    G8_BAR;
    if constexpr (AFTER_DRAIN) {
        UnitD eu = cur; int fr_ = fr, fq_ = fq, ln_ = lane; asm volatile("" : "+s"(eu.pm), "+s"(eu.pn), "+v"(fr_), "+v"(fq_), "+v"(ln_)); E.fused(acc, eu, wr, wc, fr_, fq_, lds, wid, ln_); }
#undef G8_SA
#undef G8_SB
#undef G8_STAGE
#undef G8_LDA
#undef G8_LDB
#undef G8_MMA
#undef G8_WAIT_V
#undef G8_WAIT_L
#undef G8_BAR
#undef G8_SCHED
}
}

#define XB_TMO      128
#define XB_XCNT(j)  (256  + 64 * (j))
#define XB_XSUB(j)  (1280 + 64 * (j))
#define XB_XGEN(j)  (2304 + 64 * (j))
#define XB_TOP      3328
#define XB_TOPGEN   3392
#define XCD_BAR_WORDS 3456
#define XB_SPIN_CAP (1u << 18)
__device__ __forceinline__ unsigned xb_ld(unsigned* p)              { return __hip_atomic_load(p, __ATOMIC_RELAXED, __HIP_MEMORY_SCOPE_AGENT); }
__device__ __forceinline__ unsigned xb_add(unsigned* p, unsigned v) { return __hip_atomic_fetch_add(p, v, __ATOMIC_RELAXED, __HIP_MEMORY_SCOPE_AGENT); }
__device__ __forceinline__ unsigned xb_xcc_id() { return (unsigned)__builtin_amdgcn_s_getreg((3 << 11) | 20) & 0xFu; }
#define XB_SPIN(cond, bar) do { unsigned _sp = 0; while (cond) { __builtin_amdgcn_s_sleep(1); \
    if ((++_sp & 255u) == 0u) { if (xb_ld(&(bar)[XB_TMO])) break; if (_sp > XB_SPIN_CAP) { atomicAdd(&(bar)[XB_TMO], 1u); break; } } } } while (0)
struct XcdBarrier { unsigned* bar; unsigned x; volatile LAS unsigned* st; };
__device__ __forceinline__ XcdBarrier xcd_barrier_post(unsigned* bar, volatile LAS unsigned* st) {
    XcdBarrier b; b.bar = bar; b.x = xb_xcc_id(); b.st = st;
    if (threadIdx.x == 0) (void)xb_add(&bar[XB_XCNT(b.x)], 1u);
    return b;
}
__device__ __forceinline__ void xcd_barrier_complete(unsigned* bar, unsigned x, unsigned& nloc, unsigned& nx) {
    const unsigned G = gridDim.x * gridDim.y * gridDim.z;
    unsigned sum, cnt, mine, sp = 0u;
    for (;;) {
        sum = 0u; cnt = 0u; mine = 0u;
#pragma unroll
        for (unsigned j = 0; j < 16; ++j) { const unsigned c = xb_ld(&bar[XB_XCNT(j)]); sum += c; cnt += (c > 0u) ? 1u : 0u; mine = (j == x) ? c : mine; }
        if (sum == G) break;
        __builtin_amdgcn_s_sleep(1);
        if ((++sp & 255u) == 0u) { if (xb_ld(&bar[XB_TMO])) break; if (sp > XB_SPIN_CAP) { atomicAdd(&bar[XB_TMO], 1u); break; } }
    }
    nloc = mine > 0u ? mine : 1u; nx = cnt > 0u ? cnt : 1u;
}
__device__ __forceinline__ void xcd_barrier(const XcdBarrier& b) {
    asm volatile("s_waitcnt vmcnt(0)" ::: "memory");
    __syncthreads();
    if (threadIdx.x == 0) {
        unsigned* bar = b.bar; unsigned bx = b.x; asm volatile("" : "+s"(bar), "+s"(bx));
        __builtin_amdgcn_s_waitcnt(0);
        unsigned nloc = b.st[0], nx = b.st[1];
        if (nloc == 0u) { xcd_barrier_complete(bar, bx, nloc, nx); b.st[0] = nloc; b.st[1] = nx; }
        const unsigned old = xb_add(&bar[XB_XSUB(bx)], 1u);
        const unsigned gen = old / nloc;
        if (old + 1u == (gen + 1u) * nloc) {
            __builtin_amdgcn_fence(__ATOMIC_RELEASE, "agent");
            asm volatile("s_waitcnt vmcnt(0)" ::: "memory");
            const unsigned og = xb_add(&bar[XB_TOP], 1u);
            const unsigned tg = og / nx;
            if (og + 1u == (tg + 1u) * nx) xb_add(&bar[XB_TOPGEN], 1u);
            else XB_SPIN(xb_ld(&bar[XB_TOPGEN]) == tg, bar);
            __builtin_amdgcn_fence(__ATOMIC_ACQUIRE, "agent");
            xb_add(&bar[XB_XGEN(bx)], 1u);
            asm volatile("s_waitcnt vmcnt(0)" ::: "memory");
        } else {
            XB_SPIN(xb_ld(&bar[XB_XGEN(bx)]) == gen, bar);
            __builtin_amdgcn_fence(__ATOMIC_ACQUIRE, "agent");
            asm volatile("s_waitcnt vmcnt(0)" ::: "memory");
        }
    }
    __syncthreads();
}
constexpr int T = 16384, DM = 1024, SEQ = 2048, NBATCH = 8, DEPTH = 2, N_IN = 10432;
constexpr int NWAVES = 8;
constexpr float EPS = 1e-6f;
constexpr size_t MiB = 1u << 20;
constexpr size_t WS_CTL = 0, CTL_ZERO_BYTES = 64 * 1024;
constexpr size_t WS_WB = 1 * MiB;
constexpr size_t WB_W1T = 0;
constexpr size_t WB_W2T = WB_W1T + (size_t)4352 * 1024 * 2;
constexpr size_t WB_WQT = WB_W2T + (size_t)6144 * 1024 * 2;
constexpr size_t WB_WKVT = WB_WQT + (size_t)1536 * 384 * 2;
constexpr size_t WB_WPT = WB_WKVT + (size_t)2048 * 384 * 2;
constexpr size_t WB_WOT = WB_WPT + (size_t)1024 * 3328 * 2;
constexpr size_t WB_END = WB_WOT + (size_t)1024 * 1024 * 2;
static_assert(WB_END <= 32 * MiB, "weights region");
constexpr size_t WS_H = 33 * MiB;
constexpr size_t WS_Y = 65 * MiB;
constexpr int YLD = 3328;
constexpr size_t WS_BIG = 169 * MiB;
constexpr size_t WS_MISC = WS_BIG;
constexpr size_t WS_XC = WS_MISC + 24 * MiB;
constexpr size_t WS_Q = WS_XC + 40 * MiB;
constexpr size_t WS_VV = WS_Q + 48 * MiB;
constexpr size_t WS_KR = WS_VV + 32 * MiB;
constexpr size_t WS_V1 = WS_BIG;
constexpr size_t WS_G = WS_V1 + 32 * MiB;
constexpr size_t WS_O = WS_BIG;
constexpr size_t WS_SMALL = 315 * MiB;
constexpr size_t WS_SLAB = WS_SMALL;
constexpr size_t WS_AGG = WS_SLAB + 1536 * 1024;
constexpr size_t WS_ROPE = WS_AGG + 2560 * 1024;
constexpr size_t WS_LW = WS_ROPE + 512 * 1024;
constexpr size_t WS_GMW = WS_LW + 480 * 1024;
constexpr size_t WS_LCT = WS_GMW + 128 * 1024;
constexpr size_t WS_END = WS_LCT + 64 * 1024;
static_assert(WS_KR + 2 * MiB <= WS_SMALL && WS_G + 96 * MiB <= WS_SMALL && WS_END <= 326 * MiB, "d_ws map");
constexpr int CW_NORM = 12288;
constexpr int CW_BAR = 1024;
static_assert((CW_BAR + XCD_BAR_WORDS) * 4 <= (int)CTL_ZERO_BYTES, "ctl");
constexpr int RING_BYTES = 131072, MISC_OFF = RING_BYTES + 320, LDS_BYTES = 147456;

enum { I_X = 0, I_PRE_G, I_W_IN, I_GM_LN_G, I_GM_LN_B, I_GM_WS, I_GM_BS, I_QN_G, I_W_UQ, I_KVN_G, I_W_UKV, I_CONV_W, I_CONV_B, I_W_A, I_B_A, I_W_X, I_B_X, I_LAM,
       I_W_PA, I_W_PB, I_W_PC, I_W_OUT, I_POST_G, N_INPUTS };
struct Args { const float* in[N_INPUTS]; float* out; unsigned char* ws; int ph_lo, ph_hi, probe, pad; };

struct Frame { LAS unsigned char* lds; int wave, vcu, G; };
__device__ __forceinline__ int lane_id() { int l; asm volatile("v_mbcnt_lo_u32_b32 %0, -1, 0\n\tv_mbcnt_hi_u32_b32 %0, -1, %0" : "=v"(l)); return l; }

__device__ __forceinline__ float softplus_neg(float x) { const float e = __expf(-x);
    const float p = e * (1.f - e * (0.5f - e * (0.33333334f - e * (0.25f - e * (0.2f - e * (0.16666667f - e * (0.14285715f - e * 0.125f)))))));
    return (e < 0.2f) ? p : __logf(1.f + e); }
struct MapW1 { __device__ __forceinline__ int operator()(int j) const {
    if (j < 384) return 3072 + j; if (j < 640) return 3456 + (j - 384); if (j < 704) { const int jj = j - 640, g = jj >> 3, e = jj & 7; return 3712 + (e < 4 ? 4 * g + e : 32 + 4 * g + (e - 4)); } if (j < 768) return -1;
    if (j < 2048) return 4800 + (j - 768); if (j < 3328) return 6080 + (j - 2048); return 3776 + (j - 3328); } };
struct MapW2 { __device__ __forceinline__ int operator()(int j) const {
    if (j < 2048) { const int tl = j >> 8, lc = j & 255; return (lc < 128) ? (128 * tl + lc) : (2048 + 128 * tl + (lc - 128)); }
    if (j < 3072) return 1024 + (j - 2048); return 7360 + (j - 3072); } };
struct MapQ { __device__ __forceinline__ int operator()(int j) const {
    if (j < 1024) { const int hd = j >> 7, d = j & 127; return hd * 192 + d; }
    const int jj = j - 1024, hh = jj >> 6, w = jj & 63, g = w >> 3, e = w & 7; return hh * 192 + (e < 4 ? 128 + 4 * g + e : 160 + 4 * g + (e - 4)); } };
struct MapId { __device__ __forceinline__ int operator()(int j) const { return j; } };

template <class Map>
__device__ __forceinline__ void tr_item(const float* W, int ldw, int nkb  , bf16_t* WT, int ldt, const Map map, const float* kscale, LAS float* scr, int item, int lane) {
    const int kb = item % nkb, nb = item / nkb, k0 = 64 * kb, n0 = 32 * nb;
    const int nn = lane & 31; const int sc = map(n0 + nn);
    float wv[32];
    const float* wp = W + (size_t)(k0 + (lane >> 5)) * ldw + (sc >= 0 ? sc : 0);
#pragma unroll
    for (int i = 0; i < 32; ++i) wv[i] = (sc >= 0) ? wp[(size_t)(2 * i) * ldw] : 0.f;
#pragma unroll
    for (int i = 0; i < 32; ++i) { const int kk = 2 * i + (lane >> 5); float v = wv[i]; if (kscale) v *= kscale[k0 + kk]; scr[kk * 33 + nn] = v; }
    LDS_WAIT(); asm volatile("" ::: "memory");
    const int c = lane & 7;
#pragma unroll
    for (int j = 0; j < 4; ++j) { const int n = (lane >> 3) + 8 * j; const LAS float* s = scr + (8 * c) * 33 + n;
        u32x4 o; o.x = pk_bf16(s[0 * 33], s[1 * 33]); o.y = pk_bf16(s[2 * 33], s[3 * 33]); o.z = pk_bf16(s[4 * 33], s[5 * 33]); o.w = pk_bf16(s[6 * 33], s[7 * 33]);
        *(u32x4*)(WT + (size_t)(n0 + n) * ldt + k0 + 8 * c) = o; }
    LDS_WAIT(); asm volatile("" ::: "memory");
}

__device__ __forceinline__ void convert_weights(const Frame& F, const Args& a, unsigned char* ws, int l) {
    const int lane = lane_id();
    LAS float* scr = (LAS float*)(F.lds + F.wave * 16384);
    const int gw = F.vcu * NWAVES + F.wave, NGW = F.G * NWAVES;
    unsigned char* wb = ws + WS_WB;
    constexpr int I1 = 16 * (4352 / 32), I2 = 16 * (6144 / 32), IQ = 6 * (1536 / 32), IKV = 4 * (2048 / 32), IPA = 16 * 32, IPB = 16 * 32, IPC = 20 * 32, IO = 16 * 32;
    constexpr int NITEMS = I1 + I2 + IQ + IKV + IPA + IPB + IPC + IO;
    const float* w_in = a.in[I_W_IN] + (size_t)l * 1024 * N_IN;
    for (int it = gw; it < NITEMS; it += NGW) {
        int r = it;
        if (r < I1) { tr_item(w_in, N_IN, 16, (bf16_t*)(wb + WB_W1T), 1024, MapW1(), nullptr, scr, r, lane); continue; } r -= I1;
        if (r < I2) { tr_item(w_in, N_IN, 16, (bf16_t*)(wb + WB_W2T), 1024, MapW2(), nullptr, scr, r, lane); continue; } r -= I2;
        if (r < IQ) { tr_item(a.in[I_W_UQ] + (size_t)l * 384 * 1536, 1536, 6, (bf16_t*)(wb + WB_WQT), 384, MapQ(), a.in[I_QN_G] + l * 384, scr, r, lane); continue; } r -= IQ;
        if (r < IKV) { tr_item(a.in[I_W_UKV] + (size_t)l * 256 * 2048, 2048, 4, (bf16_t*)(wb + WB_WKVT), 384, MapId(), a.in[I_KVN_G] + l * 256, scr, r, lane); continue; } r -= IKV;
        if (r < IPA) { tr_item(a.in[I_W_PA] + (size_t)l * 1024 * 1024, 1024, 16, (bf16_t*)(wb + WB_WPT), 3328, MapId(), nullptr, scr, r, lane); continue; } r -= IPA;
        if (r < IPB) { tr_item(a.in[I_W_PB] + (size_t)l * 1024 * 1024, 1024, 16, (bf16_t*)(wb + WB_WPT) + 1024, 3328, MapId(), nullptr, scr, r, lane); continue; } r -= IPB;
        if (r < IPC) { tr_item(a.in[I_W_PC] + (size_t)l * 1280 * 1024, 1024, 20, (bf16_t*)(wb + WB_WPT) + 2048, 3328, MapId(), nullptr, scr, r, lane); continue; } r -= IPC;
        tr_item(a.in[I_W_OUT] + (size_t)l * 1024 * 1024, 1024, 16, (bf16_t*)(wb + WB_WOT), 1024, MapId(), nullptr, scr, r, lane);
    }
    const int gt = (F.vcu * NWAVES + F.wave) * 64 + lane, NGT = F.G * NWAVES * 64;
    bf16_t* lwa = (bf16_t*)(ws + WS_LW); bf16_t* lwx = lwa + 16 * 80 * 96;
    const float* w_a = a.in[I_W_A] + (size_t)l * 16 * 80 * 80; const float* w_x = a.in[I_W_X] + (size_t)l * 16 * 80 * 80;
    for (int i = gt; i < 16 * 80 * 96; i += NGT) { const int k = i % 96, j = (i / 96) % 80, blk = i / (96 * 80);
        const float va = (k < 80) ? w_a[((size_t)blk * 80 + k) * 80 + j] : 0.f, vx = (k < 80) ? w_x[((size_t)blk * 80 + k) * 80 + j] : 0.f;
        lwa[i] = f2bf(va); lwx[i] = f2bf(vx); }
    { float* lct = (float*)(ws + WS_LCT); const float* cw = a.in[I_CONV_W] + (size_t)l * 4 * 1280;
      for (int c = gt; c < 1280; c += NGT) { f32x4 v0 = {cw[c], cw[1280 + c], cw[2560 + c], cw[3840 + c]};
          f32x4 v1 = {a.in[I_CONV_B][l * 1280 + c], a.in[I_B_A][l * 1280 + c], a.in[I_B_X][l * 1280 + c], -8.f * softplus_neg(a.in[I_LAM][l * 1280 + c])};
          *(f32x4*)(lct + c * 8) = v0; *(f32x4*)(lct + c * 8 + 4) = v1; } }
    bf16_t* gmw = (bf16_t*)(ws + WS_GMW); const float* gws = a.in[I_GM_WS] + (size_t)l * 4 * 128 * 128;
    for (int i = gt; i < 4 * 128 * 128; i += NGT) { const int j = i & 127, ii = (i >> 7) & 127; gmw[i] = f2bf(((j >> 6) <= (ii >> 6)) ? gws[i] : 0.f); }
}
__device__ __forceinline__ void rope_table(const Frame& F, unsigned char* ws) {
    const int gt = (F.vcu * NWAVES + F.wave) * 64 + lane_id(), NGT = F.G * NWAVES * 64;
    float* cs = (float*)(ws + WS_ROPE); float* sn = cs + 2048 * 32;
    for (int i = gt; i < 2048 * 32; i += NGT) { const int s = i >> 5, fi = i & 31; const float inv_freq = powf(10000.f, -(float)(2 * fi) / 64.f); const float ang = (float)s * inv_freq;
        cs[i] = cosf(ang); sn[i] = sinf(ang); }
}
__device__ __forceinline__ void norm_rows(const Frame& F, const bool nostore, const float* xin, const bf16_t* o, const float* g_post, float* xout, const float* g_pre, bf16_t* h) {
    const int gw = F.vcu * NWAVES + F.wave, NGW = F.G * NWAVES; const int lane = lane_id();
    f32x4 v[4], ov[4], nv[4]; u32x2 nov[4];
    if (gw < T) {
#pragma unroll
        for (int j = 0; j < 4; ++j) { nv[j] = *((const f32x4*)(xin + (size_t)gw * DM) + lane + 64 * j); nov[j] = o ? *((const u32x2*)(o + (size_t)gw * DM) + lane + 64 * j) : (u32x2){0u, 0u}; }
    }
    for (int m = gw; m < T; m += NGW) {
#pragma unroll
        for (int j = 0; j < 4; ++j) { v[j] = nv[j]; ov[j] = (f32x4){bf_lo(nov[j].x), bf_hi(nov[j].x), bf_lo(nov[j].y), bf_hi(nov[j].y)}; }
        const int mn = m + NGW;
        if (mn < T) {
#pragma unroll
            for (int j = 0; j < 4; ++j) { nv[j] = *((const f32x4*)(xin + (size_t)mn * DM) + lane + 64 * j); if (o) nov[j] = *((const u32x2*)(o + (size_t)mn * DM) + lane + 64 * j); }
        }
        if (o) {
            float s = 0.f;
#pragma unroll
            for (int j = 0; j < 4; ++j) s += (ov[j].x * ov[j].x + ov[j].y * ov[j].y) + (ov[j].z * ov[j].z + ov[j].w * ov[j].w);
            const float r = rsqrtf(wave_sum(s) * (1.f / DM) + EPS);
            f32x4* xo = (f32x4*)(xout + (size_t)m * DM) + lane;
#pragma unroll
            for (int j = 0; j < 4; ++j) { const f32x4 gp = *((const f32x4*)g_post + lane + 64 * j); v[j] = v[j] + ov[j] * r * gp; if (!nostore) xo[64 * j] = v[j]; }
        }
        if (g_pre) {
            float s = 0.f;
#pragma unroll
            for (int j = 0; j < 4; ++j) s += (v[j].x * v[j].x + v[j].y * v[j].y) + (v[j].z * v[j].z + v[j].w * v[j].w);
            const float r = rsqrtf(wave_sum(s) * (1.f / DM) + EPS);
            u32x2* ho = (u32x2*)(h + (size_t)m * DM) + lane;
#pragma unroll
            for (int j = 0; j < 4; ++j) { const f32x4 gp = *((const f32x4*)g_pre + lane + 64 * j); const f32x4 y = v[j] * r * gp; u32x2 w; w.x = pk_bf16(y.x, y.y); w.y = pk_bf16(y.z, y.w); if (!nostore) ho[64 * j] = w; }
        }
    }
}
using g8::UnitD;
constexpr float QSCALE = 0.07216878364870322f * 1.4426950408889634f;

struct SchedA {
    g8::TileOrder ord; const char* A; const char* B;
    __device__ __forceinline__ bool next(int i, UnitD& u) const { int pm, pn; if (!ord.tile(i, pm, pn)) return false;
        u.A = A + (size_t)pm * 256 * 2048; u.B = B + (size_t)pn * 256 * 2048; u.nt = 16; u.pm = pm; u.pn = pn; u.kind = 0; return true; }
};
struct EpiA {
    bf16_t* misc; bf16_t* xc; bf16_t* y; float* slab; bf16_t* kr; const float* cs; const float* sn;
    __device__ __forceinline__ void operator()(f32x4 (&acc)[2][2][4][2], const UnitD& u, int wr, int wc, int fr, int fq) const {
        const int pn = u.pn, rowp = wr * 64 + fr, lc = wc * 32 + 8 * fq;
        bf16_t* dst; int ld; bool act;
        if (pn < 3) { dst = misc + 256 * pn; ld = 768; act = false; }
        else if (pn < 8) { dst = xc + 256 * (pn - 3); ld = 1280; act = false; }
        else if (pn < 13) { dst = y + 2048 + 256 * (pn - 8); ld = YLD; act = true; }
        else { dst = y + 1024 + 256 * (pn - 13); ld = YLD; act = true; }
#pragma unroll
        for (int ai = 0; ai < 2; ++ai)
#pragma unroll
            for (int m = 0; m < 4; ++m) { const int rp = rowp + ai * 128 + m * 16; bf16_t* p = dst + ((size_t)u.pm * 256 + rp) * ld + lc;
#pragma unroll
                for (int bj = 0; bj < 2; ++bj) { f32x4 v0 = acc[ai][bj][m][0], v1 = acc[ai][bj][m][1];
                    if (pn == 2 && bj == 1) { if (wc < 2) { const int g = 4 * wc + fq; const size_t r = (size_t)u.pm * 256 + rp; const int pos = (int)(r & 2047);
                            const f32x4 c4 = *(const f32x4*)(cs + pos * 32 + 4 * g), s4 = *(const f32x4*)(sn + pos * 32 + 4 * g);
                            const f32x4 o1 = v0 * c4 - v1 * s4, o2 = v1 * c4 + v0 * s4; bf16_t* kp = kr + r * 64 + 4 * g;
                            u32x2 w1, w2; w1.x = pk_bf16(o1.x, o1.y); w1.y = pk_bf16(o1.z, o1.w); w2.x = pk_bf16(o2.x, o2.y); w2.y = pk_bf16(o2.z, o2.w);
                            *(u32x2*)kp = w1; *(u32x2*)(kp + 32) = w2; }
                        continue; }
                    if (pn < 3) { float ss = (v0.x * v0.x + v0.y * v0.y) + (v0.z * v0.z + v0.w * v0.w) + (v1.x * v1.x + v1.y * v1.y) + (v1.z * v1.z + v1.w * v1.w);
                        ss += sx<16>(ss); ss = xsum32(ss);
                        if (fq == 0) slab[(((size_t)u.pm * 6 + pn * 2 + bj) * 4 + wc) * 256 + rp] = ss; }
                    if (act) { v0.x = fsilu(v0.x); v0.y = fsilu(v0.y); v0.z = fsilu(v0.z); v0.w = fsilu(v0.w); v1.x = fsilu(v1.x); v1.y = fsilu(v1.y); v1.z = fsilu(v1.z); v1.w = fsilu(v1.w); }
                    u32x4 w; w.x = pk_bf16(v0.x, v0.y); w.y = pk_bf16(v0.z, v0.w); w.z = pk_bf16(v1.x, v1.y); w.w = pk_bf16(v1.z, v1.w);
                    *(u32x4*)(p + bj * 128) = w; } }
    }
};

struct SchedZ {
    int v; const char* A; const char* B;
    __device__ __forceinline__ bool next(int i, UnitD& u) const { if (i > 0 || (v & 3) != 0 || v >= 256) return false; const int pm = v >> 2;
        u.A = A + (size_t)pm * 256 * 2048; u.B = B + (size_t)16 * 256 * 2048; u.nt = 16; u.pm = pm; u.pn = 16; u.kind = 0; return true; }
};
struct SchedQKV {
    int v; const char* misc; const char* wq; const char* wkv;
    __device__ __forceinline__ bool next(int i, UnitD& u) const { if (v >= 256) return false; const int role = v & 3, pm = v >> 2; int pn;
        if (role == 0) { if (i > 0) return false; pn = 0; }
        else if (role == 1) { if (i > 4) return false; pn = (i == 0) ? 1 : 5 + i; }
        else { if (i > 3) return false; pn = (i < 2) ? (2 * role - 2 + i) : (10 + 2 * (role - 2) + (i - 2)); }
        u.pm = pm; u.pn = pn; u.kind = 0;
        if (pn < 6) { u.A = misc + (size_t)pm * 256 * 1536; u.B = wq + (size_t)pn * 256 * 768; u.nt = 6; }
        else { u.A = misc + (size_t)pm * 256 * 1536 + 384 * 2; u.B = wkv + (size_t)(pn - 6) * 256 * 768; u.nt = 4; }
        return true; }
};
struct EpiQKV {
    bf16_t* q; bf16_t* y; bf16_t* vv; const float* slab; const float* cs; const float* sn;
    __device__ __forceinline__ void operator()(f32x4 (&acc)[2][2][4][2], const UnitD& u, int wr, int wc, int fr, int fq) const {
        const int pn = u.pn, rowp = wr * 64 + fr, lc = wc * 32 + 8 * fq; const bool isq = pn < 6;
#pragma unroll
        for (int ai = 0; ai < 2; ++ai)
#pragma unroll
            for (int m = 0; m < 4; ++m) { const int rp = rowp + ai * 128 + m * 16; const size_t r = (size_t)u.pm * 256 + rp;
                float s = 0.f; const float* sl = slab + (size_t)u.pm * 6 * 4 * 256 + rp;
                if (isq) {
#pragma unroll
                    for (int e = 0; e < 3; ++e) { const int j = fq * 3 + e; s += sl[(size_t)((j >> 2) * 4 + (j & 3)) * 256]; }
                } else {
#pragma unroll
                    for (int e = 0; e < 2; ++e) { const int j = fq * 2 + e; s += sl[(size_t)((3 + (j >> 2)) * 4 + (j & 3)) * 256]; }
                }
                s += sx<16>(s); s = xsum32(s);
                float rs = rsqrtf(s * (isq ? (1.f / 384.f) : (1.f / 256.f)) + EPS); if (isq) rs *= QSCALE;
#pragma unroll
                for (int bj = 0; bj < 2; ++bj) { f32x4 v0 = acc[ai][bj][m][0] * rs, v1 = acc[ai][bj][m][1] * rs;
                    if (pn < 4) { const int j0 = 256 * pn + 128 * bj + lc; bf16_t* p = q + r * 1536 + (j0 >> 7) * 192 + (j0 & 127);
                        u32x4 w; w.x = pk_bf16(v0.x, v0.y); w.y = pk_bf16(v0.z, v0.w); w.z = pk_bf16(v1.x, v1.y); w.w = pk_bf16(v1.z, v1.w); *(u32x4*)p = w; }
                    else if (pn < 6) { const int jj = 256 * (pn - 4) + 128 * bj + lc, hh = jj >> 6, g = (jj & 63) >> 3; const int pos = (int)(r & 2047);
                        const f32x4 c4 = *(const f32x4*)(cs + pos * 32 + 4 * g), s4 = *(const f32x4*)(sn + pos * 32 + 4 * g);
                        const f32x4 o1 = v0 * c4 - v1 * s4, o2 = v1 * c4 + v0 * s4; bf16_t* p = q + r * 1536 + hh * 192 + 128 + 4 * g;
                        u32x2 w1, w2; w1.x = pk_bf16(o1.x, o1.y); w1.y = pk_bf16(o1.z, o1.w); w2.x = pk_bf16(o2.x, o2.y); w2.y = pk_bf16(o2.z, o2.w);
                        *(u32x2*)p = w1; *(u32x2*)(p + 32) = w2; }
                    else { const int hd = pn - 6; bf16_t* p = (bj == 0) ? (y + r * YLD + hd * 128 + lc) : (vv + r * 1024 + hd * 128 + lc);
                        u32x4 w; w.x = pk_bf16(v0.x, v0.y); w.y = pk_bf16(v0.z, v0.w); w.z = pk_bf16(v1.x, v1.y); w.w = pk_bf16(v1.z, v1.w); *(u32x4*)p = w; } } }
    }
};

struct SchedD {
    g8::TileOrder ord; const char* A; const char* B;
    __device__ __forceinline__ bool next(int i, UnitD& u) const { int pm, pn; if (!ord.tile(i, pm, pn)) return false;
        u.A = A + (size_t)pm * 256 * 2048; u.B = B + (size_t)pn * 256 * 2048; u.nt = 16; u.pm = pm; u.pn = pn; u.kind = 0; return true; }
};
struct EpiD {
    bf16_t* y; bf16_t* v1; bf16_t* g; float* vslab;
    __device__ __forceinline__ void operator()(f32x4 (&acc)[2][2][4][2], const UnitD& u, int wr, int wc, int fr, int fq) const {
        const int pn = u.pn, rowp = wr * 64 + fr, lc = wc * 32 + 8 * fq;
#pragma unroll
        for (int ai = 0; ai < 2; ++ai)
#pragma unroll
            for (int m = 0; m < 4; ++m) { const size_t r = (size_t)u.pm * 256 + rowp + ai * 128 + m * 16;
                if (pn < 8) { const f32x4 u0 = acc[ai][0][m][0], u1 = acc[ai][0][m][1], z0 = acc[ai][1][m][0], z1 = acc[ai][1][m][1];
                    u32x4 w; w.x = pk_bf16(u0.x * fsilu(z0.x), u0.y * fsilu(z0.y)); w.y = pk_bf16(u0.z * fsilu(z0.z), u0.w * fsilu(z0.w));
                    w.z = pk_bf16(u1.x * fsilu(z1.x), u1.y * fsilu(z1.y)); w.w = pk_bf16(u1.z * fsilu(z1.z), u1.w * fsilu(z1.w));
                    *(u32x4*)(y + r * YLD + 128 * pn + lc) = w; }
                else {
#pragma unroll
                    for (int bj = 0; bj < 2; ++bj) { f32x4 v0 = acc[ai][bj][m][0], v1_ = acc[ai][bj][m][1]; bf16_t* p;
                        if (pn < 12) { p = v1 + r * 1024 + 256 * (pn - 8) + 128 * bj + lc;
                            float s1 = (v0.x + v0.y) + (v0.z + v0.w) + (v1_.x + v1_.y) + (v1_.z + v1_.w);
                            float s2 = (v0.x * v0.x + v0.y * v0.y) + (v0.z * v0.z + v0.w * v0.w) + (v1_.x * v1_.x + v1_.y * v1_.y) + (v1_.z * v1_.z + v1_.w * v1_.w);
                            s1 += sx<16>(s1); s1 = xsum32(s1); s2 += sx<16>(s2); s2 = xsum32(s2);
                            if (fq == 0) *(f32x2*)(vslab + r * 64 + (((pn - 8) * 2 + bj) * 4 + wc) * 2) = (f32x2){s1, s2}; }
                        else { p = g + r * 3072 + 256 * (pn - 12) + 128 * bj + lc;
                            v0.x = fsigmoid(v0.x); v0.y = fsigmoid(v0.y); v0.z = fsigmoid(v0.z); v0.w = fsigmoid(v0.w); v1_.x = fsigmoid(v1_.x); v1_.y = fsigmoid(v1_.y); v1_.z = fsigmoid(v1_.z); v1_.w = fsigmoid(v1_.w); }
                        u32x4 w; w.x = pk_bf16(v0.x, v0.y); w.y = pk_bf16(v0.z, v0.w); w.z = pk_bf16(v1_.x, v1_.y); w.w = pk_bf16(v1_.z, v1_.w); *(u32x4*)p = w; } } }
    }
};

struct SchedF {
    g8::TileOrder ord; const char* A; const char* B;
    __device__ __forceinline__ bool next(int i, UnitD& u) const { if (i >= 3) return false; int pm, pn; if (!ord.tile(0, pm, pn)) return false;
        const size_t ko = (i == 0) ? 0 : (i == 1 ? 1024 * 2 : 2048 * 2);
        u.A = A + (size_t)pm * 256 * (YLD * 2) + ko; u.B = B + (size_t)pn * 256 * (YLD * 2) + ko; u.nt = (i == 2) ? 20 : 16; u.pm = pm; u.pn = pn; u.kind = (i < 2) ? (i | g8::KEEP_ACC) : i; return true; }
};
struct EpiF {
    const bf16_t* g; bf16_t* merged;
    __device__ __forceinline__ void operator()(f32x4 (&acc)[2][2][4][2], const UnitD& u, int wr, int wc, int fr, int fq) const {
        const int seg = u.kind & 3, rowp = wr * 64 + fr, lc = wc * 32 + 8 * fq;
#pragma unroll
        for (int ai = 0; ai < 2; ++ai)
#pragma unroll
            for (int m = 0; m < 4; ++m) { const size_t r = (size_t)u.pm * 256 + rowp + ai * 128 + m * 16;
#pragma unroll
                for (int bj = 0; bj < 2; ++bj) { const int col = 256 * u.pn + 128 * bj + lc; const bf16_t* gp = g + r * 3072 + seg * 1024 + col;
                    const u32x4 a = *(const u32x4*)gp; f32x4 f0, f1;
                    f0.x = bf_lo(a.x); f0.y = bf_hi(a.x); f0.z = bf_lo(a.y); f0.w = bf_hi(a.y); f1.x = bf_lo(a.z); f1.y = bf_hi(a.z); f1.z = bf_lo(a.w); f1.w = bf_hi(a.w);
                    if (seg < 2) { const u32x4 b = *(const u32x4*)(gp + 1024);
                        f0.x *= __builtin_amdgcn_rcpf(bf_lo(b.x)); f0.y *= __builtin_amdgcn_rcpf(bf_hi(b.x)); f0.z *= __builtin_amdgcn_rcpf(bf_lo(b.y)); f0.w *= __builtin_amdgcn_rcpf(bf_hi(b.y));
                        f1.x *= __builtin_amdgcn_rcpf(bf_lo(b.z)); f1.y *= __builtin_amdgcn_rcpf(bf_hi(b.z)); f1.z *= __builtin_amdgcn_rcpf(bf_lo(b.w)); f1.w *= __builtin_amdgcn_rcpf(bf_hi(b.w));
                        acc[ai][bj][m][0] *= f0; acc[ai][bj][m][1] *= f1; }
                    else { const f32x4 v0 = acc[ai][bj][m][0] * f0, v1 = acc[ai][bj][m][1] * f1;
                        u32x4 w; w.x = pk_bf16(v0.x, v0.y); w.y = pk_bf16(v0.z, v0.w); w.z = pk_bf16(v1.x, v1.y); w.w = pk_bf16(v1.z, v1.w);
                        *(u32x4*)(merged + r * 1024 + col) = w; } } }
    }
};

struct SchedG1 {
    int v; const char* A; const char* B;
    __device__ __forceinline__ bool next(int i, UnitD& u) const { if (i > 0 || v >= 256) return false; const int pm = v >> 2, pn = v & 3;
        u.A = A + (size_t)pm * 256 * 2048; u.B = B + (size_t)pn * 256 * 2048; u.nt = 16; u.pm = pm; u.pn = pn; u.kind = 0; return true; }
};
struct EpiNorm {
    const float* xin; float* xout; bf16_t* h; const float* g_post; const float* g_pre;
    float* slots; unsigned* cnt;
    __device__ __forceinline__ void exchange(const f32x4 (&v)[2][2][4][2], int pm, int pn, int wr, int wc, int fr, int fq, LAS unsigned char* lds, int wid, int lane, float* sl, unsigned* cn) const {
        LAS float* P = (LAS float*)lds; LAS float* S = (LAS float*)(lds + 4096);
#pragma unroll
        for (int ai = 0; ai < 2; ++ai)
#pragma unroll
            for (int m = 0; m < 4; ++m) { float s = 0.f;
#pragma unroll
                for (int bj = 0; bj < 2; ++bj)
#pragma unroll
                    for (int n = 0; n < 2; ++n) { const f32x4 x = v[ai][bj][m][n]; s += (x.x * x.x + x.y * x.y) + (x.z * x.z + x.w * x.w); }
                s += sx<16>(s); s = xsum32(s);
                if (fq == 0) P[(ai * 128 + wr * 64 + m * 16 + fr) * 4 + wc] = s; }
        asm volatile("s_waitcnt lgkmcnt(0)" ::: "memory"); __builtin_amdgcn_s_barrier(); asm volatile("" ::: "memory");
        const int row = wid * 32 + (lane & 31);
        if (lane < 32) { const f32x4 p4 = *(const LAS f32x4*)(P + row * 4); const float tot = (p4.x + p4.y) + (p4.z + p4.w);
            __hip_atomic_store((unsigned*)sl + ((size_t)pm * 256 + row) * 4 + pn, __float_as_uint(tot), __ATOMIC_RELAXED, __HIP_MEMORY_SCOPE_AGENT); }
        asm volatile("s_waitcnt vmcnt(0)" ::: "memory");
        if (lane == 0) __hip_atomic_fetch_add(cn, 1u, __ATOMIC_RELAXED, __HIP_MEMORY_SCOPE_AGENT);
        if (wid == 0) { for (unsigned sp = 0; sp < (1u << 20); ++sp) { if ((unsigned)__builtin_amdgcn_readfirstlane(__hip_atomic_load(cn, __ATOMIC_RELAXED, __HIP_MEMORY_SCOPE_AGENT)) >= 32u) break; __builtin_amdgcn_s_sleep(2); } }
        asm volatile("s_waitcnt vmcnt(0) lgkmcnt(0)" ::: "memory"); __builtin_amdgcn_s_barrier(); asm volatile("" ::: "memory");
        if (lane < 32) { const unsigned* sp4 = (const unsigned*)sl + ((size_t)pm * 256 + row) * 4; float tot = 0.f;
#pragma unroll
            for (int t = 0; t < 4; ++t) tot += __uint_as_float(__hip_atomic_load(sp4 + t, __ATOMIC_RELAXED, __HIP_MEMORY_SCOPE_AGENT));
            S[row] = rsqrtf(tot * (1.f / 1024.f) + EPS); }
        asm volatile("s_waitcnt lgkmcnt(0)" ::: "memory"); __builtin_amdgcn_s_barrier(); asm volatile("" ::: "memory");
    }
    __device__ __forceinline__ void fused(f32x4 (&acc)[2][2][4][2], const UnitD& u, int wr, int wc, int fr, int fq, LAS unsigned char* lds, int wid, int lane) const {
        const LAS float* S = (const LAS float*)(lds + 4096);
        const int lc = wc * 32 + 8 * fq, col0 = 256 * u.pn + lc;
        exchange(acc, u.pm, u.pn, wr, wc, fr, fq, lds, wid, lane, slots, cnt + u.pm * 16);
#pragma unroll
        for (int ai = 0; ai < 2; ++ai)
#pragma unroll
            for (int m = 0; m < 4; ++m) { const int r = ai * 128 + wr * 64 + m * 16 + fr; const float rs = S[r]; const size_t off = ((size_t)u.pm * 256 + r) * 1024 + col0;
#pragma unroll
                for (int bj = 0; bj < 2; ++bj) { const f32x4 x0 = *(const f32x4*)(xin + off + bj * 128), x1 = *(const f32x4*)(xin + off + bj * 128 + 4);
                    const f32x4 g0 = *(const f32x4*)(g_post + col0 + bj * 128), g1 = *(const f32x4*)(g_post + col0 + bj * 128 + 4);
                    const f32x4 y0 = x0 + acc[ai][bj][m][0] * rs * g0, y1 = x1 + acc[ai][bj][m][1] * rs * g1;
                    acc[ai][bj][m][0] = y0; acc[ai][bj][m][1] = y1;
                    *(f32x4*)(xout + off + bj * 128) = y0; *(f32x4*)(xout + off + bj * 128 + 4) = y1; }
                if (m & 1) asm volatile("" ::: "memory"); }
        if (g_pre) {
            exchange(acc, u.pm, u.pn, wr, wc, fr, fq, lds, wid, lane, slots + (size_t)T * 4, cnt + 64 * 16 + u.pm * 16);
#pragma unroll
            for (int ai = 0; ai < 2; ++ai)
#pragma unroll
                for (int m = 0; m < 4; ++m) { const int r = ai * 128 + wr * 64 + m * 16 + fr; const float rs = S[r]; const size_t off = ((size_t)u.pm * 256 + r) * 1024 + col0;
#pragma unroll
                    for (int bj = 0; bj < 2; ++bj) { const f32x4 g0 = *(const f32x4*)(g_pre + col0 + bj * 128), g1 = *(const f32x4*)(g_pre + col0 + bj * 128 + 4);
                        const f32x4 y0 = acc[ai][bj][m][0] * rs * g0, y1 = acc[ai][bj][m][1] * rs * g1;
                        u32x4 w; w.x = pk_bf16(y0.x, y0.y); w.y = pk_bf16(y0.z, y0.w); w.z = pk_bf16(y1.x, y1.y); w.w = pk_bf16(y1.z, y1.w);
                        *(u32x4*)(h + off + bj * 128) = w; } }
        }
    }
    __device__ __forceinline__ void operator()(f32x4 (&)[2][2][4][2], const UnitD&, int, int, int, int) const {}
};
typedef float f32x2v __attribute__((ext_vector_type(2)));

constexpr int LRU_HIN_OFF = RING_BYTES + 1024;
template <int PASS>
__device__ __forceinline__ void lru_item(const Frame& F, const Args& a, const unsigned char* ws, const bool nostore, int l, int item, const bf16_t* xcb, bf16_t* y, float* agg) {
    const int b = item >> 5, k = item & 31; const size_t r0 = (size_t)b * SEQ + (size_t)k * 64;
    int lane_ = lane_id(); asm volatile("" : "+v"(lane_));
    const int lane = lane_, cl = lane & 15, kg = lane >> 4;
    LAS unsigned char* xt = F.lds + F.wave * 16384;
    const bf16_t* lwa = (const bf16_t*)(ws + WS_LW); const bf16_t* lwx = lwa + 16 * 80 * 96;
    const float* lct = (const float*)(ws + WS_LCT);
    LAS float* hin_l = (LAS float*)(F.lds + LRU_HIN_OFF);
    if (PASS == 2) {
        for (int c = F.wave * 64 + lane; c < 1280; c += 512) { const float* ag = agg + ((size_t)b * 32 * 1280 + c) * 2; float h = 0.f;
#pragma unroll 8
            for (int j = 0; j < k; ++j) { const f32x2v ab = *(const f32x2v*)(ag + (size_t)j * 2560); h = ab.x * h + ab.y; }
            hin_l[c] = h; }
        LDS_WAIT(); __syncthreads();
    }
#pragma unroll 1
    for (int bi = 0; bi < 2; ++bi) {
        const int blk = 2 * F.wave + bi;
        {
            u32x4 xch[11]; int ln = lane; asm volatile("" : "+v"(ln));
            const bf16_t* xbase = xcb + (r0 - 3) * 1280 + blk * 80;
#pragma unroll
            for (int i = 0; i < 11; ++i) { const int idx = ln + 64 * i; const int row = idx / 10, ch = idx - row * 10; xch[i] = (u32x4){0u, 0u, 0u, 0u};
                if (idx < 670 && !(k == 0 && row < 3)) xch[i] = *(const u32x4*)(xbase + (unsigned)(row * 1280 + ch * 8)); }
#pragma unroll
            for (int i = 0; i < 11; ++i) { const int idx = ln + 64 * i; const int row = idx / 10, ch = idx - row * 10; if (idx < 670) *(LAS u32x4*)(xt + row * 208 + ch * 16) = xch[i]; }
            LAS u32x4* z = (LAS u32x4*)(xt + (lane + 3) * 208 + 160); z[0] = (u32x4){0u, 0u, 0u, 0u}; z[1] = (u32x4){0u, 0u, 0u, 0u};
        }
        LDS_WAIT(); asm volatile("" ::: "memory");
#pragma unroll
        for (int ct = 0; ct < 5; ++ct) { const int c = blk * 80 + 16 * ct + cl; const f32x4 cw = *(const f32x4*)(lct + c * 8); const float cb = lct[c * 8 + 4];
            float xv[4][7];
#pragma unroll
            for (int rt = 0; rt < 4; ++rt)
#pragma unroll
                for (int j = 0; j < 7; ++j) xv[rt][j] = bf1(*(const LAS bf16_t*)(xt + (16 * rt + 4 * kg + j) * 208 + (16 * ct + cl) * 2));
            asm volatile("" ::: "memory");
#pragma unroll
            for (int rt = 0; rt < 4; ++rt)
#pragma unroll
                for (int e = 0; e < 4; ++e) { const float v = cb + cw.x * xv[rt][e] + cw.y * xv[rt][e + 1] + cw.z * xv[rt][e + 2] + cw.w * xv[rt][e + 3];
                    *(LAS bf16_t*)(xt + (16 * rt + 4 * kg + e + 3) * 208 + (16 * ct + cl) * 2) = f2bf(v); }
            asm volatile("" ::: "memory"); }
        LDS_WAIT(); asm volatile("" ::: "memory");
        bf16x8 af[4][3];
#pragma unroll
        for (int rt = 0; rt < 4; ++rt)
#pragma unroll
            for (int ks = 0; ks < 3; ++ks) af[rt][ks] = *(const LAS bf16x8*)(xt + (16 * rt + cl + 3) * 208 + (32 * ks + 8 * kg) * 2);
        bf16x8 wA[2][3], wX[2][3];
#pragma unroll
        for (int ks = 0; ks < 3; ++ks) { const size_t wo = ((size_t)blk * 80 + cl) * 96 + 32 * ks + 8 * kg; wA[0][ks] = *(const bf16x8*)(lwa + wo); wX[0][ks] = *(const bf16x8*)(lwx + wo); }
#pragma unroll
        for (int ct = 0; ct < 5; ++ct) { const int c = blk * 80 + 16 * ct + cl; const int cur = ct & 1;
            if (ct + 1 < 5) {
#pragma unroll
                for (int ks = 0; ks < 3; ++ks) { const size_t wo = ((size_t)blk * 80 + 16 * (ct + 1) + cl) * 96 + 32 * ks + 8 * kg; wA[cur ^ 1][ks] = *(const bf16x8*)(lwa + wo); wX[cur ^ 1][ks] = *(const bf16x8*)(lwx + wo); } }
            const f32x4 c1 = *(const f32x4*)(lct + c * 8 + 4); const float ba_c = c1.y, bx_c = c1.z, sp8 = c1.w;
            f32x4 ra[4], rx[4];
#pragma unroll
            for (int rt = 0; rt < 4; ++rt) { ra[rt] = (f32x4){0.f, 0.f, 0.f, 0.f}; rx[rt] = (f32x4){0.f, 0.f, 0.f, 0.f}; }
#pragma unroll
            for (int ks = 0; ks < 3; ++ks)
#pragma unroll
                for (int rt = 0; rt < 4; ++rt) { ra[rt] = __builtin_amdgcn_mfma_f32_16x16x32_bf16(af[rt][ks], wA[cur][ks], ra[rt], 0, 0, 0); rx[rt] = __builtin_amdgcn_mfma_f32_16x16x32_bf16(af[rt][ks], wX[cur][ks], rx[rt], 0, 0, 0); }
            float hin = (PASS == 2) ? hin_l[c] : 0.f; float totA = 1.f, totB = 0.f;
#pragma unroll
            for (int rt = 0; rt < 4; ++rt) { float av[4], bv[4];
#pragma unroll
                for (int e = 0; e < 4; ++e) { const float r = fsigmoid(ra[rt][e] + ba_c), ig = fsigmoid(rx[rt][e] + bx_c);
                    const float aa = __expf(sp8 * r); const float mult = sqrtf(fmaxf(1.f - aa * aa, 0.f));
                    const float xcv = bf1(*(const LAS bf16_t*)(xt + (16 * rt + 4 * kg + e + 3) * 208 + (16 * ct + cl) * 2));
                    av[e] = aa; bv[e] = mult * ig * xcv; }
                float sA = av[0], sB = bv[0];
#pragma unroll
                for (int e = 1; e < 4; ++e) { sB = av[e] * sB + bv[e]; sA *= av[e]; }
                float iA = sA, iB = sB;
                { const float pA = __shfl(iA, lane - 16), pB = __shfl(iB, lane - 16); if (kg >= 1) { iB = iA * pB + iB; iA = iA * pA; } }
                { const float pA = __shfl(iA, lane - 32), pB = __shfl(iB, lane - 32); if (kg >= 2) { iB = iA * pB + iB; iA = iA * pA; } }
                const float tA = __shfl(iA, 48 + cl), tB = __shfl(iB, 48 + cl);
                if (PASS == 1) { totB = tA * totB + tB; totA *= tA; }
                else {
                    float eA = __shfl(iA, lane - 16), eB = __shfl(iB, lane - 16); if (kg == 0) { eA = 1.f; eB = 0.f; }
                    float h = eA * hin + eB;
#pragma unroll
                    for (int e = 0; e < 4; ++e) { h = av[e] * h + bv[e]; *(LAS bf16_t*)(xt + (16 * rt + 4 * kg + e + 3) * 208 + (16 * ct + cl) * 2) = f2bf(h); }
                    hin = tA * hin + tB;
                }
            }
            if (PASS == 1) { if (kg == 0) *(f32x2v*)(agg + (((size_t)b * 32 + k) * 1280 + c) * 2) = (f32x2v){totA, totB}; }
        }
        LDS_WAIT(); asm volatile("" ::: "memory");
        if (PASS == 2) {
            int ln = lane; asm volatile("" : "+v"(ln));
            bf16_t* ybase = y + r0 * YLD + 2048 + blk * 80; u32x4 zc[10];
#pragma unroll
            for (int i = 0; i < 10; ++i) { const int idx = ln + 64 * i; const int row = idx / 10, ch = idx - row * 10; zc[i] = *(const u32x4*)(ybase + (unsigned)(row * YLD + ch * 8)); }
#pragma unroll
            for (int i = 0; i < 10; ++i) { const int idx = ln + 64 * i; const int row = idx / 10, ch = idx - row * 10; const u32x4 hv = *(const LAS u32x4*)(xt + (row + 3) * 208 + ch * 16); u32x4 o;
                o.x = pk_bf16(bf_lo(hv.x) * bf_lo(zc[i].x), bf_hi(hv.x) * bf_hi(zc[i].x)); o.y = pk_bf16(bf_lo(hv.y) * bf_lo(zc[i].y), bf_hi(hv.y) * bf_hi(zc[i].y));
                o.z = pk_bf16(bf_lo(hv.z) * bf_lo(zc[i].z), bf_hi(hv.z) * bf_hi(zc[i].z)); o.w = pk_bf16(bf_lo(hv.w) * bf_lo(zc[i].w), bf_hi(hv.w) * bf_hi(zc[i].w));
                if (!nostore) *(u32x4*)(ybase + (unsigned)(row * YLD + ch * 8)) = o; }
            LDS_WAIT(); asm volatile("" ::: "memory");
        }
    }
    if (PASS == 2) __syncthreads();
}

constexpr int CW_LRUF = 8192;
__device__ __forceinline__ void lru_single(const Frame& F, const unsigned char* ws, unsigned* ctl, const bool nostore, int l, int item, const bf16_t* xcb, bf16_t* y, float* agg) {
    const int b = item >> 5, k = item & 31; const size_t r0 = (size_t)b * SEQ + (size_t)k * 64;
    int lane_ = lane_id(); asm volatile("" : "+v"(lane_));
    const int lane = lane_, cl = lane & 15, kg = lane >> 4;
    LAS unsigned char* xt = F.lds + F.wave * 16384;
    const bf16_t* lwa = (const bf16_t*)(ws + WS_LW); const bf16_t* lwx = lwa + 16 * 80 * 96;
    const float* lct = (const float*)(ws + WS_LCT);
    const unsigned epoch = (unsigned)l + 1u;
    unsigned* flags = ctl + CW_LRUF + b * 32 * 16;
    unsigned long long* agg64 = (unsigned long long*)agg;
#pragma unroll 1
    for (int bi = 0; bi < 2; ++bi) {
        const int blk = 2 * F.wave + bi;
        {
            u32x4 xch[11]; int ln = lane; asm volatile("" : "+v"(ln));
            const bf16_t* xbase = xcb + (r0 - 3) * 1280 + blk * 80;
#pragma unroll
            for (int i = 0; i < 11; ++i) { const int idx = ln + 64 * i; const int row = idx / 10, ch = idx - row * 10; xch[i] = (u32x4){0u, 0u, 0u, 0u};
                if (idx < 670 && !(k == 0 && row < 3)) xch[i] = *(const u32x4*)(xbase + (unsigned)(row * 1280 + ch * 8)); }
#pragma unroll
            for (int i = 0; i < 11; ++i) { const int idx = ln + 64 * i; const int row = idx / 10, ch = idx - row * 10; if (idx < 670) *(LAS u32x4*)(xt + row * 208 + ch * 16) = xch[i]; }
            LAS u32x4* z = (LAS u32x4*)(xt + (lane + 3) * 208 + 160); z[0] = (u32x4){0u, 0u, 0u, 0u}; z[1] = (u32x4){0u, 0u, 0u, 0u};
        }
        LDS_WAIT(); asm volatile("" ::: "memory");
#pragma unroll
        for (int ct = 0; ct < 5; ++ct) { const int c = blk * 80 + 16 * ct + cl; const f32x4 cw = *(const f32x4*)(lct + c * 8); const float cb = lct[c * 8 + 4];
            float xv[4][7];
#pragma unroll
            for (int rt = 0; rt < 4; ++rt)
#pragma unroll
                for (int j = 0; j < 7; ++j) xv[rt][j] = bf1(*(const LAS bf16_t*)(xt + (16 * rt + 4 * kg + j) * 208 + (16 * ct + cl) * 2));
            asm volatile("" ::: "memory");
#pragma unroll
            for (int rt = 0; rt < 4; ++rt)
#pragma unroll
                for (int e = 0; e < 4; ++e) { const float v = cb + cw.x * xv[rt][e] + cw.y * xv[rt][e + 1] + cw.z * xv[rt][e + 2] + cw.w * xv[rt][e + 3];
                    *(LAS bf16_t*)(xt + (16 * rt + 4 * kg + e + 3) * 208 + (16 * ct + cl) * 2) = f2bf(v); }
            asm volatile("" ::: "memory"); }
        LDS_WAIT(); asm volatile("" ::: "memory");
        bf16x8 af[4][3];
#pragma unroll
        for (int rt = 0; rt < 4; ++rt)
#pragma unroll
            for (int ks = 0; ks < 3; ++ks) af[rt][ks] = *(const LAS bf16x8*)(xt + (16 * rt + cl + 3) * 208 + (32 * ks + 8 * kg) * 2);
        bf16x8 wA[2][3], wX[2][3];
#pragma unroll
        for (int ks = 0; ks < 3; ++ks) { const size_t wo = ((size_t)blk * 80 + cl) * 96 + 32 * ks + 8 * kg; wA[0][ks] = *(const bf16x8*)(lwa + wo); wX[0][ks] = *(const bf16x8*)(lwx + wo); }
        unsigned pk[5][4][2];
#pragma unroll
        for (int ct = 0; ct < 5; ++ct) { const int c = blk * 80 + 16 * ct + cl; const int cur = ct & 1;
            if (ct + 1 < 5) {
#pragma unroll
                for (int ks = 0; ks < 3; ++ks) { const size_t wo = ((size_t)blk * 80 + 16 * (ct + 1) + cl) * 96 + 32 * ks + 8 * kg; wA[cur ^ 1][ks] = *(const bf16x8*)(lwa + wo); wX[cur ^ 1][ks] = *(const bf16x8*)(lwx + wo); } }
            const f32x4 c1 = *(const f32x4*)(lct + c * 8 + 4); const float ba_c = c1.y, bx_c = c1.z, sp8 = c1.w;
            f32x4 ra[4], rx[4];
#pragma unroll
            for (int rt = 0; rt < 4; ++rt) { ra[rt] = (f32x4){0.f, 0.f, 0.f, 0.f}; rx[rt] = (f32x4){0.f, 0.f, 0.f, 0.f}; }
#pragma unroll
            for (int ks = 0; ks < 3; ++ks)
#pragma unroll
                for (int rt = 0; rt < 4; ++rt) { ra[rt] = __builtin_amdgcn_mfma_f32_16x16x32_bf16(af[rt][ks], wA[cur][ks], ra[rt], 0, 0, 0); rx[rt] = __builtin_amdgcn_mfma_f32_16x16x32_bf16(af[rt][ks], wX[cur][ks], rx[rt], 0, 0, 0); }
            float hl = 0.f, pl = 1.f;
#pragma unroll
            for (int rt = 0; rt < 4; ++rt) { float av[4], bv[4];
#pragma unroll
                for (int e = 0; e < 4; ++e) { const float r = fsigmoid(ra[rt][e] + ba_c), ig = fsigmoid(rx[rt][e] + bx_c);
                    const float aa = __expf(sp8 * r); const float mult = sqrtf(fmaxf(1.f - aa * aa, 0.f));
                    const float xcv = bf1(*(const LAS bf16_t*)(xt + (16 * rt + 4 * kg + e + 3) * 208 + (16 * ct + cl) * 2));
                    av[e] = aa; bv[e] = mult * ig * xcv; }
                float sA = av[0], sB = bv[0];
#pragma unroll
                for (int e = 1; e < 4; ++e) { sB = av[e] * sB + bv[e]; sA *= av[e]; }
                float iA = sA, iB = sB;
                { const float pA = __shfl(iA, lane - 16), pB = __shfl(iB, lane - 16); if (kg >= 1) { iB = iA * pB + iB; iA = iA * pA; } }
                { const float pA = __shfl(iA, lane - 32), pB = __shfl(iB, lane - 32); if (kg >= 2) { iB = iA * pB + iB; iA = iA * pA; } }
                const float tA = __shfl(iA, 48 + cl), tB = __shfl(iB, 48 + cl);
                float eA = __shfl(iA, lane - 16), eB = __shfl(iB, lane - 16); if (kg == 0) { eA = 1.f; eB = 0.f; }
                float h = eA * hl + eB, pp = eA * pl, P[4];
#pragma unroll
                for (int e = 0; e < 4; ++e) { h = av[e] * h + bv[e]; pp *= av[e]; P[e] = pp;
                    *(LAS bf16_t*)(xt + (16 * rt + 4 * kg + e + 3) * 208 + (16 * ct + cl) * 2) = f2bf(h); }
                pk[ct][rt][0] = pk_bf16(P[0], P[1]); pk[ct][rt][1] = pk_bf16(P[2], P[3]);
                hl = tA * hl + tB; pl *= tA;
            }
            if (kg == 0) __hip_atomic_store(agg64 + ((size_t)b * 32 + k) * 1280 + c, ((unsigned long long)__float_as_uint(hl) << 32) | (unsigned long long)__float_as_uint(pl), __ATOMIC_RELAXED, __HIP_MEMORY_SCOPE_AGENT);
        }
        asm volatile("s_waitcnt vmcnt(0)" ::: "memory");
        if (lane == 0) __hip_atomic_store(flags + k * 16 + blk, epoch, __ATOMIC_RELAXED, __HIP_MEMORY_SCOPE_AGENT);
        if (k > 0) {
            for (unsigned spins = 0; spins < (1u << 20); ++spins) {
                const unsigned f = (lane < k) ? __hip_atomic_load(flags + lane * 16 + blk, __ATOMIC_RELAXED, __HIP_MEMORY_SCOPE_AGENT) : epoch;
                if (__all(f == epoch)) break;
                __builtin_amdgcn_s_sleep(2);
            }
            float fa[5], fb[5];
#pragma unroll
            for (int ct = 0; ct < 5; ++ct) { fa[ct] = 1.f; fb[ct] = 0.f; }
            const int j0 = (k * kg) >> 2, j1 = (k * (kg + 1)) >> 2;
            const unsigned long long* ag0 = agg64 + (size_t)b * 32 * 1280 + blk * 80 + cl;
#pragma unroll 2
            for (int j = j0; j < j1; ++j) {
                unsigned long long w[5];
#pragma unroll
                for (int ct = 0; ct < 5; ++ct) w[ct] = __hip_atomic_load(ag0 + (size_t)j * 1280 + 16 * ct, __ATOMIC_RELAXED, __HIP_MEMORY_SCOPE_AGENT);
#pragma unroll
                for (int ct = 0; ct < 5; ++ct) { const float A = __uint_as_float((unsigned)w[ct]), B = __uint_as_float((unsigned)(w[ct] >> 32)); fb[ct] = A * fb[ct] + B; fa[ct] *= A; } }
#pragma unroll
            for (int ct = 0; ct < 5; ++ct) { float iA = fa[ct], iB = fb[ct];
                { const float pA = __shfl(iA, lane - 16), pB = __shfl(iB, lane - 16); if (kg >= 1) { iB = iA * pB + iB; iA = iA * pA; } }
                { const float pA = __shfl(iA, lane - 32), pB = __shfl(iB, lane - 32); if (kg >= 2) { iB = iA * pB + iB; iA = iA * pA; } }
                const float cin = __shfl(iB, 48 + cl);
#pragma unroll
                for (int rt = 0; rt < 4; ++rt) { const float P[4] = {bf_lo(pk[ct][rt][0]), bf_hi(pk[ct][rt][0]), bf_lo(pk[ct][rt][1]), bf_hi(pk[ct][rt][1])};
#pragma unroll
                    for (int e = 0; e < 4; ++e) { LAS bf16_t* hp = (LAS bf16_t*)(xt + (16 * rt + 4 * kg + e + 3) * 208 + (16 * ct + cl) * 2); *hp = f2bf(bf1(*hp) + P[e] * cin); } } }
        }
        LDS_WAIT(); asm volatile("" ::: "memory");
        {
            int ln = lane; asm volatile("" : "+v"(ln));
            bf16_t* ybase = y + r0 * YLD + 2048 + blk * 80; u32x4 zc[10];
#pragma unroll
            for (int i = 0; i < 10; ++i) { const int idx = ln + 64 * i; const int row = idx / 10, ch = idx - row * 10; zc[i] = *(const u32x4*)(ybase + (unsigned)(row * YLD + ch * 8)); }
#pragma unroll
            for (int i = 0; i < 10; ++i) { const int idx = ln + 64 * i; const int row = idx / 10, ch = idx - row * 10; const u32x4 hv = *(const LAS u32x4*)(xt + (row + 3) * 208 + ch * 16); u32x4 o;
                o.x = pk_bf16(bf_lo(hv.x) * bf_lo(zc[i].x), bf_hi(hv.x) * bf_hi(zc[i].x)); o.y = pk_bf16(bf_lo(hv.y) * bf_lo(zc[i].y), bf_hi(hv.y) * bf_hi(zc[i].y));
                o.z = pk_bf16(bf_lo(hv.z) * bf_lo(zc[i].z), bf_hi(hv.z) * bf_hi(zc[i].z)); o.w = pk_bf16(bf_lo(hv.w) * bf_lo(zc[i].w), bf_hi(hv.w) * bf_hi(zc[i].w));
                if (!nostore) *(u32x4*)(ybase + (unsigned)(row * YLD + ch * 8)) = o; }
            LDS_WAIT(); asm volatile("" ::: "memory");
        }
    }
}
__device__ __forceinline__ void phaseB_lru(const Frame& F, const unsigned char* ws, unsigned* ctl, const bool nostore, int l, const bf16_t* xc, bf16_t* y, float* agg) {
    for (int item = F.vcu; item < NBATCH * 32; item += F.G) lru_single(F, ws, ctl, nostore, l, item, xc, y, agg);
}

__device__ __forceinline__ void phaseB_extra(const Frame& F, const Args& a, const unsigned char* ws, int l, const bf16_t* misc, bf16_t* kr, const bf16_t* xc, float* agg, const float* cs, const float* sn) {
    for (int item = F.vcu; item < NBATCH * 32; item += F.G) lru_item<1>(F, a, ws, false, l, item, xc, nullptr, agg);
}

namespace att {
constexpr int SHM_V = 64 * 128 * 2, SHM_K = 64 * 192 * 2, OFF_K = 2 * SHM_V, OFF_WS = OFF_K + 2 * SHM_K, LDS_TOTAL = OFF_WS + 8 * 64 * 4;
constexpr float THR = 8.f;
constexpr float NEGBIG = -1e30f;
constexpr int KVBLK_ = 64;
#define ATT_SBAR() __builtin_amdgcn_sched_barrier(0)
__device__ __forceinline__ int crow(int r, int hi) { return (r & 3) + 8 * (r >> 2) + 4 * hi; }
__device__ __forceinline__ int koff(int row, int sub, int chunk) { return sub * 8192 + row * 128 + ((chunk ^ ((row >> 1) & 7)) << 4); }
__device__ __forceinline__ void partialSM(f32x16& p0, f32x16& p1, float& m_reg, float& alpha) {
    float pmax = p0[0];
#pragma unroll
    for (int r = 1; r < 16; ++r) pmax = fmaxf(pmax, p0[r]);
#pragma unroll
    for (int r = 0; r < 16; ++r) pmax = fmaxf(pmax, p1[r]);
    { auto rr = __builtin_amdgcn_permlane32_swap(__float_as_uint(pmax), __float_as_uint(pmax), false, false); pmax = fmaxf(__uint_as_float(rr[0]), __uint_as_float(rr[1])); }
    float mn;
    if (__builtin_expect(__all(pmax - m_reg <= THR), 1)) { mn = m_reg; alpha = 1.f; }
    else { mn = fmaxf(m_reg, pmax); alpha = __builtin_amdgcn_exp2f(m_reg - mn); m_reg = mn; }
#pragma unroll
    for (int r = 0; r < 16; ++r) p0[r] = __builtin_amdgcn_exp2f(p0[r] - mn);
#pragma unroll
    for (int r = 0; r < 16; ++r) p1[r] = p1[r] - mn;
}
__device__ __forceinline__ void finishSM(f32x16& p0, f32x16& p1, float alpha, float& l_reg, bf16x8& pa0, bf16x8& pa1, bf16x8& pa2, bf16x8& pa3) {
#pragma unroll
    for (int r = 0; r < 16; ++r) p1[r] = __builtin_amdgcn_exp2f(p1[r]);
    float ps = 0.f;
#pragma unroll
    for (int r = 0; r < 16; ++r) ps += p0[r];
#pragma unroll
    for (int r = 0; r < 16; ++r) ps += p1[r];
    { auto rr = __builtin_amdgcn_permlane32_swap(__float_as_uint(ps), __float_as_uint(ps), false, false); ps = __uint_as_float(rr[0]) + __uint_as_float(rr[1]); }
    l_reg = l_reg * alpha + ps;
#define ATT_PK4(P, BASE, OUT) do { unsigned a0 = pk_bf16(P[BASE + 0], P[BASE + 1]), a1 = pk_bf16(P[BASE + 2], P[BASE + 3]);   \
    unsigned b0 = pk_bf16(P[BASE + 4], P[BASE + 5]), b1 = pk_bf16(P[BASE + 6], P[BASE + 7]);                              \
    auto r0 = __builtin_amdgcn_permlane32_swap(a0, b0, false, false); auto r1 = __builtin_amdgcn_permlane32_swap(a1, b1, false, false); \
    u32x4 w = {r0[0], r1[0], r0[1], r1[1]}; OUT = __builtin_bit_cast(bf16x8, w); } while (0)
    ATT_PK4(p0, 0, pa0); ATT_PK4(p0, 8, pa1); ATT_PK4(p1, 0, pa2); ATT_PK4(p1, 8, pa3);
#undef ATT_PK4
}
__device__ __forceinline__ void qkt(f32x16& p0, f32x16& p1, const LAS unsigned char* Ks, const bf16x8* qr, int r32, int hi) {
    p0 = f32x16{}; p1 = f32x16{};
#pragma unroll
    for (int d0 = 0; d0 < 12; ++d0) { const int sub = d0 >> 2, chunk = (d0 & 3) * 2 + hi;
        const bf16x8 b0 = *(const LAS bf16x8*)(Ks + koff(r32, sub, chunk));
        const bf16x8 b1 = *(const LAS bf16x8*)(Ks + koff(32 + r32, sub, chunk));
        p0 = __builtin_amdgcn_mfma_f32_32x32x16_bf16(b0, qr[d0], p0, 0, 0, 0);
        p1 = __builtin_amdgcn_mfma_f32_32x32x16_bf16(b1, qr[d0], p1, 0, 0, 0);
        if ((d0 & 3) == 3) ATT_SBAR(); }
}
__device__ __forceinline__ int v_st(int k, int c) { const int kk = (k & ~0xC) | ((k & 4) << 1) | ((k & 8) >> 1); return ((kk >> 3) * 4 + (c >> 5)) * 512 + ((kk & 7) * 32 + (c & 31)) * 2; }
__device__ __forceinline__ int v_rd_base(int lane) { return ((lane & 3) << 3) | (((lane >> 2) & 3) << 6) | (((lane >> 4) & 1) << 5) | (((lane >> 5) & 1) << 8); }
constexpr int v_rd_off(int d0, int ks, int half) { return d0 * 512 + ks * 4096 + half * 2048; }
template <int OFF> __device__ __forceinline__ s16x4 tr_read(int vb) { s16x4 r; asm volatile("ds_read_b64_tr_b16 %0, %1 offset:%2" : "=&v"(r) : "v"(vb), "i"(OFF) : "memory"); return r; }
template <int D0> __device__ __forceinline__ void pv_one(f32x16& od, int vb, bf16x8 pa0, bf16x8 pa1, bf16x8 pa2, bf16x8 pa3) {
    const s16x4 l0 = tr_read<v_rd_off(D0, 0, 0)>(vb), h0 = tr_read<v_rd_off(D0, 0, 1)>(vb), l1 = tr_read<v_rd_off(D0, 1, 0)>(vb), h1 = tr_read<v_rd_off(D0, 1, 1)>(vb);
    const s16x4 l2 = tr_read<v_rd_off(D0, 2, 0)>(vb), h2 = tr_read<v_rd_off(D0, 2, 1)>(vb), l3 = tr_read<v_rd_off(D0, 3, 0)>(vb), h3 = tr_read<v_rd_off(D0, 3, 1)>(vb);
    asm volatile("s_waitcnt lgkmcnt(0)" ::: "memory"); ATT_SBAR();
#define ATT_PK(L, H) (bf16x8){L[0], L[1], L[2], L[3], H[0], H[1], H[2], H[3]}
    od = __builtin_amdgcn_mfma_f32_32x32x16_bf16(pa0, ATT_PK(l0, h0), od, 0, 0, 0);
    od = __builtin_amdgcn_mfma_f32_32x32x16_bf16(pa1, ATT_PK(l1, h1), od, 0, 0, 0);
    od = __builtin_amdgcn_mfma_f32_32x32x16_bf16(pa2, ATT_PK(l2, h2), od, 0, 0, 0);
    od = __builtin_amdgcn_mfma_f32_32x32x16_bf16(pa3, ATT_PK(l3, h3), od, 0, 0, 0);
#undef ATT_PK
}
__device__ __forceinline__ void pv_d0(f32x16* o, int vb, bf16x8 pa0, bf16x8 pa1, bf16x8 pa2, bf16x8 pa3) {
    pv_one<0>(o[0], vb, pa0, pa1, pa2, pa3); pv_one<1>(o[1], vb, pa0, pa1, pa2, pa3); pv_one<2>(o[2], vb, pa0, pa1, pa2, pa3); pv_one<3>(o[3], vb, pa0, pa1, pa2, pa3);
}

__device__ __forceinline__ void unit(const Frame& F, const bool nostore, int b, int hd, int qb, const bf16_t* __restrict__ Q, bf16_t* Y, const bf16_t* __restrict__ VV, const bf16_t* __restrict__ KR) {
    int tid_ = F.wave * 64 + lane_id(); asm volatile("" : "+v"(tid_));
    const int tid = tid_, wid = F.wave, lane = tid & 63, r32 = lane & 31, hi = lane >> 5;
    LAS unsigned char* lds = F.lds;
    LAS unsigned char* V_lds = lds; LAS unsigned char* K_lds = lds + OFF_K;
    LAS float* wsf = (LAS float*)(lds + OFF_WS) + wid * 64; LAS float* li_l = wsf; LAS float* al_l = wsf + 32;
    const size_t rowbase = (size_t)b * SEQ; const int q0 = qb * 256; const int qc = 4 * qb + (wid >> 1); const int NT = 4 * qb + 4;
    float m_reg = NEGBIG, l_reg = 0.f; f32x16 o[4] = {}; bf16x8 qr[12];
    { const bf16_t* Qw = Q + (rowbase + q0 + wid * 32 + r32) * 1536 + hd * 192 + hi * 8;
#pragma unroll
      for (int d0 = 0; d0 < 12; ++d0) qr[d0] = *(const bf16x8*)(Qw + d0 * 16); }
    const bf16_t* Kn = Y + rowbase * YLD + hd * 128; const bf16_t* Vh = VV + rowbase * 1024 + hd * 128; const bf16_t* Kr = KR + rowbase * 64;
    const int sr = tid >> 4, sc = (tid & 15) * 8; const int vst0 = v_st(sr, sc), vst1 = v_st(32 + sr, sc);
    const int kst0 = koff(sr, sc >> 6, (sc & 63) >> 3), kst1 = koff(32 + sr, sc >> 6, (sc & 63) >> 3), kst2 = koff(tid >> 3, 2, tid & 7);
    const int vb0 = (int)(uintptr_t)V_lds + v_rd_base(lane);
    bf16x8 vs0, vs1, ks0, ks1, ks2;
#define ATT_SLOAD(k0) do { vs0 = *(const bf16x8*)(Vh + (size_t)((k0) + sr) * 1024 + sc); vs1 = *(const bf16x8*)(Vh + (size_t)((k0) + 32 + sr) * 1024 + sc); \
    ks0 = *(const bf16x8*)(Kn + (size_t)((k0) + sr) * YLD + sc); ks1 = *(const bf16x8*)(Kn + (size_t)((k0) + 32 + sr) * YLD + sc); \
    ks2 = *(const bf16x8*)(Kr + (size_t)((k0) + (tid >> 3)) * 64 + (tid & 7) * 8); } while (0)
#define ATT_SWRITE(bf) do { *(LAS bf16x8*)(V_lds + (bf) * SHM_V + vst0) = vs0; *(LAS bf16x8*)(V_lds + (bf) * SHM_V + vst1) = vs1; \
    *(LAS bf16x8*)(K_lds + (bf) * SHM_K + kst0) = ks0; *(LAS bf16x8*)(K_lds + (bf) * SHM_K + kst1) = ks1; *(LAS bf16x8*)(K_lds + (bf) * SHM_K + kst2) = ks2; } while (0)
#define ATT_RESC(al) do { if (__any((al) < 1.f)) { if (hi == 0) al_l[r32] = (al); asm volatile("s_waitcnt lgkmcnt(0)" ::: "memory"); \
    _Pragma("unroll") for (int d = 0; d < 4; ++d) _Pragma("unroll") for (int r = 0; r < 16; ++r) o[d][r] *= al_l[crow(r, hi)]; } } while (0)
#define ATT_QKT(P0, P1, bf, jt) do { if ((jt) <= qc) qkt(P0, P1, K_lds + (bf) * SHM_K, qr, r32, hi); else { _Pragma("unroll") for (int r = 0; r < 16; ++r) { P0[r] = NEGBIG; P1[r] = NEGBIG; } } } while (0)
    f32x16 pA0, pA1, pB0, pB1; float alA, alB; bf16x8 pa0, pa1, pa2, pa3;
    ATT_SLOAD(0); asm volatile("s_waitcnt vmcnt(0)" ::: "memory"); ATT_SWRITE(0); __syncthreads();
    ATT_QKT(pA0, pA1, 0, 0); partialSM(pA0, pA1, m_reg, alA);
    ATT_SLOAD(KVBLK_); asm volatile("s_waitcnt vmcnt(0)" ::: "memory"); ATT_SWRITE(1); __syncthreads();
    for (int j = 1; j + 1 < NT; j += 2) {
        ATT_SBAR(); ATT_QKT(pB0, pB1, 1, j);
        finishSM(pA0, pA1, alA, l_reg, pa0, pa1, pa2, pa3); ATT_SBAR();
        ATT_SLOAD((j + 1) * KVBLK_); ATT_SBAR();
        pv_d0(o, vb0, pa0, pa1, pa2, pa3); partialSM(pB0, pB1, m_reg, alB);
        __syncthreads(); asm volatile("s_waitcnt vmcnt(0)" ::: "memory"); ATT_SWRITE(0);
        ATT_RESC(alB); __syncthreads();
        ATT_SBAR(); ATT_QKT(pA0, pA1, 0, j + 1);
        finishSM(pB0, pB1, alB, l_reg, pa0, pa1, pa2, pa3); ATT_SBAR();
        ATT_SLOAD((j + 2) * KVBLK_); ATT_SBAR();
        pv_d0(o, vb0 + SHM_V, pa0, pa1, pa2, pa3); partialSM(pA0, pA1, m_reg, alA);
        __syncthreads(); asm volatile("s_waitcnt vmcnt(0)" ::: "memory"); ATT_SWRITE(1);
        ATT_RESC(alA); __syncthreads();
    }
    ATT_SBAR(); ATT_QKT(pB0, pB1, 1, NT - 1);
    finishSM(pA0, pA1, alA, l_reg, pa0, pa1, pa2, pa3); ATT_SBAR();
    pv_d0(o, vb0, pa0, pa1, pa2, pa3); partialSM(pB0, pB1, m_reg, alB);
    __syncthreads(); ATT_RESC(alB);
    finishSM(pB0, pB1, alB, l_reg, pa0, pa1, pa2, pa3); ATT_SBAR();
    pv_d0(o, vb0 + SHM_V, pa0, pa1, pa2, pa3);
    if (hi == 0) li_l[r32] = l_reg; asm volatile("s_waitcnt lgkmcnt(0)" ::: "memory");
    float rli[16];
#pragma unroll
    for (int r = 0; r < 16; ++r) rli[r] = __builtin_amdgcn_rcpf(li_l[crow(r, hi)]);
    __syncthreads();
    int hi2 = hi, r32b = r32, ln = lane; asm volatile("" : "+v"(hi2), "+v"(r32b), "+v"(ln));
    LAS unsigned char* stg = lds + wid * 8704;
#pragma unroll
    for (int r = 0; r < 16; ++r) { const int orow = (r & 3) + 8 * (r >> 2) + 4 * hi2;
#pragma unroll
        for (int d0 = 0; d0 < 4; ++d0) *(LAS bf16_t*)(stg + orow * 272 + (d0 * 32 + r32b) * 2) = f2bf(o[d0][r] * rli[r]); }
    asm volatile("s_waitcnt lgkmcnt(0)" ::: "memory");
    bf16_t* Ow = Y + (rowbase + q0 + wid * 32) * YLD + 1024 + hd * 128;
    u32x4 zb[8];
#pragma unroll
    for (int i = 0; i < 8; ++i) { const int row = i * 4 + (ln >> 4), ch = ln & 15; zb[i] = *(const u32x4*)(Ow + (unsigned)(row * YLD + ch * 8)); }
#pragma unroll
    for (int i = 0; i < 8; ++i) { const int row = i * 4 + (ln >> 4), ch = ln & 15; const u32x4 ov = *(const LAS u32x4*)(stg + row * 272 + ch * 16); u32x4 w;
        w.x = pk_bf16(bf_lo(ov.x) * bf_lo(zb[i].x), bf_hi(ov.x) * bf_hi(zb[i].x)); w.y = pk_bf16(bf_lo(ov.y) * bf_lo(zb[i].y), bf_hi(ov.y) * bf_hi(zb[i].y));
        w.z = pk_bf16(bf_lo(ov.z) * bf_lo(zb[i].z), bf_hi(ov.z) * bf_hi(zb[i].z)); w.w = pk_bf16(bf_lo(ov.w) * bf_lo(zb[i].w), bf_hi(ov.w) * bf_hi(zb[i].w));
        if (!nostore) *(u32x4*)(Ow + (unsigned)(row * YLD + ch * 8)) = w; }
    asm volatile("s_waitcnt lgkmcnt(0)" ::: "memory");
    __syncthreads();
#undef ATT_SLOAD
#undef ATT_SWRITE
#undef ATT_RESC
#undef ATT_QKT
}
}

__device__ __forceinline__ void phaseC_att(const Frame& F, const bool nostore, const bf16_t* q, bf16_t* y, const bf16_t* vv, const bf16_t* kr) {
    for (int v = F.vcu; v < 256; v += F.G) { const int bh = v >> 2, s = v & 3;
        att::unit(F, nostore, bh >> 3, bh & 7, 7 - s, q, y, vv, kr);
        att::unit(F, nostore, bh >> 3, bh & 7, s, q, y, vv, kr); }
}
__device__ __forceinline__ void phaseC_lru(const Frame& F, const Args& a, const unsigned char* ws, const bool nostore, int l, bf16_t* y, const bf16_t* xc, const float* agg) {
    for (int item = F.vcu; item < NBATCH * 32; item += F.G) lru_item<2>(F, a, ws, nostore, l, item, xc, y, const_cast<float*>(agg));
}

__device__ __forceinline__ void gmlp_item(const Frame& F, const Args& a, const unsigned char* ws, const bool nostore, int l, int item, const bf16_t* v1, bf16_t* y, const float* vslab) {
    const int nb = item >> 2, g = item & 3; const size_t t0 = (size_t)nb * 128;
    int lane_ = lane_id(); asm volatile("" : "+v"(lane_));
    const int lane = lane_, w = F.wave, cl = lane & 15, kg = lane >> 4;
    LAS f32x2v* stat = (LAS f32x2v*)F.lds; LAS unsigned char* vnT = F.lds + 1024;
    { float pv[16];
#pragma unroll
      for (int i = 0; i < 16; ++i) pv[i] = vslab[(t0 + 16 * w + i) * 64 + lane];
#pragma unroll
      for (int i = 0; i < 16; ++i) { float v = pv[i]; v += sx<2>(v); v += sx<4>(v); v += sx<8>(v); v += sx<16>(v); v = xsum32(v);
          const float o = sx<1>(v);
          const float mu = v * (1.f / 1024.f); const float var = fmaxf(o * (1.f / 1024.f) - mu * mu, 0.f);
          if (lane == 0) stat[16 * w + i] = (f32x2v){mu, rsqrtf(var + EPS)}; } }
    LDS_WAIT(); __syncthreads();
    { const f32x2v st0 = stat[2 * lane], st1 = stat[2 * lane + 1];
      const float* lg = a.in[I_GM_LN_G] + l * 1024 + g * 256; const float* lb = a.in[I_GM_LN_B] + l * 1024 + g * 256;
      u32x4 xa[4], xb[4];
#pragma unroll
      for (int i = 0; i < 4; ++i) { const int c8 = 4 * w + i; xa[i] = *(const u32x4*)(v1 + (t0 + 2 * lane) * 1024 + g * 256 + c8 * 8); xb[i] = *(const u32x4*)(v1 + (t0 + 2 * lane + 1) * 1024 + g * 256 + c8 * 8); }
#pragma unroll
      for (int i = 0; i < 4; ++i) { const int c8 = 4 * w + i;
          const f32x4 g0 = *(const f32x4*)(lg + c8 * 8), g1 = *(const f32x4*)(lg + c8 * 8 + 4), b0 = *(const f32x4*)(lb + c8 * 8), b1 = *(const f32x4*)(lb + c8 * 8 + 4);
          const float ga[8] = {g0.x, g0.y, g0.z, g0.w, g1.x, g1.y, g1.z, g1.w}, be[8] = {b0.x, b0.y, b0.z, b0.w, b1.x, b1.y, b1.z, b1.w};
          const unsigned wa[4] = {xa[i].x, xa[i].y, xa[i].z, xa[i].w}, wb[4] = {xb[i].x, xb[i].y, xb[i].z, xb[i].w};
#pragma unroll
          for (int e = 0; e < 8; ++e) {
              const float fa = (e & 1) ? bf_hi(wa[e >> 1]) : bf_lo(wa[e >> 1]), fb = (e & 1) ? bf_hi(wb[e >> 1]) : bf_lo(wb[e >> 1]);
              const float na = (fa - st0.x) * st0.y * ga[e] + be[e], nbv = (fb - st1.x) * st1.y * ga[e] + be[e];
              *(LAS unsigned*)(vnT + (c8 * 8 + e) * 272 + lane * 4) = pk_bf16(na, nbv); } } }
    const bf16_t* gmw = (const bf16_t*)(ws + WS_GMW) + (size_t)g * 128 * 128;
    const float* bs = a.in[I_GM_BS] + l * 512 + g * 128;
    bf16_t* ybase = y + t0 * YLD + g * 256;
    const int tid = w * 64 + lane;
    u32x4 pa[8];
#pragma unroll
    for (int i = 0; i < 8; ++i) { const int idx = tid + 512 * i; pa[i] = *(const u32x4*)(ybase + (unsigned)((idx >> 5) * YLD + (idx & 31) * 8)); }
    float bsv[8];
#pragma unroll
    for (int ct = 0; ct < 8; ++ct) bsv[ct] = bs[16 * ct + cl];
    bf16x8 wf[2][4];
#pragma unroll
    for (int ks = 0; ks < 2; ++ks) wf[0][ks] = *(const bf16x8*)(gmw + (size_t)cl * 128 + 32 * ks + 8 * kg);
    LDS_WAIT(); __syncthreads();
    bf16x8 af[2][4];
#pragma unroll
    for (int r = 0; r < 2; ++r)
#pragma unroll
        for (int ks = 0; ks < 4; ++ks) af[r][ks] = *(const LAS bf16x8*)(vnT + (16 * (2 * w + r) + cl) * 272 + (32 * ks + 8 * kg) * 2);
    LDS_WAIT(); __syncthreads();
    LAS unsigned char* stg = vnT;
#pragma unroll
    for (int ct = 0; ct < 8; ++ct) { const int cur = ct & 1;
        if (ct + 1 < 8) {
#pragma unroll
            for (int ks = 0; ks < 4; ++ks) if (ks < ((ct + 1 < 4) ? 2 : 4)) wf[cur ^ 1][ks] = *(const bf16x8*)(gmw + (size_t)(16 * (ct + 1) + cl) * 128 + 32 * ks + 8 * kg); }
        f32x4 acc[2] = {(f32x4){0.f, 0.f, 0.f, 0.f}, (f32x4){0.f, 0.f, 0.f, 0.f}};
#pragma unroll
        for (int ks = 0; ks < 4; ++ks) if (ks < ((ct < 4) ? 2 : 4)) {
            acc[0] = __builtin_amdgcn_mfma_f32_16x16x32_bf16(af[0][ks], wf[cur][ks], acc[0], 0, 0, 0); acc[1] = __builtin_amdgcn_mfma_f32_16x16x32_bf16(af[1][ks], wf[cur][ks], acc[1], 0, 0, 0); }
#pragma unroll
        for (int r = 0; r < 2; ++r) { u32x2 o; o.x = pk_bf16(acc[r][0] + bsv[ct], acc[r][1] + bsv[ct]); o.y = pk_bf16(acc[r][2] + bsv[ct], acc[r][3] + bsv[ct]);
            *(LAS u32x2*)(stg + (16 * ct + cl) * 528 + (16 * (2 * w + r) + 4 * kg) * 2) = o; }
    }
    LDS_WAIT(); __syncthreads();
#pragma unroll
    for (int i = 0; i < 8; ++i) { const int idx = tid + 512 * i; const u32x4 sv = *(const LAS u32x4*)(stg + (idx >> 5) * 528 + (idx & 31) * 16); u32x4 o;
        o.x = pk_bf16(bf_lo(pa[i].x) * bf_lo(sv.x), bf_hi(pa[i].x) * bf_hi(sv.x)); o.y = pk_bf16(bf_lo(pa[i].y) * bf_lo(sv.y), bf_hi(pa[i].y) * bf_hi(sv.y));
        o.z = pk_bf16(bf_lo(pa[i].z) * bf_lo(sv.z), bf_hi(pa[i].z) * bf_hi(sv.z)); o.w = pk_bf16(bf_lo(pa[i].w) * bf_lo(sv.w), bf_hi(pa[i].w) * bf_hi(sv.w));
        if (!nostore) *(u32x4*)(ybase + (unsigned)((idx >> 5) * YLD + (idx & 31) * 8)) = o; }
    LDS_WAIT(); __syncthreads();
}
__device__ __forceinline__ void phaseE(const Frame& F, const Args& a, const unsigned char* ws, const bool nostore, int l, const bf16_t* v1, bf16_t* y, const float* vslab) {
    for (int item = F.vcu; item < 512; item += F.G) gmlp_item(F, a, ws, nostore, l, item, v1, y, vslab);
}
constexpr int N_PHASES = 1 + 8 * DEPTH;
#ifndef MK_PER_PHASE
#define MK_PER_PHASE 0
#endif
#ifndef MK_MAX_PHASE
#define MK_MAX_PHASE N_PHASES
#endif

__global__ void __launch_bounds__(NWAVES * 64, 2) mk_fwd(Args args) {
    extern __shared__ __attribute__((aligned(16))) unsigned char lds_raw[];
    Frame F;
    F.lds = (LAS unsigned char*)lds_raw;
    F.wave = __builtin_amdgcn_readfirstlane((int)threadIdx.x >> 6);
    F.G = gridDim.x; { const int bx = blockIdx.x; F.vcu = (F.G % 8 == 0) ? (bx % 8) * (F.G / 8) + bx / 8 : bx; }
    volatile LAS unsigned* MISCW = (volatile LAS unsigned*)(F.lds + MISC_OFF);
    for (int u = threadIdx.x; u < (LDS_BYTES - RING_BYTES) / 4; u += NWAVES * 64) ((LAS unsigned*)(F.lds + RING_BYTES))[u] = 0u;
    __syncthreads();
    unsigned* ctl = (unsigned*)(args.ws + WS_CTL);
#if MK_PER_PHASE
    const int lo = args.ph_lo, hi = args.ph_hi;
    const bool multi = (hi - lo) > 1;
#else
    constexpr int lo = 0, hi = N_PHASES;
    constexpr bool multi = true;
#endif
    XcdBarrier bar; bar.bar = ctl + CW_BAR; bar.x = 0; bar.st = nullptr;
    if (multi) bar = xcd_barrier_post(ctl + CW_BAR, MISCW + 8);
#define IN(k) (lo <= (k) && (k) < hi)
#define SEAM(k) do { if (IN((k) + 1)) xcd_barrier(bar); } while (0)
#define xcd_barrier_if(c, b) do { if (c) xcd_barrier(b); } while (0)

typedef const __attribute__((address_space(4))) Args* KArgP;
#define PHASE_PTRS \
    KArgP kp = (KArgP)__builtin_amdgcn_kernarg_segment_ptr(); asm volatile("" : "+s"(kp)); Args la; \
    _Pragma("unroll") for (int i_ = 0; i_ < N_INPUTS; ++i_) la.in[i_] = kp->in[i_]; la.out = kp->out; la.ws = kp->ws; la.ph_lo = 0; la.ph_hi = 0; \
    unsigned char* ws = la.ws; asm volatile("" : "+s"(ws)); Frame Fp = F; int bid = (int)blockIdx.x; asm volatile("" : "+s"(Fp.wave), "+s"(Fp.vcu), "+s"(Fp.G), "+s"(bid)); (void)bid; \
    bf16_t* Hb = (bf16_t*)(ws + WS_H); bf16_t* Yb = (bf16_t*)(ws + WS_Y); \
    bf16_t* MISCb = (bf16_t*)(ws + WS_MISC); bf16_t* XCb = (bf16_t*)(ws + WS_XC); bf16_t* Qb = (bf16_t*)(ws + WS_Q); bf16_t* VVb = (bf16_t*)(ws + WS_VV); bf16_t* KRb = (bf16_t*)(ws + WS_KR); \
    bf16_t* V1b = (bf16_t*)(ws + WS_V1); bf16_t* Gb = (bf16_t*)(ws + WS_G); bf16_t* Ob = (bf16_t*)(ws + WS_O); \
    float* SLAB = (float*)(ws + WS_SLAB); float* AGG = (float*)(ws + WS_AGG); const float* CS = (const float*)(ws + WS_ROPE); const float* SN = CS + 2048 * 32; \
    const unsigned char* wb = ws + WS_WB; (void)Hb; (void)Yb; (void)MISCb; (void)XCb; (void)Qb; (void)VVb; (void)KRb; (void)V1b; (void)Gb; (void)Ob; (void)SLAB; (void)AGG; (void)CS; (void)SN; (void)wb;
    if (IN(0)) {
        { PHASE_PTRS
        convert_weights(Fp, la, ws, 0);
        rope_table(Fp, ws);
        norm_rows(Fp, false, la.in[I_X], nullptr, nullptr, nullptr, la.in[I_PRE_G], Hb);
        }
        SEAM(0);
    }
#pragma nounroll
    for (int l = 0; l < DEPTH; ++l) {
        const int pb = 1 + 8 * l;
        if (IN(pb + 0)) {
            { const bool nostore = false; (void)nostore;
            PHASE_PTRS
            SchedA S; S.ord.init(64, 16, Fp.G, bid); S.A = (const char*)Hb; S.B = (const char*)(wb + WB_W1T);
            EpiA E{MISCb, XCb, Yb, SLAB, KRb, CS, SN};
            g8::gemm_stream(Fp.lds, Fp.wave * 64 + lane_id(), 2048u, 2048u, S, E);
            }
            SEAM(pb + 0);
        }
        if (IN(pb + 1)) {
            { const bool nostore = false; (void)nostore;
            PHASE_PTRS
            { SchedZ SZ; SZ.v = Fp.vcu; SZ.A = (const char*)Hb; SZ.B = (const char*)(wb + WB_W1T); EpiA EZ{MISCb, XCb, Yb, SLAB, KRb, CS, SN};
              g8::gemm_stream(Fp.lds, Fp.wave * 64 + lane_id(), 2048u, 2048u, SZ, EZ); }
            SchedQKV S; S.v = Fp.vcu; S.misc = (const char*)MISCb; S.wq = (const char*)(wb + WB_WQT); S.wkv = (const char*)(wb + WB_WKVT);
            EpiQKV E{Qb, Yb, VVb, SLAB, CS, SN};
            g8::gemm_stream(Fp.lds, Fp.wave * 64 + lane_id(), 1536u, 768u, S, E);
            phaseB_lru(Fp, ws, (unsigned*)(ws + WS_CTL), nostore, l, XCb, Yb, AGG);
            }
            SEAM(pb + 1);
        }
        if (IN(pb + 2)) {
            { const bool nostore = false; (void)nostore;
            PHASE_PTRS
            phaseC_att(Fp, nostore, Qb, Yb, VVb, KRb);
            }
            SEAM(pb + 2);
        }
        if (IN(pb + 3)) {
            { const bool nostore = false; (void)nostore;
            PHASE_PTRS
            SchedD S; S.ord.init(64, 24, Fp.G, bid); S.A = (const char*)Hb; S.B = (const char*)(wb + WB_W2T);
            EpiD E{Yb, V1b, Gb, SLAB};
            g8::gemm_stream(Fp.lds, Fp.wave * 64 + lane_id(), 2048u, 2048u, S, E);
            }
            SEAM(pb + 3);
        }
        if (IN(pb + 4)) {
            { const bool nostore = false; (void)nostore;
            PHASE_PTRS
            phaseE(Fp, la, ws, nostore, l, V1b, Yb, SLAB);
            }
            SEAM(pb + 4);
        }
        if (IN(pb + 5)) {
            { const bool nostore = false; (void)nostore;
            PHASE_PTRS
            SchedF S; S.ord.init(64, 4, Fp.G, bid); S.A = (const char*)Yb; S.B = (const char*)(wb + WB_WPT);
            EpiF E{Gb, V1b};
            g8::gemm_stream(Fp.lds, Fp.wave * 64 + lane_id(), (unsigned)(YLD * 2), (unsigned)(YLD * 2), S, E);
            }
            SEAM(pb + 5);
        }
        if (IN(pb + 6)) {
            { const bool nostore = false; (void)nostore;
            PHASE_PTRS
            SchedG1 S; S.v = Fp.vcu; S.A = (const char*)V1b; S.B = (const char*)(wb + WB_WOT);
            const float* xin = (l == 0) ? la.in[I_X] : la.out;
            EpiNorm E{xin, la.out, Hb, la.in[I_POST_G] + l * DM, (l + 1 < DEPTH) ? la.in[I_PRE_G] + (l + 1) * DM : nullptr, SLAB, (unsigned*)(ws + WS_CTL) + CW_NORM + l * 2048};
            g8::gemm_stream<true>(Fp.lds, Fp.wave * 64 + lane_id(), 2048u, 2048u, S, E);
            }
            if (l + 1 < DEPTH) SEAM(pb + 6);
        }
        if (IN(pb + 7) && l + 1 < DEPTH) {
            { const bool nostore = false; (void)nostore;
            PHASE_PTRS
            if (l + 1 < DEPTH) convert_weights(Fp, la, ws, l + 1);
            }
            SEAM(pb + 7);
        }
    }
#undef IN
#undef SEAM
}

#ifndef MK_PROBE
#define MK_PROBE 0
#endif
static int mk_setup(size_t ws_size) {
    static int grid = 0;
    if (grid == 0) {
        if (ws_size < WS_END) { fprintf(stderr, "kernel_launch: workspace too small: %zu < %zu\n", ws_size, (size_t)WS_END); grid = -1; return grid; }
        int dev = 0, cus = 0, per_cu = 0;
        if (hipGetDevice(&dev) != hipSuccess || hipDeviceGetAttribute(&cus, hipDeviceAttributeMultiprocessorCount, dev) != hipSuccess) { grid = -1; return grid; }
        if (hipFuncSetAttribute((const void*)mk_fwd, hipFuncAttributeMaxDynamicSharedMemorySize, LDS_BYTES) != hipSuccess) { fprintf(stderr, "kernel_launch: hipFuncSetAttribute failed\n"); grid = -1; return grid; }
        if (hipOccupancyMaxActiveBlocksPerMultiprocessor(&per_cu, (const void*)mk_fwd, NWAVES * 64, LDS_BYTES) != hipSuccess || per_cu < 1)
            fprintf(stderr, "kernel_launch: occupancy query reports %d blocks/CU\n", per_cu);
        (void)hipGetLastError();
        grid = cus;
        if (grid != 256) fprintf(stderr, "kernel_launch: note: %d CUs (tile schedules assume 256)\n", grid);
    }
    return grid;
}
static void mk_launch(void* const* d_in, void* d_out, void* d_ws, hipStream_t stream, int grid, int lo, int hi) {
    Args a{};
    for (int i = 0; i < N_INPUTS; ++i) a.in[i] = (const float*)d_in[i];
    a.out = (float*)d_out; a.ws = (unsigned char*)d_ws; a.ph_lo = lo; a.ph_hi = hi; a.probe = MK_PROBE; a.pad = 0;
    hipLaunchKernelGGL(mk_fwd, dim3(grid), dim3(NWAVES * 64), LDS_BYTES, stream, a);
}
extern "C" void kernel_launch(void* const* d_in, const int* in_sizes, int n_in, void* d_out, int out_size, void* d_ws, size_t ws_size, hipStream_t stream) {
    const int grid = mk_setup(ws_size); if (grid < 0) return;
    hipMemsetAsync((char*)d_ws + WS_CTL, 0, CTL_ZERO_BYTES, stream);
#if MK_PER_PHASE
    for (int ph = 0; ph < N_PHASES; ++ph) mk_launch(d_in, d_out, d_ws, stream, grid, ph, ph + 1);
#else
    mk_launch(d_in, d_out, d_ws, stream, grid, 0, N_PHASES);
#endif
}
```

```cpp
#define MK_PROBE 0
#include <hip/hip_runtime.h>
#include <cstdio>
#include <cstdint>

#define LAS __attribute__((address_space(3)))
#define GAS __attribute__((address_space(1)))
typedef unsigned short bf16_t;
typedef short bf16x8 __attribute__((ext_vector_type(8)));
typedef short s16x4 __attribute__((ext_vector_type(4)));
typedef float f32x2 __attribute__((ext_vector_type(2)));
typedef float f32x4 __attribute__((ext_vector_type(4)));
typedef float f32x16 __attribute__((ext_vector_type(16)));
typedef unsigned u32x2 __attribute__((ext_vector_type(2)));
typedef unsigned u32x4 __attribute__((ext_vector_type(4)));
typedef __bf16 bf16x2_t __attribute__((ext_vector_type(2)));

__device__ __forceinline__ unsigned pk_bf16(float lo, float hi) { f32x2 v = {lo, hi}; bf16x2_t b = __builtin_convertvector(v, bf16x2_t); return __builtin_bit_cast(unsigned, b); }
__device__ __forceinline__ float bf_lo(unsigned w) { return __uint_as_float(w << 16); }
__device__ __forceinline__ float bf_hi(unsigned w) { return __uint_as_float(w & 0xffff0000u); }
__device__ __forceinline__ float bf1(bf16_t h) { return __uint_as_float(((unsigned)h) << 16); }
__device__ __forceinline__ bf16_t f2bf(float f) { return (bf16_t)(pk_bf16(f, 0.f) & 0xffffu); }
__device__ __forceinline__ float fsigmoid(float x) { return __builtin_amdgcn_rcpf(1.f + __expf(-x)); }
__device__ __forceinline__ float fsilu(float x) { return x * __builtin_amdgcn_rcpf(1.f + __expf(-x)); }
template <int XM> __device__ __forceinline__ float sx(float v) { return __int_as_float(__builtin_amdgcn_ds_swizzle(__float_as_int(v), (XM << 10) | 0x1f)); }
__device__ __forceinline__ float xsum32(float v) { auto rr = __builtin_amdgcn_permlane32_swap(__float_as_uint(v), __float_as_uint(v), false, false); return __uint_as_float(rr[0]) + __uint_as_float(rr[1]); }
__device__ __forceinline__ float wave_sum(float v) { v += sx<1>(v); v += sx<2>(v); v += sx<4>(v); v += sx<8>(v); v += sx<16>(v); return xsum32(v); }
#define LDS_WAIT() asm volatile("s_waitcnt lgkmcnt(0)" ::: "memory")
#define VM_WAIT() asm volatile("s_waitcnt vmcnt(0)" ::: "memory")

namespace g8 {
constexpr int BM = 256, BK = 64, HALF = 128, HTB = HALF * BK * 2, STAGE_BYTES = 8 * HTB, NXCD = 8, WGM = 8;
__host__ __device__ __forceinline__ int lds_byte(int r, int c) { const int st = (r >> 4) * 2 + (c >> 5), rr = r & 15, cc = c & 31, ob = rr * 64 + cc * 2; return st * 1024 + (ob ^ (((ob >> 9) & 1) << 5)); }
__host__ __device__ __forceinline__ void stage_rc(int b, int& R, int& C) { const int st = b / 1024, sb = b % 1024, swz = sb ^ (((sb >> 9) & 1) << 5); R = (st >> 1) * 16 + swz / 64; C = (st & 1) * 32 + (swz % 64) / 2; }
__host__ __device__ __forceinline__ int perm32(int rho) { const int n = rho >> 4, i = rho & 15; return 8 * (i >> 2) + 4 * n + (i & 3); }

struct UnitD { const char* A; const char* B; int nt, pm, pn, kind; };
constexpr int KEEP_ACC = 0x100;

struct TileOrder {
    int nM, nN, nwg, G, c;
    __device__ void init(int nM_, int nN_, int G_, int c_) { nM = nM_; nN = nN_; nwg = nM * nN; G = G_; c = c_; }
    __device__ bool tile(int i, int& pm, int& pn) const {
        const long L = (long)i * G + c; if (L >= nwg) return false;
        int wgid = (int)L; { const int q = nwg / NXCD, r = nwg % NXCD, xcd = wgid % NXCD, off = wgid / NXCD; wgid = (xcd < r ? xcd * (q + 1) : r * (q + 1) + (xcd - r) * q) + off; }
        const int nig = WGM * nN, gid = wgid / nig, fm = gid * WGM, gsz = (nM - fm) < WGM ? (nM - fm) : WGM;
        pm = fm + ((wgid % nig) % gsz); pn = (wgid % nig) / gsz; return true;
    }
};

template <bool AFTER_DRAIN = false, class Sched, class Epi>
__device__ __forceinline__ void gemm_stream(LAS unsigned char* lds, int tid_in, const unsigned lda, const unsigned ldb, const Sched& S, const Epi& E) {
    int tid_ = tid_in; asm volatile("" : "+v"(tid_));
    const int tid = tid_, wid = __builtin_amdgcn_readfirstlane(tid >> 6), lane = tid & 63, wr = wid >> 2, wc = wid & 3, fr = lane & 15, fq = lane >> 4;
    unsigned voffA[2], voffB[2];
#pragma unroll
    for (int i = 0; i < 2; ++i) { int R, C; stage_rc(tid * 16 + i * 8192, R, C); const int Rb = (R & ~31) + perm32(R & 31);
        voffA[i] = (unsigned)R * lda + (unsigned)C * 2u; voffB[i] = (unsigned)Rb * ldb + (unsigned)C * 2u; }
    const size_t kstep = (size_t)(BK * 2);
    const size_t hstepA = (size_t)HALF * lda, hstepB = (size_t)HALF * ldb;
    const unsigned ldsw = (unsigned)wid * 1024u;
    const int aoff = lds_byte(wr * 64 + fr, fq * 8), boff = lds_byte(wc * 32 + fr, fq * 8);
#define G8_SA(b, h) (((b) * 2 + (h)) * HTB)
#define G8_SB(b, h) ((4 + (b) * 2 + (h)) * HTB)
#define G8_STAGE(bufoff, gbase, voff) do { _Pragma("unroll") for (int _i = 0; _i < 2; ++_i) \
        __builtin_amdgcn_global_load_lds((const unsigned*)((const char*)(gbase) + (voff)[_i]), (LAS unsigned*)(lds + (bufoff) + ldsw + _i * 8192), 16, 0, 0); } while (0)
#define G8_LDA(dst, b, h) do { _Pragma("unroll") for (int m = 0; m < 4; ++m) _Pragma("unroll") for (int k = 0; k < 2; ++k) dst[m][k] = *(const LAS bf16x8*)(lds + G8_SA(b, h) + aoff + m * 2048 + k * 1024); } while (0)
#define G8_LDB(dst, b, h) do { _Pragma("unroll") for (int n = 0; n < 2; ++n) _Pragma("unroll") for (int k = 0; k < 2; ++k) dst[n][k] = *(const LAS bf16x8*)(lds + G8_SB(b, h) + boff + n * 2048 + k * 1024); } while (0)
#define G8_MMA(ai, bj, At, Bt) do { __builtin_amdgcn_s_setprio(1); _Pragma("unroll") for (int m = 0; m < 4; ++m) _Pragma("unroll") for (int n = 0; n < 2; ++n) _Pragma("unroll") for (int k = 0; k < 2; ++k) \
        acc[ai][bj][m][n] = __builtin_amdgcn_mfma_f32_16x16x32_bf16(Bt[n][k], At[m][k], acc[ai][bj][m][n], 0, 0, 0); __builtin_amdgcn_s_setprio(0); } while (0)
#define G8_WAIT_V(n) asm volatile("s_waitcnt vmcnt(" #n ")" ::: "memory")
#define G8_WAIT_L(n) asm volatile("s_waitcnt lgkmcnt(" #n ")" ::: "memory")
#define G8_BAR __builtin_amdgcn_s_barrier()
#define G8_SCHED __builtin_amdgcn_sched_barrier(0)
    UnitD cur, nxt; int ui = 0;
    if (!S.next(0, cur)) return;
    f32x4 acc[2][2][4][2];
#pragma unroll
    for (int a = 0; a < 2; ++a)
#pragma unroll
        for (int b = 0; b < 2; ++b)
#pragma unroll
            for (int m = 0; m < 4; ++m)
#pragma unroll
                for (int n = 0; n < 2; ++n) acc[a][b][m][n] = (f32x4){0.f, 0.f, 0.f, 0.f};
    bf16x8 At[4][2], B0[2][2], B1[2][2];
    const char* cA = cur.A; const char* cB = cur.B;
    G8_STAGE(G8_SB(0, 0), cB, voffB); G8_STAGE(G8_SB(0, 1), cB + hstepB, voffB); G8_STAGE(G8_SA(0, 0), cA, voffA); G8_STAGE(G8_SA(0, 1), cA + hstepA, voffA);
    if (wr == 1) G8_BAR;
    G8_WAIT_V(2); G8_BAR;
    G8_STAGE(G8_SB(1, 0), cB + kstep, voffB); G8_STAGE(G8_SA(1, 0), cA + kstep, voffA); G8_STAGE(G8_SB(1, 1), cB + hstepB + kstep, voffB);
    G8_WAIT_V(6); G8_BAR;
    for (;;) {
        const bool has_next = S.next(ui + 1, nxt);
        const char* nA = has_next ? nxt.A : cA; const char* nB = has_next ? nxt.B : cB;
        const int nt = cur.nt;
        for (int t = 0; t < nt; t += 2) {
            const bool last = (t == nt - 2);
            const char* a1 = cA + (size_t)(t + 1) * kstep;
            const char* a2 = last ? nA : cA + (size_t)(t + 2) * kstep; const char* b2 = last ? nB : cB + (size_t)(t + 2) * kstep;
            const char* a3 = a2 + kstep; const char* b3 = b2 + kstep;
            G8_LDB(B0, 0, 0); G8_LDB(B1, 0, 1); G8_SCHED; G8_LDA(At, 0, 0); G8_STAGE(G8_SA(1, 1), a1 + hstepA, voffA);
            G8_WAIT_V(8); G8_WAIT_L(0); G8_BAR; G8_MMA(0, 0, At, B0); G8_MMA(0, 1, At, B1); G8_BAR; G8_SCHED;
            G8_LDA(At, 0, 1); G8_STAGE(G8_SB(0, 0), b2, voffB); G8_STAGE(G8_SB(0, 1), b2 + hstepB, voffB); G8_STAGE(G8_SA(0, 0), a2, voffA);
            G8_WAIT_V(8); G8_WAIT_L(0); G8_BAR; G8_MMA(1, 0, At, B0); G8_MMA(1, 1, At, B1); G8_BAR; G8_SCHED;
            G8_LDB(B0, 1, 0); G8_LDB(B1, 1, 1); G8_SCHED; G8_LDA(At, 1, 0); G8_STAGE(G8_SA(0, 1), a2 + hstepA, voffA);
            G8_WAIT_V(8); G8_WAIT_L(0); G8_BAR; G8_MMA(0, 0, At, B0); G8_MMA(0, 1, At, B1); G8_BAR; G8_SCHED;
            G8_LDA(At, 1, 1); G8_STAGE(G8_SB(1, 0), b3, voffB); G8_STAGE(G8_SB(1, 1), b3 + hstepB, voffB); G8_STAGE(G8_SA(1, 0), a3, voffA);
            G8_WAIT_V(8); G8_WAIT_L(0); G8_BAR; G8_MMA(1, 0, At, B0); G8_MMA(1, 1, At, B1); G8_BAR; G8_SCHED;
        }
        if (wr == 0) G8_BAR;
        if constexpr (!AFTER_DRAIN) { UnitD eu = cur; int fr_ = fr, fq_ = fq; asm volatile("" : "+s"(eu.pm), "+s"(eu.pn), "+v"(fr_), "+v"(fq_)); E(acc, eu, wr, wc, fr_, fq_); }
        if (!has_next) break;
        if (!(cur.kind & KEEP_ACC)) {
#pragma unroll
            for (int a = 0; a < 2; ++a)
#pragma unroll
                for (int b = 0; b < 2; ++b)
#pragma unroll
                    for (int m = 0; m < 4; ++m)
#pragma unroll
                        for (int n = 0; n < 2; ++n) acc[a][b][m][n] = (f32x4){0.f, 0.f, 0.f, 0.f};
        }
        cur = nxt; cA = nA; cB = nB; ++ui;
        if (wr == 1) G8_BAR;
    }
    G8_WAIT_V(0);
    G8_BAR;
    if constexpr (AFTER_DRAIN) {
        UnitD eu = cur; int fr_ = fr, fq_ = fq, ln_ = lane; asm volatile("" : "+s"(eu.pm), "+s"(eu.pn), "+v"(fr_), "+v"(fq_), "+v"(ln_)); E.fused(acc, eu, wr, wc, fr_, fq_, lds, wid, ln_); }
#undef G8_SA
#undef G8_SB
#undef G8_STAGE
#undef G8_LDA
#undef G8_LDB
#undef G8_MMA
#undef G8_WAIT_V
#undef G8_WAIT_L
#undef G8_BAR
#undef G8_SCHED
}
}

#define XB_TMO      128
#define XB_XCNT(j)  (256  + 64 * (j))
#define XB_XSUB(j)  (1280 + 64 * (j))
#define XB_XGEN(j)  (2304 + 64 * (j))
#define XB_TOP      3328
#define XB_TOPGEN   3392
#define XCD_BAR_WORDS 3456
#define XB_SPIN_CAP (1u << 18)
__device__ __forceinline__ unsigned xb_ld(unsigned* p)              { return __hip_atomic_load(p, __ATOMIC_RELAXED, __HIP_MEMORY_SCOPE_AGENT); }
__device__ __forceinline__ unsigned xb_add(unsigned* p, unsigned v) { return __hip_atomic_fetch_add(p, v, __ATOMIC_RELAXED, __HIP_MEMORY_SCOPE_AGENT); }
__device__ __forceinline__ unsigned xb_xcc_id() { return (unsigned)__builtin_amdgcn_s_getreg((3 << 11) | 20) & 0xFu; }
#define XB_SPIN(cond, bar) do { unsigned _sp = 0; while (cond) { __builtin_amdgcn_s_sleep(1); \
    if ((++_sp & 255u) == 0u) { if (xb_ld(&(bar)[XB_TMO])) break; if (_sp > XB_SPIN_CAP) { atomicAdd(&(bar)[XB_TMO], 1u); break; } } } } while (0)
struct XcdBarrier { unsigned* bar; unsigned x; volatile LAS unsigned* st; };
__device__ __forceinline__ XcdBarrier xcd_barrier_post(unsigned* bar, volatile LAS unsigned* st) {
    XcdBarrier b; b.bar = bar; b.x = xb_xcc_id(); b.st = st;
    if (threadIdx.x == 0) (void)xb_add(&bar[XB_XCNT(b.x)], 1u);
    return b;
}
__device__ __forceinline__ void xcd_barrier_complete(unsigned* bar, unsigned x, unsigned& nloc, unsigned& nx) {
    const unsigned G = gridDim.x * gridDim.y * gridDim.z;
    unsigned sum, cnt, mine, sp = 0u;
    for (;;) {
        sum = 0u; cnt = 0u; mine = 0u;
#pragma unroll
        for (unsigned j = 0; j < 16; ++j) { const unsigned c = xb_ld(&bar[XB_XCNT(j)]); sum += c; cnt += (c > 0u) ? 1u : 0u; mine = (j == x) ? c : mine; }
        if (sum == G) break;
        __builtin_amdgcn_s_sleep(1);
        if ((++sp & 255u) == 0u) { if (xb_ld(&bar[XB_TMO])) break; if (sp > XB_SPIN_CAP) { atomicAdd(&bar[XB_TMO], 1u); break; } }
    }
    nloc = mine > 0u ? mine : 1u; nx = cnt > 0u ? cnt : 1u;
}
__device__ __forceinline__ void xcd_barrier(const XcdBarrier& b) {
    asm volatile("s_waitcnt vmcnt(0)" ::: "memory");
    __syncthreads();
    if (threadIdx.x == 0) {
        unsigned* bar = b.bar; unsigned bx = b.x; asm volatile("" : "+s"(bar), "+s"(bx));
        __builtin_amdgcn_s_waitcnt(0);
        unsigned nloc = b.st[0], nx = b.st[1];
        if (nloc == 0u) { xcd_barrier_complete(bar, bx, nloc, nx); b.st[0] = nloc; b.st[1] = nx; }
        const unsigned old = xb_add(&bar[XB_XSUB(bx)], 1u);
        const unsigned gen = old / nloc;
        if (old + 1u == (gen + 1u) * nloc) {
            __builtin_amdgcn_fence(__ATOMIC_RELEASE, "agent");
            asm volatile("s_waitcnt vmcnt(0)" ::: "memory");
            const unsigned og = xb_add(&bar[XB_TOP], 1u);
            const unsigned tg = og / nx;
            if (og + 1u == (tg + 1u) * nx) xb_add(&bar[XB_TOPGEN], 1u);
            else XB_SPIN(xb_ld(&bar[XB_TOPGEN]) == tg, bar);
            __builtin_amdgcn_fence(__ATOMIC_ACQUIRE, "agent");
            xb_add(&bar[XB_XGEN(bx)], 1u);
            asm volatile("s_waitcnt vmcnt(0)" ::: "memory");
        } else {
            XB_SPIN(xb_ld(&bar[XB_XGEN(bx)]) == gen, bar);
            __builtin_amdgcn_fence(__ATOMIC_ACQUIRE, "agent");
            asm volatile("s_waitcnt vmcnt(0)" ::: "memory");
        }
    }
    __syncthreads();
}
constexpr int T = 16384, DM = 1024, SEQ = 2048, NBATCH = 8, DEPTH = 2, N_IN = 10432;
constexpr int NWAVES = 8;
constexpr float EPS = 1e-6f;
constexpr size_t MiB = 1u << 20;
constexpr size_t WS_CTL = 0, CTL_ZERO_BYTES = 64 * 1024;
constexpr size_t WS_WB = 1 * MiB;
constexpr size_t WB_W1T = 0;
constexpr size_t WB_W2T = WB_W1T + (size_t)4352 * 1024 * 2;
constexpr size_t WB_WQT = WB_W2T + (size_t)6144 * 1024 * 2;
constexpr size_t WB_WKVT = WB_WQT + (size_t)1536 * 384 * 2;
constexpr size_t WB_WPT = WB_WKVT + (size_t)2048 * 384 * 2;
constexpr size_t WB_WOT = WB_WPT + (size_t)1024 * 3328 * 2;
constexpr size_t WB_END = WB_WOT + (size_t)1024 * 1024 * 2;
static_assert(WB_END <= 32 * MiB, "weights region");
constexpr size_t WS_H = 33 * MiB;
constexpr size_t WS_Y = 65 * MiB;
constexpr int YLD = 3328;
constexpr size_t WS_BIG = 169 * MiB;
constexpr size_t WS_MISC = WS_BIG;
constexpr size_t WS_XC = WS_MISC + 24 * MiB;
constexpr size_t WS_Q = WS_XC + 40 * MiB;
constexpr size_t WS_VV = WS_Q + 48 * MiB;
constexpr size_t WS_KR = WS_VV + 32 * MiB;
constexpr size_t WS_V1 = WS_BIG;
constexpr size_t WS_G = WS_V1 + 32 * MiB;
constexpr size_t WS_O = WS_BIG;
constexpr size_t WS_SMALL = 315 * MiB;
constexpr size_t WS_SLAB = WS_SMALL;
constexpr size_t WS_AGG = WS_SLAB + 1536 * 1024;
constexpr size_t WS_ROPE = WS_AGG + 2560 * 1024;
constexpr size_t WS_LW = WS_ROPE + 512 * 1024;
constexpr size_t WS_GMW = WS_LW + 480 * 1024;
constexpr size_t WS_LCT = WS_GMW + 128 * 1024;
constexpr size_t WS_END = WS_LCT + 64 * 1024;
static_assert(WS_KR + 2 * MiB <= WS_SMALL && WS_G + 96 * MiB <= WS_SMALL && WS_END <= 326 * MiB, "d_ws map");
constexpr int CW_NORM = 12288;
constexpr int CW_BAR = 1024;
static_assert((CW_BAR + XCD_BAR_WORDS) * 4 <= (int)CTL_ZERO_BYTES, "ctl");
constexpr int RING_BYTES = 131072, MISC_OFF = RING_BYTES + 320, LDS_BYTES = 147456;

enum { I_X = 0, I_PRE_G, I_W_IN, I_GM_LN_G, I_GM_LN_B, I_GM_WS, I_GM_BS, I_QN_G, I_W_UQ, I_KVN_G, I_W_UKV, I_CONV_W, I_CONV_B, I_W_A, I_B_A, I_W_X, I_B_X, I_LAM,
       I_W_PA, I_W_PB, I_W_PC, I_W_OUT, I_POST_G, N_INPUTS };
struct Args { const float* in[N_INPUTS]; float* out; unsigned char* ws; int ph_lo, ph_hi, probe, pad; };

struct Frame { LAS unsigned char* lds; int wave, vcu, G; };
__device__ __forceinline__ int lane_id() { int l; asm volatile("v_mbcnt_lo_u32_b32 %0, -1, 0\n\tv_mbcnt_hi_u32_b32 %0, -1, %0" : "=v"(l)); return l; }

__device__ __forceinline__ float softplus_neg(float x) { const float e = __expf(-x);
    const float p = e * (1.f - e * (0.5f - e * (0.33333334f - e * (0.25f - e * (0.2f - e * (0.16666667f - e * (0.14285715f - e * 0.125f)))))));
    return (e < 0.2f) ? p : __logf(1.f + e); }
struct MapW1 { __device__ __forceinline__ int operator()(int j) const {
    if (j < 384) return 3072 + j; if (j < 640) return 3456 + (j - 384); if (j < 704) { const int jj = j - 640, g = jj >> 3, e = jj & 7; return 3712 + (e < 4 ? 4 * g + e : 32 + 4 * g + (e - 4)); } if (j < 768) return -1;
    if (j < 2048) return 4800 + (j - 768); if (j < 3328) return 6080 + (j - 2048); return 3776 + (j - 3328); } };
struct MapW2 { __device__ __forceinline__ int operator()(int j) const {
    if (j < 2048) { const int tl = j >> 8, lc = j & 255; return (lc < 128) ? (128 * tl + lc) : (2048 + 128 * tl + (lc - 128)); }
    if (j < 3072) return 1024 + (j - 2048); return 7360 + (j - 3072); } };
struct MapQ { __device__ __forceinline__ int operator()(int j) const {
    if (j < 1024) { const int hd = j >> 7, d = j & 127; return hd * 192 + d; }
    const int jj = j - 1024, hh = jj >> 6, w = jj & 63, g = w >> 3, e = w & 7; return hh * 192 + (e < 4 ? 128 + 4 * g + e : 160 + 4 * g + (e - 4)); } };
struct MapId { __device__ __forceinline__ int operator()(int j) const { return j; } };

template <class Map>
__device__ __forceinline__ void tr_item(const float* W, int ldw, int nkb  , bf16_t* WT, int ldt, const Map map, const float* kscale, LAS float* scr, int item, int lane) {
    const int kb = item % nkb, nb = item / nkb, k0 = 64 * kb, n0 = 32 * nb;
    const int nn = lane & 31; const int sc = map(n0 + nn);
    float wv[32];
    const float* wp = W + (size_t)(k0 + (lane >> 5)) * ldw + (sc >= 0 ? sc : 0);
#pragma unroll
    for (int i = 0; i < 32; ++i) wv[i] = (sc >= 0) ? wp[(size_t)(2 * i) * ldw] : 0.f;
#pragma unroll
    for (int i = 0; i < 32; ++i) { const int kk = 2 * i + (lane >> 5); float v = wv[i]; if (kscale) v *= kscale[k0 + kk]; scr[kk * 33 + nn] = v; }
    LDS_WAIT(); asm volatile("" ::: "memory");
    const int c = lane & 7;
#pragma unroll
    for (int j = 0; j < 4; ++j) { const int n = (lane >> 3) + 8 * j; const LAS float* s = scr + (8 * c) * 33 + n;
        u32x4 o; o.x = pk_bf16(s[0 * 33], s[1 * 33]); o.y = pk_bf16(s[2 * 33], s[3 * 33]); o.z = pk_bf16(s[4 * 33], s[5 * 33]); o.w = pk_bf16(s[6 * 33], s[7 * 33]);
        *(u32x4*)(WT + (size_t)(n0 + n) * ldt + k0 + 8 * c) = o; }
    LDS_WAIT(); asm volatile("" ::: "memory");
}

__device__ __forceinline__ void convert_weights(const Frame& F, const Args& a, unsigned char* ws, int l) {
    const int lane = lane_id();
    LAS float* scr = (LAS float*)(F.lds + F.wave * 16384);
    const int gw = F.vcu * NWAVES + F.wave, NGW = F.G * NWAVES;
    unsigned char* wb = ws + WS_WB;
    constexpr int I1 = 16 * (4352 / 32), I2 = 16 * (6144 / 32), IQ = 6 * (1536 / 32), IKV = 4 * (2048 / 32), IPA = 16 * 32, IPB = 16 * 32, IPC = 20 * 32, IO = 16 * 32;
    constexpr int NITEMS = I1 + I2 + IQ + IKV + IPA + IPB + IPC + IO;
    const float* w_in = a.in[I_W_IN] + (size_t)l * 1024 * N_IN;
    for (int it = gw; it < NITEMS; it += NGW) {
        int r = it;
        if (r < I1) { tr_item(w_in, N_IN, 16, (bf16_t*)(wb + WB_W1T), 1024, MapW1(), nullptr, scr, r, lane); continue; } r -= I1;
        if (r < I2) { tr_item(w_in, N_IN, 16, (bf16_t*)(wb + WB_W2T), 1024, MapW2(), nullptr, scr, r, lane); continue; } r -= I2;
        if (r < IQ) { tr_item(a.in[I_W_UQ] + (size_t)l * 384 * 1536, 1536, 6, (bf16_t*)(wb + WB_WQT), 384, MapQ(), a.in[I_QN_G] + l * 384, scr, r, lane); continue; } r -= IQ;
        if (r < IKV) { tr_item(a.in[I_W_UKV] + (size_t)l * 256 * 2048, 2048, 4, (bf16_t*)(wb + WB_WKVT), 384, MapId(), a.in[I_KVN_G] + l * 256, scr, r, lane); continue; } r -= IKV;
        if (r < IPA) { tr_item(a.in[I_W_PA] + (size_t)l * 1024 * 1024, 1024, 16, (bf16_t*)(wb + WB_WPT), 3328, MapId(), nullptr, scr, r, lane); continue; } r -= IPA;
        if (r < IPB) { tr_item(a.in[I_W_PB] + (size_t)l * 1024 * 1024, 1024, 16, (bf16_t*)(wb + WB_WPT) + 1024, 3328, MapId(), nullptr, scr, r, lane); continue; } r -= IPB;
        if (r < IPC) { tr_item(a.in[I_W_PC] + (size_t)l * 1280 * 1024, 1024, 20, (bf16_t*)(wb + WB_WPT) + 2048, 3328, MapId(), nullptr, scr, r, lane); continue; } r -= IPC;
        tr_item(a.in[I_W_OUT] + (size_t)l * 1024 * 1024, 1024, 16, (bf16_t*)(wb + WB_WOT), 1024, MapId(), nullptr, scr, r, lane);
    }
    const int gt = (F.vcu * NWAVES + F.wave) * 64 + lane, NGT = F.G * NWAVES * 64;
    bf16_t* lwa = (bf16_t*)(ws + WS_LW); bf16_t* lwx = lwa + 16 * 80 * 96;
    const float* w_a = a.in[I_W_A] + (size_t)l * 16 * 80 * 80; const float* w_x = a.in[I_W_X] + (size_t)l * 16 * 80 * 80;
    for (int i = gt; i < 16 * 80 * 96; i += NGT) { const int k = i % 96, j = (i / 96) % 80, blk = i / (96 * 80);
        const float va = (k < 80) ? w_a[((size_t)blk * 80 + k) * 80 + j] : 0.f, vx = (k < 80) ? w_x[((size_t)blk * 80 + k) * 80 + j] : 0.f;
        lwa[i] = f2bf(va); lwx[i] = f2bf(vx); }
    { float* lct = (float*)(ws + WS_LCT); const float* cw = a.in[I_CONV_W] + (size_t)l * 4 * 1280;
      for (int c = gt; c < 1280; c += NGT) { f32x4 v0 = {cw[c], cw[1280 + c], cw[2560 + c], cw[3840 + c]};
          f32x4 v1 = {a.in[I_CONV_B][l * 1280 + c], a.in[I_B_A][l * 1280 + c], a.in[I_B_X][l * 1280 + c], -8.f * softplus_neg(a.in[I_LAM][l * 1280 + c])};
          *(f32x4*)(lct + c * 8) = v0; *(f32x4*)(lct + c * 8 + 4) = v1; } }
    bf16_t* gmw = (bf16_t*)(ws + WS_GMW); const float* gws = a.in[I_GM_WS] + (size_t)l * 4 * 128 * 128;
    for (int i = gt; i < 4 * 128 * 128; i += NGT) { const int j = i & 127, ii = (i >> 7) & 127; gmw[i] = f2bf(((j >> 6) <= (ii >> 6)) ? gws[i] : 0.f); }
}
__device__ __forceinline__ void rope_table(const Frame& F, unsigned char* ws) {
    const int gt = (F.vcu * NWAVES + F.wave) * 64 + lane_id(), NGT = F.G * NWAVES * 64;
    float* cs = (float*)(ws + WS_ROPE); float* sn = cs + 2048 * 32;
    for (int i = gt; i < 2048 * 32; i += NGT) { const int s = i >> 5, fi = i & 31; const float inv_freq = powf(10000.f, -(float)(2 * fi) / 64.f); const float ang = (float)s * inv_freq;
        cs[i] = cosf(ang); sn[i] = sinf(ang); }
}
__device__ __forceinline__ void norm_rows(const Frame& F, const bool nostore, const float* xin, const bf16_t* o, const float* g_post, float* xout, const float* g_pre, bf16_t* h) {
    const int gw = F.vcu * NWAVES + F.wave, NGW = F.G * NWAVES; const int lane = lane_id();
    f32x4 v[4], ov[4], nv[4]; u32x2 nov[4];
    if (gw < T) {
#pragma unroll
        for (int j = 0; j < 4; ++j) { nv[j] = *((const f32x4*)(xin + (size_t)gw * DM) + lane + 64 * j); nov[j] = o ? *((const u32x2*)(o + (size_t)gw * DM) + lane + 64 * j) : (u32x2){0u, 0u}; }
    }
    for (int m = gw; m < T; m += NGW) {
#pragma unroll
        for (int j = 0; j < 4; ++j) { v[j] = nv[j]; ov[j] = (f32x4){bf_lo(nov[j].x), bf_hi(nov[j].x), bf_lo(nov[j].y), bf_hi(nov[j].y)}; }
        const int mn = m + NGW;
        if (mn < T) {
#pragma unroll
            for (int j = 0; j < 4; ++j) { nv[j] = *((const f32x4*)(xin + (size_t)mn * DM) + lane + 64 * j); if (o) nov[j] = *((const u32x2*)(o + (size_t)mn * DM) + lane + 64 * j); }
        }
        if (o) {
            float s = 0.f;
#pragma unroll
            for (int j = 0; j < 4; ++j) s += (ov[j].x * ov[j].x + ov[j].y * ov[j].y) + (ov[j].z * ov[j].z + ov[j].w * ov[j].w);
            const float r = rsqrtf(wave_sum(s) * (1.f / DM) + EPS);
            f32x4* xo = (f32x4*)(xout + (size_t)m * DM) + lane;
#pragma unroll
            for (int j = 0; j < 4; ++j) { const f32x4 gp = *((const f32x4*)g_post + lane + 64 * j); v[j] = v[j] + ov[j] * r * gp; if (!nostore) xo[64 * j] = v[j]; }
        }
        if (g_pre) {
            float s = 0.f;
#pragma unroll
            for (int j = 0; j < 4; ++j) s += (v[j].x * v[j].x + v[j].y * v[j].y) + (v[j].z * v[j].z + v[j].w * v[j].w);
            const float r = rsqrtf(wave_sum(s) * (1.f / DM) + EPS);
            u32x2* ho = (u32x2*)(h + (size_t)m * DM) + lane;
#pragma unroll
            for (int j = 0; j < 4; ++j) { const f32x4 gp = *((const f32x4*)g_pre + lane + 64 * j); const f32x4 y = v[j] * r * gp; u32x2 w; w.x = pk_bf16(y.x, y.y); w.y = pk_bf16(y.z, y.w); if (!nostore) ho[64 * j] = w; }
        }
    }
}
using g8::UnitD;
constexpr float QSCALE = 0.07216878364870322f * 1.4426950408889634f;

struct SchedA {
    g8::TileOrder ord; const char* A; const char* B;
    __device__ __forceinline__ bool next(int i, UnitD& u) const { int pm, pn; if (!ord.tile(i, pm, pn)) return false;
        u.A = A + (size_t)pm * 256 * 2048; u.B = B + (size_t)pn * 256 * 2048; u.nt = 16; u.pm = pm; u.pn = pn; u.kind = 0; return true; }
};
struct EpiA {
    bf16_t* misc; bf16_t* xc; bf16_t* y; float* slab; bf16_t* kr; const float* cs; const float* sn;
    __device__ __forceinline__ void operator()(f32x4 (&acc)[2][2][4][2], const UnitD& u, int wr, int wc, int fr, int fq) const {
        const int pn = u.pn, rowp = wr * 64 + fr, lc = wc * 32 + 8 * fq;
        bf16_t* dst; int ld; bool act;
        if (pn < 3) { dst = misc + 256 * pn; ld = 768; act = false; }
        else if (pn < 8) { dst = xc + 256 * (pn - 3); ld = 1280; act = false; }
        else if (pn < 13) { dst = y + 2048 + 256 * (pn - 8); ld = YLD; act = true; }
        else { dst = y + 1024 + 256 * (pn - 13); ld = YLD; act = true; }
#pragma unroll
        for (int ai = 0; ai < 2; ++ai)
#pragma unroll
            for (int m = 0; m < 4; ++m) { const int rp = rowp + ai * 128 + m * 16; bf16_t* p = dst + ((size_t)u.pm * 256 + rp) * ld + lc;
#pragma unroll
                for (int bj = 0; bj < 2; ++bj) { f32x4 v0 = acc[ai][bj][m][0], v1 = acc[ai][bj][m][1];
                    if (pn == 2 && bj == 1) { if (wc < 2) { const int g = 4 * wc + fq; const size_t r = (size_t)u.pm * 256 + rp; const int pos = (int)(r & 2047);
                            const f32x4 c4 = *(const f32x4*)(cs + pos * 32 + 4 * g), s4 = *(const f32x4*)(sn + pos * 32 + 4 * g);
                            const f32x4 o1 = v0 * c4 - v1 * s4, o2 = v1 * c4 + v0 * s4; bf16_t* kp = kr + r * 64 + 4 * g;
                            u32x2 w1, w2; w1.x = pk_bf16(o1.x, o1.y); w1.y = pk_bf16(o1.z, o1.w); w2.x = pk_bf16(o2.x, o2.y); w2.y = pk_bf16(o2.z, o2.w);
                            *(u32x2*)kp = w1; *(u32x2*)(kp + 32) = w2; }
                        continue; }
                    if (pn < 3) { float ss = (v0.x * v0.x + v0.y * v0.y) + (v0.z * v0.z + v0.w * v0.w) + (v1.x * v1.x + v1.y * v1.y) + (v1.z * v1.z + v1.w * v1.w);
                        ss += sx<16>(ss); ss = xsum32(ss);
                        if (fq == 0) slab[(((size_t)u.pm * 6 + pn * 2 + bj) * 4 + wc) * 256 + rp] = ss; }
                    if (act) { v0.x = fsilu(v0.x); v0.y = fsilu(v0.y); v0.z = fsilu(v0.z); v0.w = fsilu(v0.w); v1.x = fsilu(v1.x); v1.y = fsilu(v1.y); v1.z = fsilu(v1.z); v1.w = fsilu(v1.w); }
                    u32x4 w; w.x = pk_bf16(v0.x, v0.y); w.y = pk_bf16(v0.z, v0.w); w.z = pk_bf16(v1.x, v1.y); w.w = pk_bf16(v1.z, v1.w);
                    *(u32x4*)(p + bj * 128) = w; } }
    }
};

struct SchedZ {
    int v; const char* A; const char* B;
    __device__ __forceinline__ bool next(int i, UnitD& u) const { if (i > 0 || (v & 3) != 0 || v >= 256) return false; const int pm = v >> 2;
        u.A = A + (size_t)pm * 256 * 2048; u.B = B + (size_t)16 * 256 * 2048; u.nt = 16; u.pm = pm; u.pn = 16; u.kind = 0; return true; }
};
struct SchedQKV {
    int v; const char* misc; const char* wq; const char* wkv;
    __device__ __forceinline__ bool next(int i, UnitD& u) const { if (v >= 256) return false; const int role = v & 3, pm = v >> 2; int pn;
        if (role == 0) { if (i > 0) return false; pn = 0; }
        else if (role == 1) { if (i > 4) return false; pn = (i == 0) ? 1 : 5 + i; }
        else { if (i > 3) return false; pn = (i < 2) ? (2 * role - 2 + i) : (10 + 2 * (role - 2) + (i - 2)); }
        u.pm = pm; u.pn = pn; u.kind = 0;
        if (pn < 6) { u.A = misc + (size_t)pm * 256 * 1536; u.B = wq + (size_t)pn * 256 * 768; u.nt = 6; }
        else { u.A = misc + (size_t)pm * 256 * 1536 + 384 * 2; u.B = wkv + (size_t)(pn - 6) * 256 * 768; u.nt = 4; }
        return true; }
};
struct EpiQKV {
    bf16_t* q; bf16_t* y; bf16_t* vv; const float* slab; const float* cs; const float* sn;
    __device__ __forceinline__ void operator()(f32x4 (&acc)[2][2][4][2], const UnitD& u, int wr, int wc, int fr, int fq) const {
        const int pn = u.pn, rowp = wr * 64 + fr, lc = wc * 32 + 8 * fq; const bool isq = pn < 6;
#pragma unroll
        for (int ai = 0; ai < 2; ++ai)
#pragma unroll
            for (int m = 0; m < 4; ++m) { const int rp = rowp + ai * 128 + m * 16; const size_t r = (size_t)u.pm * 256 + rp;
                float s = 0.f; const float* sl = slab + (size_t)u.pm * 6 * 4 * 256 + rp;
                if (isq) {
#pragma unroll
                    for (int e = 0; e < 3; ++e) { const int j = fq * 3 + e; s += sl[(size_t)((j >> 2) * 4 + (j & 3)) * 256]; }
                } else {
#pragma unroll
                    for (int e = 0; e < 2; ++e) { const int j = fq * 2 + e; s += sl[(size_t)((3 + (j >> 2)) * 4 + (j & 3)) * 256]; }
                }
                s += sx<16>(s); s = xsum32(s);
                float rs = rsqrtf(s * (isq ? (1.f / 384.f) : (1.f / 256.f)) + EPS); if (isq) rs *= QSCALE;
#pragma unroll
                for (int bj = 0; bj < 2; ++bj) { f32x4 v0 = acc[ai][bj][m][0] * rs, v1 = acc[ai][bj][m][1] * rs;
                    if (pn < 4) { const int j0 = 256 * pn + 128 * bj + lc; bf16_t* p = q + r * 1536 + (j0 >> 7) * 192 + (j0 & 127);
                        u32x4 w; w.x = pk_bf16(v0.x, v0.y); w.y = pk_bf16(v0.z, v0.w); w.z = pk_bf16(v1.x, v1.y); w.w = pk_bf16(v1.z, v1.w); *(u32x4*)p = w; }
                    else if (pn < 6) { const int jj = 256 * (pn - 4) + 128 * bj + lc, hh = jj >> 6, g = (jj & 63) >> 3; const int pos = (int)(r & 2047);
                        const f32x4 c4 = *(const f32x4*)(cs + pos * 32 + 4 * g), s4 = *(const f32x4*)(sn + pos * 32 + 4 * g);
                        const f32x4 o1 = v0 * c4 - v1 * s4, o2 = v1 * c4 + v0 * s4; bf16_t* p = q + r * 1536 + hh * 192 + 128 + 4 * g;
                        u32x2 w1, w2; w1.x = pk_bf16(o1.x, o1.y); w1.y = pk_bf16(o1.z, o1.w); w2.x = pk_bf16(o2.x, o2.y); w2.y = pk_bf16(o2.z, o2.w);
                        *(u32x2*)p = w1; *(u32x2*)(p + 32) = w2; }
                    else { const int hd = pn - 6; bf16_t* p = (bj == 0) ? (y + r * YLD + hd * 128 + lc) : (vv + r * 1024 + hd * 128 + lc);
                        u32x4 w; w.x = pk_bf16(v0.x, v0.y); w.y = pk_bf16(v0.z, v0.w); w.z = pk_bf16(v1.x, v1.y); w.w = pk_bf16(v1.z, v1.w); *(u32x4*)p = w; } } }
    }
};

struct SchedD {
    g8::TileOrder ord; const char* A; const char* B;
    __device__ __forceinline__ bool next(int i, UnitD& u) const { int pm, pn; if (!ord.tile(i, pm, pn)) return false;
        u.A = A + (size_t)pm * 256 * 2048; u.B = B + (size_t)pn * 256 * 2048; u.nt = 16; u.pm = pm; u.pn = pn; u.kind = 0; return true; }
};
struct EpiD {
    bf16_t* y; bf16_t* v1; bf16_t* g; float* vslab;
    __device__ __forceinline__ void operator()(f32x4 (&acc)[2][2][4][2], const UnitD& u, int wr, int wc, int fr, int fq) const {
        const int pn = u.pn, rowp = wr * 64 + fr, lc = wc * 32 + 8 * fq;
#pragma unroll
        for (int ai = 0; ai < 2; ++ai)
#pragma unroll
            for (int m = 0; m < 4; ++m) { const size_t r = (size_t)u.pm * 256 + rowp + ai * 128 + m * 16;
                if (pn < 8) { const f32x4 u0 = acc[ai][0][m][0], u1 = acc[ai][0][m][1], z0 = acc[ai][1][m][0], z1 = acc[ai][1][m][1];
                    u32x4 w; w.x = pk_bf16(u0.x * fsilu(z0.x), u0.y * fsilu(z0.y)); w.y = pk_bf16(u0.z * fsilu(z0.z), u0.w * fsilu(z0.w));
                    w.z = pk_bf16(u1.x * fsilu(z1.x), u1.y * fsilu(z1.y)); w.w = pk_bf16(u1.z * fsilu(z1.z), u1.w * fsilu(z1.w));
                    *(u32x4*)(y + r * YLD + 128 * pn + lc) = w; }
                else {
#pragma unroll
                    for (int bj = 0; bj < 2; ++bj) { f32x4 v0 = acc[ai][bj][m][0], v1_ = acc[ai][bj][m][1]; bf16_t* p;
                        if (pn < 12) { p = v1 + r * 1024 + 256 * (pn - 8) + 128 * bj + lc;
                            float s1 = (v0.x + v0.y) + (v0.z + v0.w) + (v1_.x + v1_.y) + (v1_.z + v1_.w);
                            float s2 = (v0.x * v0.x + v0.y * v0.y) + (v0.z * v0.z + v0.w * v0.w) + (v1_.x * v1_.x + v1_.y * v1_.y) + (v1_.z * v1_.z + v1_.w * v1_.w);
                            s1 += sx<16>(s1); s1 = xsum32(s1); s2 += sx<16>(s2); s2 = xsum32(s2);
                            if (fq == 0) *(f32x2*)(vslab + r * 64 + (((pn - 8) * 2 + bj) * 4 + wc) * 2) = (f32x2){s1, s2}; }
                        else { p = g + r * 3072 + 256 * (pn - 12) + 128 * bj + lc;
                            v0.x = fsigmoid(v0.x); v0.y = fsigmoid(v0.y); v0.z = fsigmoid(v0.z); v0.w = fsigmoid(v0.w); v1_.x = fsigmoid(v1_.x); v1_.y = fsigmoid(v1_.y); v1_.z = fsigmoid(v1_.z); v1_.w = fsigmoid(v1_.w); }
                        u32x4 w; w.x = pk_bf16(v0.x, v0.y); w.y = pk_bf16(v0.z, v0.w); w.z = pk_bf16(v1_.x, v1_.y); w.w = pk_bf16(v1_.z, v1_.w); *(u32x4*)p = w; } } }
    }
};

struct SchedF {
    g8::TileOrder ord; const char* A; const char* B;
    __device__ __forceinline__ bool next(int i, UnitD& u) const { if (i >= 3) return false; int pm, pn; if (!ord.tile(0, pm, pn)) return false;
        const size_t ko = (i == 0) ? 0 : (i == 1 ? 1024 * 2 : 2048 * 2);
        u.A = A + (size_t)pm * 256 * (YLD * 2) + ko; u.B = B + (size_t)pn * 256 * (YLD * 2) + ko; u.nt = (i == 2) ? 20 : 16; u.pm = pm; u.pn = pn; u.kind = (i < 2) ? (i | g8::KEEP_ACC) : i; return true; }
};
struct EpiF {
    const bf16_t* g; bf16_t* merged;
    __device__ __forceinline__ void operator()(f32x4 (&acc)[2][2][4][2], const UnitD& u, int wr, int wc, int fr, int fq) const {
        const int seg = u.kind & 3, rowp = wr * 64 + fr, lc = wc * 32 + 8 * fq;
#pragma unroll
        for (int ai = 0; ai < 2; ++ai)
#pragma unroll
            for (int m = 0; m < 4; ++m) { const size_t r = (size_t)u.pm * 256 + rowp + ai * 128 + m * 16;
#pragma unroll
                for (int bj = 0; bj < 2; ++bj) { const int col = 256 * u.pn + 128 * bj + lc; const bf16_t* gp = g + r * 3072 + seg * 1024 + col;
                    const u32x4 a = *(const u32x4*)gp; f32x4 f0, f1;
                    f0.x = bf_lo(a.x); f0.y = bf_hi(a.x); f0.z = bf_lo(a.y); f0.w = bf_hi(a.y); f1.x = bf_lo(a.z); f1.y = bf_hi(a.z); f1.z = bf_lo(a.w); f1.w = bf_hi(a.w);
                    if (seg < 2) { const u32x4 b = *(const u32x4*)(gp + 1024);
                        f0.x *= __builtin_amdgcn_rcpf(bf_lo(b.x)); f0.y *= __builtin_amdgcn_rcpf(bf_hi(b.x)); f0.z *= __builtin_amdgcn_rcpf(bf_lo(b.y)); f0.w *= __builtin_amdgcn_rcpf(bf_hi(b.y));
                        f1.x *= __builtin_amdgcn_rcpf(bf_lo(b.z)); f1.y *= __builtin_amdgcn_rcpf(bf_hi(b.z)); f1.z *= __builtin_amdgcn_rcpf(bf_lo(b.w)); f1.w *= __builtin_amdgcn_rcpf(bf_hi(b.w));
                        acc[ai][bj][m][0] *= f0; acc[ai][bj][m][1] *= f1; }
                    else { const f32x4 v0 = acc[ai][bj][m][0] * f0, v1 = acc[ai][bj][m][1] * f1;
                        u32x4 w; w.x = pk_bf16(v0.x, v0.y); w.y = pk_bf16(v0.z, v0.w); w.z = pk_bf16(v1.x, v1.y); w.w = pk_bf16(v1.z, v1.w);
                        *(u32x4*)(merged + r * 1024 + col) = w; } } }
    }
};

struct SchedG1 {
    int v; const char* A; const char* B;
    __device__ __forceinline__ bool next(int i, UnitD& u) const { if (i > 0 || v >= 256) return false; const int pm = v >> 2, pn = v & 3;
        u.A = A + (size_t)pm * 256 * 2048; u.B = B + (size_t)pn * 256 * 2048; u.nt = 16; u.pm = pm; u.pn = pn; u.kind = 0; return true; }
};
struct EpiNorm {
    const float* xin; float* xout; bf16_t* h; const float* g_post; const float* g_pre;
    float* slots; unsigned* cnt;
    __device__ __forceinline__ void exchange(const f32x4 (&v)[2][2][4][2], int pm, int pn, int wr, int wc, int fr, int fq, LAS unsigned char* lds, int wid, int lane, float* sl, unsigned* cn) const {
        LAS float* P = (LAS float*)lds; LAS float* S = (LAS float*)(lds + 4096);
#pragma unroll
        for (int ai = 0; ai < 2; ++ai)
#pragma unroll
            for (int m = 0; m < 4; ++m) { float s = 0.f;
#pragma unroll
                for (int bj = 0; bj < 2; ++bj)
#pragma unroll
                    for (int n = 0; n < 2; ++n) { const f32x4 x = v[ai][bj][m][n]; s += (x.x * x.x + x.y * x.y) + (x.z * x.z + x.w * x.w); }
                s += sx<16>(s); s = xsum32(s);
                if (fq == 0) P[(ai * 128 + wr * 64 + m * 16 + fr) * 4 + wc] = s; }
        asm volatile("s_waitcnt lgkmcnt(0)" ::: "memory"); __builtin_amdgcn_s_barrier(); asm volatile("" ::: "memory");
        const int row = wid * 32 + (lane & 31);
        if (lane < 32) { const f32x4 p4 = *(const LAS f32x4*)(P + row * 4); const float tot = (p4.x + p4.y) + (p4.z + p4.w);
            __hip_atomic_store((unsigned*)sl + ((size_t)pm * 256 + row) * 4 + pn, __float_as_uint(tot), __ATOMIC_RELAXED, __HIP_MEMORY_SCOPE_AGENT); }
        asm volatile("s_waitcnt vmcnt(0)" ::: "memory");
        if (lane == 0) __hip_atomic_fetch_add(cn, 1u, __ATOMIC_RELAXED, __HIP_MEMORY_SCOPE_AGENT);
        if (wid == 0) { for (unsigned sp = 0; sp < (1u << 20); ++sp) { if ((unsigned)__builtin_amdgcn_readfirstlane(__hip_atomic_load(cn, __ATOMIC_RELAXED, __HIP_MEMORY_SCOPE_AGENT)) >= 32u) break; __builtin_amdgcn_s_sleep(2); } }
        asm volatile("s_waitcnt vmcnt(0) lgkmcnt(0)" ::: "memory"); __builtin_amdgcn_s_barrier(); asm volatile("" ::: "memory");
        if (lane < 32) { const unsigned* sp4 = (const unsigned*)sl + ((size_t)pm * 256 + row) * 4; float tot = 0.f;
#pragma unroll
            for (int t = 0; t < 4; ++t) tot += __uint_as_float(__hip_atomic_load(sp4 + t, __ATOMIC_RELAXED, __HIP_MEMORY_SCOPE_AGENT));
            S[row] = rsqrtf(tot * (1.f / 1024.f) + EPS); }
        asm volatile("s_waitcnt lgkmcnt(0)" ::: "memory"); __builtin_amdgcn_s_barrier(); asm volatile("" ::: "memory");
    }
    __device__ __forceinline__ void fused(f32x4 (&acc)[2][2][4][2], const UnitD& u, int wr, int wc, int fr, int fq, LAS unsigned char* lds, int wid, int lane) const {
        const LAS float* S = (const LAS float*)(lds + 4096);
        const int lc = wc * 32 + 8 * fq, col0 = 256 * u.pn + lc;
        exchange(acc, u.pm, u.pn, wr, wc, fr, fq, lds, wid, lane, slots, cnt + u.pm * 16);
#pragma unroll
        for (int ai = 0; ai < 2; ++ai)
#pragma unroll
            for (int m = 0; m < 4; ++m) { const int r = ai * 128 + wr * 64 + m * 16 + fr; const float rs = S[r]; const size_t off = ((size_t)u.pm * 256 + r) * 1024 + col0;
#pragma unroll
                for (int bj = 0; bj < 2; ++bj) { const f32x4 x0 = *(const f32x4*)(xin + off + bj * 128), x1 = *(const f32x4*)(xin + off + bj * 128 + 4);
                    const f32x4 g0 = *(const f32x4*)(g_post + col0 + bj * 128), g1 = *(const f32x4*)(g_post + col0 + bj * 128 + 4);
                    const f32x4 y0 = x0 + acc[ai][bj][m][0] * rs * g0, y1 = x1 + acc[ai][bj][m][1] * rs * g1;
                    acc[ai][bj][m][0] = y0; acc[ai][bj][m][1] = y1;
                    *(f32x4*)(xout + off + bj * 128) = y0; *(f32x4*)(xout + off + bj * 128 + 4) = y1; }
                if (m & 1) asm volatile("" ::: "memory"); }
        if (g_pre) {
            exchange(acc, u.pm, u.pn, wr, wc, fr, fq, lds, wid, lane, slots + (size_t)T * 4, cnt + 64 * 16 + u.pm * 16);
#pragma unroll
            for (int ai = 0; ai < 2; ++ai)
#pragma unroll
                for (int m = 0; m < 4; ++m) { const int r = ai * 128 + wr * 64 + m * 16 + fr; const float rs = S[r]; const size_t off = ((size_t)u.pm * 256 + r) * 1024 + col0;
#pragma unroll
                    for (int bj = 0; bj < 2; ++bj) { const f32x4 g0 = *(const f32x4*)(g_pre + col0 + bj * 128), g1 = *(const f32x4*)(g_pre + col0 + bj * 128 + 4);
                        const f32x4 y0 = acc[ai][bj][m][0] * rs * g0, y1 = acc[ai][bj][m][1] * rs * g1;
                        u32x4 w; w.x = pk_bf16(y0.x, y0.y); w.y = pk_bf16(y0.z, y0.w); w.z = pk_bf16(y1.x, y1.y); w.w = pk_bf16(y1.z, y1.w);
                        *(u32x4*)(h + off + bj * 128) = w; } }
        }
    }
    __device__ __forceinline__ void operator()(f32x4 (&)[2][2][4][2], const UnitD&, int, int, int, int) const {}
};
typedef float f32x2v __attribute__((ext_vector_type(2)));

constexpr int LRU_HIN_OFF = RING_BYTES + 1024;
template <int PASS>
__device__ __forceinline__ void lru_item(const Frame& F, const Args& a, const unsigned char* ws, const bool nostore, int l, int item, const bf16_t* xcb, bf16_t* y, float* agg) {
    const int b = item >> 5, k = item & 31; const size_t r0 = (size_t)b * SEQ + (size_t)k * 64;
    int lane_ = lane_id(); asm volatile("" : "+v"(lane_));
    const int lane = lane_, cl = lane & 15, kg = lane >> 4;
    LAS unsigned char* xt = F.lds + F.wave * 16384;
    const bf16_t* lwa = (const bf16_t*)(ws + WS_LW); const bf16_t* lwx = lwa + 16 * 80 * 96;
    const float* lct = (const float*)(ws + WS_LCT);
    LAS float* hin_l = (LAS float*)(F.lds + LRU_HIN_OFF);
    if (PASS == 2) {
        for (int c = F.wave * 64 + lane; c < 1280; c += 512) { const float* ag = agg + ((size_t)b * 32 * 1280 + c) * 2; float h = 0.f;
#pragma unroll 8
            for (int j = 0; j < k; ++j) { const f32x2v ab = *(const f32x2v*)(ag + (size_t)j * 2560); h = ab.x * h + ab.y; }
            hin_l[c] = h; }
        LDS_WAIT(); __syncthreads();
    }
#pragma unroll 1
    for (int bi = 0; bi < 2; ++bi) {
        const int blk = 2 * F.wave + bi;
        {
            u32x4 xch[11]; int ln = lane; asm volatile("" : "+v"(ln));
            const bf16_t* xbase = xcb + (r0 - 3) * 1280 + blk * 80;
#pragma unroll
            for (int i = 0; i < 11; ++i) { const int idx = ln + 64 * i; const int row = idx / 10, ch = idx - row * 10; xch[i] = (u32x4){0u, 0u, 0u, 0u};
                if (idx < 670 && !(k == 0 && row < 3)) xch[i] = *(const u32x4*)(xbase + (unsigned)(row * 1280 + ch * 8)); }
#pragma unroll
            for (int i = 0; i < 11; ++i) { const int idx = ln + 64 * i; const int row = idx / 10, ch = idx - row * 10; if (idx < 670) *(LAS u32x4*)(xt + row * 208 + ch * 16) = xch[i]; }
            LAS u32x4* z = (LAS u32x4*)(xt + (lane + 3) * 208 + 160); z[0] = (u32x4){0u, 0u, 0u, 0u}; z[1] = (u32x4){0u, 0u, 0u, 0u};
        }
        LDS_WAIT(); asm volatile("" ::: "memory");
#pragma unroll
        for (int ct = 0; ct < 5; ++ct) { const int c = blk * 80 + 16 * ct + cl; const f32x4 cw = *(const f32x4*)(lct + c * 8); const float cb = lct[c * 8 + 4];
            float xv[4][7];
#pragma unroll
            for (int rt = 0; rt < 4; ++rt)
#pragma unroll
                for (int j = 0; j < 7; ++j) xv[rt][j] = bf1(*(const LAS bf16_t*)(xt + (16 * rt + 4 * kg + j) * 208 + (16 * ct + cl) * 2));
            asm volatile("" ::: "memory");
#pragma unroll
            for (int rt = 0; rt < 4; ++rt)
#pragma unroll
                for (int e = 0; e < 4; ++e) { const float v = cb + cw.x * xv[rt][e] + cw.y * xv[rt][e + 1] + cw.z * xv[rt][e + 2] + cw.w * xv[rt][e + 3];
                    *(LAS bf16_t*)(xt + (16 * rt + 4 * kg + e + 3) * 208 + (16 * ct + cl) * 2) = f2bf(v); }
            asm volatile("" ::: "memory"); }
        LDS_WAIT(); asm volatile("" ::: "memory");
        bf16x8 af[4][3];
#pragma unroll
        for (int rt = 0; rt < 4; ++rt)
#pragma unroll
            for (int ks = 0; ks < 3; ++ks) af[rt][ks] = *(const LAS bf16x8*)(xt + (16 * rt + cl + 3) * 208 + (32 * ks + 8 * kg) * 2);
        bf16x8 wA[2][3], wX[2][3];
#pragma unroll
        for (int ks = 0; ks < 3; ++ks) { const size_t wo = ((size_t)blk * 80 + cl) * 96 + 32 * ks + 8 * kg; wA[0][ks] = *(const bf16x8*)(lwa + wo); wX[0][ks] = *(const bf16x8*)(lwx + wo); }
#pragma unroll
        for (int ct = 0; ct < 5; ++ct) { const int c = blk * 80 + 16 * ct + cl; const int cur = ct & 1;
            if (ct + 1 < 5) {
#pragma unroll
                for (int ks = 0; ks < 3; ++ks) { const size_t wo = ((size_t)blk * 80 + 16 * (ct + 1) + cl) * 96 + 32 * ks + 8 * kg; wA[cur ^ 1][ks] = *(const bf16x8*)(lwa + wo); wX[cur ^ 1][ks] = *(const bf16x8*)(lwx + wo); } }
            const f32x4 c1 = *(const f32x4*)(lct + c * 8 + 4); const float ba_c = c1.y, bx_c = c1.z, sp8 = c1.w;
            f32x4 ra[4], rx[4];
#pragma unroll
            for (int rt = 0; rt < 4; ++rt) { ra[rt] = (f32x4){0.f, 0.f, 0.f, 0.f}; rx[rt] = (f32x4){0.f, 0.f, 0.f, 0.f}; }
#pragma unroll
            for (int ks = 0; ks < 3; ++ks)
#pragma unroll
                for (int rt = 0; rt < 4; ++rt) { ra[rt] = __builtin_amdgcn_mfma_f32_16x16x32_bf16(af[rt][ks], wA[cur][ks], ra[rt], 0, 0, 0); rx[rt] = __builtin_amdgcn_mfma_f32_16x16x32_bf16(af[rt][ks], wX[cur][ks], rx[rt], 0, 0, 0); }
            float hin = (PASS == 2) ? hin_l[c] : 0.f; float totA = 1.f, totB = 0.f;
#pragma unroll
            for (int rt = 0; rt < 4; ++rt) { float av[4], bv[4];
#pragma unroll
                for (int e = 0; e < 4; ++e) { const float r = fsigmoid(ra[rt][e] + ba_c), ig = fsigmoid(rx[rt][e] + bx_c);
                    const float aa = __expf(sp8 * r); const float mult = sqrtf(fmaxf(1.f - aa * aa, 0.f));
                    const float xcv = bf1(*(const LAS bf16_t*)(xt + (16 * rt + 4 * kg + e + 3) * 208 + (16 * ct + cl) * 2));
                    av[e] = aa; bv[e] = mult * ig * xcv; }
                float sA = av[0], sB = bv[0];
#pragma unroll
                for (int e = 1; e < 4; ++e) { sB = av[e] * sB + bv[e]; sA *= av[e]; }
                float iA = sA, iB = sB;
                { const float pA = __shfl(iA, lane - 16), pB = __shfl(iB, lane - 16); if (kg >= 1) { iB = iA * pB + iB; iA = iA * pA; } }
                { const float pA = __shfl(iA, lane - 32), pB = __shfl(iB, lane - 32); if (kg >= 2) { iB = iA * pB + iB; iA = iA * pA; } }
                const float tA = __shfl(iA, 48 + cl), tB = __shfl(iB, 48 + cl);
                if (PASS == 1) { totB = tA * totB + tB; totA *= tA; }
                else {
                    float eA = __shfl(iA, lane - 16), eB = __shfl(iB, lane - 16); if (kg == 0) { eA = 1.f; eB = 0.f; }
                    float h = eA * hin + eB;
#pragma unroll
                    for (int e = 0; e < 4; ++e) { h = av[e] * h + bv[e]; *(LAS bf16_t*)(xt + (16 * rt + 4 * kg + e + 3) * 208 + (16 * ct + cl) * 2) = f2bf(h); }
                    hin = tA * hin + tB;
                }
            }
            if (PASS == 1) { if (kg == 0) *(f32x2v*)(agg + (((size_t)b * 32 + k) * 1280 + c) * 2) = (f32x2v){totA, totB}; }
        }
        LDS_WAIT(); asm volatile("" ::: "memory");
        if (PASS == 2) {
            int ln = lane; asm volatile("" : "+v"(ln));
            bf16_t* ybase = y + r0 * YLD + 2048 + blk * 80; u32x4 zc[10];
#pragma unroll
            for (int i = 0; i < 10; ++i) { const int idx = ln + 64 * i; const int row = idx / 10, ch = idx - row * 10; zc[i] = *(const u32x4*)(ybase + (unsigned)(row * YLD + ch * 8)); }
#pragma unroll
            for (int i = 0; i < 10; ++i) { const int idx = ln + 64 * i; const int row = idx / 10, ch = idx - row * 10; const u32x4 hv = *(const LAS u32x4*)(xt + (row + 3) * 208 + ch * 16); u32x4 o;
                o.x = pk_bf16(bf_lo(hv.x) * bf_lo(zc[i].x), bf_hi(hv.x) * bf_hi(zc[i].x)); o.y = pk_bf16(bf_lo(hv.y) * bf_lo(zc[i].y), bf_hi(hv.y) * bf_hi(zc[i].y));
                o.z = pk_bf16(bf_lo(hv.z) * bf_lo(zc[i].z), bf_hi(hv.z) * bf_hi(zc[i].z)); o.w = pk_bf16(bf_lo(hv.w) * bf_lo(zc[i].w), bf_hi(hv.w) * bf_hi(zc[i].w));
                if (!nostore) *(u32x4*)(ybase + (unsigned)(row * YLD + ch * 8)) = o; }
            LDS_WAIT(); asm volatile("" ::: "memory");
        }
    }
    if (PASS == 2) __syncthreads();
}

constexpr int CW_LRUF = 8192;
__device__ __forceinline__ void lru_single(const Frame& F, const unsigned char* ws, unsigned* ctl, const bool nostore, int l, int item, const bf16_t* xcb, bf16_t* y, float* agg) {
    const int b = item >> 5, k = item & 31; const size_t r0 = (size_t)b * SEQ + (size_t)k * 64;
    int lane_ = lane_id(); asm volatile("" : "+v"(lane_));
    const int lane = lane_, cl = lane & 15, kg = lane >> 4;
    LAS unsigned char* xt = F.lds + F.wave * 16384;
    const bf16_t* lwa = (const bf16_t*)(ws + WS_LW); const bf16_t* lwx = lwa + 16 * 80 * 96;
    const float* lct = (const float*)(ws + WS_LCT);
    const unsigned epoch = (unsigned)l + 1u;
    unsigned* flags = ctl + CW_LRUF + b * 32 * 16;
    unsigned long long* agg64 = (unsigned long long*)agg;
#pragma unroll 1
    for (int bi = 0; bi < 2; ++bi) {
        const int blk = 2 * F.wave + bi;
        {
            u32x4 xch[11]; int ln = lane; asm volatile("" : "+v"(ln));
            const bf16_t* xbase = xcb + (r0 - 3) * 1280 + blk * 80;
#pragma unroll
            for (int i = 0; i < 11; ++i) { const int idx = ln + 64 * i; const int row = idx / 10, ch = idx - row * 10; xch[i] = (u32x4){0u, 0u, 0u, 0u};
                if (idx < 670 && !(k == 0 && row < 3)) xch[i] = *(const u32x4*)(xbase + (unsigned)(row * 1280 + ch * 8)); }
#pragma unroll
            for (int i = 0; i < 11; ++i) { const int idx = ln + 64 * i; const int row = idx / 10, ch = idx - row * 10; if (idx < 670) *(LAS u32x4*)(xt + row * 208 + ch * 16) = xch[i]; }
            LAS u32x4* z = (LAS u32x4*)(xt + (lane + 3) * 208 + 160); z[0] = (u32x4){0u, 0u, 0u, 0u}; z[1] = (u32x4){0u, 0u, 0u, 0u};
        }
        LDS_WAIT(); asm volatile("" ::: "memory");
#pragma unroll
        for (int ct = 0; ct < 5; ++ct) { const int c = blk * 80 + 16 * ct + cl; const f32x4 cw = *(const f32x4*)(lct + c * 8); const float cb = lct[c * 8 + 4];
            float xv[4][7];
#pragma unroll
            for (int rt = 0; rt < 4; ++rt)
#pragma unroll
                for (int j = 0; j < 7; ++j) xv[rt][j] = bf1(*(const LAS bf16_t*)(xt + (16 * rt + 4 * kg + j) * 208 + (16 * ct + cl) * 2));
            asm volatile("" ::: "memory");
#pragma unroll
            for (int rt = 0; rt < 4; ++rt)
#pragma unroll
                for (int e = 0; e < 4; ++e) { const float v = cb + cw.x * xv[rt][e] + cw.y * xv[rt][e + 1] + cw.z * xv[rt][e + 2] + cw.w * xv[rt][e + 3];
                    *(LAS bf16_t*)(xt + (16 * rt + 4 * kg + e + 3) * 208 + (16 * ct + cl) * 2) = f2bf(v); }
            asm volatile("" ::: "memory"); }
        LDS_WAIT(); asm volatile("" ::: "memory");
        bf16x8 af[4][3];
#pragma unroll
        for (int rt = 0; rt < 4; ++rt)
#pragma unroll
            for (int ks = 0; ks < 3; ++ks) af[rt][ks] = *(const LAS bf16x8*)(xt + (16 * rt + cl + 3) * 208 + (32 * ks + 8 * kg) * 2);
        bf16x8 wA[3], wX[3];
#pragma unroll
        for (int ks = 0; ks < 3; ++ks) { const size_t wo = ((size_t)blk * 80 + cl) * 96 + 32 * ks + 8 * kg; wA[ks] = *(const bf16x8*)(lwa + wo); wX[ks] = *(const bf16x8*)(lwx + wo); }
        unsigned pk[5][4][2];
#pragma unroll
        for (int ct = 0; ct < 5; ++ct) { const int c = blk * 80 + 16 * ct + cl;
            const f32x4 c1 = *(const f32x4*)(lct + c * 8 + 4); const float ba_c = c1.y, bx_c = c1.z, sp8 = c1.w;
            f32x4 ra[4], rx[4];
#pragma unroll
            for (int rt = 0; rt < 4; ++rt) { ra[rt] = (f32x4){0.f, 0.f, 0.f, 0.f}; rx[rt] = (f32x4){0.f, 0.f, 0.f, 0.f}; }
#pragma unroll
            for (int ks = 0; ks < 3; ++ks)
#pragma unroll
                for (int rt = 0; rt < 4; ++rt) { ra[rt] = __builtin_amdgcn_mfma_f32_16x16x32_bf16(af[rt][ks], wA[ks], ra[rt], 0, 0, 0); rx[rt] = __builtin_amdgcn_mfma_f32_16x16x32_bf16(af[rt][ks], wX[ks], rx[rt], 0, 0, 0); }
            if (ct + 1 < 5) {
#pragma unroll
                for (int ks = 0; ks < 3; ++ks) { const size_t wo = ((size_t)blk * 80 + 16 * (ct + 1) + cl) * 96 + 32 * ks + 8 * kg; wA[ks] = *(const bf16x8*)(lwa + wo); wX[ks] = *(const bf16x8*)(lwx + wo); } }
            float av[4][4], bv[4][4], iA[4], iB[4];
#pragma unroll
            for (int rt = 0; rt < 4; ++rt) {
#pragma unroll
                for (int e = 0; e < 4; ++e) { const float r = fsigmoid(ra[rt][e] + ba_c), ig = fsigmoid(rx[rt][e] + bx_c);
                    const float aa = __expf(sp8 * r); const float mult = sqrtf(fmaxf(1.f - aa * aa, 0.f));
                    const float xcv = bf1(*(const LAS bf16_t*)(xt + (16 * rt + 4 * kg + e + 3) * 208 + (16 * ct + cl) * 2));
                    av[rt][e] = aa; bv[rt][e] = mult * ig * xcv; }
                float sA = av[rt][0], sB = bv[rt][0];
#pragma unroll
                for (int e = 1; e < 4; ++e) { sB = av[rt][e] * sB + bv[rt][e]; sA *= av[rt][e]; }
                iA[rt] = sA; iB[rt] = sB; }
            { float pA[4], pB[4];
#pragma unroll
              for (int rt = 0; rt < 4; ++rt) { pA[rt] = __shfl(iA[rt], lane - 16); pB[rt] = __shfl(iB[rt], lane - 16); }
#pragma unroll
              for (int rt = 0; rt < 4; ++rt) if (kg >= 1) { iB[rt] = iA[rt] * pB[rt] + iB[rt]; iA[rt] = iA[rt] * pA[rt]; }
#pragma unroll
              for (int rt = 0; rt < 4; ++rt) { pA[rt] = __shfl(iA[rt], lane - 32); pB[rt] = __shfl(iB[rt], lane - 32); }
#pragma unroll
              for (int rt = 0; rt < 4; ++rt) if (kg >= 2) { iB[rt] = iA[rt] * pB[rt] + iB[rt]; iA[rt] = iA[rt] * pA[rt]; } }
            float tA[4], tB[4], eA[4], eB[4];
#pragma unroll
            for (int rt = 0; rt < 4; ++rt) { tA[rt] = __shfl(iA[rt], 48 + cl); tB[rt] = __shfl(iB[rt], 48 + cl); eA[rt] = __shfl(iA[rt], lane - 16); eB[rt] = __shfl(iB[rt], lane - 16); }
            float hl = 0.f, pl = 1.f;
#pragma unroll
            for (int rt = 0; rt < 4; ++rt) { if (kg == 0) { eA[rt] = 1.f; eB[rt] = 0.f; }
                float h = eA[rt] * hl + eB[rt], pp = eA[rt] * pl, P[4];
#pragma unroll
                for (int e = 0; e < 4; ++e) { h = av[rt][e] * h + bv[rt][e]; pp *= av[rt][e]; P[e] = pp;
                    *(LAS bf16_t*)(xt + (16 * rt + 4 * kg + e + 3) * 208 + (16 * ct + cl) * 2) = f2bf(h); }
                pk[ct][rt][0] = pk_bf16(P[0], P[1]); pk[ct][rt][1] = pk_bf16(P[2], P[3]);
                hl = tA[rt] * hl + tB[rt]; pl *= tA[rt];
            }
            if (kg == 0) __hip_atomic_store(agg64 + ((size_t)b * 32 + k) * 1280 + c, ((unsigned long long)__float_as_uint(hl) << 32) | (unsigned long long)__float_as_uint(pl), __ATOMIC_RELAXED, __HIP_MEMORY_SCOPE_AGENT);
        }
        asm volatile("s_waitcnt vmcnt(0)" ::: "memory");
        if (lane == 0) __hip_atomic_store(flags + k * 16 + blk, epoch, __ATOMIC_RELAXED, __HIP_MEMORY_SCOPE_AGENT);
        if (k > 0) {
            for (unsigned spins = 0; spins < (1u << 20); ++spins) {
                const unsigned f = (lane < k) ? __hip_atomic_load(flags + lane * 16 + blk, __ATOMIC_RELAXED, __HIP_MEMORY_SCOPE_AGENT) : epoch;
                if (__all(f == epoch)) break;
                __builtin_amdgcn_s_sleep(2);
            }
            float fa[5], fb[5];
#pragma unroll
            for (int ct = 0; ct < 5; ++ct) { fa[ct] = 1.f; fb[ct] = 0.f; }
            const int j0 = (k * kg) >> 2, j1 = (k * (kg + 1)) >> 2;
            const unsigned long long* ag0 = agg64 + (size_t)b * 32 * 1280 + blk * 80 + cl;
#pragma unroll 2
            for (int j = j0; j < j1; ++j) {
                unsigned long long w[5];
#pragma unroll
                for (int ct = 0; ct < 5; ++ct) w[ct] = __hip_atomic_load(ag0 + (size_t)j * 1280 + 16 * ct, __ATOMIC_RELAXED, __HIP_MEMORY_SCOPE_AGENT);
#pragma unroll
                for (int ct = 0; ct < 5; ++ct) { const float A = __uint_as_float((unsigned)w[ct]), B = __uint_as_float((unsigned)(w[ct] >> 32)); fb[ct] = A * fb[ct] + B; fa[ct] *= A; } }
#pragma unroll
            for (int ct = 0; ct < 5; ++ct) { float iA = fa[ct], iB = fb[ct];
                { const float pA = __shfl(iA, lane - 16), pB = __shfl(iB, lane - 16); if (kg >= 1) { iB = iA * pB + iB; iA = iA * pA; } }
                { const float pA = __shfl(iA, lane - 32), pB = __shfl(iB, lane - 32); if (kg >= 2) { iB = iA * pB + iB; iA = iA * pA; } }
                const float cin = __shfl(iB, 48 + cl);
#pragma unroll
                for (int rt = 0; rt < 4; ++rt) { const float P[4] = {bf_lo(pk[ct][rt][0]), bf_hi(pk[ct][rt][0]), bf_lo(pk[ct][rt][1]), bf_hi(pk[ct][rt][1])};
#pragma unroll
                    for (int e = 0; e < 4; ++e) { LAS bf16_t* hp = (LAS bf16_t*)(xt + (16 * rt + 4 * kg + e + 3) * 208 + (16 * ct + cl) * 2); *hp = f2bf(bf1(*hp) + P[e] * cin); } } }
        }
        LDS_WAIT(); asm volatile("" ::: "memory");
        {
            int ln = lane; asm volatile("" : "+v"(ln));
            bf16_t* ybase = y + r0 * YLD + 2048 + blk * 80; u32x4 zc[10];
#pragma unroll
            for (int i = 0; i < 10; ++i) { const int idx = ln + 64 * i; const int row = idx / 10, ch = idx - row * 10; zc[i] = *(const u32x4*)(ybase + (unsigned)(row * YLD + ch * 8)); }
#pragma unroll
            for (int i = 0; i < 10; ++i) { const int idx = ln + 64 * i; const int row = idx / 10, ch = idx - row * 10; const u32x4 hv = *(const LAS u32x4*)(xt + (row + 3) * 208 + ch * 16); u32x4 o;
                o.x = pk_bf16(bf_lo(hv.x) * bf_lo(zc[i].x), bf_hi(hv.x) * bf_hi(zc[i].x)); o.y = pk_bf16(bf_lo(hv.y) * bf_lo(zc[i].y), bf_hi(hv.y) * bf_hi(zc[i].y));
                o.z = pk_bf16(bf_lo(hv.z) * bf_lo(zc[i].z), bf_hi(hv.z) * bf_hi(zc[i].z)); o.w = pk_bf16(bf_lo(hv.w) * bf_lo(zc[i].w), bf_hi(hv.w) * bf_hi(zc[i].w));
                if (!nostore) *(u32x4*)(ybase + (unsigned)(row * YLD + ch * 8)) = o; }
            LDS_WAIT(); asm volatile("" ::: "memory");
        }
    }
}
__device__ __forceinline__ void phaseB_lru(const Frame& F, const unsigned char* ws, unsigned* ctl, const bool nostore, int l, const bf16_t* xc, bf16_t* y, float* agg) {
    for (int item = F.vcu; item < NBATCH * 32; item += F.G) lru_single(F, ws, ctl, nostore, l, item, xc, y, agg);
}

__device__ __forceinline__ void phaseB_extra(const Frame& F, const Args& a, const unsigned char* ws, int l, const bf16_t* misc, bf16_t* kr, const bf16_t* xc, float* agg, const float* cs, const float* sn) {
    for (int item = F.vcu; item < NBATCH * 32; item += F.G) lru_item<1>(F, a, ws, false, l, item, xc, nullptr, agg);
}

namespace att {
constexpr int SHM_V = 64 * 128 * 2, SHM_K = 64 * 192 * 2, OFF_K = 2 * SHM_V, OFF_WS = OFF_K + 2 * SHM_K, LDS_TOTAL = OFF_WS + 8 * 64 * 4;
constexpr float THR = 8.f;
constexpr float NEGBIG = -1e30f;
constexpr int KVBLK_ = 64;
#define ATT_SBAR() __builtin_amdgcn_sched_barrier(0)
__device__ __forceinline__ int crow(int r, int hi) { return (r & 3) + 8 * (r >> 2) + 4 * hi; }
__device__ __forceinline__ int koff(int row, int sub, int chunk) { return sub * 8192 + row * 128 + ((chunk ^ ((row >> 1) & 7)) << 4); }
__device__ __forceinline__ void partialSM(f32x16& p0, f32x16& p1, float& m_reg, float& alpha) {
    float pmax = p0[0];
#pragma unroll
    for (int r = 1; r < 16; ++r) pmax = fmaxf(pmax, p0[r]);
#pragma unroll
    for (int r = 0; r < 16; ++r) pmax = fmaxf(pmax, p1[r]);
    { auto rr = __builtin_amdgcn_permlane32_swap(__float_as_uint(pmax), __float_as_uint(pmax), false, false); pmax = fmaxf(__uint_as_float(rr[0]), __uint_as_float(rr[1])); }
    float mn;
    if (__builtin_expect(__all(pmax - m_reg <= THR), 1)) { mn = m_reg; alpha = 1.f; }
    else { mn = fmaxf(m_reg, pmax); alpha = __builtin_amdgcn_exp2f(m_reg - mn); m_reg = mn; }
#pragma unroll
    for (int r = 0; r < 16; ++r) p0[r] = __builtin_amdgcn_exp2f(p0[r] - mn);
#pragma unroll
    for (int r = 0; r < 16; ++r) p1[r] = p1[r] - mn;
}
__device__ __forceinline__ void finishSM(f32x16& p0, f32x16& p1, float alpha, float& l_reg, bf16x8& pa0, bf16x8& pa1, bf16x8& pa2, bf16x8& pa3) {
#pragma unroll
    for (int r = 0; r < 16; ++r) p1[r] = __builtin_amdgcn_exp2f(p1[r]);
    float ps = 0.f;
#pragma unroll
    for (int r = 0; r < 16; ++r) ps += p0[r];
#pragma unroll
    for (int r = 0; r < 16; ++r) ps += p1[r];
    { auto rr = __builtin_amdgcn_permlane32_swap(__float_as_uint(ps), __float_as_uint(ps), false, false); ps = __uint_as_float(rr[0]) + __uint_as_float(rr[1]); }
    l_reg = l_reg * alpha + ps;
#define ATT_PK4(P, BASE, OUT) do { unsigned a0 = pk_bf16(P[BASE + 0], P[BASE + 1]), a1 = pk_bf16(P[BASE + 2], P[BASE + 3]);   \
    unsigned b0 = pk_bf16(P[BASE + 4], P[BASE + 5]), b1 = pk_bf16(P[BASE + 6], P[BASE + 7]);                              \
    auto r0 = __builtin_amdgcn_permlane32_swap(a0, b0, false, false); auto r1 = __builtin_amdgcn_permlane32_swap(a1, b1, false, false); \
    u32x4 w = {r0[0], r1[0], r0[1], r1[1]}; OUT = __builtin_bit_cast(bf16x8, w); } while (0)
    ATT_PK4(p0, 0, pa0); ATT_PK4(p0, 8, pa1); ATT_PK4(p1, 0, pa2); ATT_PK4(p1, 8, pa3);
#undef ATT_PK4
}
__device__ __forceinline__ void qkt(f32x16& p0, f32x16& p1, const LAS unsigned char* Ks, const bf16x8* qr, int r32, int hi) {
    p0 = f32x16{}; p1 = f32x16{};
#pragma unroll
    for (int d0 = 0; d0 < 12; ++d0) { const int sub = d0 >> 2, chunk = (d0 & 3) * 2 + hi;
        const bf16x8 b0 = *(const LAS bf16x8*)(Ks + koff(r32, sub, chunk));
        const bf16x8 b1 = *(const LAS bf16x8*)(Ks + koff(32 + r32, sub, chunk));
        p0 = __builtin_amdgcn_mfma_f32_32x32x16_bf16(b0, qr[d0], p0, 0, 0, 0);
        p1 = __builtin_amdgcn_mfma_f32_32x32x16_bf16(b1, qr[d0], p1, 0, 0, 0);
        if ((d0 & 3) == 3) ATT_SBAR(); }
}
__device__ __forceinline__ int v_st(int k, int c) { const int kk = (k & ~0xC) | ((k & 4) << 1) | ((k & 8) >> 1); return ((kk >> 3) * 4 + (c >> 5)) * 512 + ((kk & 7) * 32 + (c & 31)) * 2; }
__device__ __forceinline__ int v_rd_base(int lane) { return ((lane & 3) << 3) | (((lane >> 2) & 3) << 6) | (((lane >> 4) & 1) << 5) | (((lane >> 5) & 1) << 8); }
constexpr int v_rd_off(int d0, int ks, int half) { return d0 * 512 + ks * 4096 + half * 2048; }
template <int OFF> __device__ __forceinline__ s16x4 tr_read(int vb) { s16x4 r; asm volatile("ds_read_b64_tr_b16 %0, %1 offset:%2" : "=&v"(r) : "v"(vb), "i"(OFF) : "memory"); return r; }
template <int D0> __device__ __forceinline__ void pv_one(f32x16& od, int vb, bf16x8 pa0, bf16x8 pa1, bf16x8 pa2, bf16x8 pa3) {
    const s16x4 l0 = tr_read<v_rd_off(D0, 0, 0)>(vb), h0 = tr_read<v_rd_off(D0, 0, 1)>(vb), l1 = tr_read<v_rd_off(D0, 1, 0)>(vb), h1 = tr_read<v_rd_off(D0, 1, 1)>(vb);
    const s16x4 l2 = tr_read<v_rd_off(D0, 2, 0)>(vb), h2 = tr_read<v_rd_off(D0, 2, 1)>(vb), l3 = tr_read<v_rd_off(D0, 3, 0)>(vb), h3 = tr_read<v_rd_off(D0, 3, 1)>(vb);
    asm volatile("s_waitcnt lgkmcnt(0)" ::: "memory"); ATT_SBAR();
#define ATT_PK(L, H) (bf16x8){L[0], L[1], L[2], L[3], H[0], H[1], H[2], H[3]}
    od = __builtin_amdgcn_mfma_f32_32x32x16_bf16(pa0, ATT_PK(l0, h0), od, 0, 0, 0);
    od = __builtin_amdgcn_mfma_f32_32x32x16_bf16(pa1, ATT_PK(l1, h1), od, 0, 0, 0);
    od = __builtin_amdgcn_mfma_f32_32x32x16_bf16(pa2, ATT_PK(l2, h2), od, 0, 0, 0);
    od = __builtin_amdgcn_mfma_f32_32x32x16_bf16(pa3, ATT_PK(l3, h3), od, 0, 0, 0);
#undef ATT_PK
}
__device__ __forceinline__ void pv_d0(f32x16* o, int vb, bf16x8 pa0, bf16x8 pa1, bf16x8 pa2, bf16x8 pa3) {
    pv_one<0>(o[0], vb, pa0, pa1, pa2, pa3); pv_one<1>(o[1], vb, pa0, pa1, pa2, pa3); pv_one<2>(o[2], vb, pa0, pa1, pa2, pa3); pv_one<3>(o[3], vb, pa0, pa1, pa2, pa3);
}

__device__ __forceinline__ void unit(const Frame& F, const bool nostore, int b, int hd, int qb, const bf16_t* __restrict__ Q, bf16_t* Y, const bf16_t* __restrict__ VV, const bf16_t* __restrict__ KR) {
    int tid_ = F.wave * 64 + lane_id(); asm volatile("" : "+v"(tid_));
    const int tid = tid_, wid = F.wave, lane = tid & 63, r32 = lane & 31, hi = lane >> 5;
    LAS unsigned char* lds = F.lds;
    LAS unsigned char* V_lds = lds; LAS unsigned char* K_lds = lds + OFF_K;
    LAS float* wsf = (LAS float*)(lds + OFF_WS) + wid * 64; LAS float* li_l = wsf; LAS float* al_l = wsf + 32;
    const size_t rowbase = (size_t)b * SEQ; const int q0 = qb * 256; const int qc = 4 * qb + (wid >> 1); const int NT = 4 * qb + 4;
    float m_reg = NEGBIG, l_reg = 0.f; f32x16 o[4] = {}; bf16x8 qr[12];
    { const bf16_t* Qw = Q + (rowbase + q0 + wid * 32 + r32) * 1536 + hd * 192 + hi * 8;
#pragma unroll
      for (int d0 = 0; d0 < 12; ++d0) qr[d0] = *(const bf16x8*)(Qw + d0 * 16); }
    const bf16_t* Kn = Y + rowbase * YLD + hd * 128; const bf16_t* Vh = VV + rowbase * 1024 + hd * 128; const bf16_t* Kr = KR + rowbase * 64;
    const int sr = tid >> 4, sc = (tid & 15) * 8; const int vst0 = v_st(sr, sc), vst1 = v_st(32 + sr, sc);
    const int kst0 = koff(sr, sc >> 6, (sc & 63) >> 3), kst1 = koff(32 + sr, sc >> 6, (sc & 63) >> 3), kst2 = koff(tid >> 3, 2, tid & 7);
    const int vb0 = (int)(uintptr_t)V_lds + v_rd_base(lane);
    bf16x8 vs0, vs1, ks0, ks1, ks2;
#define ATT_SLOAD(k0) do { vs0 = *(const bf16x8*)(Vh + (size_t)((k0) + sr) * 1024 + sc); vs1 = *(const bf16x8*)(Vh + (size_t)((k0) + 32 + sr) * 1024 + sc); \
    ks0 = *(const bf16x8*)(Kn + (size_t)((k0) + sr) * YLD + sc); ks1 = *(const bf16x8*)(Kn + (size_t)((k0) + 32 + sr) * YLD + sc); \
    ks2 = *(const bf16x8*)(Kr + (size_t)((k0) + (tid >> 3)) * 64 + (tid & 7) * 8); } while (0)
#define ATT_SWRITE(bf) do { *(LAS bf16x8*)(V_lds + (bf) * SHM_V + vst0) = vs0; *(LAS bf16x8*)(V_lds + (bf) * SHM_V + vst1) = vs1; \
    *(LAS bf16x8*)(K_lds + (bf) * SHM_K + kst0) = ks0; *(LAS bf16x8*)(K_lds + (bf) * SHM_K + kst1) = ks1; *(LAS bf16x8*)(K_lds + (bf) * SHM_K + kst2) = ks2; } while (0)
#define ATT_RESC(al) do { if (__any((al) < 1.f)) { if (hi == 0) al_l[r32] = (al); asm volatile("s_waitcnt lgkmcnt(0)" ::: "memory"); \
    _Pragma("unroll") for (int d = 0; d < 4; ++d) _Pragma("unroll") for (int r = 0; r < 16; ++r) o[d][r] *= al_l[crow(r, hi)]; } } while (0)
#define ATT_QKT(P0, P1, bf, jt) do { if ((jt) <= qc) qkt(P0, P1, K_lds + (bf) * SHM_K, qr, r32, hi); else { _Pragma("unroll") for (int r = 0; r < 16; ++r) { P0[r] = NEGBIG; P1[r] = NEGBIG; } } } while (0)
    f32x16 pA0, pA1, pB0, pB1; float alA, alB; bf16x8 pa0, pa1, pa2, pa3;
    ATT_SLOAD(0); asm volatile("s_waitcnt vmcnt(0)" ::: "memory"); ATT_SWRITE(0); __syncthreads();
    ATT_QKT(pA0, pA1, 0, 0); partialSM(pA0, pA1, m_reg, alA);
    ATT_SLOAD(KVBLK_); asm volatile("s_waitcnt vmcnt(0)" ::: "memory"); ATT_SWRITE(1); __syncthreads();
    for (int j = 1; j + 1 < NT; j += 2) {
        ATT_SBAR(); ATT_QKT(pB0, pB1, 1, j);
        finishSM(pA0, pA1, alA, l_reg, pa0, pa1, pa2, pa3); ATT_SBAR();
        ATT_SLOAD((j + 1) * KVBLK_); ATT_SBAR();
        pv_d0(o, vb0, pa0, pa1, pa2, pa3); partialSM(pB0, pB1, m_reg, alB);
        __syncthreads(); asm volatile("s_waitcnt vmcnt(0)" ::: "memory"); ATT_SWRITE(0);
        ATT_RESC(alB); __syncthreads();
        ATT_SBAR(); ATT_QKT(pA0, pA1, 0, j + 1);
        finishSM(pB0, pB1, alB, l_reg, pa0, pa1, pa2, pa3); ATT_SBAR();
        ATT_SLOAD((j + 2) * KVBLK_); ATT_SBAR();
        pv_d0(o, vb0 + SHM_V, pa0, pa1, pa2, pa3); partialSM(pA0, pA1, m_reg, alA);
        __syncthreads(); asm volatile("s_waitcnt vmcnt(0)" ::: "memory"); ATT_SWRITE(1);
        ATT_RESC(alA); __syncthreads();
    }
    ATT_SBAR(); ATT_QKT(pB0, pB1, 1, NT - 1);
    finishSM(pA0, pA1, alA, l_reg, pa0, pa1, pa2, pa3); ATT_SBAR();
    pv_d0(o, vb0, pa0, pa1, pa2, pa3); partialSM(pB0, pB1, m_reg, alB);
    __syncthreads(); ATT_RESC(alB);
    finishSM(pB0, pB1, alB, l_reg, pa0, pa1, pa2, pa3); ATT_SBAR();
    pv_d0(o, vb0 + SHM_V, pa0, pa1, pa2, pa3);
    if (hi == 0) li_l[r32] = l_reg; asm volatile("s_waitcnt lgkmcnt(0)" ::: "memory");
    float rli[16];
#pragma unroll
    for (int r = 0; r < 16; ++r) rli[r] = __builtin_amdgcn_rcpf(li_l[crow(r, hi)]);
    __syncthreads();
    int hi2 = hi, r32b = r32, ln = lane; asm volatile("" : "+v"(hi2), "+v"(r32b), "+v"(ln));
    LAS unsigned char* stg = lds + wid * 8704;
#pragma unroll
    for (int r = 0; r < 16; ++r) { const int orow = (r & 3) + 8 * (r >> 2) + 4 * hi2;
#pragma unroll
        for (int d0 = 0; d0 < 4; ++d0) *(LAS bf16_t*)(stg + orow * 272 + (d0 * 32 + r32b) * 2) = f2bf(o[d0][r] * rli[r]); }
    asm volatile("s_waitcnt lgkmcnt(0)" ::: "memory");
    bf16_t* Ow = Y + (rowbase + q0 + wid * 32) * YLD + 1024 + hd * 128;
    u32x4 zb[8];
#pragma unroll
    for (int i = 0; i < 8; ++i) { const int row = i * 4 + (ln >> 4), ch = ln & 15; zb[i] = *(const u32x4*)(Ow + (unsigned)(row * YLD + ch * 8)); }
#pragma unroll
    for (int i = 0; i < 8; ++i) { const int row = i * 4 + (ln >> 4), ch = ln & 15; const u32x4 ov = *(const LAS u32x4*)(stg + row * 272 + ch * 16); u32x4 w;
        w.x = pk_bf16(bf_lo(ov.x) * bf_lo(zb[i].x), bf_hi(ov.x) * bf_hi(zb[i].x)); w.y = pk_bf16(bf_lo(ov.y) * bf_lo(zb[i].y), bf_hi(ov.y) * bf_hi(zb[i].y));
        w.z = pk_bf16(bf_lo(ov.z) * bf_lo(zb[i].z), bf_hi(ov.z) * bf_hi(zb[i].z)); w.w = pk_bf16(bf_lo(ov.w) * bf_lo(zb[i].w), bf_hi(ov.w) * bf_hi(zb[i].w));
        if (!nostore) *(u32x4*)(Ow + (unsigned)(row * YLD + ch * 8)) = w; }
    asm volatile("s_waitcnt lgkmcnt(0)" ::: "memory");
    __syncthreads();
#undef ATT_SLOAD
#undef ATT_SWRITE
#undef ATT_RESC
#undef ATT_QKT
}
}

__device__ __forceinline__ void phaseC_att(const Frame& F, const bool nostore, const bf16_t* q, bf16_t* y, const bf16_t* vv, const bf16_t* kr) {
    for (int v = F.vcu; v < 256; v += F.G) { const int bh = v >> 2, s = v & 3;
        att::unit(F, nostore, bh >> 3, bh & 7, 7 - s, q, y, vv, kr);
        att::unit(F, nostore, bh >> 3, bh & 7, s, q, y, vv, kr); }
}
__device__ __forceinline__ void phaseC_lru(const Frame& F, const Args& a, const unsigned char* ws, const bool nostore, int l, bf16_t* y, const bf16_t* xc, const float* agg) {
    for (int item = F.vcu; item < NBATCH * 32; item += F.G) lru_item<2>(F, a, ws, nostore, l, item, xc, y, const_cast<float*>(agg));
}

__device__ __forceinline__ void gmlp_item(const Frame& F, const Args& a, const unsigned char* ws, const bool nostore, int l, int item, const bf16_t* v1, bf16_t* y, const float* vslab) {
    const int nb = item >> 2, g = item & 3; const size_t t0 = (size_t)nb * 128;
    int lane_ = lane_id(); asm volatile("" : "+v"(lane_));
    const int lane = lane_, w = F.wave, cl = lane & 15, kg = lane >> 4;
    LAS f32x2v* stat = (LAS f32x2v*)F.lds; LAS unsigned char* vnT = F.lds + 1024;
    { float pv[16];
#pragma unroll
      for (int i = 0; i < 16; ++i) pv[i] = vslab[(t0 + 16 * w + i) * 64 + lane];
#pragma unroll
      for (int i = 0; i < 16; ++i) { float v = pv[i]; v += sx<2>(v); v += sx<4>(v); v += sx<8>(v); v += sx<16>(v); v = xsum32(v);
          const float o = sx<1>(v);
          const float mu = v * (1.f / 1024.f); const float var = fmaxf(o * (1.f / 1024.f) - mu * mu, 0.f);
          if (lane == 0) stat[16 * w + i] = (f32x2v){mu, rsqrtf(var + EPS)}; } }
    LDS_WAIT(); __syncthreads();
    { const f32x2v st0 = stat[2 * lane], st1 = stat[2 * lane + 1];
      const float* lg = a.in[I_GM_LN_G] + l * 1024 + g * 256; const float* lb = a.in[I_GM_LN_B] + l * 1024 + g * 256;
      u32x4 xa[4], xb[4];
#pragma unroll
      for (int i = 0; i < 4; ++i) { const int c8 = 4 * w + i; xa[i] = *(const u32x4*)(v1 + (t0 + 2 * lane) * 1024 + g * 256 + c8 * 8); xb[i] = *(const u32x4*)(v1 + (t0 + 2 * lane + 1) * 1024 + g * 256 + c8 * 8); }
#pragma unroll
      for (int i = 0; i < 4; ++i) { const int c8 = 4 * w + i;
          const f32x4 g0 = *(const f32x4*)(lg + c8 * 8), g1 = *(const f32x4*)(lg + c8 * 8 + 4), b0 = *(const f32x4*)(lb + c8 * 8), b1 = *(const f32x4*)(lb + c8 * 8 + 4);
          const float ga[8] = {g0.x, g0.y, g0.z, g0.w, g1.x, g1.y, g1.z, g1.w}, be[8] = {b0.x, b0.y, b0.z, b0.w, b1.x, b1.y, b1.z, b1.w};
          const unsigned wa[4] = {xa[i].x, xa[i].y, xa[i].z, xa[i].w}, wb[4] = {xb[i].x, xb[i].y, xb[i].z, xb[i].w};
#pragma unroll
          for (int e = 0; e < 8; ++e) {
              const float fa = (e & 1) ? bf_hi(wa[e >> 1]) : bf_lo(wa[e >> 1]), fb = (e & 1) ? bf_hi(wb[e >> 1]) : bf_lo(wb[e >> 1]);
              const float na = (fa - st0.x) * st0.y * ga[e] + be[e], nbv = (fb - st1.x) * st1.y * ga[e] + be[e];
              *(LAS unsigned*)(vnT + (c8 * 8 + e) * 272 + lane * 4) = pk_bf16(na, nbv); } } }
    const bf16_t* gmw = (const bf16_t*)(ws + WS_GMW) + (size_t)g * 128 * 128;
    const float* bs = a.in[I_GM_BS] + l * 512 + g * 128;
    bf16_t* ybase = y + t0 * YLD + g * 256;
    const int tid = w * 64 + lane;
    u32x4 pa[8];
#pragma unroll
    for (int i = 0; i < 8; ++i) { const int idx = tid + 512 * i; pa[i] = *(const u32x4*)(ybase + (unsigned)((idx >> 5) * YLD + (idx & 31) * 8)); }
    float bsv[8];
#pragma unroll
    for (int ct = 0; ct < 8; ++ct) bsv[ct] = bs[16 * ct + cl];
    bf16x8 wf[2][4];
#pragma unroll
    for (int ks = 0; ks < 2; ++ks) wf[0][ks] = *(const bf16x8*)(gmw + (size_t)cl * 128 + 32 * ks + 8 * kg);
    LDS_WAIT(); __syncthreads();
    bf16x8 af[2][4];
#pragma unroll
    for (int r = 0; r < 2; ++r)
#pragma unroll
        for (int ks = 0; ks < 4; ++ks) af[r][ks] = *(const LAS bf16x8*)(vnT + (16 * (2 * w + r) + cl) * 272 + (32 * ks + 8 * kg) * 2);
    LDS_WAIT(); __syncthreads();
    LAS unsigned char* stg = vnT;
#pragma unroll
    for (int ct = 0; ct < 8; ++ct) { const int cur = ct & 1;
        if (ct + 1 < 8) {
#pragma unroll
            for (int ks = 0; ks < 4; ++ks) if (ks < ((ct + 1 < 4) ? 2 : 4)) wf[cur ^ 1][ks] = *(const bf16x8*)(gmw + (size_t)(16 * (ct + 1) + cl) * 128 + 32 * ks + 8 * kg); }
        f32x4 acc[2] = {(f32x4){0.f, 0.f, 0.f, 0.f}, (f32x4){0.f, 0.f, 0.f, 0.f}};
#pragma unroll
        for (int ks = 0; ks < 4; ++ks) if (ks < ((ct < 4) ? 2 : 4)) {
            acc[0] = __builtin_amdgcn_mfma_f32_16x16x32_bf16(af[0][ks], wf[cur][ks], acc[0], 0, 0, 0); acc[1] = __builtin_amdgcn_mfma_f32_16x16x32_bf16(af[1][ks], wf[cur][ks], acc[1], 0, 0, 0); }
#pragma unroll
        for (int r = 0; r < 2; ++r) { u32x2 o; o.x = pk_bf16(acc[r][0] + bsv[ct], acc[r][1] + bsv[ct]); o.y = pk_bf16(acc[r][2] + bsv[ct], acc[r][3] + bsv[ct]);
            *(LAS u32x2*)(stg + (16 * ct + cl) * 528 + (16 * (2 * w + r) + 4 * kg) * 2) = o; }
    }
    LDS_WAIT(); __syncthreads();
#pragma unroll
    for (int i = 0; i < 8; ++i) { const int idx = tid + 512 * i; const u32x4 sv = *(const LAS u32x4*)(stg + (idx >> 5) * 528 + (idx & 31) * 16); u32x4 o;
        o.x = pk_bf16(bf_lo(pa[i].x) * bf_lo(sv.x), bf_hi(pa[i].x) * bf_hi(sv.x)); o.y = pk_bf16(bf_lo(pa[i].y) * bf_lo(sv.y), bf_hi(pa[i].y) * bf_hi(sv.y));
        o.z = pk_bf16(bf_lo(pa[i].z) * bf_lo(sv.z), bf_hi(pa[i].z) * bf_hi(sv.z)); o.w = pk_bf16(bf_lo(pa[i].w) * bf_lo(sv.w), bf_hi(pa[i].w) * bf_hi(sv.w));
        if (!nostore) *(u32x4*)(ybase + (unsigned)((idx >> 5) * YLD + (idx & 31) * 8)) = o; }
    LDS_WAIT(); __syncthreads();
}
__device__ __forceinline__ void phaseE(const Frame& F, const Args& a, const unsigned char* ws, const bool nostore, int l, const bf16_t* v1, bf16_t* y, const float* vslab) {
    for (int item = F.vcu; item < 512; item += F.G) gmlp_item(F, a, ws, nostore, l, item, v1, y, vslab);
}
constexpr int N_PHASES = 1 + 8 * DEPTH;
#ifndef MK_PER_PHASE
#define MK_PER_PHASE 0
#endif
#ifndef MK_MAX_PHASE
#define MK_MAX_PHASE N_PHASES
#endif

__global__ void __launch_bounds__(NWAVES * 64, 2) mk_fwd(Args args) {
    extern __shared__ __attribute__((aligned(16))) unsigned char lds_raw[];
    Frame F;
    F.lds = (LAS unsigned char*)lds_raw;
    F.wave = __builtin_amdgcn_readfirstlane((int)threadIdx.x >> 6);
    F.G = gridDim.x; { const int bx = blockIdx.x; F.vcu = (F.G % 8 == 0) ? (bx % 8) * (F.G / 8) + bx / 8 : bx; }
    volatile LAS unsigned* MISCW = (volatile LAS unsigned*)(F.lds + MISC_OFF);
    for (int u = threadIdx.x; u < (LDS_BYTES - RING_BYTES) / 4; u += NWAVES * 64) ((LAS unsigned*)(F.lds + RING_BYTES))[u] = 0u;
    __syncthreads();
    unsigned* ctl = (unsigned*)(args.ws + WS_CTL);
#if MK_PER_PHASE
    const int lo = args.ph_lo, hi = args.ph_hi;
    const bool multi = (hi - lo) > 1;
#else
    constexpr int lo = 0, hi = N_PHASES;
    constexpr bool multi = true;
#endif
    XcdBarrier bar; bar.bar = ctl + CW_BAR; bar.x = 0; bar.st = nullptr;
    if (multi) bar = xcd_barrier_post(ctl + CW_BAR, MISCW + 8);
#define IN(k) (lo <= (k) && (k) < hi)
#define SEAM(k) do { if (IN((k) + 1)) xcd_barrier(bar); } while (0)
#define xcd_barrier_if(c, b) do { if (c) xcd_barrier(b); } while (0)

typedef const __attribute__((address_space(4))) Args* KArgP;
#define PHASE_PTRS \
    KArgP kp = (KArgP)__builtin_amdgcn_kernarg_segment_ptr(); asm volatile("" : "+s"(kp)); Args la; \
    _Pragma("unroll") for (int i_ = 0; i_ < N_INPUTS; ++i_) la.in[i_] = kp->in[i_]; la.out = kp->out; la.ws = kp->ws; la.ph_lo = 0; la.ph_hi = 0; \
    unsigned char* ws = la.ws; asm volatile("" : "+s"(ws)); Frame Fp = F; int bid = (int)blockIdx.x; asm volatile("" : "+s"(Fp.wave), "+s"(Fp.vcu), "+s"(Fp.G), "+s"(bid)); (void)bid; \
    bf16_t* Hb = (bf16_t*)(ws + WS_H); bf16_t* Yb = (bf16_t*)(ws + WS_Y); \
    bf16_t* MISCb = (bf16_t*)(ws + WS_MISC); bf16_t* XCb = (bf16_t*)(ws + WS_XC); bf16_t* Qb = (bf16_t*)(ws + WS_Q); bf16_t* VVb = (bf16_t*)(ws + WS_VV); bf16_t* KRb = (bf16_t*)(ws + WS_KR); \
    bf16_t* V1b = (bf16_t*)(ws + WS_V1); bf16_t* Gb = (bf16_t*)(ws + WS_G); bf16_t* Ob = (bf16_t*)(ws + WS_O); \
    float* SLAB = (float*)(ws + WS_SLAB); float* AGG = (float*)(ws + WS_AGG); const float* CS = (const float*)(ws + WS_ROPE); const float* SN = CS + 2048 * 32; \
    const unsigned char* wb = ws + WS_WB; (void)Hb; (void)Yb; (void)MISCb; (void)XCb; (void)Qb; (void)VVb; (void)KRb; (void)V1b; (void)Gb; (void)Ob; (void)SLAB; (void)AGG; (void)CS; (void)SN; (void)wb;
    if (IN(0)) {
        { PHASE_PTRS
        convert_weights(Fp, la, ws, 0);
        rope_table(Fp, ws);
        norm_rows(Fp, false, la.in[I_X], nullptr, nullptr, nullptr, la.in[I_PRE_G], Hb);
        }
        SEAM(0);
    }
#pragma nounroll
    for (int l = 0; l < DEPTH; ++l) {
        const int pb = 1 + 8 * l;
        if (IN(pb + 0)) {
            { const bool nostore = false; (void)nostore;
            PHASE_PTRS
            SchedA S; S.ord.init(64, 16, Fp.G, bid); S.A = (const char*)Hb; S.B = (const char*)(wb + WB_W1T);
            EpiA E{MISCb, XCb, Yb, SLAB, KRb, CS, SN};
            g8::gemm_stream(Fp.lds, Fp.wave * 64 + lane_id(), 2048u, 2048u, S, E);
            }
            SEAM(pb + 0);
        }
        if (IN(pb + 1)) {
            { const bool nostore = false; (void)nostore;
            PHASE_PTRS
            { SchedZ SZ; SZ.v = Fp.vcu; SZ.A = (const char*)Hb; SZ.B = (const char*)(wb + WB_W1T); EpiA EZ{MISCb, XCb, Yb, SLAB, KRb, CS, SN};
              g8::gemm_stream(Fp.lds, Fp.wave * 64 + lane_id(), 2048u, 2048u, SZ, EZ); }
            SchedQKV S; S.v = Fp.vcu; S.misc = (const char*)MISCb; S.wq = (const char*)(wb + WB_WQT); S.wkv = (const char*)(wb + WB_WKVT);
            EpiQKV E{Qb, Yb, VVb, SLAB, CS, SN};
            g8::gemm_stream(Fp.lds, Fp.wave * 64 + lane_id(), 1536u, 768u, S, E);
            phaseB_lru(Fp, ws, (unsigned*)(ws + WS_CTL), nostore, l, XCb, Yb, AGG);
            }
            SEAM(pb + 1);
        }
        if (IN(pb + 2)) {
            { const bool nostore = false; (void)nostore;
            PHASE_PTRS
            phaseC_att(Fp, nostore, Qb, Yb, VVb, KRb);
            }
            SEAM(pb + 2);
        }
        if (IN(pb + 3)) {
            { const bool nostore = false; (void)nostore;
            PHASE_PTRS
            SchedD S; S.ord.init(64, 24, Fp.G, bid); S.A = (const char*)Hb; S.B = (const char*)(wb + WB_W2T);
            EpiD E{Yb, V1b, Gb, SLAB};
            g8::gemm_stream(Fp.lds, Fp.wave * 64 + lane_id(), 2048u, 2048u, S, E);
            }
            SEAM(pb + 3);
        }
        if (IN(pb + 4)) {
            { const bool nostore = false; (void)nostore;
            PHASE_PTRS
            phaseE(Fp, la, ws, nostore, l, V1b, Yb, SLAB);
            }
            SEAM(pb + 4);
        }
        if (IN(pb + 5)) {
            { const bool nostore = false; (void)nostore;
            PHASE_PTRS
            SchedF S; S.ord.init(64, 4, Fp.G, bid); S.A = (const char*)Yb; S.B = (const char*)(wb + WB_WPT);
            EpiF E{Gb, V1b};
            g8::gemm_stream(Fp.lds, Fp.wave * 64 + lane_id(), (unsigned)(YLD * 2), (unsigned)(YLD * 2), S, E);
            }
            SEAM(pb + 5);
        }
        if (IN(pb + 6)) {
            { const bool nostore = false; (void)nostore;
            PHASE_PTRS
            SchedG1 S; S.v = Fp.vcu; S.A = (const char*)V1b; S.B = (const char*)(wb + WB_WOT);
            const float* xin = (l == 0) ? la.in[I_X] : la.out;
            EpiNorm E{xin, la.out, Hb, la.in[I_POST_G] + l * DM, (l + 1 < DEPTH) ? la.in[I_PRE_G] + (l + 1) * DM : nullptr, SLAB, (unsigned*)(ws + WS_CTL) + CW_NORM + l * 2048};
            g8::gemm_stream<true>(Fp.lds, Fp.wave * 64 + lane_id(), 2048u, 2048u, S, E);
            }
            if (l + 1 < DEPTH) SEAM(pb + 6);
        }
        if (IN(pb + 7) && l + 1 < DEPTH) {
            { const bool nostore = false; (void)nostore;
            PHASE_PTRS
            if (l + 1 < DEPTH) convert_weights(Fp, la, ws, l + 1);
            }
            SEAM(pb + 7);
        }
    }
#undef IN
#undef SEAM
}

#ifndef MK_PROBE
#define MK_PROBE 0
#endif
static int mk_setup(size_t ws_size) {
    static int grid = 0;
    if (grid == 0) {
        if (ws_size < WS_END) { fprintf(stderr, "kernel_launch: workspace too small: %zu < %zu\n", ws_size, (size_t)WS_END); grid = -1; return grid; }
        int dev = 0, cus = 0, per_cu = 0;
        if (hipGetDevice(&dev) != hipSuccess || hipDeviceGetAttribute(&cus, hipDeviceAttributeMultiprocessorCount, dev) != hipSuccess) { grid = -1; return grid; }
        if (hipFuncSetAttribute((const void*)mk_fwd, hipFuncAttributeMaxDynamicSharedMemorySize, LDS_BYTES) != hipSuccess) { fprintf(stderr, "kernel_launch: hipFuncSetAttribute failed\n"); grid = -1; return grid; }
        if (hipOccupancyMaxActiveBlocksPerMultiprocessor(&per_cu, (const void*)mk_fwd, NWAVES * 64, LDS_BYTES) != hipSuccess || per_cu < 1)
            fprintf(stderr, "kernel_launch: occupancy query reports %d blocks/CU\n", per_cu);
        (void)hipGetLastError();
        grid = cus;
        if (grid != 256) fprintf(stderr, "kernel_launch: note: %d CUs (tile schedules assume 256)\n", grid);
    }
    return grid;
}
static void mk_launch(void* const* d_in, void* d_out, void* d_ws, hipStream_t stream, int grid, int lo, int hi) {
    Args a{};
    for (int i = 0; i < N_INPUTS; ++i) a.in[i] = (const float*)d_in[i];
    a.out = (float*)d_out; a.ws = (unsigned char*)d_ws; a.ph_lo = lo; a.ph_hi = hi; a.probe = MK_PROBE; a.pad = 0;
    hipLaunchKernelGGL(mk_fwd, dim3(grid), dim3(NWAVES * 64), LDS_BYTES, stream, a);
}
extern "C" void kernel_launch(void* const* d_in, const int* in_sizes, int n_in, void* d_out, int out_size, void* d_ws, size_t ws_size, hipStream_t stream) {
    const int grid = mk_setup(ws_size); if (grid < 0) return;
    hipMemsetAsync((char*)d_ws + WS_CTL, 0, CTL_ZERO_BYTES, stream);
#if MK_PER_PHASE
    for (int ph = 0; ph < N_PHASES; ++ph) mk_launch(d_in, d_out, d_ws, stream, grid, ph, ph + 1);
#else
    mk_launch(d_in, d_out, d_ws, stream, grid, 0, N_PHASES);
#endif
}
```

```cpp
#define MK_PROBE 0
#include <hip/hip_runtime.h>
#include <cstdio>
#include <cstdint>

#define LAS __attribute__((address_space(3)))
#define GAS __attribute__((address_space(1)))
typedef unsigned short bf16_t;
typedef short bf16x8 __attribute__((ext_vector_type(8)));
typedef short s16x4 __attribute__((ext_vector_type(4)));
typedef float f32x2 __attribute__((ext_vector_type(2)));
typedef float f32x4 __attribute__((ext_vector_type(4)));
typedef float f32x16 __attribute__((ext_vector_type(16)));
typedef unsigned u32x2 __attribute__((ext_vector_type(2)));
typedef unsigned u32x4 __attribute__((ext_vector_type(4)));
typedef __bf16 bf16x2_t __attribute__((ext_vector_type(2)));

__device__ __forceinline__ unsigned pk_bf16(float lo, float hi) { f32x2 v = {lo, hi}; bf16x2_t b = __builtin_convertvector(v, bf16x2_t); return __builtin_bit_cast(unsigned, b); }
__device__ __forceinline__ float bf_lo(unsigned w) { return __uint_as_float(w << 16); }
__device__ __forceinline__ float bf_hi(unsigned w) { return __uint_as_float(w & 0xffff0000u); }
__device__ __forceinline__ float bf1(bf16_t h) { return __uint_as_float(((unsigned)h) << 16); }
__device__ __forceinline__ bf16_t f2bf(float f) { return (bf16_t)(pk_bf16(f, 0.f) & 0xffffu); }
__device__ __forceinline__ float fexp2(float x) { return __builtin_amdgcn_exp2f(x); }
__device__ __forceinline__ float fsigmoid(float x) { return __builtin_amdgcn_rcpf(1.f + fexp2(x * -1.4426950408889634f)); }
__device__ __forceinline__ float fsilu(float x) { return x * __builtin_amdgcn_rcpf(1.f + fexp2(x * -1.4426950408889634f)); }
template <int XM> __device__ __forceinline__ float sx(float v) { return __int_as_float(__builtin_amdgcn_ds_swizzle(__float_as_int(v), (XM << 10) | 0x1f)); }
__device__ __forceinline__ float xsum32(float v) { auto rr = __builtin_amdgcn_permlane32_swap(__float_as_uint(v), __float_as_uint(v), false, false); return __uint_as_float(rr[0]) + __uint_as_float(rr[1]); }
__device__ __forceinline__ float wave_sum(float v) { v += sx<1>(v); v += sx<2>(v); v += sx<4>(v); v += sx<8>(v); v += sx<16>(v); return xsum32(v); }
#define LDS_WAIT() asm volatile("s_waitcnt lgkmcnt(0)" ::: "memory")
#define VM_WAIT() asm volatile("s_waitcnt vmcnt(0)" ::: "memory")

namespace g8 {
constexpr int BM = 256, BK = 64, HALF = 128, HTB = HALF * BK * 2, STAGE_BYTES = 8 * HTB, NXCD = 8, WGM = 8;
__host__ __device__ __forceinline__ int lds_byte(int r, int c) { const int st = (r >> 4) * 2 + (c >> 5), rr = r & 15, cc = c & 31, ob = rr * 64 + cc * 2; return st * 1024 + (ob ^ (((ob >> 9) & 1) << 5)); }
__host__ __device__ __forceinline__ void stage_rc(int b, int& R, int& C) { const int st = b / 1024, sb = b % 1024, swz = sb ^ (((sb >> 9) & 1) << 5); R = (st >> 1) * 16 + swz / 64; C = (st & 1) * 32 + (swz % 64) / 2; }
__host__ __device__ __forceinline__ int perm32(int rho) { const int n = rho >> 4, i = rho & 15; return 8 * (i >> 2) + 4 * n + (i & 3); }

struct UnitD { const char* A; const char* B; int nt, pm, pn, kind; };
constexpr int KEEP_ACC = 0x100;

struct TileOrder {
    int nM, nN, nwg, G, c;
    __device__ void init(int nM_, int nN_, int G_, int c_) { nM = nM_; nN = nN_; nwg = nM * nN; G = G_; c = c_; }
    __device__ bool tile(int i, int& pm, int& pn) const {
        const long L = (long)i * G + c; if (L >= nwg) return false;
        int wgid = (int)L; { const int q = nwg / NXCD, r = nwg % NXCD, xcd = wgid % NXCD, off = wgid / NXCD; wgid = (xcd < r ? xcd * (q + 1) : r * (q + 1) + (xcd - r) * q) + off; }
        const int nig = WGM * nN, gid = wgid / nig, fm = gid * WGM, gsz = (nM - fm) < WGM ? (nM - fm) : WGM;
        pm = fm + ((wgid % nig) % gsz); pn = (wgid % nig) / gsz; return true;
    }
};

template <bool AFTER_DRAIN = false, class Sched, class Epi>
__device__ __forceinline__ void gemm_stream(LAS unsigned char* lds, int tid_in, const unsigned lda, const unsigned ldb, const Sched& S, const Epi& E) {
    int tid_ = tid_in; asm volatile("" : "+v"(tid_));
    const int tid = tid_, wid = __builtin_amdgcn_readfirstlane(tid >> 6), lane = tid & 63, wr = wid >> 2, wc = wid & 3, fr = lane & 15, fq = lane >> 4;
    unsigned voffA[2], voffB[2];
#pragma unroll
    for (int i = 0; i < 2; ++i) { int R, C; stage_rc(tid * 16 + i * 8192, R, C); const int Rb = (R & ~31) + perm32(R & 31);
        voffA[i] = (unsigned)R * lda + (unsigned)C * 2u; voffB[i] = (unsigned)Rb * ldb + (unsigned)C * 2u; }
    const size_t kstep = (size_t)(BK * 2);
    const size_t hstepA = (size_t)HALF * lda, hstepB = (size_t)HALF * ldb;
    const unsigned ldsw = (unsigned)wid * 1024u;
    const int aoff = lds_byte(wr * 64 + fr, fq * 8), boff = lds_byte(wc * 32 + fr, fq * 8);
#define G8_SA(b, h) (((b) * 2 + (h)) * HTB)
#define G8_SB(b, h) ((4 + (b) * 2 + (h)) * HTB)
#define G8_STAGE(bufoff, gbase, voff) do { _Pragma("unroll") for (int _i = 0; _i < 2; ++_i) \
        __builtin_amdgcn_global_load_lds((const unsigned*)((const char*)(gbase) + (voff)[_i]), (LAS unsigned*)(lds + (bufoff) + ldsw + _i * 8192), 16, 0, 0); } while (0)
#define G8_LDA(dst, b, h) do { _Pragma("unroll") for (int m = 0; m < 4; ++m) _Pragma("unroll") for (int k = 0; k < 2; ++k) dst[m][k] = *(const LAS bf16x8*)(lds + G8_SA(b, h) + aoff + m * 2048 + k * 1024); } while (0)
#define G8_LDB(dst, b, h) do { _Pragma("unroll") for (int n = 0; n < 2; ++n) _Pragma("unroll") for (int k = 0; k < 2; ++k) dst[n][k] = *(const LAS bf16x8*)(lds + G8_SB(b, h) + boff + n * 2048 + k * 1024); } while (0)
#define G8_MMA(ai, bj, At, Bt) do { __builtin_amdgcn_s_setprio(1); _Pragma("unroll") for (int m = 0; m < 4; ++m) _Pragma("unroll") for (int n = 0; n < 2; ++n) _Pragma("unroll") for (int k = 0; k < 2; ++k) \
        acc[ai][bj][m][n] = __builtin_amdgcn_mfma_f32_16x16x32_bf16(Bt[n][k], At[m][k], acc[ai][bj][m][n], 0, 0, 0); __builtin_amdgcn_s_setprio(0); } while (0)
#define G8_WAIT_V(n) asm volatile("s_waitcnt vmcnt(" #n ")" ::: "memory")
#define G8_WAIT_L(n) asm volatile("s_waitcnt lgkmcnt(" #n ")" ::: "memory")
#define G8_BAR __builtin_amdgcn_s_barrier()
#define G8_SCHED __builtin_amdgcn_sched_barrier(0)
    UnitD cur, nxt; int ui = 0;
    if (!S.next(0, cur)) return;
    f32x4 acc[2][2][4][2];
#pragma unroll
    for (int a = 0; a < 2; ++a)
#pragma unroll
        for (int b = 0; b < 2; ++b)
#pragma unroll
            for (int m = 0; m < 4; ++m)
#pragma unroll
                for (int n = 0; n < 2; ++n) acc[a][b][m][n] = (f32x4){0.f, 0.f, 0.f, 0.f};
    bf16x8 At[4][2], B0[2][2], B1[2][2];
    const char* cA = cur.A; const char* cB = cur.B;
    G8_STAGE(G8_SB(0, 0), cB, voffB); G8_STAGE(G8_SB(0, 1), cB + hstepB, voffB); G8_STAGE(G8_SA(0, 0), cA, voffA); G8_STAGE(G8_SA(0, 1), cA + hstepA, voffA);
    if (wr == 1) G8_BAR;
    G8_WAIT_V(2); G8_BAR;
    G8_STAGE(G8_SB(1, 0), cB + kstep, voffB); G8_STAGE(G8_SA(1, 0), cA + kstep, voffA); G8_STAGE(G8_SB(1, 1), cB + hstepB + kstep, voffB);
    G8_WAIT_V(6); G8_BAR;
    for (;;) {
        const bool has_next = S.next(ui + 1, nxt);
        const char* nA = has_next ? nxt.A : cA; const char* nB = has_next ? nxt.B : cB;
        const int nt = cur.nt;
        for (int t = 0; t < nt; t += 2) {
            const bool last = (t == nt - 2);
            const char* a1 = cA + (size_t)(t + 1) * kstep;
            const char* a2 = last ? nA : cA + (size_t)(t + 2) * kstep; const char* b2 = last ? nB : cB + (size_t)(t + 2) * kstep;
            const char* a3 = a2 + kstep; const char* b3 = b2 + kstep;
            G8_LDB(B0, 0, 0); G8_LDB(B1, 0, 1); G8_SCHED; G8_LDA(At, 0, 0); G8_STAGE(G8_SA(1, 1), a1 + hstepA, voffA);
            G8_WAIT_V(8); G8_WAIT_L(0); G8_BAR; G8_MMA(0, 0, At, B0); G8_MMA(0, 1, At, B1); G8_BAR; G8_SCHED;
            G8_LDA(At, 0, 1); G8_STAGE(G8_SB(0, 0), b2, voffB); G8_STAGE(G8_SB(0, 1), b2 + hstepB, voffB); G8_STAGE(G8_SA(0, 0), a2, voffA);
            G8_WAIT_V(8); G8_WAIT_L(0); G8_BAR; G8_MMA(1, 0, At, B0); G8_MMA(1, 1, At, B1); G8_BAR; G8_SCHED;
            G8_LDB(B0, 1, 0); G8_LDB(B1, 1, 1); G8_SCHED; G8_LDA(At, 1, 0); G8_STAGE(G8_SA(0, 1), a2 + hstepA, voffA);
            G8_WAIT_V(8); G8_WAIT_L(0); G8_BAR; G8_MMA(0, 0, At, B0); G8_MMA(0, 1, At, B1); G8_BAR; G8_SCHED;
            G8_LDA(At, 1, 1); G8_STAGE(G8_SB(1, 0), b3, voffB); G8_STAGE(G8_SB(1, 1), b3 + hstepB, voffB); G8_STAGE(G8_SA(1, 0), a3, voffA);
            G8_WAIT_V(8); G8_WAIT_L(0); G8_BAR; G8_MMA(1, 0, At, B0); G8_MMA(1, 1, At, B1); G8_BAR; G8_SCHED;
        }
        if (wr == 0) G8_BAR;
        if constexpr (!AFTER_DRAIN) { UnitD eu = cur; int fr_ = fr, fq_ = fq; asm volatile("" : "+s"(eu.pm), "+s"(eu.pn), "+v"(fr_), "+v"(fq_)); E(acc, eu, wr, wc, fr_, fq_); }
        if (!has_next) break;
        if (!(cur.kind & KEEP_ACC)) {
#pragma unroll
            for (int a = 0; a < 2; ++a)
#pragma unroll
                for (int b = 0; b < 2; ++b)
#pragma unroll
                    for (int m = 0; m < 4; ++m)
#pragma unroll
                        for (int n = 0; n < 2; ++n) acc[a][b][m][n] = (f32x4){0.f, 0.f, 0.f, 0.f};
        }
        cur = nxt; cA = nA; cB = nB; ++ui;
        if (wr == 1) G8_BAR;
    }
    G8_WAIT_V(0);
    G8_BAR;
    if constexpr (AFTER_DRAIN) {
        UnitD eu = cur; int fr_ = fr, fq_ = fq, ln_ = lane; asm volatile("" : "+s"(eu.pm), "+s"(eu.pn), "+v"(fr_), "+v"(fq_), "+v"(ln_)); E.fused(acc, eu, wr, wc, fr_, fq_, lds, wid, ln_); }
#undef G8_SA
#undef G8_SB
#undef G8_STAGE
#undef G8_LDA
#undef G8_LDB
#undef G8_MMA
#undef G8_WAIT_V
#undef G8_WAIT_L
#undef G8_BAR
#undef G8_SCHED
}
}

#define XB_TMO      128
#define XB_XCNT(j)  (256  + 64 * (j))
#define XB_XSUB(j)  (1280 + 64 * (j))
#define XB_XGEN(j)  (2304 + 64 * (j))
#define XB_TOP      3328
#define XB_TOPGEN   3392
#define XCD_BAR_WORDS 3456
#define XB_SPIN_CAP (1u << 18)
__device__ __forceinline__ unsigned xb_ld(unsigned* p)              { return __hip_atomic_load(p, __ATOMIC_RELAXED, __HIP_MEMORY_SCOPE_AGENT); }
__device__ __forceinline__ unsigned xb_add(unsigned* p, unsigned v) { return __hip_atomic_fetch_add(p, v, __ATOMIC_RELAXED, __HIP_MEMORY_SCOPE_AGENT); }
__device__ __forceinline__ unsigned xb_xcc_id() { return (unsigned)__builtin_amdgcn_s_getreg((3 << 11) | 20) & 0xFu; }
#define XB_SPIN(cond, bar) do { unsigned _sp = 0; while (cond) { __builtin_amdgcn_s_sleep(1); \
    if ((++_sp & 255u) == 0u) { if (xb_ld(&(bar)[XB_TMO])) break; if (_sp > XB_SPIN_CAP) { atomicAdd(&(bar)[XB_TMO], 1u); break; } } } } while (0)
struct XcdBarrier { unsigned* bar; unsigned x; volatile LAS unsigned* st; };
__device__ __forceinline__ XcdBarrier xcd_barrier_post(unsigned* bar, volatile LAS unsigned* st) {
    XcdBarrier b; b.bar = bar; b.x = xb_xcc_id(); b.st = st;
    if (threadIdx.x == 0) (void)xb_add(&bar[XB_XCNT(b.x)], 1u);
    return b;
}
__device__ __forceinline__ void xcd_barrier_complete(unsigned* bar, unsigned x, unsigned& nloc, unsigned& nx) {
    const unsigned G = gridDim.x * gridDim.y * gridDim.z;
    unsigned sum, cnt, mine, sp = 0u;
    for (;;) {
        sum = 0u; cnt = 0u; mine = 0u;
#pragma unroll
        for (unsigned j = 0; j < 16; ++j) { const unsigned c = xb_ld(&bar[XB_XCNT(j)]); sum += c; cnt += (c > 0u) ? 1u : 0u; mine = (j == x) ? c : mine; }
        if (sum == G) break;
        __builtin_amdgcn_s_sleep(1);
        if ((++sp & 255u) == 0u) { if (xb_ld(&bar[XB_TMO])) break; if (sp > XB_SPIN_CAP) { atomicAdd(&bar[XB_TMO], 1u); break; } }
    }
    nloc = mine > 0u ? mine : 1u; nx = cnt > 0u ? cnt : 1u;
}
__device__ __forceinline__ void xcd_barrier(const XcdBarrier& b) {
    asm volatile("s_waitcnt vmcnt(0)" ::: "memory");
    __syncthreads();
    if (threadIdx.x == 0) {
        unsigned* bar = b.bar; unsigned bx = b.x; asm volatile("" : "+s"(bar), "+s"(bx));
        __builtin_amdgcn_s_waitcnt(0);
        unsigned nloc = b.st[0], nx = b.st[1];
        if (nloc == 0u) { xcd_barrier_complete(bar, bx, nloc, nx); b.st[0] = nloc; b.st[1] = nx; }
        const unsigned old = xb_add(&bar[XB_XSUB(bx)], 1u);
        const unsigned gen = old / nloc;
        if (old + 1u == (gen + 1u) * nloc) {
            __builtin_amdgcn_fence(__ATOMIC_RELEASE, "agent");
            asm volatile("s_waitcnt vmcnt(0)" ::: "memory");
            const unsigned og = xb_add(&bar[XB_TOP], 1u);
            const unsigned tg = og / nx;
            if (og + 1u == (tg + 1u) * nx) xb_add(&bar[XB_TOPGEN], 1u);
            else XB_SPIN(xb_ld(&bar[XB_TOPGEN]) == tg, bar);
            __builtin_amdgcn_fence(__ATOMIC_ACQUIRE, "agent");
            xb_add(&bar[XB_XGEN(bx)], 1u);
            asm volatile("s_waitcnt vmcnt(0)" ::: "memory");
        } else {
            XB_SPIN(xb_ld(&bar[XB_XGEN(bx)]) == gen, bar);
            __builtin_amdgcn_fence(__ATOMIC_ACQUIRE, "agent");
            asm volatile("s_waitcnt vmcnt(0)" ::: "memory");
        }
    }
    __syncthreads();
}
constexpr int T = 16384, DM = 1024, SEQ = 2048, NBATCH = 8, DEPTH = 2, N_IN = 10432;
constexpr int NWAVES = 8;
constexpr float EPS = 1e-6f;
constexpr size_t MiB = 1u << 20;
constexpr size_t WS_CTL = 0, CTL_ZERO_BYTES = 64 * 1024;
constexpr size_t WS_WB = 1 * MiB;
constexpr size_t WB_W1T = 0;
constexpr size_t WB_W2T = WB_W1T + (size_t)4352 * 1024 * 2;
constexpr size_t WB_WQT = WB_W2T + (size_t)6144 * 1024 * 2;
constexpr size_t WB_WKVT = WB_WQT + (size_t)1536 * 384 * 2;
constexpr size_t WB_WPT = WB_WKVT + (size_t)2048 * 384 * 2;
constexpr size_t WB_WOT = WB_WPT + (size_t)1024 * 3328 * 2;
constexpr size_t WB_END = WB_WOT + (size_t)1024 * 1024 * 2;
static_assert(WB_END <= 32 * MiB, "weights region");
constexpr size_t WS_H = 33 * MiB;
constexpr size_t WS_Y = 65 * MiB;
constexpr int YLD = 3328;
constexpr size_t WS_BIG = 169 * MiB;
constexpr size_t WS_MISC = WS_BIG;
constexpr size_t WS_XC = WS_MISC + 24 * MiB;
constexpr size_t WS_Q = WS_XC + 40 * MiB;
constexpr size_t WS_VV = WS_Q + 48 * MiB;
constexpr size_t WS_KR = WS_VV + 32 * MiB;
constexpr size_t WS_V1 = WS_BIG;
constexpr size_t WS_G = WS_V1 + 32 * MiB;
constexpr size_t WS_O = WS_BIG;
constexpr size_t WS_SMALL = 315 * MiB;
constexpr size_t WS_SLAB = WS_SMALL;
constexpr size_t WS_AGG = WS_SLAB + 1536 * 1024;
constexpr size_t WS_ROPE = WS_AGG + 2560 * 1024;
constexpr size_t WS_LW = WS_ROPE + 512 * 1024;
constexpr size_t WS_GMW = WS_LW + 480 * 1024;
constexpr size_t WS_LCT = WS_GMW + 128 * 1024;
constexpr size_t WS_END = WS_LCT + 64 * 1024;
static_assert(WS_KR + 2 * MiB <= WS_SMALL && WS_G + 96 * MiB <= WS_SMALL && WS_END <= 326 * MiB, "d_ws map");
constexpr int CW_NORM = 12288;
constexpr int CW_BAR = 1024;
static_assert((CW_BAR + XCD_BAR_WORDS) * 4 <= (int)CTL_ZERO_BYTES, "ctl");
constexpr int RING_BYTES = 131072, MISC_OFF = RING_BYTES + 320, LDS_BYTES = 147456;

enum { I_X = 0, I_PRE_G, I_W_IN, I_GM_LN_G, I_GM_LN_B, I_GM_WS, I_GM_BS, I_QN_G, I_W_UQ, I_KVN_G, I_W_UKV, I_CONV_W, I_CONV_B, I_W_A, I_B_A, I_W_X, I_B_X, I_LAM,
       I_W_PA, I_W_PB, I_W_PC, I_W_OUT, I_POST_G, N_INPUTS };
struct Args { const float* in[N_INPUTS]; float* out; unsigned char* ws; int ph_lo, ph_hi, probe, pad; };

struct Frame { LAS unsigned char* lds; int wave, vcu, G; };
__device__ __forceinline__ int lane_id() { int l; asm volatile("v_mbcnt_lo_u32_b32 %0, -1, 0\n\tv_mbcnt_hi_u32_b32 %0, -1, %0" : "=v"(l)); return l; }

__device__ __forceinline__ float softplus_neg(float x) { const float e = __expf(-x);
    const float p = e * (1.f - e * (0.5f - e * (0.33333334f - e * (0.25f - e * (0.2f - e * (0.16666667f - e * (0.14285715f - e * 0.125f)))))));
    return (e < 0.2f) ? p : __logf(1.f + e); }
struct MapW1 { __device__ __forceinline__ int operator()(int j) const {
    if (j < 384) return 3072 + j; if (j < 640) return 3456 + (j - 384); if (j < 704) { const int jj = j - 640, g = jj >> 3, e = jj & 7; return 3712 + (e < 4 ? 4 * g + e : 32 + 4 * g + (e - 4)); } if (j < 768) return -1;
    if (j < 2048) return 4800 + (j - 768); if (j < 3328) return 6080 + (j - 2048); return 3776 + (j - 3328); } };
struct MapW2 { __device__ __forceinline__ int operator()(int j) const {
    if (j < 2048) { const int tl = j >> 8, lc = j & 255; return (lc < 128) ? (128 * tl + lc) : (2048 + 128 * tl + (lc - 128)); }
    if (j < 3072) return 1024 + (j - 2048); return 7360 + (j - 3072); } };
struct MapQ { __device__ __forceinline__ int operator()(int j) const {
    if (j < 1024) { const int hd = j >> 7, d = j & 127; return hd * 192 + d; }
    const int jj = j - 1024, hh = jj >> 6, w = jj & 63, g = w >> 3, e = w & 7; return hh * 192 + (e < 4 ? 128 + 4 * g + e : 160 + 4 * g + (e - 4)); } };
struct MapId { __device__ __forceinline__ int operator()(int j) const { return j; } };

template <class Map>
__device__ __forceinline__ void tr_item(const float* W, int ldw, int nkb  , bf16_t* WT, int ldt, const Map map, const float* kscale, LAS float* scr, int item, int lane) {
    const int kb = item % nkb, nb = item / nkb, k0 = 64 * kb, n0 = 32 * nb;
    const int nn = lane & 31; const int sc = map(n0 + nn);
    float wv[32];
    const float* wp = W + (size_t)(k0 + (lane >> 5)) * ldw + (sc >= 0 ? sc : 0);
#pragma unroll
    for (int i = 0; i < 32; ++i) wv[i] = (sc >= 0) ? wp[(size_t)(2 * i) * ldw] : 0.f;
#pragma unroll
    for (int i = 0; i < 32; ++i) { const int kk = 2 * i + (lane >> 5); float v = wv[i]; if (kscale) v *= kscale[k0 + kk]; scr[kk * 33 + nn] = v; }
    LDS_WAIT(); asm volatile("" ::: "memory");
    const int c = lane & 7;
#pragma unroll
    for (int j = 0; j < 4; ++j) { const int n = (lane >> 3) + 8 * j; const LAS float* s = scr + (8 * c) * 33 + n;
        u32x4 o; o.x = pk_bf16(s[0 * 33], s[1 * 33]); o.y = pk_bf16(s[2 * 33], s[3 * 33]); o.z = pk_bf16(s[4 * 33], s[5 * 33]); o.w = pk_bf16(s[6 * 33], s[7 * 33]);
        *(u32x4*)(WT + (size_t)(n0 + n) * ldt + k0 + 8 * c) = o; }
    LDS_WAIT(); asm volatile("" ::: "memory");
}

__device__ __forceinline__ void convert_weights(const Frame& F, const Args& a, unsigned char* ws, int l) {
    const int lane = lane_id();
    LAS float* scr = (LAS float*)(F.lds + F.wave * 16384);
    const int gw = F.vcu * NWAVES + F.wave, NGW = F.G * NWAVES;
    unsigned char* wb = ws + WS_WB;
    constexpr int I1 = 16 * (4352 / 32), I2 = 16 * (6144 / 32), IQ = 6 * (1536 / 32), IKV = 4 * (2048 / 32), IPA = 16 * 32, IPB = 16 * 32, IPC = 20 * 32, IO = 16 * 32;
    constexpr int NITEMS = I1 + I2 + IQ + IKV + IPA + IPB + IPC + IO;
    const float* w_in = a.in[I_W_IN] + (size_t)l * 1024 * N_IN;
    for (int it = gw; it < NITEMS; it += NGW) {
        int r = it;
        if (r < I1) { tr_item(w_in, N_IN, 16, (bf16_t*)(wb + WB_W1T), 1024, MapW1(), nullptr, scr, r, lane); continue; } r -= I1;
        if (r < I2) { tr_item(w_in, N_IN, 16, (bf16_t*)(wb + WB_W2T), 1024, MapW2(), nullptr, scr, r, lane); continue; } r -= I2;
        if (r < IQ) { tr_item(a.in[I_W_UQ] + (size_t)l * 384 * 1536, 1536, 6, (bf16_t*)(wb + WB_WQT), 384, MapQ(), a.in[I_QN_G] + l * 384, scr, r, lane); continue; } r -= IQ;
        if (r < IKV) { tr_item(a.in[I_W_UKV] + (size_t)l * 256 * 2048, 2048, 4, (bf16_t*)(wb + WB_WKVT), 384, MapId(), a.in[I_KVN_G] + l * 256, scr, r, lane); continue; } r -= IKV;
        if (r < IPA) { tr_item(a.in[I_W_PA] + (size_t)l * 1024 * 1024, 1024, 16, (bf16_t*)(wb + WB_WPT), 3328, MapId(), nullptr, scr, r, lane); continue; } r -= IPA;
        if (r < IPB) { tr_item(a.in[I_W_PB] + (size_t)l * 1024 * 1024, 1024, 16, (bf16_t*)(wb + WB_WPT) + 1024, 3328, MapId(), nullptr, scr, r, lane); continue; } r -= IPB;
        if (r < IPC) { tr_item(a.in[I_W_PC] + (size_t)l * 1280 * 1024, 1024, 20, (bf16_t*)(wb + WB_WPT) + 2048, 3328, MapId(), nullptr, scr, r, lane); continue; } r -= IPC;
        tr_item(a.in[I_W_OUT] + (size_t)l * 1024 * 1024, 1024, 16, (bf16_t*)(wb + WB_WOT), 1024, MapId(), nullptr, scr, r, lane);
    }
    const int gt = (F.vcu * NWAVES + F.wave) * 64 + lane, NGT = F.G * NWAVES * 64;
    bf16_t* lwa = (bf16_t*)(ws + WS_LW); bf16_t* lwx = lwa + 16 * 80 * 96;
    const float* w_a = a.in[I_W_A] + (size_t)l * 16 * 80 * 80; const float* w_x = a.in[I_W_X] + (size_t)l * 16 * 80 * 80;
    for (int i = gt; i < 16 * 80 * 96; i += NGT) { const int k = i % 96, j = (i / 96) % 80, blk = i / (96 * 80);
        const float va = (k < 80) ? w_a[((size_t)blk * 80 + k) * 80 + j] : 0.f, vx = (k < 80) ? w_x[((size_t)blk * 80 + k) * 80 + j] : 0.f;
        lwa[i] = f2bf(va); lwx[i] = f2bf(vx); }
    { float* lct = (float*)(ws + WS_LCT); const float* cw = a.in[I_CONV_W] + (size_t)l * 4 * 1280;
      for (int c = gt; c < 1280; c += NGT) { f32x4 v0 = {cw[c], cw[1280 + c], cw[2560 + c], cw[3840 + c]};
          f32x4 v1 = {a.in[I_CONV_B][l * 1280 + c], a.in[I_B_A][l * 1280 + c], a.in[I_B_X][l * 1280 + c], -8.f * 1.4426950408889634f * softplus_neg(a.in[I_LAM][l * 1280 + c])};
          *(f32x4*)(lct + c * 8) = v0; *(f32x4*)(lct + c * 8 + 4) = v1; } }
    bf16_t* gmw = (bf16_t*)(ws + WS_GMW); const float* gws = a.in[I_GM_WS] + (size_t)l * 4 * 128 * 128;
    for (int i = gt; i < 4 * 128 * 128; i += NGT) { const int j = i & 127, ii = (i >> 7) & 127; gmw[i] = f2bf(((j >> 6) <= (ii >> 6)) ? gws[i] : 0.f); }
}
__device__ __forceinline__ void rope_table(const Frame& F, unsigned char* ws) {
    const int gt = (F.vcu * NWAVES + F.wave) * 64 + lane_id(), NGT = F.G * NWAVES * 64;
    float* cs = (float*)(ws + WS_ROPE); float* sn = cs + 2048 * 32;
    for (int i = gt; i < 2048 * 32; i += NGT) { const int s = i >> 5, fi = i & 31; const float inv_freq = powf(10000.f, -(float)(2 * fi) / 64.f); const float ang = (float)s * inv_freq;
        cs[i] = cosf(ang); sn[i] = sinf(ang); }
}
__device__ __forceinline__ void norm_rows(const Frame& F, const bool nostore, const float* xin, const bf16_t* o, const float* g_post, float* xout, const float* g_pre, bf16_t* h) {
    const int gw = F.vcu * NWAVES + F.wave, NGW = F.G * NWAVES; const int lane = lane_id();
    f32x4 v[4], ov[4], nv[4]; u32x2 nov[4];
    if (gw < T) {
#pragma unroll
        for (int j = 0; j < 4; ++j) { nv[j] = *((const f32x4*)(xin + (size_t)gw * DM) + lane + 64 * j); nov[j] = o ? *((const u32x2*)(o + (size_t)gw * DM) + lane + 64 * j) : (u32x2){0u, 0u}; }
    }
    for (int m = gw; m < T; m += NGW) {
#pragma unroll
        for (int j = 0; j < 4; ++j) { v[j] = nv[j]; ov[j] = (f32x4){bf_lo(nov[j].x), bf_hi(nov[j].x), bf_lo(nov[j].y), bf_hi(nov[j].y)}; }
        const int mn = m + NGW;
        if (mn < T) {
#pragma unroll
            for (int j = 0; j < 4; ++j) { nv[j] = *((const f32x4*)(xin + (size_t)mn * DM) + lane + 64 * j); if (o) nov[j] = *((const u32x2*)(o + (size_t)mn * DM) + lane + 64 * j); }
        }
        if (o) {
            float s = 0.f;
#pragma unroll
            for (int j = 0; j < 4; ++j) s += (ov[j].x * ov[j].x + ov[j].y * ov[j].y) + (ov[j].z * ov[j].z + ov[j].w * ov[j].w);
            const float r = rsqrtf(wave_sum(s) * (1.f / DM) + EPS);
            f32x4* xo = (f32x4*)(xout + (size_t)m * DM) + lane;
#pragma unroll
            for (int j = 0; j < 4; ++j) { const f32x4 gp = *((const f32x4*)g_post + lane + 64 * j); v[j] = v[j] + ov[j] * r * gp; if (!nostore) xo[64 * j] = v[j]; }
        }
        if (g_pre) {
            float s = 0.f;
#pragma unroll
            for (int j = 0; j < 4; ++j) s += (v[j].x * v[j].x + v[j].y * v[j].y) + (v[j].z * v[j].z + v[j].w * v[j].w);
            const float r = rsqrtf(wave_sum(s) * (1.f / DM) + EPS);
            u32x2* ho = (u32x2*)(h + (size_t)m * DM) + lane;
#pragma unroll
            for (int j = 0; j < 4; ++j) { const f32x4 gp = *((const f32x4*)g_pre + lane + 64 * j); const f32x4 y = v[j] * r * gp; u32x2 w; w.x = pk_bf16(y.x, y.y); w.y = pk_bf16(y.z, y.w); if (!nostore) ho[64 * j] = w; }
        }
    }
}
using g8::UnitD;
constexpr float QSCALE = 0.07216878364870322f * 1.4426950408889634f;

struct SchedA {
    g8::TileOrder ord; const char* A; const char* B;
    __device__ __forceinline__ bool next(int i, UnitD& u) const { int pm, pn; if (!ord.tile(i, pm, pn)) return false;
        u.A = A + (size_t)pm * 256 * 2048; u.B = B + (size_t)pn * 256 * 2048; u.nt = 16; u.pm = pm; u.pn = pn; u.kind = 0; return true; }
};
struct EpiA {
    bf16_t* misc; bf16_t* xc; bf16_t* y; float* slab; bf16_t* kr; const float* cs; const float* sn;
    template <int KIND>
    __device__ __forceinline__ void body(f32x4 (&acc)[2][2][4][2], const UnitD& u, bf16_t* dst, int ld, int wr, int wc, int fr, int fq) const {
        const int pn = u.pn, rowp = wr * 64 + fr, lc = wc * 32 + 8 * fq;
#pragma unroll
        for (int ai = 0; ai < 2; ++ai)
#pragma unroll
            for (int m = 0; m < 4; ++m) { const int rp = rowp + ai * 128 + m * 16; bf16_t* p = dst + ((size_t)u.pm * 256 + rp) * ld + lc;
#pragma unroll
                for (int bj = 0; bj < 2; ++bj) { f32x4 v0 = acc[ai][bj][m][0], v1 = acc[ai][bj][m][1];
                    if (KIND == 0) {
                        if (pn == 2 && bj == 1) { if (wc < 2) { const int g = 4 * wc + fq; const size_t r = (size_t)u.pm * 256 + rp; const int pos = (int)(r & 2047);
                                const f32x4 c4 = *(const f32x4*)(cs + pos * 32 + 4 * g), s4 = *(const f32x4*)(sn + pos * 32 + 4 * g);
                                const f32x4 o1 = v0 * c4 - v1 * s4, o2 = v1 * c4 + v0 * s4; bf16_t* kp = kr + r * 64 + 4 * g;
                                u32x2 w1, w2; w1.x = pk_bf16(o1.x, o1.y); w1.y = pk_bf16(o1.z, o1.w); w2.x = pk_bf16(o2.x, o2.y); w2.y = pk_bf16(o2.z, o2.w);
                                *(u32x2*)kp = w1; *(u32x2*)(kp + 32) = w2; }
                            continue; }
                        float ss = (v0.x * v0.x + v0.y * v0.y) + (v0.z * v0.z + v0.w * v0.w) + (v1.x * v1.x + v1.y * v1.y) + (v1.z * v1.z + v1.w * v1.w);
                        ss += sx<16>(ss); ss = xsum32(ss);
                        if (fq == 0) slab[(((size_t)u.pm * 6 + pn * 2 + bj) * 4 + wc) * 256 + rp] = ss; }
                    if (KIND == 2) { v0.x = fsilu(v0.x); v0.y = fsilu(v0.y); v0.z = fsilu(v0.z); v0.w = fsilu(v0.w); v1.x = fsilu(v1.x); v1.y = fsilu(v1.y); v1.z = fsilu(v1.z); v1.w = fsilu(v1.w); }
                    u32x4 w; w.x = pk_bf16(v0.x, v0.y); w.y = pk_bf16(v0.z, v0.w); w.z = pk_bf16(v1.x, v1.y); w.w = pk_bf16(v1.z, v1.w);
                    *(u32x4*)(p + bj * 128) = w; } }
    }
    __device__ __forceinline__ void operator()(f32x4 (&acc)[2][2][4][2], const UnitD& u, int wr, int wc, int fr, int fq) const {
        const int pn = u.pn;
        if (pn < 3) body<0>(acc, u, misc + 256 * pn, 768, wr, wc, fr, fq);
        else if (pn < 8) body<1>(acc, u, xc + 256 * (pn - 3), 1280, wr, wc, fr, fq);
        else if (pn < 13) body<2>(acc, u, y + 2048 + 256 * (pn - 8), YLD, wr, wc, fr, fq);
        else body<2>(acc, u, y + 1024 + 256 * (pn - 13), YLD, wr, wc, fr, fq);
    }
};

struct SchedZ {
    int v; const char* A; const char* B;
    __device__ __forceinline__ bool next(int i, UnitD& u) const { if (i > 0 || (v & 3) != 0 || v >= 256) return false; const int pm = v >> 2;
        u.A = A + (size_t)pm * 256 * 2048; u.B = B + (size_t)16 * 256 * 2048; u.nt = 16; u.pm = pm; u.pn = 16; u.kind = 0; return true; }
};
struct SchedQKV {
    int v; const char* misc; const char* wq; const char* wkv;
    __device__ __forceinline__ bool next(int i, UnitD& u) const { if (v >= 256) return false; const int role = v & 3, pm = v >> 2; int pn;
        if (role == 0) { if (i > 0) return false; pn = 0; }
        else if (role == 1) { if (i > 4) return false; pn = (i == 0) ? 1 : 5 + i; }
        else { if (i > 3) return false; pn = (i < 2) ? (2 * role - 2 + i) : (10 + 2 * (role - 2) + (i - 2)); }
        u.pm = pm; u.pn = pn; u.kind = 0;
        if (pn < 6) { u.A = misc + (size_t)pm * 256 * 1536; u.B = wq + (size_t)pn * 256 * 768; u.nt = 6; }
        else { u.A = misc + (size_t)pm * 256 * 1536 + 384 * 2; u.B = wkv + (size_t)(pn - 6) * 256 * 768; u.nt = 4; }
        return true; }
};
struct EpiQKV {
    bf16_t* q; bf16_t* y; bf16_t* vv; const float* slab; const float* cs; const float* sn;
    __device__ __forceinline__ void operator()(f32x4 (&acc)[2][2][4][2], const UnitD& u, int wr, int wc, int fr, int fq) const {
        const int pn = u.pn, rowp = wr * 64 + fr, lc = wc * 32 + 8 * fq; const bool isq = pn < 6;
#pragma unroll
        for (int ai = 0; ai < 2; ++ai)
#pragma unroll
            for (int m = 0; m < 4; ++m) { const int rp = rowp + ai * 128 + m * 16; const size_t r = (size_t)u.pm * 256 + rp;
                float s = 0.f; const float* sl = slab + (size_t)u.pm * 6 * 4 * 256 + rp;
                if (isq) {
#pragma unroll
                    for (int e = 0; e < 3; ++e) { const int j = fq * 3 + e; s += sl[(size_t)((j >> 2) * 4 + (j & 3)) * 256]; }
                } else {
#pragma unroll
                    for (int e = 0; e < 2; ++e) { const int j = fq * 2 + e; s += sl[(size_t)((3 + (j >> 2)) * 4 + (j & 3)) * 256]; }
                }
                s += sx<16>(s); s = xsum32(s);
                float rs = rsqrtf(s * (isq ? (1.f / 384.f) : (1.f / 256.f)) + EPS); if (isq) rs *= QSCALE;
#pragma unroll
                for (int bj = 0; bj < 2; ++bj) { f32x4 v0 = acc[ai][bj][m][0] * rs, v1 = acc[ai][bj][m][1] * rs;
                    if (pn < 4) { const int j0 = 256 * pn + 128 * bj + lc; bf16_t* p = q + r * 1536 + (j0 >> 7) * 192 + (j0 & 127);
                        u32x4 w; w.x = pk_bf16(v0.x, v0.y); w.y = pk_bf16(v0.z, v0.w); w.z = pk_bf16(v1.x, v1.y); w.w = pk_bf16(v1.z, v1.w); *(u32x4*)p = w; }
                    else if (pn < 6) { const int jj = 256 * (pn - 4) + 128 * bj + lc, hh = jj >> 6, g = (jj & 63) >> 3; const int pos = (int)(r & 2047);
                        const f32x4 c4 = *(const f32x4*)(cs + pos * 32 + 4 * g), s4 = *(const f32x4*)(sn + pos * 32 + 4 * g);
                        const f32x4 o1 = v0 * c4 - v1 * s4, o2 = v1 * c4 + v0 * s4; bf16_t* p = q + r * 1536 + hh * 192 + 128 + 4 * g;
                        u32x2 w1, w2; w1.x = pk_bf16(o1.x, o1.y); w1.y = pk_bf16(o1.z, o1.w); w2.x = pk_bf16(o2.x, o2.y); w2.y = pk_bf16(o2.z, o2.w);
                        *(u32x2*)p = w1; *(u32x2*)(p + 32) = w2; }
                    else { const int hd = pn - 6; bf16_t* p = (bj == 0) ? (y + r * YLD + hd * 128 + lc) : (vv + r * 1024 + hd * 128 + lc);
                        u32x4 w; w.x = pk_bf16(v0.x, v0.y); w.y = pk_bf16(v0.z, v0.w); w.z = pk_bf16(v1.x, v1.y); w.w = pk_bf16(v1.z, v1.w); *(u32x4*)p = w; } } }
    }
};

struct SchedD {
    g8::TileOrder ord; const char* A; const char* B;
    __device__ __forceinline__ bool next(int i, UnitD& u) const { int pm, pn; if (!ord.tile(i, pm, pn)) return false;
        u.A = A + (size_t)pm * 256 * 2048; u.B = B + (size_t)pn * 256 * 2048; u.nt = 16; u.pm = pm; u.pn = pn; u.kind = 0; return true; }
};
struct EpiD {
    bf16_t* y; bf16_t* v1; bf16_t* g; float* vslab;
    template <int KIND>
    __device__ __forceinline__ void body(f32x4 (&acc)[2][2][4][2], const UnitD& u, int wr, int wc, int fr, int fq) const {
        const int pn = u.pn, rowp = wr * 64 + fr, lc = wc * 32 + 8 * fq;
#pragma unroll
        for (int ai = 0; ai < 2; ++ai)
#pragma unroll
            for (int m = 0; m < 4; ++m) { const size_t r = (size_t)u.pm * 256 + rowp + ai * 128 + m * 16;
                if (KIND == 0) { const f32x4 u0 = acc[ai][0][m][0], u1 = acc[ai][0][m][1], z0 = acc[ai][1][m][0], z1 = acc[ai][1][m][1];
                    u32x4 w; w.x = pk_bf16(u0.x * fsilu(z0.x), u0.y * fsilu(z0.y)); w.y = pk_bf16(u0.z * fsilu(z0.z), u0.w * fsilu(z0.w));
                    w.z = pk_bf16(u1.x * fsilu(z1.x), u1.y * fsilu(z1.y)); w.w = pk_bf16(u1.z * fsilu(z1.z), u1.w * fsilu(z1.w));
                    *(u32x4*)(y + r * YLD + 128 * pn + lc) = w; }
                else {
#pragma unroll
                    for (int bj = 0; bj < 2; ++bj) { f32x4 v0 = acc[ai][bj][m][0], v1_ = acc[ai][bj][m][1]; bf16_t* p;
                        if (KIND == 1) { p = v1 + r * 1024 + 256 * (pn - 8) + 128 * bj + lc;
                            float s1 = (v0.x + v0.y) + (v0.z + v0.w) + (v1_.x + v1_.y) + (v1_.z + v1_.w);
                            float s2 = (v0.x * v0.x + v0.y * v0.y) + (v0.z * v0.z + v0.w * v0.w) + (v1_.x * v1_.x + v1_.y * v1_.y) + (v1_.z * v1_.z + v1_.w * v1_.w);
                            s1 += sx<16>(s1); s1 = xsum32(s1); s2 += sx<16>(s2); s2 = xsum32(s2);
                            if (fq == 0) *(f32x2*)(vslab + r * 64 + (((pn - 8) * 2 + bj) * 4 + wc) * 2) = (f32x2){s1, s2}; }
                        else { p = g + r * 3072 + 256 * (pn - 12) + 128 * bj + lc;
                            v0.x = fsigmoid(v0.x); v0.y = fsigmoid(v0.y); v0.z = fsigmoid(v0.z); v0.w = fsigmoid(v0.w); v1_.x = fsigmoid(v1_.x); v1_.y = fsigmoid(v1_.y); v1_.z = fsigmoid(v1_.z); v1_.w = fsigmoid(v1_.w); }
                        u32x4 w; w.x = pk_bf16(v0.x, v0.y); w.y = pk_bf16(v0.z, v0.w); w.z = pk_bf16(v1_.x, v1_.y); w.w = pk_bf16(v1_.z, v1_.w); *(u32x4*)p = w; } } }
    }
    __device__ __forceinline__ void operator()(f32x4 (&acc)[2][2][4][2], const UnitD& u, int wr, int wc, int fr, int fq) const {
        if (u.pn < 8) body<0>(acc, u, wr, wc, fr, fq); else if (u.pn < 12) body<1>(acc, u, wr, wc, fr, fq); else body<2>(acc, u, wr, wc, fr, fq);
    }
};

struct SchedF {
    g8::TileOrder ord; const char* A; const char* B;
    __device__ __forceinline__ bool next(int i, UnitD& u) const { if (i >= 3) return false; int pm, pn; if (!ord.tile(0, pm, pn)) return false;
        const size_t ko = (i == 0) ? 0 : (i == 1 ? 1024 * 2 : 2048 * 2);
        u.A = A + (size_t)pm * 256 * (YLD * 2) + ko; u.B = B + (size_t)pn * 256 * (YLD * 2) + ko; u.nt = (i == 2) ? 20 : 16; u.pm = pm; u.pn = pn; u.kind = (i < 2) ? (i | g8::KEEP_ACC) : i; return true; }
};
struct EpiF {
    const bf16_t* g; bf16_t* merged;
    __device__ __forceinline__ void operator()(f32x4 (&acc)[2][2][4][2], const UnitD& u, int wr, int wc, int fr, int fq) const {
        const int seg = u.kind & 3, rowp = wr * 64 + fr, lc = wc * 32 + 8 * fq;
#pragma unroll
        for (int ai = 0; ai < 2; ++ai)
#pragma unroll
            for (int m = 0; m < 4; ++m) { const size_t r = (size_t)u.pm * 256 + rowp + ai * 128 + m * 16;
#pragma unroll
                for (int bj = 0; bj < 2; ++bj) { const int col = 256 * u.pn + 128 * bj + lc; const bf16_t* gp = g + r * 3072 + seg * 1024 + col;
                    const u32x4 a = *(const u32x4*)gp; f32x4 f0, f1;
                    f0.x = bf_lo(a.x); f0.y = bf_hi(a.x); f0.z = bf_lo(a.y); f0.w = bf_hi(a.y); f1.x = bf_lo(a.z); f1.y = bf_hi(a.z); f1.z = bf_lo(a.w); f1.w = bf_hi(a.w);
                    if (seg < 2) { const u32x4 b = *(const u32x4*)(gp + 1024);
                        f0.x *= __builtin_amdgcn_rcpf(bf_lo(b.x)); f0.y *= __builtin_amdgcn_rcpf(bf_hi(b.x)); f0.z *= __builtin_amdgcn_rcpf(bf_lo(b.y)); f0.w *= __builtin_amdgcn_rcpf(bf_hi(b.y));
                        f1.x *= __builtin_amdgcn_rcpf(bf_lo(b.z)); f1.y *= __builtin_amdgcn_rcpf(bf_hi(b.z)); f1.z *= __builtin_amdgcn_rcpf(bf_lo(b.w)); f1.w *= __builtin_amdgcn_rcpf(bf_hi(b.w));
                        acc[ai][bj][m][0] *= f0; acc[ai][bj][m][1] *= f1; }
                    else { const f32x4 v0 = acc[ai][bj][m][0] * f0, v1 = acc[ai][bj][m][1] * f1;
                        u32x4 w; w.x = pk_bf16(v0.x, v0.y); w.y = pk_bf16(v0.z, v0.w); w.z = pk_bf16(v1.x, v1.y); w.w = pk_bf16(v1.z, v1.w);
                        *(u32x4*)(merged + r * 1024 + col) = w; } } }
    }
};

struct SchedG1 {
    int v; const char* A; const char* B;
    __device__ __forceinline__ bool next(int i, UnitD& u) const { if (i > 0 || v >= 256) return false; const int pm = v >> 2, pn = v & 3;
        u.A = A + (size_t)pm * 256 * 2048; u.B = B + (size_t)pn * 256 * 2048; u.nt = 16; u.pm = pm; u.pn = pn; u.kind = 0; return true; }
};
struct EpiNorm {
    const float* xin; float* xout; bf16_t* h; const float* g_post; const float* g_pre;
    float* slots; unsigned* cnt;
    __device__ __forceinline__ void exchange(const f32x4 (&v)[2][2][4][2], int pm, int pn, int wr, int wc, int fr, int fq, LAS unsigned char* lds, int wid, int lane, float* sl, unsigned* cn) const {
        LAS float* P = (LAS float*)lds; LAS float* S = (LAS float*)(lds + 4096);
#pragma unroll
        for (int ai = 0; ai < 2; ++ai)
#pragma unroll
            for (int m = 0; m < 4; ++m) { float s = 0.f;
#pragma unroll
                for (int bj = 0; bj < 2; ++bj)
#pragma unroll
                    for (int n = 0; n < 2; ++n) { const f32x4 x = v[ai][bj][m][n]; s += (x.x * x.x + x.y * x.y) + (x.z * x.z + x.w * x.w); }
                s += sx<16>(s); s = xsum32(s);
                if (fq == 0) P[(ai * 128 + wr * 64 + m * 16 + fr) * 4 + wc] = s; }
        asm volatile("s_waitcnt lgkmcnt(0)" ::: "memory"); __builtin_amdgcn_s_barrier(); asm volatile("" ::: "memory");
        const int row = wid * 32 + (lane & 31);
        if (lane < 32) { const f32x4 p4 = *(const LAS f32x4*)(P + row * 4); const float tot = (p4.x + p4.y) + (p4.z + p4.w);
            __hip_atomic_store((unsigned*)sl + ((size_t)pm * 256 + row) * 4 + pn, __float_as_uint(tot), __ATOMIC_RELAXED, __HIP_MEMORY_SCOPE_AGENT); }
        asm volatile("s_waitcnt vmcnt(0)" ::: "memory");
        if (lane == 0) __hip_atomic_fetch_add(cn, 1u, __ATOMIC_RELAXED, __HIP_MEMORY_SCOPE_AGENT);
        if (wid == 0) { for (unsigned sp = 0; sp < (1u << 20); ++sp) { if ((unsigned)__builtin_amdgcn_readfirstlane(__hip_atomic_load(cn, __ATOMIC_RELAXED, __HIP_MEMORY_SCOPE_AGENT)) >= 32u) break; __builtin_amdgcn_s_sleep(2); } }
        asm volatile("s_waitcnt vmcnt(0) lgkmcnt(0)" ::: "memory"); __builtin_amdgcn_s_barrier(); asm volatile("" ::: "memory");
        if (lane < 32) { const unsigned* sp4 = (const unsigned*)sl + ((size_t)pm * 256 + row) * 4; float tot = 0.f;
#pragma unroll
            for (int t = 0; t < 4; ++t) tot += __uint_as_float(__hip_atomic_load(sp4 + t, __ATOMIC_RELAXED, __HIP_MEMORY_SCOPE_AGENT));
            S[row] = rsqrtf(tot * (1.f / 1024.f) + EPS); }
        asm volatile("s_waitcnt lgkmcnt(0)" ::: "memory"); __builtin_amdgcn_s_barrier(); asm volatile("" ::: "memory");
    }
    __device__ __forceinline__ void fused(f32x4 (&acc)[2][2][4][2], const UnitD& u, int wr, int wc, int fr, int fq, LAS unsigned char* lds, int wid, int lane) const {
        const LAS float* S = (const LAS float*)(lds + 4096);
        const int lc = wc * 32 + 8 * fq, col0 = 256 * u.pn + lc;
        exchange(acc, u.pm, u.pn, wr, wc, fr, fq, lds, wid, lane, slots, cnt + u.pm * 16);
#pragma unroll
        for (int ai = 0; ai < 2; ++ai)
#pragma unroll
            for (int m = 0; m < 4; ++m) { const int r = ai * 128 + wr * 64 + m * 16 + fr; const float rs = S[r]; const size_t off = ((size_t)u.pm * 256 + r) * 1024 + col0;
#pragma unroll
                for (int bj = 0; bj < 2; ++bj) { const f32x4 x0 = *(const f32x4*)(xin + off + bj * 128), x1 = *(const f32x4*)(xin + off + bj * 128 + 4);
                    const f32x4 g0 = *(const f32x4*)(g_post + col0 + bj * 128), g1 = *(const f32x4*)(g_post + col0 + bj * 128 + 4);
                    const f32x4 y0 = x0 + acc[ai][bj][m][0] * rs * g0, y1 = x1 + acc[ai][bj][m][1] * rs * g1;
                    acc[ai][bj][m][0] = y0; acc[ai][bj][m][1] = y1;
                    *(f32x4*)(xout + off + bj * 128) = y0; *(f32x4*)(xout + off + bj * 128 + 4) = y1; }
                if (m & 1) asm volatile("" ::: "memory"); }
        if (g_pre) {
            exchange(acc, u.pm, u.pn, wr, wc, fr, fq, lds, wid, lane, slots + (size_t)T * 4, cnt + 64 * 16 + u.pm * 16);
#pragma unroll
            for (int ai = 0; ai < 2; ++ai)
#pragma unroll
                for (int m = 0; m < 4; ++m) { const int r = ai * 128 + wr * 64 + m * 16 + fr; const float rs = S[r]; const size_t off = ((size_t)u.pm * 256 + r) * 1024 + col0;
#pragma unroll
                    for (int bj = 0; bj < 2; ++bj) { const f32x4 g0 = *(const f32x4*)(g_pre + col0 + bj * 128), g1 = *(const f32x4*)(g_pre + col0 + bj * 128 + 4);
                        const f32x4 y0 = acc[ai][bj][m][0] * rs * g0, y1 = acc[ai][bj][m][1] * rs * g1;
                        u32x4 w; w.x = pk_bf16(y0.x, y0.y); w.y = pk_bf16(y0.z, y0.w); w.z = pk_bf16(y1.x, y1.y); w.w = pk_bf16(y1.z, y1.w);
                        *(u32x4*)(h + off + bj * 128) = w; } }
        }
    }
    __device__ __forceinline__ void operator()(f32x4 (&)[2][2][4][2], const UnitD&, int, int, int, int) const {}
};
typedef float f32x2v __attribute__((ext_vector_type(2)));

constexpr int LRU_HIN_OFF = RING_BYTES + 1024;
template <int PASS>
__device__ __forceinline__ void lru_item(const Frame& F, const Args& a, const unsigned char* ws, const bool nostore, int l, int item, const bf16_t* xcb, bf16_t* y, float* agg) {
    const int b = item >> 5, k = item & 31; const size_t r0 = (size_t)b * SEQ + (size_t)k * 64;
    int lane_ = lane_id(); asm volatile("" : "+v"(lane_));
    const int lane = lane_, cl = lane & 15, kg = lane >> 4;
    LAS unsigned char* xt = F.lds + F.wave * 16384;
    const bf16_t* lwa = (const bf16_t*)(ws + WS_LW); const bf16_t* lwx = lwa + 16 * 80 * 96;
    const float* lct = (const float*)(ws + WS_LCT);
    LAS float* hin_l = (LAS float*)(F.lds + LRU_HIN_OFF);
    if (PASS == 2) {
        for (int c = F.wave * 64 + lane; c < 1280; c += 512) { const float* ag = agg + ((size_t)b * 32 * 1280 + c) * 2; float h = 0.f;
#pragma unroll 8
            for (int j = 0; j < k; ++j) { const f32x2v ab = *(const f32x2v*)(ag + (size_t)j * 2560); h = ab.x * h + ab.y; }
            hin_l[c] = h; }
        LDS_WAIT(); __syncthreads();
    }
#pragma unroll 1
    for (int bi = 0; bi < 2; ++bi) {
        const int blk = 2 * F.wave + bi;
        {
            u32x4 xch[11]; int ln = lane; asm volatile("" : "+v"(ln));
            const bf16_t* xbase = xcb + (r0 - 3) * 1280 + blk * 80;
#pragma unroll
            for (int i = 0; i < 11; ++i) { const int idx = ln + 64 * i; const int row = idx / 10, ch = idx - row * 10; xch[i] = (u32x4){0u, 0u, 0u, 0u};
                if (idx < 670 && !(k == 0 && row < 3)) xch[i] = *(const u32x4*)(xbase + (unsigned)(row * 1280 + ch * 8)); }
#pragma unroll
            for (int i = 0; i < 11; ++i) { const int idx = ln + 64 * i; const int row = idx / 10, ch = idx - row * 10; if (idx < 670) *(LAS u32x4*)(xt + row * 208 + ch * 16) = xch[i]; }
            LAS u32x4* z = (LAS u32x4*)(xt + (lane + 3) * 208 + 160); z[0] = (u32x4){0u, 0u, 0u, 0u}; z[1] = (u32x4){0u, 0u, 0u, 0u};
        }
        LDS_WAIT(); asm volatile("" ::: "memory");
#pragma unroll
        for (int ct = 0; ct < 5; ++ct) { const int c = blk * 80 + 16 * ct + cl; const f32x4 cw = *(const f32x4*)(lct + c * 8); const float cb = lct[c * 8 + 4];
            float xv[4][7];
#pragma unroll
            for (int rt = 0; rt < 4; ++rt)
#pragma unroll
                for (int j = 0; j < 7; ++j) xv[rt][j] = bf1(*(const LAS bf16_t*)(xt + (16 * rt + 4 * kg + j) * 208 + (16 * ct + cl) * 2));
            asm volatile("" ::: "memory");
#pragma unroll
            for (int rt = 0; rt < 4; ++rt)
#pragma unroll
                for (int e = 0; e < 4; ++e) { const float v = cb + cw.x * xv[rt][e] + cw.y * xv[rt][e + 1] + cw.z * xv[rt][e + 2] + cw.w * xv[rt][e + 3];
                    *(LAS bf16_t*)(xt + (16 * rt + 4 * kg + e + 3) * 208 + (16 * ct + cl) * 2) = f2bf(v); }
            asm volatile("" ::: "memory"); }
        LDS_WAIT(); asm volatile("" ::: "memory");
        bf16x8 af[4][3];
#pragma unroll
        for (int rt = 0; rt < 4; ++rt)
#pragma unroll
            for (int ks = 0; ks < 3; ++ks) af[rt][ks] = *(const LAS bf16x8*)(xt + (16 * rt + cl + 3) * 208 + (32 * ks + 8 * kg) * 2);
        bf16x8 wA[2][3], wX[2][3];
#pragma unroll
        for (int ks = 0; ks < 3; ++ks) { const size_t wo = ((size_t)blk * 80 + cl) * 96 + 32 * ks + 8 * kg; wA[0][ks] = *(const bf16x8*)(lwa + wo); wX[0][ks] = *(const bf16x8*)(lwx + wo); }
#pragma unroll
        for (int ct = 0; ct < 5; ++ct) { const int c = blk * 80 + 16 * ct + cl; const int cur = ct & 1;
            if (ct + 1 < 5) {
#pragma unroll
                for (int ks = 0; ks < 3; ++ks) { const size_t wo = ((size_t)blk * 80 + 16 * (ct + 1) + cl) * 96 + 32 * ks + 8 * kg; wA[cur ^ 1][ks] = *(const bf16x8*)(lwa + wo); wX[cur ^ 1][ks] = *(const bf16x8*)(lwx + wo); } }
            const f32x4 c1 = *(const f32x4*)(lct + c * 8 + 4); const float ba_c = c1.y, bx_c = c1.z, sp8 = c1.w;
            f32x4 ra[4], rx[4];
#pragma unroll
            for (int rt = 0; rt < 4; ++rt) { ra[rt] = (f32x4){0.f, 0.f, 0.f, 0.f}; rx[rt] = (f32x4){0.f, 0.f, 0.f, 0.f}; }
#pragma unroll
            for (int ks = 0; ks < 3; ++ks)
#pragma unroll
                for (int rt = 0; rt < 4; ++rt) { ra[rt] = __builtin_amdgcn_mfma_f32_16x16x32_bf16(af[rt][ks], wA[cur][ks], ra[rt], 0, 0, 0); rx[rt] = __builtin_amdgcn_mfma_f32_16x16x32_bf16(af[rt][ks], wX[cur][ks], rx[rt], 0, 0, 0); }
            float hin = (PASS == 2) ? hin_l[c] : 0.f; float totA = 1.f, totB = 0.f;
#pragma unroll
            for (int rt = 0; rt < 4; ++rt) { float av[4], bv[4];
#pragma unroll
                for (int e = 0; e < 4; ++e) { const float r = fsigmoid(ra[rt][e] + ba_c), ig = fsigmoid(rx[rt][e] + bx_c);
                    const float aa = fexp2(sp8 * r); const float mult = __builtin_amdgcn_sqrtf(fmaxf(1.f - aa * aa, 0.f));
                    const float xcv = bf1(*(const LAS bf16_t*)(xt + (16 * rt + 4 * kg + e + 3) * 208 + (16 * ct + cl) * 2));
                    av[e] = aa; bv[e] = mult * ig * xcv; }
                float sA = av[0], sB = bv[0];
#pragma unroll
                for (int e = 1; e < 4; ++e) { sB = av[e] * sB + bv[e]; sA *= av[e]; }
                float iA = sA, iB = sB;
                { const float pA = __shfl(iA, lane - 16), pB = __shfl(iB, lane - 16); if (kg >= 1) { iB = iA * pB + iB; iA = iA * pA; } }
                { const float pA = __shfl(iA, lane - 32), pB = __shfl(iB, lane - 32); if (kg >= 2) { iB = iA * pB + iB; iA = iA * pA; } }
                const float tA = __shfl(iA, 48 + cl), tB = __shfl(iB, 48 + cl);
                if (PASS == 1) { totB = tA * totB + tB; totA *= tA; }
                else {
                    float eA = __shfl(iA, lane - 16), eB = __shfl(iB, lane - 16); if (kg == 0) { eA = 1.f; eB = 0.f; }
                    float h = eA * hin + eB;
#pragma unroll
                    for (int e = 0; e < 4; ++e) { h = av[e] * h + bv[e]; *(LAS bf16_t*)(xt + (16 * rt + 4 * kg + e + 3) * 208 + (16 * ct + cl) * 2) = f2bf(h); }
                    hin = tA * hin + tB;
                }
            }
            if (PASS == 1) { if (kg == 0) *(f32x2v*)(agg + (((size_t)b * 32 + k) * 1280 + c) * 2) = (f32x2v){totA, totB}; }
        }
        LDS_WAIT(); asm volatile("" ::: "memory");
        if (PASS == 2) {
            int ln = lane; asm volatile("" : "+v"(ln));
            bf16_t* ybase = y + r0 * YLD + 2048 + blk * 80; u32x4 zc[10];
#pragma unroll
            for (int i = 0; i < 10; ++i) { const int idx = ln + 64 * i; const int row = idx / 10, ch = idx - row * 10; zc[i] = *(const u32x4*)(ybase + (unsigned)(row * YLD + ch * 8)); }
#pragma unroll
            for (int i = 0; i < 10; ++i) { const int idx = ln + 64 * i; const int row = idx / 10, ch = idx - row * 10; const u32x4 hv = *(const LAS u32x4*)(xt + (row + 3) * 208 + ch * 16); u32x4 o;
                o.x = pk_bf16(bf_lo(hv.x) * bf_lo(zc[i].x), bf_hi(hv.x) * bf_hi(zc[i].x)); o.y = pk_bf16(bf_lo(hv.y) * bf_lo(zc[i].y), bf_hi(hv.y) * bf_hi(zc[i].y));
                o.z = pk_bf16(bf_lo(hv.z) * bf_lo(zc[i].z), bf_hi(hv.z) * bf_hi(zc[i].z)); o.w = pk_bf16(bf_lo(hv.w) * bf_lo(zc[i].w), bf_hi(hv.w) * bf_hi(zc[i].w));
                if (!nostore) *(u32x4*)(ybase + (unsigned)(row * YLD + ch * 8)) = o; }
            LDS_WAIT(); asm volatile("" ::: "memory");
        }
    }
    if (PASS == 2) __syncthreads();
}

constexpr int CW_LRUF = 8192;
__device__ __forceinline__ void lru_single(const Frame& F, const unsigned char* ws, unsigned* ctl, const bool nostore, int l, int item, const bf16_t* xcb, bf16_t* y, float* agg) {
    const int b = item >> 5, k = item & 31; const size_t r0 = (size_t)b * SEQ + (size_t)k * 64;
    int lane_ = lane_id(); asm volatile("" : "+v"(lane_));
    const int lane = lane_, cl = lane & 15, kg = lane >> 4;
    LAS unsigned char* xt = F.lds + F.wave * 16384;
    const bf16_t* lwa = (const bf16_t*)(ws + WS_LW); const bf16_t* lwx = lwa + 16 * 80 * 96;
    const float* lct = (const float*)(ws + WS_LCT);
    const unsigned epoch = (unsigned)l + 1u;
    unsigned* flags = ctl + CW_LRUF + b * 32 * 16;
    unsigned long long* agg64 = (unsigned long long*)agg;
#pragma unroll 1
    for (int bi = 0; bi < 2; ++bi) {
        const int blk = 2 * F.wave + bi;
        {
            u32x4 xch[11]; int ln = lane; asm volatile("" : "+v"(ln));
            const bf16_t* xbase = xcb + (r0 - 3) * 1280 + blk * 80;
#pragma unroll
            for (int i = 0; i < 11; ++i) { const int idx = ln + 64 * i; const int row = idx / 10, ch = idx - row * 10; xch[i] = (u32x4){0u, 0u, 0u, 0u};
                if (idx < 670 && !(k == 0 && row < 3)) xch[i] = *(const u32x4*)(xbase + (unsigned)(row * 1280 + ch * 8)); }
#pragma unroll
            for (int i = 0; i < 11; ++i) { const int idx = ln + 64 * i; const int row = idx / 10, ch = idx - row * 10; if (idx < 670) *(LAS u32x4*)(xt + row * 208 + ch * 16) = xch[i]; }
            LAS u32x4* z = (LAS u32x4*)(xt + (lane + 3) * 208 + 160); z[0] = (u32x4){0u, 0u, 0u, 0u}; z[1] = (u32x4){0u, 0u, 0u, 0u};
        }
        LDS_WAIT(); asm volatile("" ::: "memory");
#pragma unroll
        for (int ct = 0; ct < 5; ++ct) { const int c = blk * 80 + 16 * ct + cl; const f32x4 cw = *(const f32x4*)(lct + c * 8); const float cb = lct[c * 8 + 4];
            float xv[4][7];
#pragma unroll
            for (int rt = 0; rt < 4; ++rt)
#pragma unroll
                for (int j = 0; j < 7; ++j) xv[rt][j] = bf1(*(const LAS bf16_t*)(xt + (16 * rt + 4 * kg + j) * 208 + (16 * ct + cl) * 2));
            asm volatile("" ::: "memory");
#pragma unroll
            for (int rt = 0; rt < 4; ++rt)
#pragma unroll
                for (int e = 0; e < 4; ++e) { const float v = cb + cw.x * xv[rt][e] + cw.y * xv[rt][e + 1] + cw.z * xv[rt][e + 2] + cw.w * xv[rt][e + 3];
                    *(LAS bf16_t*)(xt + (16 * rt + 4 * kg + e + 3) * 208 + (16 * ct + cl) * 2) = f2bf(v); }
            asm volatile("" ::: "memory"); }
        LDS_WAIT(); asm volatile("" ::: "memory");
        bf16x8 af[4][3];
#pragma unroll
        for (int rt = 0; rt < 4; ++rt)
#pragma unroll
            for (int ks = 0; ks < 3; ++ks) af[rt][ks] = *(const LAS bf16x8*)(xt + (16 * rt + cl + 3) * 208 + (32 * ks + 8 * kg) * 2);
        bf16x8 wA[3], wX[3];
#pragma unroll
        for (int ks = 0; ks < 3; ++ks) { const size_t wo = ((size_t)blk * 80 + cl) * 96 + 32 * ks + 8 * kg; wA[ks] = *(const bf16x8*)(lwa + wo); wX[ks] = *(const bf16x8*)(lwx + wo); }
        unsigned pk[5][4][2];
#pragma unroll
        for (int ct = 0; ct < 5; ++ct) { const int c = blk * 80 + 16 * ct + cl;
            const f32x4 c1 = *(const f32x4*)(lct + c * 8 + 4); const float ba_c = c1.y, bx_c = c1.z, sp8 = c1.w;
            f32x4 ra[4], rx[4];
#pragma unroll
            for (int rt = 0; rt < 4; ++rt) { ra[rt] = (f32x4){0.f, 0.f, 0.f, 0.f}; rx[rt] = (f32x4){0.f, 0.f, 0.f, 0.f}; }
#pragma unroll
            for (int ks = 0; ks < 3; ++ks)
#pragma unroll
                for (int rt = 0; rt < 4; ++rt) { ra[rt] = __builtin_amdgcn_mfma_f32_16x16x32_bf16(af[rt][ks], wA[ks], ra[rt], 0, 0, 0); rx[rt] = __builtin_amdgcn_mfma_f32_16x16x32_bf16(af[rt][ks], wX[ks], rx[rt], 0, 0, 0); }
            if (ct + 1 < 5) {
#pragma unroll
                for (int ks = 0; ks < 3; ++ks) { const size_t wo = ((size_t)blk * 80 + 16 * (ct + 1) + cl) * 96 + 32 * ks + 8 * kg; wA[ks] = *(const bf16x8*)(lwa + wo); wX[ks] = *(const bf16x8*)(lwx + wo); } }
            float av[4][4], bv[4][4], iA[4], iB[4];
#pragma unroll
            for (int rt = 0; rt < 4; ++rt) {
#pragma unroll
                for (int e = 0; e < 4; ++e) { const float r = fsigmoid(ra[rt][e] + ba_c), ig = fsigmoid(rx[rt][e] + bx_c);
                    const float aa = fexp2(sp8 * r); const float mult = __builtin_amdgcn_sqrtf(fmaxf(1.f - aa * aa, 0.f));
                    const float xcv = bf1(*(const LAS bf16_t*)(xt + (16 * rt + 4 * kg + e + 3) * 208 + (16 * ct + cl) * 2));
                    av[rt][e] = aa; bv[rt][e] = mult * ig * xcv; }
                float sA = av[rt][0], sB = bv[rt][0];
#pragma unroll
                for (int e = 1; e < 4; ++e) { sB = av[rt][e] * sB + bv[rt][e]; sA *= av[rt][e]; }
                iA[rt] = sA; iB[rt] = sB; }
            { float pA[4], pB[4];
#pragma unroll
              for (int rt = 0; rt < 4; ++rt) { pA[rt] = __shfl(iA[rt], lane - 16); pB[rt] = __shfl(iB[rt], lane - 16); }
#pragma unroll
              for (int rt = 0; rt < 4; ++rt) if (kg >= 1) { iB[rt] = iA[rt] * pB[rt] + iB[rt]; iA[rt] = iA[rt] * pA[rt]; }
#pragma unroll
              for (int rt = 0; rt < 4; ++rt) { pA[rt] = __shfl(iA[rt], lane - 32); pB[rt] = __shfl(iB[rt], lane - 32); }
#pragma unroll
              for (int rt = 0; rt < 4; ++rt) if (kg >= 2) { iB[rt] = iA[rt] * pB[rt] + iB[rt]; iA[rt] = iA[rt] * pA[rt]; } }
            float tA[4], tB[4], eA[4], eB[4];
#pragma unroll
            for (int rt = 0; rt < 4; ++rt) { tA[rt] = __shfl(iA[rt], 48 + cl); tB[rt] = __shfl(iB[rt], 48 + cl); eA[rt] = __shfl(iA[rt], lane - 16); eB[rt] = __shfl(iB[rt], lane - 16); }
            float hl = 0.f, pl = 1.f;
#pragma unroll
            for (int rt = 0; rt < 4; ++rt) { if (kg == 0) { eA[rt] = 1.f; eB[rt] = 0.f; }
                float h = eA[rt] * hl + eB[rt], pp = eA[rt] * pl, P[4];
#pragma unroll
                for (int e = 0; e < 4; ++e) { h = av[rt][e] * h + bv[rt][e]; pp *= av[rt][e]; P[e] = pp;
                    *(LAS bf16_t*)(xt + (16 * rt + 4 * kg + e + 3) * 208 + (16 * ct + cl) * 2) = f2bf(h); }
                pk[ct][rt][0] = pk_bf16(P[0], P[1]); pk[ct][rt][1] = pk_bf16(P[2], P[3]);
                hl = tA[rt] * hl + tB[rt]; pl *= tA[rt];
            }
            if (kg == 0) __hip_atomic_store(agg64 + ((size_t)b * 32 + k) * 1280 + c, ((unsigned long long)__float_as_uint(hl) << 32) | (unsigned long long)__float_as_uint(pl), __ATOMIC_RELAXED, __HIP_MEMORY_SCOPE_AGENT);
        }
        asm volatile("s_waitcnt vmcnt(0)" ::: "memory");
        if (lane == 0) __hip_atomic_store(flags + k * 16 + blk, epoch, __ATOMIC_RELAXED, __HIP_MEMORY_SCOPE_AGENT);
        if (k > 0) {
            for (unsigned spins = 0; spins < (1u << 20); ++spins) {
                const unsigned f = (lane < k) ? __hip_atomic_load(flags + lane * 16 + blk, __ATOMIC_RELAXED, __HIP_MEMORY_SCOPE_AGENT) : epoch;
                if (__all(f == epoch)) break;
                __builtin_amdgcn_s_sleep(2);
            }
            float fa[5], fb[5];
#pragma unroll
            for (int ct = 0; ct < 5; ++ct) { fa[ct] = 1.f; fb[ct] = 0.f; }
            const int j0 = (k * kg) >> 2, j1 = (k * (kg + 1)) >> 2;
            const unsigned long long* ag0 = agg64 + (size_t)b * 32 * 1280 + blk * 80 + cl;
            {
                unsigned long long w[8][5];
#pragma unroll
                for (int jj = 0; jj < 8; ++jj)
#pragma unroll
                    for (int ct = 0; ct < 5; ++ct) w[jj][ct] = (j0 + jj < j1) ? __hip_atomic_load(ag0 + (size_t)(j0 + jj) * 1280 + 16 * ct, __ATOMIC_RELAXED, __HIP_MEMORY_SCOPE_AGENT) : 0x000000003f800000ull;
#pragma unroll
                for (int jj = 0; jj < 8; ++jj)
#pragma unroll
                    for (int ct = 0; ct < 5; ++ct) { const float A = __uint_as_float((unsigned)w[jj][ct]), B = __uint_as_float((unsigned)(w[jj][ct] >> 32)); fb[ct] = A * fb[ct] + B; fa[ct] *= A; } }
#pragma unroll
            for (int ct = 0; ct < 5; ++ct) { float iA = fa[ct], iB = fb[ct];
                { const float pA = __shfl(iA, lane - 16), pB = __shfl(iB, lane - 16); if (kg >= 1) { iB = iA * pB + iB; iA = iA * pA; } }
                { const float pA = __shfl(iA, lane - 32), pB = __shfl(iB, lane - 32); if (kg >= 2) { iB = iA * pB + iB; iA = iA * pA; } }
                const float cin = __shfl(iB, 48 + cl);
#pragma unroll
                for (int rt = 0; rt < 4; ++rt) { const float P[4] = {bf_lo(pk[ct][rt][0]), bf_hi(pk[ct][rt][0]), bf_lo(pk[ct][rt][1]), bf_hi(pk[ct][rt][1])};
#pragma unroll
                    for (int e = 0; e < 4; ++e) { LAS bf16_t* hp = (LAS bf16_t*)(xt + (16 * rt + 4 * kg + e + 3) * 208 + (16 * ct + cl) * 2); *hp = f2bf(bf1(*hp) + P[e] * cin); } } }
        }
        LDS_WAIT(); asm volatile("" ::: "memory");
        {
            int ln = lane; asm volatile("" : "+v"(ln));
            bf16_t* ybase = y + r0 * YLD + 2048 + blk * 80; u32x4 zc[10];
#pragma unroll
            for (int i = 0; i < 10; ++i) { const int idx = ln + 64 * i; const int row = idx / 10, ch = idx - row * 10; zc[i] = *(const u32x4*)(ybase + (unsigned)(row * YLD + ch * 8)); }
#pragma unroll
            for (int i = 0; i < 10; ++i) { const int idx = ln + 64 * i; const int row = idx / 10, ch = idx - row * 10; const u32x4 hv = *(const LAS u32x4*)(xt + (row + 3) * 208 + ch * 16); u32x4 o;
                o.x = pk_bf16(bf_lo(hv.x) * bf_lo(zc[i].x), bf_hi(hv.x) * bf_hi(zc[i].x)); o.y = pk_bf16(bf_lo(hv.y) * bf_lo(zc[i].y), bf_hi(hv.y) * bf_hi(zc[i].y));
                o.z = pk_bf16(bf_lo(hv.z) * bf_lo(zc[i].z), bf_hi(hv.z) * bf_hi(zc[i].z)); o.w = pk_bf16(bf_lo(hv.w) * bf_lo(zc[i].w), bf_hi(hv.w) * bf_hi(zc[i].w));
                if (!nostore) *(u32x4*)(ybase + (unsigned)(row * YLD + ch * 8)) = o; }
            LDS_WAIT(); asm volatile("" ::: "memory");
        }
    }
}
__device__ __forceinline__ void phaseB_lru(const Frame& F, const unsigned char* ws, unsigned* ctl, const bool nostore, int l, const bf16_t* xc, bf16_t* y, float* agg) {
    for (int item = F.vcu; item < NBATCH * 32; item += F.G) lru_single(F, ws, ctl, nostore, l, item, xc, y, agg);
}

__device__ __forceinline__ void phaseB_extra(const Frame& F, const Args& a, const unsigned char* ws, int l, const bf16_t* misc, bf16_t* kr, const bf16_t* xc, float* agg, const float* cs, const float* sn) {
    for (int item = F.vcu; item < NBATCH * 32; item += F.G) lru_item<1>(F, a, ws, false, l, item, xc, nullptr, agg);
}

namespace att {
constexpr int SHM_V = 64 * 128 * 2, SHM_K = 64 * 192 * 2, OFF_K = 2 * SHM_V, OFF_WS = OFF_K + 2 * SHM_K, LDS_TOTAL = OFF_WS + 8 * 64 * 4;
constexpr float THR = 8.f;
constexpr float NEGBIG = -1e30f;
constexpr int KVBLK_ = 64;
#define ATT_SBAR() __builtin_amdgcn_sched_barrier(0)
__device__ __forceinline__ int crow(int r, int hi) { return (r & 3) + 8 * (r >> 2) + 4 * hi; }
__device__ __forceinline__ int koff(int row, int sub, int chunk) { return sub * 8192 + row * 128 + ((chunk ^ ((row >> 1) & 7)) << 4); }
__device__ __forceinline__ void partialSM(f32x16& p0, f32x16& p1, float& m_reg, float& alpha) {
    float pmax = p0[0];
#pragma unroll
    for (int r = 1; r < 16; ++r) pmax = fmaxf(pmax, p0[r]);
#pragma unroll
    for (int r = 0; r < 16; ++r) pmax = fmaxf(pmax, p1[r]);
    { auto rr = __builtin_amdgcn_permlane32_swap(__float_as_uint(pmax), __float_as_uint(pmax), false, false); pmax = fmaxf(__uint_as_float(rr[0]), __uint_as_float(rr[1])); }
    float mn;
    if (__builtin_expect(__all(pmax - m_reg <= THR), 1)) { mn = m_reg; alpha = 1.f; }
    else { mn = fmaxf(m_reg, pmax); alpha = __builtin_amdgcn_exp2f(m_reg - mn); m_reg = mn; }
#pragma unroll
    for (int r = 0; r < 16; ++r) p0[r] = __builtin_amdgcn_exp2f(p0[r] - mn);
#pragma unroll
    for (int r = 0; r < 16; ++r) p1[r] = p1[r] - mn;
}
__device__ __forceinline__ void finishSM(f32x16& p0, f32x16& p1, float alpha, float& l_reg, bf16x8& pa0, bf16x8& pa1, bf16x8& pa2, bf16x8& pa3) {
#pragma unroll
    for (int r = 0; r < 16; ++r) p1[r] = __builtin_amdgcn_exp2f(p1[r]);
    float ps = 0.f;
#pragma unroll
    for (int r = 0; r < 16; ++r) ps += p0[r];
#pragma unroll
    for (int r = 0; r < 16; ++r) ps += p1[r];
    { auto rr = __builtin_amdgcn_permlane32_swap(__float_as_uint(ps), __float_as_uint(ps), false, false); ps = __uint_as_float(rr[0]) + __uint_as_float(rr[1]); }
    l_reg = l_reg * alpha + ps;
#define ATT_PK4(P, BASE, OUT) do { unsigned a0 = pk_bf16(P[BASE + 0], P[BASE + 1]), a1 = pk_bf16(P[BASE + 2], P[BASE + 3]);   \
    unsigned b0 = pk_bf16(P[BASE + 4], P[BASE + 5]), b1 = pk_bf16(P[BASE + 6], P[BASE + 7]);                              \
    auto r0 = __builtin_amdgcn_permlane32_swap(a0, b0, false, false); auto r1 = __builtin_amdgcn_permlane32_swap(a1, b1, false, false); \
    u32x4 w = {r0[0], r1[0], r0[1], r1[1]}; OUT = __builtin_bit_cast(bf16x8, w); } while (0)
    ATT_PK4(p0, 0, pa0); ATT_PK4(p0, 8, pa1); ATT_PK4(p1, 0, pa2); ATT_PK4(p1, 8, pa3);
#undef ATT_PK4
}
__device__ __forceinline__ void qkt(f32x16& p0, f32x16& p1, const LAS unsigned char* Ks, const bf16x8* qr, int r32, int hi) {
    p0 = f32x16{}; p1 = f32x16{};
#pragma unroll
    for (int d0 = 0; d0 < 12; ++d0) { const int sub = d0 >> 2, chunk = (d0 & 3) * 2 + hi;
        const bf16x8 b0 = *(const LAS bf16x8*)(Ks + koff(r32, sub, chunk));
        const bf16x8 b1 = *(const LAS bf16x8*)(Ks + koff(32 + r32, sub, chunk));
        p0 = __builtin_amdgcn_mfma_f32_32x32x16_bf16(b0, qr[d0], p0, 0, 0, 0);
        p1 = __builtin_amdgcn_mfma_f32_32x32x16_bf16(b1, qr[d0], p1, 0, 0, 0);
        if ((d0 & 3) == 3) ATT_SBAR(); }
}
__device__ __forceinline__ int v_st(int k, int c) { const int kk = (k & ~0xC) | ((k & 4) << 1) | ((k & 8) >> 1); return ((kk >> 3) * 4 + (c >> 5)) * 512 + ((kk & 7) * 32 + (c & 31)) * 2; }
__device__ __forceinline__ int v_rd_base(int lane) { return ((lane & 3) << 3) | (((lane >> 2) & 3) << 6) | (((lane >> 4) & 1) << 5) | (((lane >> 5) & 1) << 8); }
constexpr int v_rd_off(int d0, int ks, int half) { return d0 * 512 + ks * 4096 + half * 2048; }
template <int OFF> __device__ __forceinline__ s16x4 tr_read(int vb) { s16x4 r; asm volatile("ds_read_b64_tr_b16 %0, %1 offset:%2" : "=&v"(r) : "v"(vb), "i"(OFF) : "memory"); return r; }
template <int D0> __device__ __forceinline__ void pv_one(f32x16& od, int vb, bf16x8 pa0, bf16x8 pa1, bf16x8 pa2, bf16x8 pa3) {
    const s16x4 l0 = tr_read<v_rd_off(D0, 0, 0)>(vb), h0 = tr_read<v_rd_off(D0, 0, 1)>(vb), l1 = tr_read<v_rd_off(D0, 1, 0)>(vb), h1 = tr_read<v_rd_off(D0, 1, 1)>(vb);
    const s16x4 l2 = tr_read<v_rd_off(D0, 2, 0)>(vb), h2 = tr_read<v_rd_off(D0, 2, 1)>(vb), l3 = tr_read<v_rd_off(D0, 3, 0)>(vb), h3 = tr_read<v_rd_off(D0, 3, 1)>(vb);
    asm volatile("s_waitcnt lgkmcnt(0)" ::: "memory"); ATT_SBAR();
#define ATT_PK(L, H) (bf16x8){L[0], L[1], L[2], L[3], H[0], H[1], H[2], H[3]}
    od = __builtin_amdgcn_mfma_f32_32x32x16_bf16(pa0, ATT_PK(l0, h0), od, 0, 0, 0);
    od = __builtin_amdgcn_mfma_f32_32x32x16_bf16(pa1, ATT_PK(l1, h1), od, 0, 0, 0);
    od = __builtin_amdgcn_mfma_f32_32x32x16_bf16(pa2, ATT_PK(l2, h2), od, 0, 0, 0);
    od = __builtin_amdgcn_mfma_f32_32x32x16_bf16(pa3, ATT_PK(l3, h3), od, 0, 0, 0);
#undef ATT_PK
}
__device__ __forceinline__ void pv_d0(f32x16* o, int vb, bf16x8 pa0, bf16x8 pa1, bf16x8 pa2, bf16x8 pa3) {
    pv_one<0>(o[0], vb, pa0, pa1, pa2, pa3); pv_one<1>(o[1], vb, pa0, pa1, pa2, pa3); pv_one<2>(o[2], vb, pa0, pa1, pa2, pa3); pv_one<3>(o[3], vb, pa0, pa1, pa2, pa3);
}

__device__ __forceinline__ void unit(const Frame& F, const bool nostore, int b, int hd, int qb, const bf16_t* __restrict__ Q, bf16_t* Y, const bf16_t* __restrict__ VV, const bf16_t* __restrict__ KR) {
    int tid_ = F.wave * 64 + lane_id(); asm volatile("" : "+v"(tid_));
    const int tid = tid_, wid = F.wave, lane = tid & 63, r32 = lane & 31, hi = lane >> 5;
    LAS unsigned char* lds = F.lds;
    LAS unsigned char* V_lds = lds; LAS unsigned char* K_lds = lds + OFF_K;
    LAS float* wsf = (LAS float*)(lds + OFF_WS) + wid * 64; LAS float* li_l = wsf; LAS float* al_l = wsf + 32;
    const size_t rowbase = (size_t)b * SEQ; const int q0 = qb * 256; const int qc = 4 * qb + (wid >> 1); const int NT = 4 * qb + 4;
    float m_reg = NEGBIG, l_reg = 0.f; f32x16 o[4] = {}; bf16x8 qr[12];
    { const bf16_t* Qw = Q + (rowbase + q0 + wid * 32 + r32) * 1536 + hd * 192 + hi * 8;
#pragma unroll
      for (int d0 = 0; d0 < 12; ++d0) qr[d0] = *(const bf16x8*)(Qw + d0 * 16); }
    const bf16_t* Kn = Y + rowbase * YLD + hd * 128; const bf16_t* Vh = VV + rowbase * 1024 + hd * 128; const bf16_t* Kr = KR + rowbase * 64;
    const int sr = tid >> 4, sc = (tid & 15) * 8; const int vst0 = v_st(sr, sc), vst1 = v_st(32 + sr, sc);
    const int kst0 = koff(sr, sc >> 6, (sc & 63) >> 3), kst1 = koff(32 + sr, sc >> 6, (sc & 63) >> 3), kst2 = koff(tid >> 3, 2, tid & 7);
    const int vb0 = (int)(uintptr_t)V_lds + v_rd_base(lane);
    bf16x8 vs0, vs1, ks0, ks1, ks2;
#define ATT_SLOAD(k0) do { vs0 = *(const bf16x8*)(Vh + (size_t)((k0) + sr) * 1024 + sc); vs1 = *(const bf16x8*)(Vh + (size_t)((k0) + 32 + sr) * 1024 + sc); \
    ks0 = *(const bf16x8*)(Kn + (size_t)((k0) + sr) * YLD + sc); ks1 = *(const bf16x8*)(Kn + (size_t)((k0) + 32 + sr) * YLD + sc); \
    ks2 = *(const bf16x8*)(Kr + (size_t)((k0) + (tid >> 3)) * 64 + (tid & 7) * 8); } while (0)
#define ATT_SWRITE(bf) do { *(LAS bf16x8*)(V_lds + (bf) * SHM_V + vst0) = vs0; *(LAS bf16x8*)(V_lds + (bf) * SHM_V + vst1) = vs1; \
    *(LAS bf16x8*)(K_lds + (bf) * SHM_K + kst0) = ks0; *(LAS bf16x8*)(K_lds + (bf) * SHM_K + kst1) = ks1; *(LAS bf16x8*)(K_lds + (bf) * SHM_K + kst2) = ks2; } while (0)
#define ATT_RESC(al) do { if (__any((al) < 1.f)) { if (hi == 0) al_l[r32] = (al); asm volatile("s_waitcnt lgkmcnt(0)" ::: "memory"); \
    _Pragma("unroll") for (int d = 0; d < 4; ++d) _Pragma("unroll") for (int r = 0; r < 16; ++r) o[d][r] *= al_l[crow(r, hi)]; } } while (0)
#define ATT_QKT(P0, P1, bf, jt) do { if ((jt) <= qc) qkt(P0, P1, K_lds + (bf) * SHM_K, qr, r32, hi); else { _Pragma("unroll") for (int r = 0; r < 16; ++r) { P0[r] = NEGBIG; P1[r] = NEGBIG; } } } while (0)
    f32x16 pA0, pA1, pB0, pB1; float alA, alB; bf16x8 pa0, pa1, pa2, pa3;
    ATT_SLOAD(0); asm volatile("s_waitcnt vmcnt(0)" ::: "memory"); ATT_SWRITE(0); __syncthreads();
    ATT_QKT(pA0, pA1, 0, 0); partialSM(pA0, pA1, m_reg, alA);
    ATT_SLOAD(KVBLK_); asm volatile("s_waitcnt vmcnt(0)" ::: "memory"); ATT_SWRITE(1); __syncthreads();
    for (int j = 1; j + 1 < NT; j += 2) {
        ATT_SBAR(); ATT_QKT(pB0, pB1, 1, j);
        finishSM(pA0, pA1, alA, l_reg, pa0, pa1, pa2, pa3); ATT_SBAR();
        ATT_SLOAD((j + 1) * KVBLK_); ATT_SBAR();
        pv_d0(o, vb0, pa0, pa1, pa2, pa3); partialSM(pB0, pB1, m_reg, alB);
        __syncthreads(); asm volatile("s_waitcnt vmcnt(0)" ::: "memory"); ATT_SWRITE(0);
        ATT_RESC(alB); __syncthreads();
        ATT_SBAR(); ATT_QKT(pA0, pA1, 0, j + 1);
        finishSM(pB0, pB1, alB, l_reg, pa0, pa1, pa2, pa3); ATT_SBAR();
        ATT_SLOAD((j + 2) * KVBLK_); ATT_SBAR();
        pv_d0(o, vb0 + SHM_V, pa0, pa1, pa2, pa3); partialSM(pA0, pA1, m_reg, alA);
        __syncthreads(); asm volatile("s_waitcnt vmcnt(0)" ::: "memory"); ATT_SWRITE(1);
        ATT_RESC(alA); __syncthreads();
    }
    ATT_SBAR(); ATT_QKT(pB0, pB1, 1, NT - 1);
    finishSM(pA0, pA1, alA, l_reg, pa0, pa1, pa2, pa3); ATT_SBAR();
    pv_d0(o, vb0, pa0, pa1, pa2, pa3); partialSM(pB0, pB1, m_reg, alB);
    __syncthreads(); ATT_RESC(alB);
    finishSM(pB0, pB1, alB, l_reg, pa0, pa1, pa2, pa3); ATT_SBAR();
    pv_d0(o, vb0 + SHM_V, pa0, pa1, pa2, pa3);
    if (hi == 0) li_l[r32] = l_reg; asm volatile("s_waitcnt lgkmcnt(0)" ::: "memory");
    float rli[16];
#pragma unroll
    for (int r = 0; r < 16; ++r) rli[r] = __builtin_amdgcn_rcpf(li_l[crow(r, hi)]);
    __syncthreads();
    int hi2 = hi, r32b = r32, ln = lane; asm volatile("" : "+v"(hi2), "+v"(r32b), "+v"(ln));
    LAS unsigned char* stg = lds + wid * 8704;
#pragma unroll
    for (int r = 0; r < 16; ++r) { const int orow = (r & 3) + 8 * (r >> 2) + 4 * hi2;
#pragma unroll
        for (int d0 = 0; d0 < 4; ++d0) *(LAS bf16_t*)(stg + orow * 272 + (d0 * 32 + r32b) * 2) = f2bf(o[d0][r] * rli[r]); }
    asm volatile("s_waitcnt lgkmcnt(0)" ::: "memory");
    bf16_t* Ow = Y + (rowbase + q0 + wid * 32) * YLD + 1024 + hd * 128;
    u32x4 zb[8];
#pragma unroll
    for (int i = 0; i < 8; ++i) { const int row = i * 4 + (ln >> 4), ch = ln & 15; zb[i] = *(const u32x4*)(Ow + (unsigned)(row * YLD + ch * 8)); }
#pragma unroll
    for (int i = 0; i < 8; ++i) { const int row = i * 4 + (ln >> 4), ch = ln & 15; const u32x4 ov = *(const LAS u32x4*)(stg + row * 272 + ch * 16); u32x4 w;
        w.x = pk_bf16(bf_lo(ov.x) * bf_lo(zb[i].x), bf_hi(ov.x) * bf_hi(zb[i].x)); w.y = pk_bf16(bf_lo(ov.y) * bf_lo(zb[i].y), bf_hi(ov.y) * bf_hi(zb[i].y));
        w.z = pk_bf16(bf_lo(ov.z) * bf_lo(zb[i].z), bf_hi(ov.z) * bf_hi(zb[i].z)); w.w = pk_bf16(bf_lo(ov.w) * bf_lo(zb[i].w), bf_hi(ov.w) * bf_hi(zb[i].w));
        if (!nostore) *(u32x4*)(Ow + (unsigned)(row * YLD + ch * 8)) = w; }
    asm volatile("s_waitcnt lgkmcnt(0)" ::: "memory");
    __syncthreads();
#undef ATT_SLOAD
#undef ATT_SWRITE
#undef ATT_RESC
#undef ATT_QKT
}
}

__device__ __forceinline__ void phaseC_att(const Frame& F, const bool nostore, const bf16_t* q, bf16_t* y, const bf16_t* vv, const bf16_t* kr) {
    for (int v = F.vcu; v < 256; v += F.G) { const int bh = v >> 2, s = v & 3;
        att::unit(F, nostore, bh >> 3, bh & 7, 7 - s, q, y, vv, kr);
        att::unit(F, nostore, bh >> 3, bh & 7, s, q, y, vv, kr); }
}
__device__ __forceinline__ void phaseC_lru(const Frame& F, const Args& a, const unsigned char* ws, const bool nostore, int l, bf16_t* y, const bf16_t* xc, const float* agg) {
    for (int item = F.vcu; item < NBATCH * 32; item += F.G) lru_item<2>(F, a, ws, nostore, l, item, xc, y, const_cast<float*>(agg));
}

__device__ __forceinline__ void gmlp_item(const Frame& F, const Args& a, const unsigned char* ws, const bool nostore, int l, int item, const bf16_t* v1, bf16_t* y, const float* vslab) {
    const int nb = item >> 2, g = item & 3; const size_t t0 = (size_t)nb * 128;
    int lane_ = lane_id(); asm volatile("" : "+v"(lane_));
    const int lane = lane_, w = F.wave, cl = lane & 15, kg = lane >> 4;
    LAS f32x2v* stat = (LAS f32x2v*)F.lds; LAS unsigned char* vnT = F.lds + 1024;
    { float pv[16];
#pragma unroll
      for (int i = 0; i < 16; ++i) pv[i] = vslab[(t0 + 16 * w + i) * 64 + lane];
#pragma unroll
      for (int i = 0; i < 16; ++i) { float v = pv[i]; v += sx<2>(v); v += sx<4>(v); v += sx<8>(v); v += sx<16>(v); v = xsum32(v);
          const float o = sx<1>(v);
          const float mu = v * (1.f / 1024.f); const float var = fmaxf(o * (1.f / 1024.f) - mu * mu, 0.f);
          if (lane == 0) stat[16 * w + i] = (f32x2v){mu, rsqrtf(var + EPS)}; } }
    LDS_WAIT(); __syncthreads();
    { const f32x2v st0 = stat[2 * lane], st1 = stat[2 * lane + 1];
      const float* lg = a.in[I_GM_LN_G] + l * 1024 + g * 256; const float* lb = a.in[I_GM_LN_B] + l * 1024 + g * 256;
      u32x4 xa[4], xb[4];
#pragma unroll
      for (int i = 0; i < 4; ++i) { const int c8 = 4 * w + i; xa[i] = *(const u32x4*)(v1 + (t0 + 2 * lane) * 1024 + g * 256 + c8 * 8); xb[i] = *(const u32x4*)(v1 + (t0 + 2 * lane + 1) * 1024 + g * 256 + c8 * 8); }
#pragma unroll
      for (int i = 0; i < 4; ++i) { const int c8 = 4 * w + i;
          const f32x4 g0 = *(const f32x4*)(lg + c8 * 8), g1 = *(const f32x4*)(lg + c8 * 8 + 4), b0 = *(const f32x4*)(lb + c8 * 8), b1 = *(const f32x4*)(lb + c8 * 8 + 4);
          const float ga[8] = {g0.x, g0.y, g0.z, g0.w, g1.x, g1.y, g1.z, g1.w}, be[8] = {b0.x, b0.y, b0.z, b0.w, b1.x, b1.y, b1.z, b1.w};
          const unsigned wa[4] = {xa[i].x, xa[i].y, xa[i].z, xa[i].w}, wb[4] = {xb[i].x, xb[i].y, xb[i].z, xb[i].w};
#pragma unroll
          for (int e = 0; e < 8; ++e) {
              const float fa = (e & 1) ? bf_hi(wa[e >> 1]) : bf_lo(wa[e >> 1]), fb = (e & 1) ? bf_hi(wb[e >> 1]) : bf_lo(wb[e >> 1]);
              const float na = (fa - st0.x) * st0.y * ga[e] + be[e], nbv = (fb - st1.x) * st1.y * ga[e] + be[e];
              *(LAS unsigned*)(vnT + (c8 * 8 + e) * 272 + lane * 4) = pk_bf16(na, nbv); } } }
    const bf16_t* gmw = (const bf16_t*)(ws + WS_GMW) + (size_t)g * 128 * 128;
    const float* bs = a.in[I_GM_BS] + l * 512 + g * 128;
    bf16_t* ybase = y + t0 * YLD + g * 256;
    const int tid = w * 64 + lane;
    u32x4 pa[8];
#pragma unroll
    for (int i = 0; i < 8; ++i) { const int idx = tid + 512 * i; pa[i] = *(const u32x4*)(ybase + (unsigned)((idx >> 5) * YLD + (idx & 31) * 8)); }
    float bsv[8];
#pragma unroll
    for (int ct = 0; ct < 8; ++ct) bsv[ct] = bs[16 * ct + cl];
    bf16x8 wf[2][4];
#pragma unroll
    for (int ks = 0; ks < 2; ++ks) wf[0][ks] = *(const bf16x8*)(gmw + (size_t)cl * 128 + 32 * ks + 8 * kg);
    LDS_WAIT(); __syncthreads();
    bf16x8 af[2][4];
#pragma unroll
    for (int r = 0; r < 2; ++r)
#pragma unroll
        for (int ks = 0; ks < 4; ++ks) af[r][ks] = *(const LAS bf16x8*)(vnT + (16 * (2 * w + r) + cl) * 272 + (32 * ks + 8 * kg) * 2);
    LDS_WAIT(); __syncthreads();
    LAS unsigned char* stg = vnT;
#pragma unroll
    for (int ct = 0; ct < 8; ++ct) { const int cur = ct & 1;
        if (ct + 1 < 8) {
#pragma unroll
            for (int ks = 0; ks < 4; ++ks) if (ks < ((ct + 1 < 4) ? 2 : 4)) wf[cur ^ 1][ks] = *(const bf16x8*)(gmw + (size_t)(16 * (ct + 1) + cl) * 128 + 32 * ks + 8 * kg); }
        f32x4 acc[2] = {(f32x4){0.f, 0.f, 0.f, 0.f}, (f32x4){0.f, 0.f, 0.f, 0.f}};
#pragma unroll
        for (int ks = 0; ks < 4; ++ks) if (ks < ((ct < 4) ? 2 : 4)) {
            acc[0] = __builtin_amdgcn_mfma_f32_16x16x32_bf16(af[0][ks], wf[cur][ks], acc[0], 0, 0, 0); acc[1] = __builtin_amdgcn_mfma_f32_16x16x32_bf16(af[1][ks], wf[cur][ks], acc[1], 0, 0, 0); }
#pragma unroll
        for (int r = 0; r < 2; ++r) { u32x2 o; o.x = pk_bf16(acc[r][0] + bsv[ct], acc[r][1] + bsv[ct]); o.y = pk_bf16(acc[r][2] + bsv[ct], acc[r][3] + bsv[ct]);
            *(LAS u32x2*)(stg + (16 * ct + cl) * 528 + (16 * (2 * w + r) + 4 * kg) * 2) = o; }
    }
    LDS_WAIT(); __syncthreads();
#pragma unroll
    for (int i = 0; i < 8; ++i) { const int idx = tid + 512 * i; const u32x4 sv = *(const LAS u32x4*)(stg + (idx >> 5) * 528 + (idx & 31) * 16); u32x4 o;
        o.x = pk_bf16(bf_lo(pa[i].x) * bf_lo(sv.x), bf_hi(pa[i].x) * bf_hi(sv.x)); o.y = pk_bf16(bf_lo(pa[i].y) * bf_lo(sv.y), bf_hi(pa[i].y) * bf_hi(sv.y));
        o.z = pk_bf16(bf_lo(pa[i].z) * bf_lo(sv.z), bf_hi(pa[i].z) * bf_hi(sv.z)); o.w = pk_bf16(bf_lo(pa[i].w) * bf_lo(sv.w), bf_hi(pa[i].w) * bf_hi(sv.w));
        if (!nostore) *(u32x4*)(ybase + (unsigned)((idx >> 5) * YLD + (idx & 31) * 8)) = o; }
    LDS_WAIT(); __syncthreads();
}
__device__ __forceinline__ void phaseE(const Frame& F, const Args& a, const unsigned char* ws, const bool nostore, int l, const bf16_t* v1, bf16_t* y, const float* vslab) {
    for (int item = F.vcu; item < 512; item += F.G) gmlp_item(F, a, ws, nostore, l, item, v1, y, vslab);
}
constexpr int N_PHASES = 1 + 8 * DEPTH;
#ifndef MK_PER_PHASE
#define MK_PER_PHASE 0
#endif
#ifndef MK_MAX_PHASE
#define MK_MAX_PHASE N_PHASES
#endif

__global__ void __launch_bounds__(NWAVES * 64, 2) mk_fwd(Args args) {
    extern __shared__ __attribute__((aligned(16))) unsigned char lds_raw[];
    Frame F;
    F.lds = (LAS unsigned char*)lds_raw;
    F.wave = __builtin_amdgcn_readfirstlane((int)threadIdx.x >> 6);
    F.G = gridDim.x; { const int bx = blockIdx.x; F.vcu = (F.G % 8 == 0) ? (bx % 8) * (F.G / 8) + bx / 8 : bx; }
    volatile LAS unsigned* MISCW = (volatile LAS unsigned*)(F.lds + MISC_OFF);
    for (int u = threadIdx.x; u < (LDS_BYTES - RING_BYTES) / 4; u += NWAVES * 64) ((LAS unsigned*)(F.lds + RING_BYTES))[u] = 0u;
    __syncthreads();
    unsigned* ctl = (unsigned*)(args.ws + WS_CTL);
#if MK_PER_PHASE
    const int lo = args.ph_lo, hi = args.ph_hi;
    const bool multi = (hi - lo) > 1;
#else
    constexpr int lo = 0, hi = N_PHASES;
    constexpr bool multi = true;
#endif
    XcdBarrier bar; bar.bar = ctl + CW_BAR; bar.x = 0; bar.st = nullptr;
    if (multi) bar = xcd_barrier_post(ctl + CW_BAR, MISCW + 8);
#define IN(k) (lo <= (k) && (k) < hi)
#define SEAM(k) do { if (IN((k) + 1)) xcd_barrier(bar); } while (0)
#define xcd_barrier_if(c, b) do { if (c) xcd_barrier(b); } while (0)

typedef const __attribute__((address_space(4))) Args* KArgP;
#if defined(__HIP_DEVICE_COMPILE__)
#define AS_GLOBAL(p) __builtin_assume(!__builtin_amdgcn_is_shared((const __attribute__((address_space(0))) void*)(p)) && !__builtin_amdgcn_is_private((const __attribute__((address_space(0))) void*)(p)))
#else
#define AS_GLOBAL(p) ((void)0)
#endif
#define PHASE_PTRS \
    KArgP kp = (KArgP)__builtin_amdgcn_kernarg_segment_ptr(); asm volatile("" : "+s"(kp)); Args la; \
    _Pragma("unroll") for (int i_ = 0; i_ < N_INPUTS; ++i_) { la.in[i_] = kp->in[i_]; AS_GLOBAL(la.in[i_]); } la.out = kp->out; AS_GLOBAL(la.out); la.ph_lo = 0; la.ph_hi = 0; \
    unsigned char* ws = kp->ws; AS_GLOBAL(ws); la.ws = ws; Frame Fp = F; int bid = (int)blockIdx.x; asm volatile("" : "+s"(Fp.wave), "+s"(Fp.vcu), "+s"(Fp.G), "+s"(bid)); (void)bid; \
    bf16_t* Hb = (bf16_t*)(ws + WS_H); bf16_t* Yb = (bf16_t*)(ws + WS_Y); \
    bf16_t* MISCb = (bf16_t*)(ws + WS_MISC); bf16_t* XCb = (bf16_t*)(ws + WS_XC); bf16_t* Qb = (bf16_t*)(ws + WS_Q); bf16_t* VVb = (bf16_t*)(ws + WS_VV); bf16_t* KRb = (bf16_t*)(ws + WS_KR); \
    bf16_t* V1b = (bf16_t*)(ws + WS_V1); bf16_t* Gb = (bf16_t*)(ws + WS_G); bf16_t* Ob = (bf16_t*)(ws + WS_O); \
    float* SLAB = (float*)(ws + WS_SLAB); float* AGG = (float*)(ws + WS_AGG); const float* CS = (const float*)(ws + WS_ROPE); const float* SN = CS + 2048 * 32; \
    const unsigned char* wb = ws + WS_WB; (void)Hb; (void)Yb; (void)MISCb; (void)XCb; (void)Qb; (void)VVb; (void)KRb; (void)V1b; (void)Gb; (void)Ob; (void)SLAB; (void)AGG; (void)CS; (void)SN; (void)wb;
    if (IN(0)) {
        { PHASE_PTRS
        convert_weights(Fp, la, ws, 0);
        rope_table(Fp, ws);
        norm_rows(Fp, false, la.in[I_X], nullptr, nullptr, nullptr, la.in[I_PRE_G], Hb);
        }
        SEAM(0);
    }
#pragma nounroll
    for (int l = 0; l < DEPTH; ++l) {
        const int pb = 1 + 8 * l;
        if (IN(pb + 0)) {
            { const bool nostore = false; (void)nostore;
            PHASE_PTRS
            SchedA S; S.ord.init(64, 16, Fp.G, bid); S.A = (const char*)Hb; S.B = (const char*)(wb + WB_W1T);
            EpiA E{MISCb, XCb, Yb, SLAB, KRb, CS, SN};
            g8::gemm_stream(Fp.lds, Fp.wave * 64 + lane_id(), 2048u, 2048u, S, E);
            }
            SEAM(pb + 0);
        }
        if (IN(pb + 1)) {
            { const bool nostore = false; (void)nostore;
            PHASE_PTRS
            { SchedZ SZ; SZ.v = Fp.vcu; SZ.A = (const char*)Hb; SZ.B = (const char*)(wb + WB_W1T); EpiA EZ{MISCb, XCb, Yb, SLAB, KRb, CS, SN};
              g8::gemm_stream(Fp.lds, Fp.wave * 64 + lane_id(), 2048u, 2048u, SZ, EZ); }
            SchedQKV S; S.v = Fp.vcu; S.misc = (const char*)MISCb; S.wq = (const char*)(wb + WB_WQT); S.wkv = (const char*)(wb + WB_WKVT);
            EpiQKV E{Qb, Yb, VVb, SLAB, CS, SN};
            g8::gemm_stream(Fp.lds, Fp.wave * 64 + lane_id(), 1536u, 768u, S, E);
            phaseB_lru(Fp, ws, (unsigned*)(ws + WS_CTL), nostore, l, XCb, Yb, AGG);
            }
            SEAM(pb + 1);
        }
        if (IN(pb + 2)) {
            { const bool nostore = false; (void)nostore;
            PHASE_PTRS
            phaseC_att(Fp, nostore, Qb, Yb, VVb, KRb);
            }
            SEAM(pb + 2);
        }
        if (IN(pb + 3)) {
            { const bool nostore = false; (void)nostore;
            PHASE_PTRS
            SchedD S; S.ord.init(64, 24, Fp.G, bid); S.A = (const char*)Hb; S.B = (const char*)(wb + WB_W2T);
            EpiD E{Yb, V1b, Gb, SLAB};
            g8::gemm_stream(Fp.lds, Fp.wave * 64 + lane_id(), 2048u, 2048u, S, E);
            }
            SEAM(pb + 3);
        }
        if (IN(pb + 4)) {
            { const bool nostore = false; (void)nostore;
            PHASE_PTRS
            phaseE(Fp, la, ws, nostore, l, V1b, Yb, SLAB);
            }
            SEAM(pb + 4);
        }
        if (IN(pb + 5)) {
            { const bool nostore = false; (void)nostore;
            PHASE_PTRS
            SchedF S; S.ord.init(64, 4, Fp.G, bid); S.A = (const char*)Yb; S.B = (const char*)(wb + WB_WPT);
            EpiF E{Gb, V1b};
            g8::gemm_stream(Fp.lds, Fp.wave * 64 + lane_id(), (unsigned)(YLD * 2), (unsigned)(YLD * 2), S, E);
            }
            SEAM(pb + 5);
        }
        if (IN(pb + 6)) {
            { const bool nostore = false; (void)nostore;
            PHASE_PTRS
            SchedG1 S; S.v = Fp.vcu; S.A = (const char*)V1b; S.B = (const char*)(wb + WB_WOT);
            const float* xin = (l == 0) ? la.in[I_X] : la.out;
            EpiNorm E{xin, la.out, Hb, la.in[I_POST_G] + l * DM, (l + 1 < DEPTH) ? la.in[I_PRE_G] + (l + 1) * DM : nullptr, SLAB, (unsigned*)(ws + WS_CTL) + CW_NORM + l * 2048};
            g8::gemm_stream<true>(Fp.lds, Fp.wave * 64 + lane_id(), 2048u, 2048u, S, E);
            }
            if (l + 1 < DEPTH) SEAM(pb + 6);
        }
        if (IN(pb + 7) && l + 1 < DEPTH) {
            { const bool nostore = false; (void)nostore;
            PHASE_PTRS
            if (l + 1 < DEPTH) convert_weights(Fp, la, ws, l + 1);
            }
            SEAM(pb + 7);
        }
    }
#undef IN
#undef SEAM
}

#ifndef MK_PROBE
#define MK_PROBE 0
#endif
static int mk_setup(size_t ws_size) {
    static int grid = 0;
    if (grid == 0) {
        if (ws_size < WS_END) { fprintf(stderr, "kernel_launch: workspace too small: %zu < %zu\n", ws_size, (size_t)WS_END); grid = -1; return grid; }
        int dev = 0, cus = 0, per_cu = 0;
        if (hipGetDevice(&dev) != hipSuccess || hipDeviceGetAttribute(&cus, hipDeviceAttributeMultiprocessorCount, dev) != hipSuccess) { grid = -1; return grid; }
        if (hipFuncSetAttribute((const void*)mk_fwd, hipFuncAttributeMaxDynamicSharedMemorySize, LDS_BYTES) != hipSuccess) { fprintf(stderr, "kernel_launch: hipFuncSetAttribute failed\n"); grid = -1; return grid; }
        if (hipOccupancyMaxActiveBlocksPerMultiprocessor(&per_cu, (const void*)mk_fwd, NWAVES * 64, LDS_BYTES) != hipSuccess || per_cu < 1)
            fprintf(stderr, "kernel_launch: occupancy query reports %d blocks/CU\n", per_cu);
        (void)hipGetLastError();
        grid = cus;
        if (grid != 256) fprintf(stderr, "kernel_launch: note: %d CUs (tile schedules assume 256)\n", grid);
    }
    return grid;
}
static void mk_launch(void* const* d_in, void* d_out, void* d_ws, hipStream_t stream, int grid, int lo, int hi) {
    Args a{};
    for (int i = 0; i < N_INPUTS; ++i) a.in[i] = (const float*)d_in[i];
    a.out = (float*)d_out; a.ws = (unsigned char*)d_ws; a.ph_lo = lo; a.ph_hi = hi; a.probe = MK_PROBE; a.pad = 0;
    hipLaunchKernelGGL(mk_fwd, dim3(grid), dim3(NWAVES * 64), LDS_BYTES, stream, a);
}
extern "C" void kernel_launch(void* const* d_in, const int* in_sizes, int n_in, void* d_out, int out_size, void* d_ws, size_t ws_size, hipStream_t stream) {
    const int grid = mk_setup(ws_size); if (grid < 0) return;
    hipMemsetAsync((char*)d_ws + WS_CTL, 0, CTL_ZERO_BYTES, stream);
#if MK_PER_PHASE
    for (int ph = 0; ph < N_PHASES; ++ph) mk_launch(d_in, d_out, d_ws, stream, grid, ph, ph + 1);
#else
    mk_launch(d_in, d_out, d_ws, stream, grid, 0, N_PHASES);
#endif
}
```

```cpp
#define MK_PROBE 0
#include <hip/hip_runtime.h>
#include <cstdio>
#include <cstdint>

#define LAS __attribute__((address_space(3)))
#define GAS __attribute__((address_space(1)))
typedef unsigned short bf16_t;
typedef short bf16x8 __attribute__((ext_vector_type(8)));
typedef short s16x4 __attribute__((ext_vector_type(4)));
typedef float f32x2 __attribute__((ext_vector_type(2)));
typedef float f32x4 __attribute__((ext_vector_type(4)));
typedef float f32x16 __attribute__((ext_vector_type(16)));
typedef unsigned u32x2 __attribute__((ext_vector_type(2)));
typedef unsigned u32x4 __attribute__((ext_vector_type(4)));
typedef __bf16 bf16x2_t __attribute__((ext_vector_type(2)));

__device__ __forceinline__ unsigned pk_bf16(float lo, float hi) { f32x2 v = {lo, hi}; bf16x2_t b = __builtin_convertvector(v, bf16x2_t); return __builtin_bit_cast(unsigned, b); }
__device__ __forceinline__ float bf_lo(unsigned w) { return __uint_as_float(w << 16); }
__device__ __forceinline__ float bf_hi(unsigned w) { return __uint_as_float(w & 0xffff0000u); }
__device__ __forceinline__ float bf1(bf16_t h) { return __uint_as_float(((unsigned)h) << 16); }
__device__ __forceinline__ bf16_t f2bf(float f) { return (bf16_t)(pk_bf16(f, 0.f) & 0xffffu); }
__device__ __forceinline__ float fexp2(float x) { return __builtin_amdgcn_exp2f(x); }
__device__ __forceinline__ float fsigmoid(float x) { return __builtin_amdgcn_rcpf(1.f + fexp2(x * -1.4426950408889634f)); }
__device__ __forceinline__ float fsilu(float x) { return x * __builtin_amdgcn_rcpf(1.f + fexp2(x * -1.4426950408889634f)); }
template <int XM> __device__ __forceinline__ float sx(float v) { return __int_as_float(__builtin_amdgcn_ds_swizzle(__float_as_int(v), (XM << 10) | 0x1f)); }
__device__ __forceinline__ float xsum32(float v) { auto rr = __builtin_amdgcn_permlane32_swap(__float_as_uint(v), __float_as_uint(v), false, false); return __uint_as_float(rr[0]) + __uint_as_float(rr[1]); }
__device__ __forceinline__ float wave_sum(float v) { v += sx<1>(v); v += sx<2>(v); v += sx<4>(v); v += sx<8>(v); v += sx<16>(v); return xsum32(v); }
#define LDS_WAIT() asm volatile("s_waitcnt lgkmcnt(0)" ::: "memory")
#define VM_WAIT() asm volatile("s_waitcnt vmcnt(0)" ::: "memory")

namespace g8 {
constexpr int BM = 256, BK = 64, HALF = 128, HTB = HALF * BK * 2, STAGE_BYTES = 8 * HTB, NXCD = 8, WGM = 8;
__host__ __device__ __forceinline__ int lds_byte(int r, int c) { const int st = (r >> 4) * 2 + (c >> 5), rr = r & 15, cc = c & 31, ob = rr * 64 + cc * 2; return st * 1024 + (ob ^ (((ob >> 9) & 1) << 5)); }
__host__ __device__ __forceinline__ void stage_rc(int b, int& R, int& C) { const int st = b / 1024, sb = b % 1024, swz = sb ^ (((sb >> 9) & 1) << 5); R = (st >> 1) * 16 + swz / 64; C = (st & 1) * 32 + (swz % 64) / 2; }
__host__ __device__ __forceinline__ int perm32(int rho) { const int n = rho >> 4, i = rho & 15; return 8 * (i >> 2) + 4 * n + (i & 3); }

struct UnitD { const char* A; const char* B; int nt, pm, pn, kind; };
constexpr int KEEP_ACC = 0x100;

struct TileOrder {
    int nM, nN, nwg, G, c;
    __device__ void init(int nM_, int nN_, int G_, int c_) { nM = nM_; nN = nN_; nwg = nM * nN; G = G_; c = c_; }
    __device__ bool tile(int i, int& pm, int& pn) const {
        const long L = (long)i * G + c; if (L >= nwg) return false;
        int wgid = (int)L; { const int q = nwg / NXCD, r = nwg % NXCD, xcd = wgid % NXCD, off = wgid / NXCD; wgid = (xcd < r ? xcd * (q + 1) : r * (q + 1) + (xcd - r) * q) + off; }
        const int nig = WGM * nN, gid = wgid / nig, fm = gid * WGM, gsz = (nM - fm) < WGM ? (nM - fm) : WGM;
        pm = fm + ((wgid % nig) % gsz); pn = (wgid % nig) / gsz; return true;
    }
};

template <bool AFTER_DRAIN = false, class Sched, class Epi>
__device__ __forceinline__ void gemm_stream(LAS unsigned char* lds, int tid_in, const unsigned lda, const unsigned ldb, const Sched& S, const Epi& E) {
    int tid_ = tid_in; asm volatile("" : "+v"(tid_));
    const int tid = tid_, wid = __builtin_amdgcn_readfirstlane(tid >> 6), lane = tid & 63, wr = wid >> 2, wc = wid & 3, fr = lane & 15, fq = lane >> 4;
    unsigned voffA[2], voffB[2];
#pragma unroll
    for (int i = 0; i < 2; ++i) { int R, C; stage_rc(tid * 16 + i * 8192, R, C); const int Rb = (R & ~31) + perm32(R & 31);
        voffA[i] = (unsigned)R * lda + (unsigned)C * 2u; voffB[i] = (unsigned)Rb * ldb + (unsigned)C * 2u; }
    const size_t kstep = (size_t)(BK * 2);
    const size_t hstepA = (size_t)HALF * lda, hstepB = (size_t)HALF * ldb;
    const unsigned ldsw = (unsigned)wid * 1024u;
    const int aoff = lds_byte(wr * 64 + fr, fq * 8), boff = lds_byte(wc * 32 + fr, fq * 8);
#define G8_SA(b, h) (((b) * 2 + (h)) * HTB)
#define G8_SB(b, h) ((4 + (b) * 2 + (h)) * HTB)
#define G8_STAGE(bufoff, gbase, voff) do { _Pragma("unroll") for (int _i = 0; _i < 2; ++_i) \
        __builtin_amdgcn_global_load_lds((const unsigned*)((const char*)(gbase) + (voff)[_i]), (LAS unsigned*)(lds + (bufoff) + ldsw + _i * 8192), 16, 0, 0); } while (0)
#define G8_LDA(dst, b, h) do { _Pragma("unroll") for (int m = 0; m < 4; ++m) _Pragma("unroll") for (int k = 0; k < 2; ++k) dst[m][k] = *(const LAS bf16x8*)(lds + G8_SA(b, h) + aoff + m * 2048 + k * 1024); } while (0)
#define G8_LDB(dst, b, h) do { _Pragma("unroll") for (int n = 0; n < 2; ++n) _Pragma("unroll") for (int k = 0; k < 2; ++k) dst[n][k] = *(const LAS bf16x8*)(lds + G8_SB(b, h) + boff + n * 2048 + k * 1024); } while (0)
#define G8_MMA(ai, bj, At, Bt) do { __builtin_amdgcn_s_setprio(1); _Pragma("unroll") for (int m = 0; m < 4; ++m) _Pragma("unroll") for (int n = 0; n < 2; ++n) _Pragma("unroll") for (int k = 0; k < 2; ++k) \
        acc[ai][bj][m][n] = __builtin_amdgcn_mfma_f32_16x16x32_bf16(Bt[n][k], At[m][k], acc[ai][bj][m][n], 0, 0, 0); __builtin_amdgcn_s_setprio(0); } while (0)
#define G8_WAIT_V(n) asm volatile("s_waitcnt vmcnt(" #n ")" ::: "memory")
#define G8_WAIT_L(n) asm volatile("s_waitcnt lgkmcnt(" #n ")" ::: "memory")
#define G8_BAR __builtin_amdgcn_s_barrier()
#define G8_SCHED __builtin_amdgcn_sched_barrier(0)
    UnitD cur, nxt; int ui = 0;
    if (!S.next(0, cur)) return;
    f32x4 acc[2][2][4][2];
#pragma unroll
    for (int a = 0; a < 2; ++a)
#pragma unroll
        for (int b = 0; b < 2; ++b)
#pragma unroll
            for (int m = 0; m < 4; ++m)
#pragma unroll
                for (int n = 0; n < 2; ++n) acc[a][b][m][n] = (f32x4){0.f, 0.f, 0.f, 0.f};
    bf16x8 At[4][2], B0[2][2], B1[2][2];
    const char* cA = cur.A; const char* cB = cur.B;
    G8_STAGE(G8_SB(0, 0), cB, voffB); G8_STAGE(G8_SB(0, 1), cB + hstepB, voffB); G8_STAGE(G8_SA(0, 0), cA, voffA); G8_STAGE(G8_SA(0, 1), cA + hstepA, voffA);
    if (wr == 1) G8_BAR;
    G8_WAIT_V(2); G8_BAR;
    G8_STAGE(G8_SB(1, 0), cB + kstep, voffB); G8_STAGE(G8_SA(1, 0), cA + kstep, voffA); G8_STAGE(G8_SB(1, 1), cB + hstepB + kstep, voffB);
    G8_WAIT_V(6); G8_BAR;
    for (;;) {
        const bool has_next = S.next(ui + 1, nxt);
        const char* nA = has_next ? nxt.A : cA; const char* nB = has_next ? nxt.B : cB;
        const int nt = cur.nt;
        for (int t = 0; t < nt; t += 2) {
            const bool last = (t == nt - 2);
            const char* a1 = cA + (size_t)(t + 1) * kstep;
            const char* a2 = last ? nA : cA + (size_t)(t + 2) * kstep; const char* b2 = last ? nB : cB + (size_t)(t + 2) * kstep;
            const char* a3 = a2 + kstep; const char* b3 = b2 + kstep;
            G8_LDB(B0, 0, 0); G8_LDB(B1, 0, 1); G8_SCHED; G8_LDA(At, 0, 0); G8_STAGE(G8_SA(1, 1), a1 + hstepA, voffA);
            G8_WAIT_V(8); G8_WAIT_L(0); G8_BAR; G8_MMA(0, 0, At, B0); G8_MMA(0, 1, At, B1); G8_BAR; G8_SCHED;
            G8_LDA(At, 0, 1); G8_STAGE(G8_SB(0, 0), b2, voffB); G8_STAGE(G8_SB(0, 1), b2 + hstepB, voffB); G8_STAGE(G8_SA(0, 0), a2, voffA);
            G8_WAIT_V(8); G8_WAIT_L(0); G8_BAR; G8_MMA(1, 0, At, B0); G8_MMA(1, 1, At, B1); G8_BAR; G8_SCHED;
            G8_LDB(B0, 1, 0); G8_LDB(B1, 1, 1); G8_SCHED; G8_LDA(At, 1, 0); G8_STAGE(G8_SA(0, 1), a2 + hstepA, voffA);
            G8_WAIT_V(8); G8_WAIT_L(0); G8_BAR; G8_MMA(0, 0, At, B0); G8_MMA(0, 1, At, B1); G8_BAR; G8_SCHED;
            G8_LDA(At, 1, 1); G8_STAGE(G8_SB(1, 0), b3, voffB); G8_STAGE(G8_SB(1, 1), b3 + hstepB, voffB); G8_STAGE(G8_SA(1, 0), a3, voffA);
            G8_WAIT_V(8); G8_WAIT_L(0); G8_BAR; G8_MMA(1, 0, At, B0); G8_MMA(1, 1, At, B1); G8_BAR; G8_SCHED;
        }
        if (wr == 0) G8_BAR;
        if constexpr (!AFTER_DRAIN) { UnitD eu = cur; int fr_ = fr, fq_ = fq; asm volatile("" : "+s"(eu.pm), "+s"(eu.pn), "+v"(fr_), "+v"(fq_)); E(acc, eu, wr, wc, fr_, fq_); }
        if (!has_next) break;
        if (!(cur.kind & KEEP_ACC)) {
#pragma unroll
            for (int a = 0; a < 2; ++a)
#pragma unroll
                for (int b = 0; b < 2; ++b)
#pragma unroll
                    for (int m = 0; m < 4; ++m)
#pragma unroll
                        for (int n = 0; n < 2; ++n) acc[a][b][m][n] = (f32x4){0.f, 0.f, 0.f, 0.f};
        }
        cur = nxt; cA = nA; cB = nB; ++ui;
        if (wr == 1) G8_BAR;
    }
    G8_WAIT_V(0);
    G8_BAR;
    if constexpr (AFTER_DRAIN) {
        UnitD eu = cur; int fr_ = fr, fq_ = fq, ln_ = lane; asm volatile("" : "+s"(eu.pm), "+s"(eu.pn), "+v"(fr_), "+v"(fq_), "+v"(ln_)); E.fused(acc, eu, wr, wc, fr_, fq_, lds, wid, ln_); }
#undef G8_SA
#undef G8_SB
#undef G8_STAGE
#undef G8_LDA
#undef G8_LDB
#undef G8_MMA
#undef G8_WAIT_V
#undef G8_WAIT_L
#undef G8_BAR
#undef G8_SCHED
}
}

#define XB_TMO      128
#define XB_XCNT(j)  (256  + 64 * (j))
#define XB_XSUB(j)  (1280 + 64 * (j))
#define XB_XGEN(j)  (2304 + 64 * (j))
#define XB_TOP      3328
#define XB_TOPGEN   3392
#define XCD_BAR_WORDS 3456
#define XB_SPIN_CAP (1u << 18)
__device__ __forceinline__ unsigned xb_ld(unsigned* p)              { return __hip_atomic_load(p, __ATOMIC_RELAXED, __HIP_MEMORY_SCOPE_AGENT); }
__device__ __forceinline__ unsigned xb_add(unsigned* p, unsigned v) { return __hip_atomic_fetch_add(p, v, __ATOMIC_RELAXED, __HIP_MEMORY_SCOPE_AGENT); }
__device__ __forceinline__ unsigned xb_xcc_id() { return (unsigned)__builtin_amdgcn_s_getreg((3 << 11) | 20) & 0xFu; }
#define XB_SPIN(cond, bar) do { unsigned _sp = 0; while (cond) { __builtin_amdgcn_s_sleep(1); \
    if ((++_sp & 255u) == 0u) { if (xb_ld(&(bar)[XB_TMO])) break; if (_sp > XB_SPIN_CAP) { atomicAdd(&(bar)[XB_TMO], 1u); break; } } } } while (0)
struct XcdBarrier { unsigned* bar; unsigned x; volatile LAS unsigned* st; };
__device__ __forceinline__ XcdBarrier xcd_barrier_post(unsigned* bar, volatile LAS unsigned* st) {
    XcdBarrier b; b.bar = bar; b.x = xb_xcc_id(); b.st = st;
    if (threadIdx.x == 0) (void)xb_add(&bar[XB_XCNT(b.x)], 1u);
    return b;
}
__device__ __forceinline__ void xcd_barrier_complete(unsigned* bar, unsigned x, unsigned& nloc, unsigned& nx) {
    const unsigned G = gridDim.x * gridDim.y * gridDim.z;
    unsigned sum, cnt, mine, sp = 0u;
    for (;;) {
        sum = 0u; cnt = 0u; mine = 0u;
#pragma unroll
        for (unsigned j = 0; j < 16; ++j) { const unsigned c = xb_ld(&bar[XB_XCNT(j)]); sum += c; cnt += (c > 0u) ? 1u : 0u; mine = (j == x) ? c : mine; }
        if (sum == G) break;
        __builtin_amdgcn_s_sleep(1);
        if ((++sp & 255u) == 0u) { if (xb_ld(&bar[XB_TMO])) break; if (sp > XB_SPIN_CAP) { atomicAdd(&bar[XB_TMO], 1u); break; } }
    }
    nloc = mine > 0u ? mine : 1u; nx = cnt > 0u ? cnt : 1u;
}
__device__ __forceinline__ void xcd_barrier(const XcdBarrier& b) {
    asm volatile("s_waitcnt vmcnt(0)" ::: "memory");
    __syncthreads();
    if (threadIdx.x == 0) {
        unsigned* bar = b.bar; unsigned bx = b.x; asm volatile("" : "+s"(bar), "+s"(bx));
        __builtin_amdgcn_s_waitcnt(0);
        unsigned nloc = b.st[0], nx = b.st[1];
        if (nloc == 0u) { xcd_barrier_complete(bar, bx, nloc, nx); b.st[0] = nloc; b.st[1] = nx; }
        const unsigned old = xb_add(&bar[XB_XSUB(bx)], 1u);
        const unsigned gen = old / nloc;
        if (old + 1u == (gen + 1u) * nloc) {
            __builtin_amdgcn_fence(__ATOMIC_RELEASE, "agent");
            asm volatile("s_waitcnt vmcnt(0)" ::: "memory");
            const unsigned og = xb_add(&bar[XB_TOP], 1u);
            const unsigned tg = og / nx;
            if (og + 1u == (tg + 1u) * nx) xb_add(&bar[XB_TOPGEN], 1u);
            else XB_SPIN(xb_ld(&bar[XB_TOPGEN]) == tg, bar);
            __builtin_amdgcn_fence(__ATOMIC_ACQUIRE, "agent");
            xb_add(&bar[XB_XGEN(bx)], 1u);
            asm volatile("s_waitcnt vmcnt(0)" ::: "memory");
        } else {
            XB_SPIN(xb_ld(&bar[XB_XGEN(bx)]) == gen, bar);
            __builtin_amdgcn_fence(__ATOMIC_ACQUIRE, "agent");
            asm volatile("s_waitcnt vmcnt(0)" ::: "memory");
        }
    }
    __syncthreads();
}
constexpr int T = 16384, DM = 1024, SEQ = 2048, NBATCH = 8, DEPTH = 2, N_IN = 10432;
constexpr int NWAVES = 8;
constexpr float EPS = 1e-6f;
constexpr size_t MiB = 1u << 20;
constexpr size_t WS_CTL = 0, CTL_ZERO_BYTES = 64 * 1024;
constexpr size_t WS_WB = 1 * MiB;
constexpr size_t WB_W1T = 0;
constexpr size_t WB_W2T = WB_W1T + (size_t)4352 * 1024 * 2;
constexpr size_t WB_WQT = WB_W2T + (size_t)6144 * 1024 * 2;
constexpr size_t WB_WKVT = WB_WQT + (size_t)1536 * 384 * 2;
constexpr size_t WB_WPT = WB_WKVT + (size_t)2048 * 384 * 2;
constexpr size_t WB_WOT = WB_WPT + (size_t)1024 * 3328 * 2;
constexpr size_t WB_END = WB_WOT + (size_t)1024 * 1024 * 2;
static_assert(WB_END <= 32 * MiB, "weights region");
constexpr size_t WS_H = 33 * MiB;
constexpr size_t WS_Y = 65 * MiB;
constexpr int YLD = 3328;
constexpr size_t WS_BIG = 169 * MiB;
constexpr size_t WS_MISC = WS_BIG;
constexpr size_t WS_XC = WS_MISC + 24 * MiB;
constexpr size_t WS_Q = WS_XC + 40 * MiB;
constexpr size_t WS_VV = WS_Q + 48 * MiB;
constexpr size_t WS_KR = WS_VV + 32 * MiB;
constexpr size_t WS_V1 = WS_BIG;
constexpr size_t WS_G = WS_V1 + 32 * MiB;
constexpr size_t WS_O = WS_BIG;
constexpr size_t WS_SMALL = 315 * MiB;
constexpr size_t WS_SLAB = WS_SMALL;
constexpr size_t WS_AGG = WS_SLAB + 1536 * 1024;
constexpr size_t WS_ROPE = WS_AGG + 2560 * 1024;
constexpr size_t WS_LW = WS_ROPE + 512 * 1024;
constexpr size_t WS_GMW = WS_LW + 480 * 1024;
constexpr size_t WS_LCT = WS_GMW + 128 * 1024;
constexpr size_t WS_END = WS_LCT + 64 * 1024;
static_assert(WS_KR + 2 * MiB <= WS_SMALL && WS_G + 96 * MiB <= WS_SMALL && WS_END <= 326 * MiB, "d_ws map");
constexpr int CW_NORM = 12288;
constexpr int CW_BAR = 1024;
static_assert((CW_BAR + XCD_BAR_WORDS) * 4 <= (int)CTL_ZERO_BYTES, "ctl");
constexpr int RING_BYTES = 131072, MISC_OFF = RING_BYTES + 320, LDS_BYTES = 147456;

enum { I_X = 0, I_PRE_G, I_W_IN, I_GM_LN_G, I_GM_LN_B, I_GM_WS, I_GM_BS, I_QN_G, I_W_UQ, I_KVN_G, I_W_UKV, I_CONV_W, I_CONV_B, I_W_A, I_B_A, I_W_X, I_B_X, I_LAM,
       I_W_PA, I_W_PB, I_W_PC, I_W_OUT, I_POST_G, N_INPUTS };
struct Args { const float* in[N_INPUTS]; float* out; unsigned char* ws; int ph_lo, ph_hi, probe, pad; };

struct Frame { LAS unsigned char* lds; int wave, vcu, G; };
__device__ __forceinline__ int lane_id() { int l; asm volatile("v_mbcnt_lo_u32_b32 %0, -1, 0\n\tv_mbcnt_hi_u32_b32 %0, -1, %0" : "=v"(l)); return l; }

__device__ __forceinline__ float softplus_neg(float x) { const float e = __expf(-x);
    const float p = e * (1.f - e * (0.5f - e * (0.33333334f - e * (0.25f - e * (0.2f - e * (0.16666667f - e * (0.14285715f - e * 0.125f)))))));
    return (e < 0.2f) ? p : __logf(1.f + e); }
struct MapW1 { __device__ __forceinline__ int operator()(int j) const {
    if (j < 384) return 3072 + j; if (j < 640) return 3456 + (j - 384); if (j < 704) { const int jj = j - 640, g = jj >> 3, e = jj & 7; return 3712 + (e < 4 ? 4 * g + e : 32 + 4 * g + (e - 4)); } if (j < 768) return -1;
    if (j < 2048) return 4800 + (j - 768); if (j < 3328) return 6080 + (j - 2048); return 3776 + (j - 3328); } };
struct MapW2 { __device__ __forceinline__ int operator()(int j) const {
    if (j < 2048) { const int tl = j >> 8, lc = j & 255; return (lc < 128) ? (128 * tl + lc) : (2048 + 128 * tl + (lc - 128)); }
    if (j < 3072) return 1024 + (j - 2048); return 7360 + (j - 3072); } };
struct MapQ { __device__ __forceinline__ int operator()(int j) const {
    if (j < 1024) { const int hd = j >> 7, d = j & 127; return hd * 192 + d; }
    const int jj = j - 1024, hh = jj >> 6, w = jj & 63, g = w >> 3, e = w & 7; return hh * 192 + (e < 4 ? 128 + 4 * g + e : 160 + 4 * g + (e - 4)); } };
struct MapId { __device__ __forceinline__ int operator()(int j) const { return j; } };

template <class Map>
__device__ __forceinline__ void tr_item(const float* W, int ldw, int nkb  , bf16_t* WT, int ldt, const Map map, const float* kscale, LAS float* scr, int item, int lane) {
    const int kb = item % nkb, nb = item / nkb, k0 = 64 * kb, n0 = 32 * nb;
    const int nn = lane & 31; const int sc = map(n0 + nn);
    float wv[32];
    const float* wp = W + (size_t)(k0 + (lane >> 5)) * ldw + (sc >= 0 ? sc : 0);
#pragma unroll
    for (int i = 0; i < 32; ++i) wv[i] = (sc >= 0) ? wp[(size_t)(2 * i) * ldw] : 0.f;
#pragma unroll
    for (int i = 0; i < 32; ++i) { const int kk = 2 * i + (lane >> 5); float v = wv[i]; if (kscale) v *= kscale[k0 + kk]; scr[kk * 33 + nn] = v; }
    LDS_WAIT(); asm volatile("" ::: "memory");
    const int c = lane & 7;
#pragma unroll
    for (int j = 0; j < 4; ++j) { const int n = (lane >> 3) + 8 * j; const LAS float* s = scr + (8 * c) * 33 + n;
        u32x4 o; o.x = pk_bf16(s[0 * 33], s[1 * 33]); o.y = pk_bf16(s[2 * 33], s[3 * 33]); o.z = pk_bf16(s[4 * 33], s[5 * 33]); o.w = pk_bf16(s[6 * 33], s[7 * 33]);
        *(u32x4*)(WT + (size_t)(n0 + n) * ldt + k0 + 8 * c) = o; }
    LDS_WAIT(); asm volatile("" ::: "memory");
}

__device__ __forceinline__ void convert_weights(const Frame& F, const Args& a, unsigned char* ws, int l) {
    const int lane = lane_id();
    LAS float* scr = (LAS float*)(F.lds + F.wave * 16384);
    const int gw = F.vcu * NWAVES + F.wave, NGW = F.G * NWAVES;
    unsigned char* wb = ws + WS_WB;
    constexpr int I1 = 16 * (4352 / 32), I2 = 16 * (6144 / 32), IQ = 6 * (1536 / 32), IKV = 4 * (2048 / 32), IPA = 16 * 32, IPB = 16 * 32, IPC = 20 * 32, IO = 16 * 32;
    constexpr int NITEMS = I1 + I2 + IQ + IKV + IPA + IPB + IPC + IO;
    const float* w_in = a.in[I_W_IN] + (size_t)l * 1024 * N_IN;
    for (int it = gw; it < NITEMS; it += NGW) {
        int r = it;
        if (r < I1) { tr_item(w_in, N_IN, 16, (bf16_t*)(wb + WB_W1T), 1024, MapW1(), nullptr, scr, r, lane); continue; } r -= I1;
        if (r < I2) { tr_item(w_in, N_IN, 16, (bf16_t*)(wb + WB_W2T), 1024, MapW2(), nullptr, scr, r, lane); continue; } r -= I2;
        if (r < IQ) { tr_item(a.in[I_W_UQ] + (size_t)l * 384 * 1536, 1536, 6, (bf16_t*)(wb + WB_WQT), 384, MapQ(), a.in[I_QN_G] + l * 384, scr, r, lane); continue; } r -= IQ;
        if (r < IKV) { tr_item(a.in[I_W_UKV] + (size_t)l * 256 * 2048, 2048, 4, (bf16_t*)(wb + WB_WKVT), 384, MapId(), a.in[I_KVN_G] + l * 256, scr, r, lane); continue; } r -= IKV;
        if (r < IPA) { tr_item(a.in[I_W_PA] + (size_t)l * 1024 * 1024, 1024, 16, (bf16_t*)(wb + WB_WPT), 3328, MapId(), nullptr, scr, r, lane); continue; } r -= IPA;
        if (r < IPB) { tr_item(a.in[I_W_PB] + (size_t)l * 1024 * 1024, 1024, 16, (bf16_t*)(wb + WB_WPT) + 1024, 3328, MapId(), nullptr, scr, r, lane); continue; } r -= IPB;
        if (r < IPC) { tr_item(a.in[I_W_PC] + (size_t)l * 1280 * 1024, 1024, 20, (bf16_t*)(wb + WB_WPT) + 2048, 3328, MapId(), nullptr, scr, r, lane); continue; } r -= IPC;
        tr_item(a.in[I_W_OUT] + (size_t)l * 1024 * 1024, 1024, 16, (bf16_t*)(wb + WB_WOT), 1024, MapId(), nullptr, scr, r, lane);
    }
    const int gt = (F.vcu * NWAVES + F.wave) * 64 + lane, NGT = F.G * NWAVES * 64;
    bf16_t* lwa = (bf16_t*)(ws + WS_LW); bf16_t* lwx = lwa + 16 * 80 * 96;
    const float* w_a = a.in[I_W_A] + (size_t)l * 16 * 80 * 80; const float* w_x = a.in[I_W_X] + (size_t)l * 16 * 80 * 80;
    for (int i = gt; i < 16 * 80 * 96; i += NGT) { const int k = i % 96, j = (i / 96) % 80, blk = i / (96 * 80);
        const float va = (k < 80) ? w_a[((size_t)blk * 80 + k) * 80 + j] : 0.f, vx = (k < 80) ? w_x[((size_t)blk * 80 + k) * 80 + j] : 0.f;
        lwa[i] = f2bf(va); lwx[i] = f2bf(vx); }
    { float* lct = (float*)(ws + WS_LCT); const float* cw = a.in[I_CONV_W] + (size_t)l * 4 * 1280;
      for (int c = gt; c < 1280; c += NGT) { f32x4 v0 = {cw[c], cw[1280 + c], cw[2560 + c], cw[3840 + c]};
          f32x4 v1 = {a.in[I_CONV_B][l * 1280 + c], a.in[I_B_A][l * 1280 + c], a.in[I_B_X][l * 1280 + c], -8.f * 1.4426950408889634f * softplus_neg(a.in[I_LAM][l * 1280 + c])};
          *(f32x4*)(lct + c * 8) = v0; *(f32x4*)(lct + c * 8 + 4) = v1; } }
    bf16_t* gmw = (bf16_t*)(ws + WS_GMW); const float* gws = a.in[I_GM_WS] + (size_t)l * 4 * 128 * 128;
    for (int i = gt; i < 4 * 128 * 128; i += NGT) { const int j = i & 127, ii = (i >> 7) & 127; gmw[i] = f2bf(((j >> 6) <= (ii >> 6)) ? gws[i] : 0.f); }
}
__device__ __forceinline__ void rope_table(const Frame& F, unsigned char* ws) {
    const int gt = (F.vcu * NWAVES + F.wave) * 64 + lane_id(), NGT = F.G * NWAVES * 64;
    float* cs = (float*)(ws + WS_ROPE); float* sn = cs + 2048 * 32;
    for (int i = gt; i < 2048 * 32; i += NGT) { const int s = i >> 5, fi = i & 31; const float inv_freq = powf(10000.f, -(float)(2 * fi) / 64.f); const float ang = (float)s * inv_freq;
        cs[i] = cosf(ang); sn[i] = sinf(ang); }
}
__device__ __forceinline__ void norm_rows(const Frame& F, const bool nostore, const float* xin, const bf16_t* o, const float* g_post, float* xout, const float* g_pre, bf16_t* h) {
    const int gw = F.vcu * NWAVES + F.wave, NGW = F.G * NWAVES; const int lane = lane_id();
    f32x4 v[4], ov[4], nv[4]; u32x2 nov[4];
    if (gw < T) {
#pragma unroll
        for (int j = 0; j < 4; ++j) { nv[j] = *((const f32x4*)(xin + (size_t)gw * DM) + lane + 64 * j); nov[j] = o ? *((const u32x2*)(o + (size_t)gw * DM) + lane + 64 * j) : (u32x2){0u, 0u}; }
    }
    for (int m = gw; m < T; m += NGW) {
#pragma unroll
        for (int j = 0; j < 4; ++j) { v[j] = nv[j]; ov[j] = (f32x4){bf_lo(nov[j].x), bf_hi(nov[j].x), bf_lo(nov[j].y), bf_hi(nov[j].y)}; }
        const int mn = m + NGW;
        if (mn < T) {
#pragma unroll
            for (int j = 0; j < 4; ++j) { nv[j] = *((const f32x4*)(xin + (size_t)mn * DM) + lane + 64 * j); if (o) nov[j] = *((const u32x2*)(o + (size_t)mn * DM) + lane + 64 * j); }
        }
        if (o) {
            float s = 0.f;
#pragma unroll
            for (int j = 0; j < 4; ++j) s += (ov[j].x * ov[j].x + ov[j].y * ov[j].y) + (ov[j].z * ov[j].z + ov[j].w * ov[j].w);
            const float r = rsqrtf(wave_sum(s) * (1.f / DM) + EPS);
            f32x4* xo = (f32x4*)(xout + (size_t)m * DM) + lane;
#pragma unroll
            for (int j = 0; j < 4; ++j) { const f32x4 gp = *((const f32x4*)g_post + lane + 64 * j); v[j] = v[j] + ov[j] * r * gp; if (!nostore) xo[64 * j] = v[j]; }
        }
        if (g_pre) {
            float s = 0.f;
#pragma unroll
            for (int j = 0; j < 4; ++j) s += (v[j].x * v[j].x + v[j].y * v[j].y) + (v[j].z * v[j].z + v[j].w * v[j].w);
            const float r = rsqrtf(wave_sum(s) * (1.f / DM) + EPS);
            u32x2* ho = (u32x2*)(h + (size_t)m * DM) + lane;
#pragma unroll
            for (int j = 0; j < 4; ++j) { const f32x4 gp = *((const f32x4*)g_pre + lane + 64 * j); const f32x4 y = v[j] * r * gp; u32x2 w; w.x = pk_bf16(y.x, y.y); w.y = pk_bf16(y.z, y.w); if (!nostore) ho[64 * j] = w; }
        }
    }
}
using g8::UnitD;
constexpr float QSCALE = 0.07216878364870322f * 1.4426950408889634f;

struct SchedA {
    g8::TileOrder ord; const char* A; const char* B;
    __device__ __forceinline__ bool next(int i, UnitD& u) const { int pm, pn; if (!ord.tile(i, pm, pn)) return false;
        u.A = A + (size_t)pm * 256 * 2048; u.B = B + (size_t)pn * 256 * 2048; u.nt = 16; u.pm = pm; u.pn = pn; u.kind = 0; return true; }
};
struct EpiA {
    bf16_t* misc; bf16_t* xc; bf16_t* y; float* slab; bf16_t* kr; const float* cs; const float* sn;
    template <int KIND>
    __device__ __forceinline__ void body(f32x4 (&acc)[2][2][4][2], const UnitD& u, bf16_t* dst, int ld, int wr, int wc, int fr, int fq) const {
        const int pn = u.pn, rowp = wr * 64 + fr, lc = wc * 32 + 8 * fq;
#pragma unroll
        for (int ai = 0; ai < 2; ++ai)
#pragma unroll
            for (int m = 0; m < 4; ++m) { const int rp = rowp + ai * 128 + m * 16; bf16_t* p = dst + ((size_t)u.pm * 256 + rp) * ld + lc;
#pragma unroll
                for (int bj = 0; bj < 2; ++bj) { f32x4 v0 = acc[ai][bj][m][0], v1 = acc[ai][bj][m][1];
                    if (KIND == 0) {
                        if (pn == 2 && bj == 1) { if (wc < 2) { const int g = 4 * wc + fq; const size_t r = (size_t)u.pm * 256 + rp; const int pos = (int)(r & 2047);
                                const f32x4 c4 = *(const f32x4*)(cs + pos * 32 + 4 * g), s4 = *(const f32x4*)(sn + pos * 32 + 4 * g);
                                const f32x4 o1 = v0 * c4 - v1 * s4, o2 = v1 * c4 + v0 * s4; bf16_t* kp = kr + r * 64 + 4 * g;
                                u32x2 w1, w2; w1.x = pk_bf16(o1.x, o1.y); w1.y = pk_bf16(o1.z, o1.w); w2.x = pk_bf16(o2.x, o2.y); w2.y = pk_bf16(o2.z, o2.w);
                                *(u32x2*)kp = w1; *(u32x2*)(kp + 32) = w2; }
                            continue; }
                        float ss = (v0.x * v0.x + v0.y * v0.y) + (v0.z * v0.z + v0.w * v0.w) + (v1.x * v1.x + v1.y * v1.y) + (v1.z * v1.z + v1.w * v1.w);
                        ss += sx<16>(ss); ss = xsum32(ss);
                        if (fq == 0) slab[(((size_t)u.pm * 6 + pn * 2 + bj) * 4 + wc) * 256 + rp] = ss; }
                    if (KIND == 2) { v0.x = fsilu(v0.x); v0.y = fsilu(v0.y); v0.z = fsilu(v0.z); v0.w = fsilu(v0.w); v1.x = fsilu(v1.x); v1.y = fsilu(v1.y); v1.z = fsilu(v1.z); v1.w = fsilu(v1.w); }
                    u32x4 w; w.x = pk_bf16(v0.x, v0.y); w.y = pk_bf16(v0.z, v0.w); w.z = pk_bf16(v1.x, v1.y); w.w = pk_bf16(v1.z, v1.w);
                    *(u32x4*)(p + bj * 128) = w; } }
    }
    __device__ __forceinline__ void operator()(f32x4 (&acc)[2][2][4][2], const UnitD& u, int wr, int wc, int fr, int fq) const {
        const int pn = u.pn;
        if (pn < 3) body<0>(acc, u, misc + 256 * pn, 768, wr, wc, fr, fq);
        else if (pn < 8) body<1>(acc, u, xc + 256 * (pn - 3), 1280, wr, wc, fr, fq);
        else if (pn < 13) body<2>(acc, u, y + 2048 + 256 * (pn - 8), YLD, wr, wc, fr, fq);
        else body<2>(acc, u, y + 1024 + 256 * (pn - 13), YLD, wr, wc, fr, fq);
    }
};

struct SchedZ {
    int v; const char* A; const char* B;
    __device__ __forceinline__ bool next(int i, UnitD& u) const { if (i > 0 || (v & 3) != 0 || v >= 256) return false; const int pm = v >> 2;
        u.A = A + (size_t)pm * 256 * 2048; u.B = B + (size_t)16 * 256 * 2048; u.nt = 16; u.pm = pm; u.pn = 16; u.kind = 0; return true; }
};
struct SchedQKV {
    int v; const char* misc; const char* wq; const char* wkv;
    __device__ __forceinline__ bool next(int i, UnitD& u) const { if (v >= 256) return false; const int role = v & 3, pm = v >> 2; int pn;
        if (role == 0) { if (i > 0) return false; pn = 0; }
        else if (role == 1) { if (i > 4) return false; pn = (i == 0) ? 1 : 5 + i; }
        else { if (i > 3) return false; pn = (i < 2) ? (2 * role - 2 + i) : (10 + 2 * (role - 2) + (i - 2)); }
        u.pm = pm; u.pn = pn; u.kind = 0;
        if (pn < 6) { u.A = misc + (size_t)pm * 256 * 1536; u.B = wq + (size_t)pn * 256 * 768; u.nt = 6; }
        else { u.A = misc + (size_t)pm * 256 * 1536 + 384 * 2; u.B = wkv + (size_t)(pn - 6) * 256 * 768; u.nt = 4; }
        return true; }
};
struct EpiQKV {
    bf16_t* q; bf16_t* y; bf16_t* vv; const float* slab; const float* cs; const float* sn;
    template <int KIND>
    __device__ __forceinline__ void body(f32x4 (&acc)[2][2][4][2], const UnitD& u, int wr, int wc, int fr, int fq) const {
        const int pn = u.pn, rowp = wr * 64 + fr, lc = wc * 32 + 8 * fq; constexpr bool isq = KIND < 2;
        float rsv[2][4];
#pragma unroll
        for (int ai = 0; ai < 2; ++ai)
#pragma unroll
            for (int m = 0; m < 4; ++m) { const int rp = rowp + ai * 128 + m * 16; float s = 0.f; const float* sl = slab + (size_t)u.pm * 6 * 4 * 256 + rp;
                if (isq) {
#pragma unroll
                    for (int e = 0; e < 3; ++e) { const int j = fq * 3 + e; s += sl[(size_t)((j >> 2) * 4 + (j & 3)) * 256]; }
                } else {
#pragma unroll
                    for (int e = 0; e < 2; ++e) { const int j = fq * 2 + e; s += sl[(size_t)((3 + (j >> 2)) * 4 + (j & 3)) * 256]; }
                }
                rsv[ai][m] = s; }
#pragma unroll
        for (int ai = 0; ai < 2; ++ai)
#pragma unroll
            for (int m = 0; m < 4; ++m) { const int rp = rowp + ai * 128 + m * 16; const size_t r = (size_t)u.pm * 256 + rp;
                float s = rsv[ai][m]; s += sx<16>(s); s = xsum32(s);
                float rs = rsqrtf(s * (isq ? (1.f / 384.f) : (1.f / 256.f)) + EPS); if (isq) rs *= QSCALE;
#pragma unroll
                for (int bj = 0; bj < 2; ++bj) { f32x4 v0 = acc[ai][bj][m][0] * rs, v1 = acc[ai][bj][m][1] * rs;
                    if (KIND == 0) { const int j0 = 256 * pn + 128 * bj + lc; bf16_t* p = q + r * 1536 + (j0 >> 7) * 192 + (j0 & 127);
                        u32x4 w; w.x = pk_bf16(v0.x, v0.y); w.y = pk_bf16(v0.z, v0.w); w.z = pk_bf16(v1.x, v1.y); w.w = pk_bf16(v1.z, v1.w); *(u32x4*)p = w; }
                    else if (KIND == 1) { const int jj = 256 * (pn - 4) + 128 * bj + lc, hh = jj >> 6, g = (jj & 63) >> 3; const int pos = (int)(r & 2047);
                        const f32x4 c4 = *(const f32x4*)(cs + pos * 32 + 4 * g), s4 = *(const f32x4*)(sn + pos * 32 + 4 * g);
                        const f32x4 o1 = v0 * c4 - v1 * s4, o2 = v1 * c4 + v0 * s4; bf16_t* p = q + r * 1536 + hh * 192 + 128 + 4 * g;
                        u32x2 w1, w2; w1.x = pk_bf16(o1.x, o1.y); w1.y = pk_bf16(o1.z, o1.w); w2.x = pk_bf16(o2.x, o2.y); w2.y = pk_bf16(o2.z, o2.w);
                        *(u32x2*)p = w1; *(u32x2*)(p + 32) = w2; }
                    else { const int hd = pn - 6; bf16_t* p = (bj == 0) ? (y + r * YLD + hd * 128 + lc) : (vv + r * 1024 + hd * 128 + lc);
                        u32x4 w; w.x = pk_bf16(v0.x, v0.y); w.y = pk_bf16(v0.z, v0.w); w.z = pk_bf16(v1.x, v1.y); w.w = pk_bf16(v1.z, v1.w); *(u32x4*)p = w; } } }
    }
    __device__ __forceinline__ void operator()(f32x4 (&acc)[2][2][4][2], const UnitD& u, int wr, int wc, int fr, int fq) const {
        if (u.pn < 4) body<0>(acc, u, wr, wc, fr, fq); else if (u.pn < 6) body<1>(acc, u, wr, wc, fr, fq); else body<2>(acc, u, wr, wc, fr, fq);
    }
};

struct SchedD {
    g8::TileOrder ord; const char* A; const char* B;
    __device__ __forceinline__ bool next(int i, UnitD& u) const { int pm, pn; if (!ord.tile(i, pm, pn)) return false;
        u.A = A + (size_t)pm * 256 * 2048; u.B = B + (size_t)pn * 256 * 2048; u.nt = 16; u.pm = pm; u.pn = pn; u.kind = 0; return true; }
};
struct EpiD {
    bf16_t* y; bf16_t* v1; bf16_t* g; float* vslab;
    template <int KIND>
    __device__ __forceinline__ void body(f32x4 (&acc)[2][2][4][2], const UnitD& u, int wr, int wc, int fr, int fq) const {
        const int pn = u.pn, rowp = wr * 64 + fr, lc = wc * 32 + 8 * fq;
#pragma unroll
        for (int ai = 0; ai < 2; ++ai)
#pragma unroll
            for (int m = 0; m < 4; ++m) { const size_t r = (size_t)u.pm * 256 + rowp + ai * 128 + m * 16;
                if (KIND == 0) { const f32x4 u0 = acc[ai][0][m][0], u1 = acc[ai][0][m][1], z0 = acc[ai][1][m][0], z1 = acc[ai][1][m][1];
                    u32x4 w; w.x = pk_bf16(u0.x * fsilu(z0.x), u0.y * fsilu(z0.y)); w.y = pk_bf16(u0.z * fsilu(z0.z), u0.w * fsilu(z0.w));
                    w.z = pk_bf16(u1.x * fsilu(z1.x), u1.y * fsilu(z1.y)); w.w = pk_bf16(u1.z * fsilu(z1.z), u1.w * fsilu(z1.w));
                    *(u32x4*)(y + r * YLD + 128 * pn + lc) = w; }
                else {
#pragma unroll
                    for (int bj = 0; bj < 2; ++bj) { f32x4 v0 = acc[ai][bj][m][0], v1_ = acc[ai][bj][m][1]; bf16_t* p;
                        if (KIND == 1) { p = v1 + r * 1024 + 256 * (pn - 8) + 128 * bj + lc;
                            float s1 = (v0.x + v0.y) + (v0.z + v0.w) + (v1_.x + v1_.y) + (v1_.z + v1_.w);
                            float s2 = (v0.x * v0.x + v0.y * v0.y) + (v0.z * v0.z + v0.w * v0.w) + (v1_.x * v1_.x + v1_.y * v1_.y) + (v1_.z * v1_.z + v1_.w * v1_.w);
                            s1 += sx<16>(s1); s1 = xsum32(s1); s2 += sx<16>(s2); s2 = xsum32(s2);
                            if (fq == 0) *(f32x2*)(vslab + r * 64 + (((pn - 8) * 2 + bj) * 4 + wc) * 2) = (f32x2){s1, s2}; }
                        else { p = g + r * 3072 + 256 * (pn - 12) + 128 * bj + lc;
                            v0.x = fsigmoid(v0.x); v0.y = fsigmoid(v0.y); v0.z = fsigmoid(v0.z); v0.w = fsigmoid(v0.w); v1_.x = fsigmoid(v1_.x); v1_.y = fsigmoid(v1_.y); v1_.z = fsigmoid(v1_.z); v1_.w = fsigmoid(v1_.w); }
                        u32x4 w; w.x = pk_bf16(v0.x, v0.y); w.y = pk_bf16(v0.z, v0.w); w.z = pk_bf16(v1_.x, v1_.y); w.w = pk_bf16(v1_.z, v1_.w); *(u32x4*)p = w; } } }
    }
    __device__ __forceinline__ void operator()(f32x4 (&acc)[2][2][4][2], const UnitD& u, int wr, int wc, int fr, int fq) const {
        if (u.pn < 8) body<0>(acc, u, wr, wc, fr, fq); else if (u.pn < 12) body<1>(acc, u, wr, wc, fr, fq); else body<2>(acc, u, wr, wc, fr, fq);
    }
};

struct SchedF {
    g8::TileOrder ord; const char* A; const char* B;
    __device__ __forceinline__ bool next(int i, UnitD& u) const { if (i >= 3) return false; int pm, pn; if (!ord.tile(0, pm, pn)) return false;
        const size_t ko = (i == 0) ? 0 : (i == 1 ? 1024 * 2 : 2048 * 2);
        u.A = A + (size_t)pm * 256 * (YLD * 2) + ko; u.B = B + (size_t)pn * 256 * (YLD * 2) + ko; u.nt = (i == 2) ? 20 : 16; u.pm = pm; u.pn = pn; u.kind = (i < 2) ? (i | g8::KEEP_ACC) : i; return true; }
};
struct EpiF {
    const bf16_t* g; bf16_t* merged;
    template <bool MID>
    __device__ __forceinline__ void body(f32x4 (&acc)[2][2][4][2], const UnitD& u, int seg, int wr, int wc, int fr, int fq) const {
        const int rowp = wr * 64 + fr, lc = wc * 32 + 8 * fq;
#pragma unroll
        for (int ai = 0; ai < 2; ++ai) {
            u32x4 ga[4][2], gb[4][2];
#pragma unroll
            for (int m = 0; m < 4; ++m) { const size_t r = (size_t)u.pm * 256 + rowp + ai * 128 + m * 16;
#pragma unroll
                for (int bj = 0; bj < 2; ++bj) { const bf16_t* gp = g + r * 3072 + seg * 1024 + 256 * u.pn + 128 * bj + lc; ga[m][bj] = *(const u32x4*)gp; if (MID) gb[m][bj] = *(const u32x4*)(gp + 1024); } }
#pragma unroll
            for (int m = 0; m < 4; ++m) { const size_t r = (size_t)u.pm * 256 + rowp + ai * 128 + m * 16;
#pragma unroll
                for (int bj = 0; bj < 2; ++bj) { const u32x4 a = ga[m][bj]; f32x4 f0, f1;
                    f0.x = bf_lo(a.x); f0.y = bf_hi(a.x); f0.z = bf_lo(a.y); f0.w = bf_hi(a.y); f1.x = bf_lo(a.z); f1.y = bf_hi(a.z); f1.z = bf_lo(a.w); f1.w = bf_hi(a.w);
                    if (MID) { const u32x4 b = gb[m][bj];
                        f0.x *= __builtin_amdgcn_rcpf(bf_lo(b.x)); f0.y *= __builtin_amdgcn_rcpf(bf_hi(b.x)); f0.z *= __builtin_amdgcn_rcpf(bf_lo(b.y)); f0.w *= __builtin_amdgcn_rcpf(bf_hi(b.y));
                        f1.x *= __builtin_amdgcn_rcpf(bf_lo(b.z)); f1.y *= __builtin_amdgcn_rcpf(bf_hi(b.z)); f1.z *= __builtin_amdgcn_rcpf(bf_lo(b.w)); f1.w *= __builtin_amdgcn_rcpf(bf_hi(b.w));
                        acc[ai][bj][m][0] *= f0; acc[ai][bj][m][1] *= f1; }
                    else { const f32x4 v0 = acc[ai][bj][m][0] * f0, v1 = acc[ai][bj][m][1] * f1;
                        u32x4 w; w.x = pk_bf16(v0.x, v0.y); w.y = pk_bf16(v0.z, v0.w); w.z = pk_bf16(v1.x, v1.y); w.w = pk_bf16(v1.z, v1.w);
                        *(u32x4*)(merged + r * 1024 + 256 * u.pn + 128 * bj + lc) = w; } } } }
    }
    __device__ __forceinline__ void operator()(f32x4 (&acc)[2][2][4][2], const UnitD& u, int wr, int wc, int fr, int fq) const {
        const int seg = u.kind & 3; if (seg < 2) body<true>(acc, u, seg, wr, wc, fr, fq); else body<false>(acc, u, seg, wr, wc, fr, fq);
    }
};

struct SchedG1 {
    int v; const char* A; const char* B;
    __device__ __forceinline__ bool next(int i, UnitD& u) const { if (i > 0 || v >= 256) return false; const int pm = v >> 2, pn = v & 3;
        u.A = A + (size_t)pm * 256 * 2048; u.B = B + (size_t)pn * 256 * 2048; u.nt = 16; u.pm = pm; u.pn = pn; u.kind = 0; return true; }
};
struct EpiNorm {
    const float* xin; float* xout; bf16_t* h; const float* g_post; const float* g_pre;
    float* slots; unsigned* cnt;
    __device__ __forceinline__ void exchange(const f32x4 (&v)[2][2][4][2], int pm, int pn, int wr, int wc, int fr, int fq, LAS unsigned char* lds, int wid, int lane, float* sl, unsigned* cn) const {
        LAS float* P = (LAS float*)lds; LAS float* S = (LAS float*)(lds + 4096);
#pragma unroll
        for (int ai = 0; ai < 2; ++ai)
#pragma unroll
            for (int m = 0; m < 4; ++m) { float s = 0.f;
#pragma unroll
                for (int bj = 0; bj < 2; ++bj)
#pragma unroll
                    for (int n = 0; n < 2; ++n) { const f32x4 x = v[ai][bj][m][n]; s += (x.x * x.x + x.y * x.y) + (x.z * x.z + x.w * x.w); }
                s += sx<16>(s); s = xsum32(s);
                if (fq == 0) P[(ai * 128 + wr * 64 + m * 16 + fr) * 4 + wc] = s; }
        asm volatile("s_waitcnt lgkmcnt(0)" ::: "memory"); __builtin_amdgcn_s_barrier(); asm volatile("" ::: "memory");
        const int row = wid * 32 + (lane & 31);
        if (lane < 32) { const f32x4 p4 = *(const LAS f32x4*)(P + row * 4); const float tot = (p4.x + p4.y) + (p4.z + p4.w);
            __hip_atomic_store((unsigned*)sl + ((size_t)pm * 256 + row) * 4 + pn, __float_as_uint(tot), __ATOMIC_RELAXED, __HIP_MEMORY_SCOPE_AGENT); }
        asm volatile("s_waitcnt vmcnt(0)" ::: "memory");
        if (lane == 0) __hip_atomic_fetch_add(cn, 1u, __ATOMIC_RELAXED, __HIP_MEMORY_SCOPE_AGENT);
        if (wid == 0) { for (unsigned sp = 0; sp < (1u << 20); ++sp) { if ((unsigned)__builtin_amdgcn_readfirstlane(__hip_atomic_load(cn, __ATOMIC_RELAXED, __HIP_MEMORY_SCOPE_AGENT)) >= 32u) break; __builtin_amdgcn_s_sleep(2); } }
        asm volatile("s_waitcnt vmcnt(0) lgkmcnt(0)" ::: "memory"); __builtin_amdgcn_s_barrier(); asm volatile("" ::: "memory");
        if (lane < 32) { const unsigned* sp4 = (const unsigned*)sl + ((size_t)pm * 256 + row) * 4; float tot = 0.f;
#pragma unroll
            for (int t = 0; t < 4; ++t) tot += __uint_as_float(__hip_atomic_load(sp4 + t, __ATOMIC_RELAXED, __HIP_MEMORY_SCOPE_AGENT));
            S[row] = rsqrtf(tot * (1.f / 1024.f) + EPS); }
        asm volatile("s_waitcnt lgkmcnt(0)" ::: "memory"); __builtin_amdgcn_s_barrier(); asm volatile("" ::: "memory");
    }
    __device__ __forceinline__ void fused(f32x4 (&acc)[2][2][4][2], const UnitD& u, int wr, int wc, int fr, int fq, LAS unsigned char* lds, int wid, int lane) const {
        const LAS float* S = (const LAS float*)(lds + 4096);
        const int lc = wc * 32 + 8 * fq, col0 = 256 * u.pn + lc;
        f32x4 xr[4][2][2];
#pragma unroll
        for (int m = 0; m < 4; ++m) { const size_t off = ((size_t)u.pm * 256 + wr * 64 + m * 16 + fr) * 1024 + col0;
#pragma unroll
            for (int bj = 0; bj < 2; ++bj) { xr[m][bj][0] = *(const f32x4*)(xin + off + bj * 128); xr[m][bj][1] = *(const f32x4*)(xin + off + bj * 128 + 4); } }
        exchange(acc, u.pm, u.pn, wr, wc, fr, fq, lds, wid, lane, slots, cnt + u.pm * 16);
        f32x4 gp[2][2];
#pragma unroll
        for (int bj = 0; bj < 2; ++bj) { gp[bj][0] = *(const f32x4*)(g_post + col0 + bj * 128); gp[bj][1] = *(const f32x4*)(g_post + col0 + bj * 128 + 4); }
#pragma unroll
        for (int ai = 0; ai < 2; ++ai) {
            if (ai == 1) {
#pragma unroll
                for (int m = 0; m < 4; ++m) { const size_t off = ((size_t)u.pm * 256 + 128 + wr * 64 + m * 16 + fr) * 1024 + col0;
#pragma unroll
                    for (int bj = 0; bj < 2; ++bj) { xr[m][bj][0] = *(const f32x4*)(xin + off + bj * 128); xr[m][bj][1] = *(const f32x4*)(xin + off + bj * 128 + 4); } } }
#pragma unroll
            for (int m = 0; m < 4; ++m) { const int r = ai * 128 + wr * 64 + m * 16 + fr; const float rs = S[r]; const size_t off = ((size_t)u.pm * 256 + r) * 1024 + col0;
#pragma unroll
                for (int bj = 0; bj < 2; ++bj) {
                    const f32x4 y0 = xr[m][bj][0] + acc[ai][bj][m][0] * rs * gp[bj][0], y1 = xr[m][bj][1] + acc[ai][bj][m][1] * rs * gp[bj][1];
                    acc[ai][bj][m][0] = y0; acc[ai][bj][m][1] = y1;
                    *(f32x4*)(xout + off + bj * 128) = y0; *(f32x4*)(xout + off + bj * 128 + 4) = y1; } } }
        if (g_pre) {
            exchange(acc, u.pm, u.pn, wr, wc, fr, fq, lds, wid, lane, slots + (size_t)T * 4, cnt + 64 * 16 + u.pm * 16);
#pragma unroll
            for (int bj = 0; bj < 2; ++bj) { gp[bj][0] = *(const f32x4*)(g_pre + col0 + bj * 128); gp[bj][1] = *(const f32x4*)(g_pre + col0 + bj * 128 + 4); }
#pragma unroll
            for (int ai = 0; ai < 2; ++ai)
#pragma unroll
                for (int m = 0; m < 4; ++m) { const int r = ai * 128 + wr * 64 + m * 16 + fr; const float rs = S[r]; const size_t off = ((size_t)u.pm * 256 + r) * 1024 + col0;
#pragma unroll
                    for (int bj = 0; bj < 2; ++bj) { const f32x4 y0 = acc[ai][bj][m][0] * rs * gp[bj][0], y1 = acc[ai][bj][m][1] * rs * gp[bj][1];
                        u32x4 w; w.x = pk_bf16(y0.x, y0.y); w.y = pk_bf16(y0.z, y0.w); w.z = pk_bf16(y1.x, y1.y); w.w = pk_bf16(y1.z, y1.w);
                        *(u32x4*)(h + off + bj * 128) = w; } }
        }
    }
    __device__ __forceinline__ void operator()(f32x4 (&)[2][2][4][2], const UnitD&, int, int, int, int) const {}
};
typedef float f32x2v __attribute__((ext_vector_type(2)));

constexpr int LRU_HIN_OFF = RING_BYTES + 1024;
template <int PASS>
__device__ __forceinline__ void lru_item(const Frame& F, const Args& a, const unsigned char* ws, const bool nostore, int l, int item, const bf16_t* xcb, bf16_t* y, float* agg) {
    const int b = item >> 5, k = item & 31; const size_t r0 = (size_t)b * SEQ + (size_t)k * 64;
    int lane_ = lane_id(); asm volatile("" : "+v"(lane_));
    const int lane = lane_, cl = lane & 15, kg = lane >> 4;
    LAS unsigned char* xt = F.lds + F.wave * 16384;
    const bf16_t* lwa = (const bf16_t*)(ws + WS_LW); const bf16_t* lwx = lwa + 16 * 80 * 96;
    const float* lct = (const float*)(ws + WS_LCT);
    LAS float* hin_l = (LAS float*)(F.lds + LRU_HIN_OFF);
    if (PASS == 2) {
        for (int c = F.wave * 64 + lane; c < 1280; c += 512) { const float* ag = agg + ((size_t)b * 32 * 1280 + c) * 2; float h = 0.f;
#pragma unroll 8
            for (int j = 0; j < k; ++j) { const f32x2v ab = *(const f32x2v*)(ag + (size_t)j * 2560); h = ab.x * h + ab.y; }
            hin_l[c] = h; }
        LDS_WAIT(); __syncthreads();
    }
#pragma unroll 1
    for (int bi = 0; bi < 2; ++bi) {
        const int blk = 2 * F.wave + bi;
        {
            u32x4 xch[11]; int ln = lane; asm volatile("" : "+v"(ln));
            const bf16_t* xbase = xcb + (r0 - 3) * 1280 + blk * 80;
#pragma unroll
            for (int i = 0; i < 11; ++i) { const int idx = ln + 64 * i; const int row = idx / 10, ch = idx - row * 10; xch[i] = (u32x4){0u, 0u, 0u, 0u};
                if (idx < 670 && !(k == 0 && row < 3)) xch[i] = *(const u32x4*)(xbase + (unsigned)(row * 1280 + ch * 8)); }
#pragma unroll
            for (int i = 0; i < 11; ++i) { const int idx = ln + 64 * i; const int row = idx / 10, ch = idx - row * 10; if (idx < 670) *(LAS u32x4*)(xt + row * 208 + ch * 16) = xch[i]; }
            LAS u32x4* z = (LAS u32x4*)(xt + (lane + 3) * 208 + 160); z[0] = (u32x4){0u, 0u, 0u, 0u}; z[1] = (u32x4){0u, 0u, 0u, 0u};
        }
        LDS_WAIT(); asm volatile("" ::: "memory");
#pragma unroll
        for (int ct = 0; ct < 5; ++ct) { const int c = blk * 80 + 16 * ct + cl; const f32x4 cw = *(const f32x4*)(lct + c * 8); const float cb = lct[c * 8 + 4];
            float xv[4][7];
#pragma unroll
            for (int rt = 0; rt < 4; ++rt)
#pragma unroll
                for (int j = 0; j < 7; ++j) xv[rt][j] = bf1(*(const LAS bf16_t*)(xt + (16 * rt + 4 * kg + j) * 208 + (16 * ct + cl) * 2));
            asm volatile("" ::: "memory");
#pragma unroll
            for (int rt = 0; rt < 4; ++rt)
#pragma unroll
                for (int e = 0; e < 4; ++e) { const float v = cb + cw.x * xv[rt][e] + cw.y * xv[rt][e + 1] + cw.z * xv[rt][e + 2] + cw.w * xv[rt][e + 3];
                    *(LAS bf16_t*)(xt + (16 * rt + 4 * kg + e + 3) * 208 + (16 * ct + cl) * 2) = f2bf(v); }
            asm volatile("" ::: "memory"); }
        LDS_WAIT(); asm volatile("" ::: "memory");
        bf16x8 af[4][3];
#pragma unroll
        for (int rt = 0; rt < 4; ++rt)
#pragma unroll
            for (int ks = 0; ks < 3; ++ks) af[rt][ks] = *(const LAS bf16x8*)(xt + (16 * rt + cl + 3) * 208 + (32 * ks + 8 * kg) * 2);
        bf16x8 wA[2][3], wX[2][3];
#pragma unroll
        for (int ks = 0; ks < 3; ++ks) { const size_t wo = ((size_t)blk * 80 + cl) * 96 + 32 * ks + 8 * kg; wA[0][ks] = *(const bf16x8*)(lwa + wo); wX[0][ks] = *(const bf16x8*)(lwx + wo); }
#pragma unroll
        for (int ct = 0; ct < 5; ++ct) { const int c = blk * 80 + 16 * ct + cl; const int cur = ct & 1;
            if (ct + 1 < 5) {
#pragma unroll
                for (int ks = 0; ks < 3; ++ks) { const size_t wo = ((size_t)blk * 80 + 16 * (ct + 1) + cl) * 96 + 32 * ks + 8 * kg; wA[cur ^ 1][ks] = *(const bf16x8*)(lwa + wo); wX[cur ^ 1][ks] = *(const bf16x8*)(lwx + wo); } }
            const f32x4 c1 = *(const f32x4*)(lct + c * 8 + 4); const float ba_c = c1.y, bx_c = c1.z, sp8 = c1.w;
            f32x4 ra[4], rx[4];
#pragma unroll
            for (int rt = 0; rt < 4; ++rt) { ra[rt] = (f32x4){0.f, 0.f, 0.f, 0.f}; rx[rt] = (f32x4){0.f, 0.f, 0.f, 0.f}; }
#pragma unroll
            for (int ks = 0; ks < 3; ++ks)
#pragma unroll
                for (int rt = 0; rt < 4; ++rt) { ra[rt] = __builtin_amdgcn_mfma_f32_16x16x32_bf16(af[rt][ks], wA[cur][ks], ra[rt], 0, 0, 0); rx[rt] = __builtin_amdgcn_mfma_f32_16x16x32_bf16(af[rt][ks], wX[cur][ks], rx[rt], 0, 0, 0); }
            float hin = (PASS == 2) ? hin_l[c] : 0.f; float totA = 1.f, totB = 0.f;
#pragma unroll
            for (int rt = 0; rt < 4; ++rt) { float av[4], bv[4];
#pragma unroll
                for (int e = 0; e < 4; ++e) { const float r = fsigmoid(ra[rt][e] + ba_c), ig = fsigmoid(rx[rt][e] + bx_c);
                    const float aa = fexp2(sp8 * r); const float mult = __builtin_amdgcn_sqrtf(fmaxf(1.f - aa * aa, 0.f));
                    const float xcv = bf1(*(const LAS bf16_t*)(xt + (16 * rt + 4 * kg + e + 3) * 208 + (16 * ct + cl) * 2));
                    av[e] = aa; bv[e] = mult * ig * xcv; }
                float sA = av[0], sB = bv[0];
#pragma unroll
                for (int e = 1; e < 4; ++e) { sB = av[e] * sB + bv[e]; sA *= av[e]; }
                float iA = sA, iB = sB;
                { const float pA = __shfl(iA, lane - 16), pB = __shfl(iB, lane - 16); if (kg >= 1) { iB = iA * pB + iB; iA = iA * pA; } }
                { const float pA = __shfl(iA, lane - 32), pB = __shfl(iB, lane - 32); if (kg >= 2) { iB = iA * pB + iB; iA = iA * pA; } }
                const float tA = __shfl(iA, 48 + cl), tB = __shfl(iB, 48 + cl);
                if (PASS == 1) { totB = tA * totB + tB; totA *= tA; }
                else {
                    float eA = __shfl(iA, lane - 16), eB = __shfl(iB, lane - 16); if (kg == 0) { eA = 1.f; eB = 0.f; }
                    float h = eA * hin + eB;
#pragma unroll
                    for (int e = 0; e < 4; ++e) { h = av[e] * h + bv[e]; *(LAS bf16_t*)(xt + (16 * rt + 4 * kg + e + 3) * 208 + (16 * ct + cl) * 2) = f2bf(h); }
                    hin = tA * hin + tB;
                }
            }
            if (PASS == 1) { if (kg == 0) *(f32x2v*)(agg + (((size_t)b * 32 + k) * 1280 + c) * 2) = (f32x2v){totA, totB}; }
        }
        LDS_WAIT(); asm volatile("" ::: "memory");
        if (PASS == 2) {
            int ln = lane; asm volatile("" : "+v"(ln));
            bf16_t* ybase = y + r0 * YLD + 2048 + blk * 80; u32x4 zc[10];
#pragma unroll
            for (int i = 0; i < 10; ++i) { const int idx = ln + 64 * i; const int row = idx / 10, ch = idx - row * 10; zc[i] = *(const u32x4*)(ybase + (unsigned)(row * YLD + ch * 8)); }
#pragma unroll
            for (int i = 0; i < 10; ++i) { const int idx = ln + 64 * i; const int row = idx / 10, ch = idx - row * 10; const u32x4 hv = *(const LAS u32x4*)(xt + (row + 3) * 208 + ch * 16); u32x4 o;
                o.x = pk_bf16(bf_lo(hv.x) * bf_lo(zc[i].x), bf_hi(hv.x) * bf_hi(zc[i].x)); o.y = pk_bf16(bf_lo(hv.y) * bf_lo(zc[i].y), bf_hi(hv.y) * bf_hi(zc[i].y));
                o.z = pk_bf16(bf_lo(hv.z) * bf_lo(zc[i].z), bf_hi(hv.z) * bf_hi(zc[i].z)); o.w = pk_bf16(bf_lo(hv.w) * bf_lo(zc[i].w), bf_hi(hv.w) * bf_hi(zc[i].w));
                if (!nostore) *(u32x4*)(ybase + (unsigned)(row * YLD + ch * 8)) = o; }
            LDS_WAIT(); asm volatile("" ::: "memory");
        }
    }
    if (PASS == 2) __syncthreads();
}

constexpr int CW_LRUF = 8192;
__device__ __forceinline__ void lru_single(const Frame& F, const unsigned char* ws, unsigned* ctl, const bool nostore, int l, int item, const bf16_t* xcb, bf16_t* y, float* agg) {
    const int b = item >> 5, k = item & 31; const size_t r0 = (size_t)b * SEQ + (size_t)k * 64;
    int lane_ = lane_id(); asm volatile("" : "+v"(lane_));
    const int lane = lane_, cl = lane & 15, kg = lane >> 4;
    LAS unsigned char* xt = F.lds + F.wave * 16384;
    const bf16_t* lwa = (const bf16_t*)(ws + WS_LW); const bf16_t* lwx = lwa + 16 * 80 * 96;
    const float* lct = (const float*)(ws + WS_LCT);
    const unsigned epoch = (unsigned)l + 1u;
    unsigned* flags = ctl + CW_LRUF + b * 32 * 16;
    unsigned long long* agg64 = (unsigned long long*)agg;
#pragma unroll 1
    for (int bi = 0; bi < 2; ++bi) {
        const int blk = 2 * F.wave + bi;
        {
            u32x4 xch[11]; int ln = lane; asm volatile("" : "+v"(ln));
            const bf16_t* xbase = xcb + (r0 - 3) * 1280 + blk * 80;
#pragma unroll
            for (int i = 0; i < 11; ++i) { const int idx = ln + 64 * i; const int row = idx / 10, ch = idx - row * 10; xch[i] = (u32x4){0u, 0u, 0u, 0u};
                if (idx < 670 && !(k == 0 && row < 3)) xch[i] = *(const u32x4*)(xbase + (unsigned)(row * 1280 + ch * 8)); }
#pragma unroll
            for (int i = 0; i < 11; ++i) { const int idx = ln + 64 * i; const int row = idx / 10, ch = idx - row * 10; if (idx < 670) *(LAS u32x4*)(xt + row * 208 + ch * 16) = xch[i]; }
            LAS u32x4* z = (LAS u32x4*)(xt + (lane + 3) * 208 + 160); z[0] = (u32x4){0u, 0u, 0u, 0u}; z[1] = (u32x4){0u, 0u, 0u, 0u};
        }
        LDS_WAIT(); asm volatile("" ::: "memory");
#pragma unroll
        for (int ct = 0; ct < 5; ++ct) { const int c = blk * 80 + 16 * ct + cl; const f32x4 cw = *(const f32x4*)(lct + c * 8); const float cb = lct[c * 8 + 4];
            float xv[4][7];
#pragma unroll
            for (int rt = 0; rt < 4; ++rt)
#pragma unroll
                for (int j = 0; j < 7; ++j) xv[rt][j] = bf1(*(const LAS bf16_t*)(xt + (16 * rt + 4 * kg + j) * 208 + (16 * ct + cl) * 2));
            asm volatile("" ::: "memory");
#pragma unroll
            for (int rt = 0; rt < 4; ++rt)
#pragma unroll
                for (int e = 0; e < 4; ++e) { const float v = cb + cw.x * xv[rt][e] + cw.y * xv[rt][e + 1] + cw.z * xv[rt][e + 2] + cw.w * xv[rt][e + 3];
                    *(LAS bf16_t*)(xt + (16 * rt + 4 * kg + e + 3) * 208 + (16 * ct + cl) * 2) = f2bf(v); }
            asm volatile("" ::: "memory"); }
        LDS_WAIT(); asm volatile("" ::: "memory");
        bf16x8 af[4][3];
#pragma unroll
        for (int rt = 0; rt < 4; ++rt)
#pragma unroll
            for (int ks = 0; ks < 3; ++ks) af[rt][ks] = *(const LAS bf16x8*)(xt + (16 * rt + cl + 3) * 208 + (32 * ks + 8 * kg) * 2);
        bf16x8 wA[3], wX[3];
#pragma unroll
        for (int ks = 0; ks < 3; ++ks) { const size_t wo = ((size_t)blk * 80 + cl) * 96 + 32 * ks + 8 * kg; wA[ks] = *(const bf16x8*)(lwa + wo); wX[ks] = *(const bf16x8*)(lwx + wo); }
        unsigned pk[5][4][2];
#pragma unroll
        for (int ct = 0; ct < 5; ++ct) { const int c = blk * 80 + 16 * ct + cl;
            const f32x4 c1 = *(const f32x4*)(lct + c * 8 + 4); const float ba_c = c1.y, bx_c = c1.z, sp8 = c1.w;
            f32x4 ra[4], rx[4];
#pragma unroll
            for (int rt = 0; rt < 4; ++rt) { ra[rt] = (f32x4){0.f, 0.f, 0.f, 0.f}; rx[rt] = (f32x4){0.f, 0.f, 0.f, 0.f}; }
#pragma unroll
            for (int ks = 0; ks < 3; ++ks)
#pragma unroll
                for (int rt = 0; rt < 4; ++rt) { ra[rt] = __builtin_amdgcn_mfma_f32_16x16x32_bf16(af[rt][ks], wA[ks], ra[rt], 0, 0, 0); rx[rt] = __builtin_amdgcn_mfma_f32_16x16x32_bf16(af[rt][ks], wX[ks], rx[rt], 0, 0, 0); }
            if (ct + 1 < 5) {
#pragma unroll
                for (int ks = 0; ks < 3; ++ks) { const size_t wo = ((size_t)blk * 80 + 16 * (ct + 1) + cl) * 96 + 32 * ks + 8 * kg; wA[ks] = *(const bf16x8*)(lwa + wo); wX[ks] = *(const bf16x8*)(lwx + wo); } }
            float av[4][4], bv[4][4], iA[4], iB[4];
#pragma unroll
            for (int rt = 0; rt < 4; ++rt) {
#pragma unroll
                for (int e = 0; e < 4; ++e) { const float r = fsigmoid(ra[rt][e] + ba_c), ig = fsigmoid(rx[rt][e] + bx_c);
                    const float aa = fexp2(sp8 * r); const float mult = __builtin_amdgcn_sqrtf(fmaxf(1.f - aa * aa, 0.f));
                    const float xcv = bf1(*(const LAS bf16_t*)(xt + (16 * rt + 4 * kg + e + 3) * 208 + (16 * ct + cl) * 2));
                    av[rt][e] = aa; bv[rt][e] = mult * ig * xcv; }
                float sA = av[rt][0], sB = bv[rt][0];
#pragma unroll
                for (int e = 1; e < 4; ++e) { sB = av[rt][e] * sB + bv[rt][e]; sA *= av[rt][e]; }
                iA[rt] = sA; iB[rt] = sB; }
            { float pA[4], pB[4];
#pragma unroll
              for (int rt = 0; rt < 4; ++rt) { pA[rt] = __shfl(iA[rt], lane - 16); pB[rt] = __shfl(iB[rt], lane - 16); }
#pragma unroll
              for (int rt = 0; rt < 4; ++rt) if (kg >= 1) { iB[rt] = iA[rt] * pB[rt] + iB[rt]; iA[rt] = iA[rt] * pA[rt]; }
#pragma unroll
              for (int rt = 0; rt < 4; ++rt) { pA[rt] = __shfl(iA[rt], lane - 32); pB[rt] = __shfl(iB[rt], lane - 32); }
#pragma unroll
              for (int rt = 0; rt < 4; ++rt) if (kg >= 2) { iB[rt] = iA[rt] * pB[rt] + iB[rt]; iA[rt] = iA[rt] * pA[rt]; } }
            float tA[4], tB[4], eA[4], eB[4];
#pragma unroll
            for (int rt = 0; rt < 4; ++rt) { tA[rt] = __shfl(iA[rt], 48 + cl); tB[rt] = __shfl(iB[rt], 48 + cl); eA[rt] = __shfl(iA[rt], lane - 16); eB[rt] = __shfl(iB[rt], lane - 16); }
            float hl = 0.f, pl = 1.f;
#pragma unroll
            for (int rt = 0; rt < 4; ++rt) { if (kg == 0) { eA[rt] = 1.f; eB[rt] = 0.f; }
                float h = eA[rt] * hl + eB[rt], pp = eA[rt] * pl, P[4];
#pragma unroll
                for (int e = 0; e < 4; ++e) { h = av[rt][e] * h + bv[rt][e]; pp *= av[rt][e]; P[e] = pp;
                    *(LAS bf16_t*)(xt + (16 * rt + 4 * kg + e + 3) * 208 + (16 * ct + cl) * 2) = f2bf(h); }
                pk[ct][rt][0] = pk_bf16(P[0], P[1]); pk[ct][rt][1] = pk_bf16(P[2], P[3]);
                hl = tA[rt] * hl + tB[rt]; pl *= tA[rt];
            }
            if (kg == 0) __hip_atomic_store(agg64 + ((size_t)b * 32 + k) * 1280 + c, ((unsigned long long)__float_as_uint(hl) << 32) | (unsigned long long)__float_as_uint(pl), __ATOMIC_RELAXED, __HIP_MEMORY_SCOPE_AGENT);
        }
        asm volatile("s_waitcnt vmcnt(0)" ::: "memory");
        if (lane == 0) __hip_atomic_store(flags + k * 16 + blk, epoch, __ATOMIC_RELAXED, __HIP_MEMORY_SCOPE_AGENT);
        if (k > 0) {
            for (unsigned spins = 0; spins < (1u << 20); ++spins) {
                const unsigned f = (lane < k) ? __hip_atomic_load(flags + lane * 16 + blk, __ATOMIC_RELAXED, __HIP_MEMORY_SCOPE_AGENT) : epoch;
                if (__all(f == epoch)) break;
                __builtin_amdgcn_s_sleep(2);
            }
            float fa[5], fb[5];
#pragma unroll
            for (int ct = 0; ct < 5; ++ct) { fa[ct] = 1.f; fb[ct] = 0.f; }
            const int j0 = (k * kg) >> 2, j1 = (k * (kg + 1)) >> 2;
            const unsigned long long* ag0 = agg64 + (size_t)b * 32 * 1280 + blk * 80 + cl;
            {
                unsigned long long w[8][5];
#pragma unroll
                for (int jj = 0; jj < 8; ++jj)
#pragma unroll
                    for (int ct = 0; ct < 5; ++ct) w[jj][ct] = (j0 + jj < j1) ? __hip_atomic_load(ag0 + (size_t)(j0 + jj) * 1280 + 16 * ct, __ATOMIC_RELAXED, __HIP_MEMORY_SCOPE_AGENT) : 0x000000003f800000ull;
#pragma unroll
                for (int jj = 0; jj < 8; ++jj)
#pragma unroll
                    for (int ct = 0; ct < 5; ++ct) { const float A = __uint_as_float((unsigned)w[jj][ct]), B = __uint_as_float((unsigned)(w[jj][ct] >> 32)); fb[ct] = A * fb[ct] + B; fa[ct] *= A; } }
#pragma unroll
            for (int ct = 0; ct < 5; ++ct) { float iA = fa[ct], iB = fb[ct];
                { const float pA = __shfl(iA, lane - 16), pB = __shfl(iB, lane - 16); if (kg >= 1) { iB = iA * pB + iB; iA = iA * pA; } }
                { const float pA = __shfl(iA, lane - 32), pB = __shfl(iB, lane - 32); if (kg >= 2) { iB = iA * pB + iB; iA = iA * pA; } }
                const float cin = __shfl(iB, 48 + cl);
#pragma unroll
                for (int rt = 0; rt < 4; ++rt) { const float P[4] = {bf_lo(pk[ct][rt][0]), bf_hi(pk[ct][rt][0]), bf_lo(pk[ct][rt][1]), bf_hi(pk[ct][rt][1])};
#pragma unroll
                    for (int e = 0; e < 4; ++e) { LAS bf16_t* hp = (LAS bf16_t*)(xt + (16 * rt + 4 * kg + e + 3) * 208 + (16 * ct + cl) * 2); *hp = f2bf(bf1(*hp) + P[e] * cin); } } }
        }
        LDS_WAIT(); asm volatile("" ::: "memory");
        {
            int ln = lane; asm volatile("" : "+v"(ln));
            bf16_t* ybase = y + r0 * YLD + 2048 + blk * 80; u32x4 zc[10];
#pragma unroll
            for (int i = 0; i < 10; ++i) { const int idx = ln + 64 * i; const int row = idx / 10, ch = idx - row * 10; zc[i] = *(const u32x4*)(ybase + (unsigned)(row * YLD + ch * 8)); }
#pragma unroll
            for (int i = 0; i < 10; ++i) { const int idx = ln + 64 * i; const int row = idx / 10, ch = idx - row * 10; const u32x4 hv = *(const LAS u32x4*)(xt + (row + 3) * 208 + ch * 16); u32x4 o;
                o.x = pk_bf16(bf_lo(hv.x) * bf_lo(zc[i].x), bf_hi(hv.x) * bf_hi(zc[i].x)); o.y = pk_bf16(bf_lo(hv.y) * bf_lo(zc[i].y), bf_hi(hv.y) * bf_hi(zc[i].y));
                o.z = pk_bf16(bf_lo(hv.z) * bf_lo(zc[i].z), bf_hi(hv.z) * bf_hi(zc[i].z)); o.w = pk_bf16(bf_lo(hv.w) * bf_lo(zc[i].w), bf_hi(hv.w) * bf_hi(zc[i].w));
                if (!nostore) *(u32x4*)(ybase + (unsigned)(row * YLD + ch * 8)) = o; }
            LDS_WAIT(); asm volatile("" ::: "memory");
        }
    }
}
__device__ __forceinline__ void phaseB_lru(const Frame& F, const unsigned char* ws, unsigned* ctl, const bool nostore, int l, const bf16_t* xc, bf16_t* y, float* agg) {
    for (int item = F.vcu; item < NBATCH * 32; item += F.G) lru_single(F, ws, ctl, nostore, l, item, xc, y, agg);
}

__device__ __forceinline__ void phaseB_extra(const Frame& F, const Args& a, const unsigned char* ws, int l, const bf16_t* misc, bf16_t* kr, const bf16_t* xc, float* agg, const float* cs, const float* sn) {
    for (int item = F.vcu; item < NBATCH * 32; item += F.G) lru_item<1>(F, a, ws, false, l, item, xc, nullptr, agg);
}

namespace att {
constexpr int SHM_V = 64 * 128 * 2, SHM_K = 64 * 192 * 2, OFF_K = 2 * SHM_V, OFF_WS = OFF_K + 2 * SHM_K, LDS_TOTAL = OFF_WS + 8 * 64 * 4;
constexpr float THR = 8.f;
constexpr float NEGBIG = -1e30f;
constexpr int KVBLK_ = 64;
#define ATT_SBAR() __builtin_amdgcn_sched_barrier(0)
__device__ __forceinline__ int crow(int r, int hi) { return (r & 3) + 8 * (r >> 2) + 4 * hi; }
__device__ __forceinline__ int koff(int row, int sub, int chunk) { return sub * 8192 + row * 128 + ((chunk ^ ((row >> 1) & 7)) << 4); }
__device__ __forceinline__ void partialSM(f32x16& p0, f32x16& p1, float& m_reg, float& alpha) {
    float pmax = p0[0];
#pragma unroll
    for (int r = 1; r < 16; ++r) pmax = fmaxf(pmax, p0[r]);
#pragma unroll
    for (int r = 0; r < 16; ++r) pmax = fmaxf(pmax, p1[r]);
    { auto rr = __builtin_amdgcn_permlane32_swap(__float_as_uint(pmax), __float_as_uint(pmax), false, false); pmax = fmaxf(__uint_as_float(rr[0]), __uint_as_float(rr[1])); }
    float mn;
    if (__builtin_expect(__all(pmax - m_reg <= THR), 1)) { mn = m_reg; alpha = 1.f; }
    else { mn = fmaxf(m_reg, pmax); alpha = __builtin_amdgcn_exp2f(m_reg - mn); m_reg = mn; }
#pragma unroll
    for (int r = 0; r < 16; ++r) p0[r] = __builtin_amdgcn_exp2f(p0[r] - mn);
#pragma unroll
    for (int r = 0; r < 16; ++r) p1[r] = p1[r] - mn;
}
__device__ __forceinline__ void finishSM(f32x16& p0, f32x16& p1, float alpha, float& l_reg, bf16x8& pa0, bf16x8& pa1, bf16x8& pa2, bf16x8& pa3) {
#pragma unroll
    for (int r = 0; r < 16; ++r) p1[r] = __builtin_amdgcn_exp2f(p1[r]);
    float ps = 0.f;
#pragma unroll
    for (int r = 0; r < 16; ++r) ps += p0[r];
#pragma unroll
    for (int r = 0; r < 16; ++r) ps += p1[r];
    { auto rr = __builtin_amdgcn_permlane32_swap(__float_as_uint(ps), __float_as_uint(ps), false, false); ps = __uint_as_float(rr[0]) + __uint_as_float(rr[1]); }
    l_reg = l_reg * alpha + ps;
#define ATT_PK4(P, BASE, OUT) do { unsigned a0 = pk_bf16(P[BASE + 0], P[BASE + 1]), a1 = pk_bf16(P[BASE + 2], P[BASE + 3]);   \
    unsigned b0 = pk_bf16(P[BASE + 4], P[BASE + 5]), b1 = pk_bf16(P[BASE + 6], P[BASE + 7]);                              \
    auto r0 = __builtin_amdgcn_permlane32_swap(a0, b0, false, false); auto r1 = __builtin_amdgcn_permlane32_swap(a1, b1, false, false); \
    u32x4 w = {r0[0], r1[0], r0[1], r1[1]}; OUT = __builtin_bit_cast(bf16x8, w); } while (0)
    ATT_PK4(p0, 0, pa0); ATT_PK4(p0, 8, pa1); ATT_PK4(p1, 0, pa2); ATT_PK4(p1, 8, pa3);
#undef ATT_PK4
}
__device__ __forceinline__ void qkt(f32x16& p0, f32x16& p1, const LAS unsigned char* Ks, const bf16x8* qr, int r32, int hi) {
    p0 = f32x16{}; p1 = f32x16{};
#pragma unroll
    for (int d0 = 0; d0 < 12; ++d0) { const int sub = d0 >> 2, chunk = (d0 & 3) * 2 + hi;
        const bf16x8 b0 = *(const LAS bf16x8*)(Ks + koff(r32, sub, chunk));
        const bf16x8 b1 = *(const LAS bf16x8*)(Ks + koff(32 + r32, sub, chunk));
        p0 = __builtin_amdgcn_mfma_f32_32x32x16_bf16(b0, qr[d0], p0, 0, 0, 0);
        p1 = __builtin_amdgcn_mfma_f32_32x32x16_bf16(b1, qr[d0], p1, 0, 0, 0);
        if ((d0 & 3) == 3) ATT_SBAR(); }
}
__device__ __forceinline__ int v_st(int k, int c) { const int kk = (k & ~0xC) | ((k & 4) << 1) | ((k & 8) >> 1); return ((kk >> 3) * 4 + (c >> 5)) * 512 + ((kk & 7) * 32 + (c & 31)) * 2; }
__device__ __forceinline__ int v_rd_base(int lane) { return ((lane & 3) << 3) | (((lane >> 2) & 3) << 6) | (((lane >> 4) & 1) << 5) | (((lane >> 5) & 1) << 8); }
constexpr int v_rd_off(int d0, int ks, int half) { return d0 * 512 + ks * 4096 + half * 2048; }
template <int OFF> __device__ __forceinline__ s16x4 tr_read(int vb) { s16x4 r; asm volatile("ds_read_b64_tr_b16 %0, %1 offset:%2" : "=&v"(r) : "v"(vb), "i"(OFF) : "memory"); return r; }
template <int D0> __device__ __forceinline__ void pv_one(f32x16& od, int vb, bf16x8 pa0, bf16x8 pa1, bf16x8 pa2, bf16x8 pa3) {
    const s16x4 l0 = tr_read<v_rd_off(D0, 0, 0)>(vb), h0 = tr_read<v_rd_off(D0, 0, 1)>(vb), l1 = tr_read<v_rd_off(D0, 1, 0)>(vb), h1 = tr_read<v_rd_off(D0, 1, 1)>(vb);
    const s16x4 l2 = tr_read<v_rd_off(D0, 2, 0)>(vb), h2 = tr_read<v_rd_off(D0, 2, 1)>(vb), l3 = tr_read<v_rd_off(D0, 3, 0)>(vb), h3 = tr_read<v_rd_off(D0, 3, 1)>(vb);
    asm volatile("s_waitcnt lgkmcnt(0)" ::: "memory"); ATT_SBAR();
#define ATT_PK(L, H) (bf16x8){L[0], L[1], L[2], L[3], H[0], H[1], H[2], H[3]}
    od = __builtin_amdgcn_mfma_f32_32x32x16_bf16(pa0, ATT_PK(l0, h0), od, 0, 0, 0);
    od = __builtin_amdgcn_mfma_f32_32x32x16_bf16(pa1, ATT_PK(l1, h1), od, 0, 0, 0);
    od = __builtin_amdgcn_mfma_f32_32x32x16_bf16(pa2, ATT_PK(l2, h2), od, 0, 0, 0);
    od = __builtin_amdgcn_mfma_f32_32x32x16_bf16(pa3, ATT_PK(l3, h3), od, 0, 0, 0);
#undef ATT_PK
}
__device__ __forceinline__ void pv_d0(f32x16* o, int vb, bf16x8 pa0, bf16x8 pa1, bf16x8 pa2, bf16x8 pa3) {
    pv_one<0>(o[0], vb, pa0, pa1, pa2, pa3); pv_one<1>(o[1], vb, pa0, pa1, pa2, pa3); pv_one<2>(o[2], vb, pa0, pa1, pa2, pa3); pv_one<3>(o[3], vb, pa0, pa1, pa2, pa3);
}

__device__ __forceinline__ void unit(const Frame& F, const bool nostore, int b, int hd, int qb, const bf16_t* __restrict__ Q, bf16_t* Y, const bf16_t* __restrict__ VV, const bf16_t* __restrict__ KR) {
    int tid_ = F.wave * 64 + lane_id(); asm volatile("" : "+v"(tid_));
    const int tid = tid_, wid = F.wave, lane = tid & 63, r32 = lane & 31, hi = lane >> 5;
    LAS unsigned char* lds = F.lds;
    LAS unsigned char* V_lds = lds; LAS unsigned char* K_lds = lds + OFF_K;
    LAS float* wsf = (LAS float*)(lds + OFF_WS) + wid * 64; LAS float* li_l = wsf; LAS float* al_l = wsf + 32;
    const size_t rowbase = (size_t)b * SEQ; const int q0 = qb * 256; const int qc = 4 * qb + (wid >> 1); const int NT = 4 * qb + 4;
    float m_reg = NEGBIG, l_reg = 0.f; f32x16 o[4] = {}; bf16x8 qr[12];
    { const bf16_t* Qw = Q + (rowbase + q0 + wid * 32 + r32) * 1536 + hd * 192 + hi * 8;
#pragma unroll
      for (int d0 = 0; d0 < 12; ++d0) qr[d0] = *(const bf16x8*)(Qw + d0 * 16); }
    const bf16_t* Kn = Y + rowbase * YLD + hd * 128; const bf16_t* Vh = VV + rowbase * 1024 + hd * 128; const bf16_t* Kr = KR + rowbase * 64;
    const int sr = tid >> 4, sc = (tid & 15) * 8; const int vst0 = v_st(sr, sc), vst1 = v_st(32 + sr, sc);
    const int kst0 = koff(sr, sc >> 6, (sc & 63) >> 3), kst1 = koff(32 + sr, sc >> 6, (sc & 63) >> 3), kst2 = koff(tid >> 3, 2, tid & 7);
    const int vb0 = (int)(uintptr_t)V_lds + v_rd_base(lane);
    bf16x8 vs0, vs1, ks0, ks1, ks2;
#define ATT_SLOAD(k0) do { vs0 = *(const bf16x8*)(Vh + (size_t)((k0) + sr) * 1024 + sc); vs1 = *(const bf16x8*)(Vh + (size_t)((k0) + 32 + sr) * 1024 + sc); \
    ks0 = *(const bf16x8*)(Kn + (size_t)((k0) + sr) * YLD + sc); ks1 = *(const bf16x8*)(Kn + (size_t)((k0) + 32 + sr) * YLD + sc); \
    ks2 = *(const bf16x8*)(Kr + (size_t)((k0) + (tid >> 3)) * 64 + (tid & 7) * 8); } while (0)
#define ATT_SWRITE(bf) do { *(LAS bf16x8*)(V_lds + (bf) * SHM_V + vst0) = vs0; *(LAS bf16x8*)(V_lds + (bf) * SHM_V + vst1) = vs1; \
    *(LAS bf16x8*)(K_lds + (bf) * SHM_K + kst0) = ks0; *(LAS bf16x8*)(K_lds + (bf) * SHM_K + kst1) = ks1; *(LAS bf16x8*)(K_lds + (bf) * SHM_K + kst2) = ks2; } while (0)
#define ATT_RESC(al) do { if (__any((al) < 1.f)) { if (hi == 0) al_l[r32] = (al); asm volatile("s_waitcnt lgkmcnt(0)" ::: "memory"); \
    _Pragma("unroll") for (int d = 0; d < 4; ++d) _Pragma("unroll") for (int r = 0; r < 16; ++r) o[d][r] *= al_l[crow(r, hi)]; } } while (0)
#define ATT_QKT(P0, P1, bf, jt) do { if ((jt) <= qc) qkt(P0, P1, K_lds + (bf) * SHM_K, qr, r32, hi); else { _Pragma("unroll") for (int r = 0; r < 16; ++r) { P0[r] = NEGBIG; P1[r] = NEGBIG; } } } while (0)
    f32x16 pA0, pA1, pB0, pB1; float alA, alB; bf16x8 pa0, pa1, pa2, pa3;
    ATT_SLOAD(0); asm volatile("s_waitcnt vmcnt(0)" ::: "memory"); ATT_SWRITE(0); __syncthreads();
    ATT_QKT(pA0, pA1, 0, 0); partialSM(pA0, pA1, m_reg, alA);
    ATT_SLOAD(KVBLK_); asm volatile("s_waitcnt vmcnt(0)" ::: "memory"); ATT_SWRITE(1); __syncthreads();
    for (int j = 1; j + 1 < NT; j += 2) {
        ATT_SBAR(); ATT_QKT(pB0, pB1, 1, j);
        finishSM(pA0, pA1, alA, l_reg, pa0, pa1, pa2, pa3); ATT_SBAR();
        ATT_SLOAD((j + 1) * KVBLK_); ATT_SBAR();
        pv_d0(o, vb0, pa0, pa1, pa2, pa3); partialSM(pB0, pB1, m_reg, alB);
        __syncthreads(); asm volatile("s_waitcnt vmcnt(0)" ::: "memory"); ATT_SWRITE(0);
        ATT_RESC(alB); __syncthreads();
        ATT_SBAR(); ATT_QKT(pA0, pA1, 0, j + 1);
        finishSM(pB0, pB1, alB, l_reg, pa0, pa1, pa2, pa3); ATT_SBAR();
        ATT_SLOAD((j + 2) * KVBLK_); ATT_SBAR();
        pv_d0(o, vb0 + SHM_V, pa0, pa1, pa2, pa3); partialSM(pA0, pA1, m_reg, alA);
        __syncthreads(); asm volatile("s_waitcnt vmcnt(0)" ::: "memory"); ATT_SWRITE(1);
        ATT_RESC(alA); __syncthreads();
    }
    ATT_SBAR(); ATT_QKT(pB0, pB1, 1, NT - 1);
    finishSM(pA0, pA1, alA, l_reg, pa0, pa1, pa2, pa3); ATT_SBAR();
    pv_d0(o, vb0, pa0, pa1, pa2, pa3); partialSM(pB0, pB1, m_reg, alB);
    __syncthreads(); ATT_RESC(alB);
    finishSM(pB0, pB1, alB, l_reg, pa0, pa1, pa2, pa3); ATT_SBAR();
    pv_d0(o, vb0 + SHM_V, pa0, pa1, pa2, pa3);
    if (hi == 0) li_l[r32] = l_reg; asm volatile("s_waitcnt lgkmcnt(0)" ::: "memory");
    float rli[16];
#pragma unroll
    for (int r = 0; r < 16; ++r) rli[r] = __builtin_amdgcn_rcpf(li_l[crow(r, hi)]);
    __syncthreads();
    int hi2 = hi, r32b = r32, ln = lane; asm volatile("" : "+v"(hi2), "+v"(r32b), "+v"(ln));
    LAS unsigned char* stg = lds + wid * 8704;
#pragma unroll
    for (int r = 0; r < 16; ++r) { const int orow = (r & 3) + 8 * (r >> 2) + 4 * hi2;
#pragma unroll
        for (int d0 = 0; d0 < 4; ++d0) *(LAS bf16_t*)(stg + orow * 272 + (d0 * 32 + r32b) * 2) = f2bf(o[d0][r] * rli[r]); }
    asm volatile("s_waitcnt lgkmcnt(0)" ::: "memory");
    bf16_t* Ow = Y + (rowbase + q0 + wid * 32) * YLD + 1024 + hd * 128;
    u32x4 zb[8];
#pragma unroll
    for (int i = 0; i < 8; ++i) { const int row = i * 4 + (ln >> 4), ch = ln & 15; zb[i] = *(const u32x4*)(Ow + (unsigned)(row * YLD + ch * 8)); }
#pragma unroll
    for (int i = 0; i < 8; ++i) { const int row = i * 4 + (ln >> 4), ch = ln & 15; const u32x4 ov = *(const LAS u32x4*)(stg + row * 272 + ch * 16); u32x4 w;
        w.x = pk_bf16(bf_lo(ov.x) * bf_lo(zb[i].x), bf_hi(ov.x) * bf_hi(zb[i].x)); w.y = pk_bf16(bf_lo(ov.y) * bf_lo(zb[i].y), bf_hi(ov.y) * bf_hi(zb[i].y));
        w.z = pk_bf16(bf_lo(ov.z) * bf_lo(zb[i].z), bf_hi(ov.z) * bf_hi(zb[i].z)); w.w = pk_bf16(bf_lo(ov.w) * bf_lo(zb[i].w), bf_hi(ov.w) * bf_hi(zb[i].w));
        if (!nostore) *(u32x4*)(Ow + (unsigned)(row * YLD + ch * 8)) = w; }
    asm volatile("s_waitcnt lgkmcnt(0)" ::: "memory");
    __syncthreads();
#undef ATT_SLOAD
#undef ATT_SWRITE
#undef ATT_RESC
#undef ATT_QKT
}
}

__device__ __forceinline__ void phaseC_att(const Frame& F, const bool nostore, const bf16_t* q, bf16_t* y, const bf16_t* vv, const bf16_t* kr) {
    for (int v = F.vcu; v < 256; v += F.G) { const int bh = v >> 2, s = v & 3;
        att::unit(F, nostore, bh >> 3, bh & 7, 7 - s, q, y, vv, kr);
        att::unit(F, nostore, bh >> 3, bh & 7, s, q, y, vv, kr); }
}
__device__ __forceinline__ void phaseC_lru(const Frame& F, const Args& a, const unsigned char* ws, const bool nostore, int l, bf16_t* y, const bf16_t* xc, const float* agg) {
    for (int item = F.vcu; item < NBATCH * 32; item += F.G) lru_item<2>(F, a, ws, nostore, l, item, xc, y, const_cast<float*>(agg));
}

__device__ __forceinline__ void gmlp_item(const Frame& F, const Args& a, const unsigned char* ws, const bool nostore, int l, int item, const bf16_t* v1, bf16_t* y, const float* vslab) {
    const int nb = item >> 2, g = item & 3; const size_t t0 = (size_t)nb * 128;
    int lane_ = lane_id(); asm volatile("" : "+v"(lane_));
    const int lane = lane_, w = F.wave, cl = lane & 15, kg = lane >> 4;
    LAS f32x2v* stat = (LAS f32x2v*)F.lds; LAS unsigned char* vnT = F.lds + 1024;
    { float pv[16];
#pragma unroll
      for (int i = 0; i < 16; ++i) pv[i] = vslab[(t0 + 16 * w + i) * 64 + lane];
#pragma unroll
      for (int i = 0; i < 16; ++i) { float v = pv[i]; v += sx<2>(v); v += sx<4>(v); v += sx<8>(v); v += sx<16>(v); v = xsum32(v);
          const float o = sx<1>(v);
          const float mu = v * (1.f / 1024.f); const float var = fmaxf(o * (1.f / 1024.f) - mu * mu, 0.f);
          if (lane == 0) stat[16 * w + i] = (f32x2v){mu, rsqrtf(var + EPS)}; } }
    LDS_WAIT(); __syncthreads();
    { const f32x2v st0 = stat[2 * lane], st1 = stat[2 * lane + 1];
      const float* lg = a.in[I_GM_LN_G] + l * 1024 + g * 256; const float* lb = a.in[I_GM_LN_B] + l * 1024 + g * 256;
      u32x4 xa[4], xb[4];
#pragma unroll
      for (int i = 0; i < 4; ++i) { const int c8 = 4 * w + i; xa[i] = *(const u32x4*)(v1 + (t0 + 2 * lane) * 1024 + g * 256 + c8 * 8); xb[i] = *(const u32x4*)(v1 + (t0 + 2 * lane + 1) * 1024 + g * 256 + c8 * 8); }
#pragma unroll
      for (int i = 0; i < 4; ++i) { const int c8 = 4 * w + i;
          const f32x4 g0 = *(const f32x4*)(lg + c8 * 8), g1 = *(const f32x4*)(lg + c8 * 8 + 4), b0 = *(const f32x4*)(lb + c8 * 8), b1 = *(const f32x4*)(lb + c8 * 8 + 4);
          const float ga[8] = {g0.x, g0.y, g0.z, g0.w, g1.x, g1.y, g1.z, g1.w}, be[8] = {b0.x, b0.y, b0.z, b0.w, b1.x, b1.y, b1.z, b1.w};
          const unsigned wa[4] = {xa[i].x, xa[i].y, xa[i].z, xa[i].w}, wb[4] = {xb[i].x, xb[i].y, xb[i].z, xb[i].w};
#pragma unroll
          for (int e = 0; e < 8; ++e) {
              const float fa = (e & 1) ? bf_hi(wa[e >> 1]) : bf_lo(wa[e >> 1]), fb = (e & 1) ? bf_hi(wb[e >> 1]) : bf_lo(wb[e >> 1]);
              const float na = (fa - st0.x) * st0.y * ga[e] + be[e], nbv = (fb - st1.x) * st1.y * ga[e] + be[e];
              *(LAS unsigned*)(vnT + (c8 * 8 + e) * 272 + lane * 4) = pk_bf16(na, nbv); } } }
    const bf16_t* gmw = (const bf16_t*)(ws + WS_GMW) + (size_t)g * 128 * 128;
    const float* bs = a.in[I_GM_BS] + l * 512 + g * 128;
    bf16_t* ybase = y + t0 * YLD + g * 256;
    const int tid = w * 64 + lane;
    u32x4 pa[8];
#pragma unroll
    for (int i = 0; i < 8; ++i) { const int idx = tid + 512 * i; pa[i] = *(const u32x4*)(ybase + (unsigned)((idx >> 5) * YLD + (idx & 31) * 8)); }
    float bsv[8];
#pragma unroll
    for (int ct = 0; ct < 8; ++ct) bsv[ct] = bs[16 * ct + cl];
    bf16x8 wf[2][4];
#pragma unroll
    for (int ks = 0; ks < 2; ++ks) wf[0][ks] = *(const bf16x8*)(gmw + (size_t)cl * 128 + 32 * ks + 8 * kg);
    LDS_WAIT(); __syncthreads();
    bf16x8 af[2][4];
#pragma unroll
    for (int r = 0; r < 2; ++r)
#pragma unroll
        for (int ks = 0; ks < 4; ++ks) af[r][ks] = *(const LAS bf16x8*)(vnT + (16 * (2 * w + r) + cl) * 272 + (32 * ks + 8 * kg) * 2);
    LDS_WAIT(); __syncthreads();
    LAS unsigned char* stg = vnT;
#pragma unroll
    for (int ct = 0; ct < 8; ++ct) { const int cur = ct & 1;
        if (ct + 1 < 8) {
#pragma unroll
            for (int ks = 0; ks < 4; ++ks) if (ks < ((ct + 1 < 4) ? 2 : 4)) wf[cur ^ 1][ks] = *(const bf16x8*)(gmw + (size_t)(16 * (ct + 1) + cl) * 128 + 32 * ks + 8 * kg); }
        f32x4 acc[2] = {(f32x4){0.f, 0.f, 0.f, 0.f}, (f32x4){0.f, 0.f, 0.f, 0.f}};
#pragma unroll
        for (int ks = 0; ks < 4; ++ks) if (ks < ((ct < 4) ? 2 : 4)) {
            acc[0] = __builtin_amdgcn_mfma_f32_16x16x32_bf16(af[0][ks], wf[cur][ks], acc[0], 0, 0, 0); acc[1] = __builtin_amdgcn_mfma_f32_16x16x32_bf16(af[1][ks], wf[cur][ks], acc[1], 0, 0, 0); }
#pragma unroll
        for (int r = 0; r < 2; ++r) { u32x2 o; o.x = pk_bf16(acc[r][0] + bsv[ct], acc[r][1] + bsv[ct]); o.y = pk_bf16(acc[r][2] + bsv[ct], acc[r][3] + bsv[ct]);
            *(LAS u32x2*)(stg + (16 * ct + cl) * 528 + (16 * (2 * w + r) + 4 * kg) * 2) = o; }
    }
    LDS_WAIT(); __syncthreads();
#pragma unroll
    for (int i = 0; i < 8; ++i) { const int idx = tid + 512 * i; const u32x4 sv = *(const LAS u32x4*)(stg + (idx >> 5) * 528 + (idx & 31) * 16); u32x4 o;
        o.x = pk_bf16(bf_lo(pa[i].x) * bf_lo(sv.x), bf_hi(pa[i].x) * bf_hi(sv.x)); o.y = pk_bf16(bf_lo(pa[i].y) * bf_lo(sv.y), bf_hi(pa[i].y) * bf_hi(sv.y));
        o.z = pk_bf16(bf_lo(pa[i].z) * bf_lo(sv.z), bf_hi(pa[i].z) * bf_hi(sv.z)); o.w = pk_bf16(bf_lo(pa[i].w) * bf_lo(sv.w), bf_hi(pa[i].w) * bf_hi(sv.w));
        if (!nostore) *(u32x4*)(ybase + (unsigned)((idx >> 5) * YLD + (idx & 31) * 8)) = o; }
    LDS_WAIT(); __syncthreads();
}
__device__ __forceinline__ void phaseE(const Frame& F, const Args& a, const unsigned char* ws, const bool nostore, int l, const bf16_t* v1, bf16_t* y, const float* vslab) {
    for (int item = F.vcu; item < 512; item += F.G) gmlp_item(F, a, ws, nostore, l, item, v1, y, vslab);
}
constexpr int N_PHASES = 1 + 8 * DEPTH;
#ifndef MK_PER_PHASE
#define MK_PER_PHASE 0
#endif
#ifndef MK_MAX_PHASE
#define MK_MAX_PHASE N_PHASES
#endif

__global__ void __launch_bounds__(NWAVES * 64, 2) mk_fwd(Args args) {
    extern __shared__ __attribute__((aligned(16))) unsigned char lds_raw[];
    Frame F;
    F.lds = (LAS unsigned char*)lds_raw;
    F.wave = __builtin_amdgcn_readfirstlane((int)threadIdx.x >> 6);
    F.G = gridDim.x; { const int bx = blockIdx.x; F.vcu = (F.G % 8 == 0) ? (bx % 8) * (F.G / 8) + bx / 8 : bx; }
    volatile LAS unsigned* MISCW = (volatile LAS unsigned*)(F.lds + MISC_OFF);
    for (int u = threadIdx.x; u < (LDS_BYTES - RING_BYTES) / 4; u += NWAVES * 64) ((LAS unsigned*)(F.lds + RING_BYTES))[u] = 0u;
    __syncthreads();
    unsigned* ctl = (unsigned*)(args.ws + WS_CTL);
#if MK_PER_PHASE
    const int lo = args.ph_lo, hi = args.ph_hi;
    const bool multi = (hi - lo) > 1;
#else
    constexpr int lo = 0, hi = N_PHASES;
    constexpr bool multi = true;
#endif
    XcdBarrier bar; bar.bar = ctl + CW_BAR; bar.x = 0; bar.st = nullptr;
    if (multi) bar = xcd_barrier_post(ctl + CW_BAR, MISCW + 8);
#define IN(k) (lo <= (k) && (k) < hi)
#define SEAM(k) do { if (IN((k) + 1)) xcd_barrier(bar); } while (0)
#define xcd_barrier_if(c, b) do { if (c) xcd_barrier(b); } while (0)

typedef const __attribute__((address_space(4))) Args* KArgP;
#if defined(__HIP_DEVICE_COMPILE__)
#define AS_GLOBAL(p) __builtin_assume(!__builtin_amdgcn_is_shared((const __attribute__((address_space(0))) void*)(p)) && !__builtin_amdgcn_is_private((const __attribute__((address_space(0))) void*)(p)))
#else
#define AS_GLOBAL(p) ((void)0)
#endif
#define PHASE_PTRS \
    KArgP kp = (KArgP)__builtin_amdgcn_kernarg_segment_ptr(); asm volatile("" : "+s"(kp)); Args la; \
    _Pragma("unroll") for (int i_ = 0; i_ < N_INPUTS; ++i_) { la.in[i_] = kp->in[i_]; AS_GLOBAL(la.in[i_]); } la.out = kp->out; AS_GLOBAL(la.out); la.ph_lo = 0; la.ph_hi = 0; \
    unsigned char* ws = kp->ws; AS_GLOBAL(ws); la.ws = ws; Frame Fp = F; int bid = (int)blockIdx.x; asm volatile("" : "+s"(Fp.wave), "+s"(Fp.vcu), "+s"(Fp.G), "+s"(bid)); (void)bid; \
    bf16_t* Hb = (bf16_t*)(ws + WS_H); bf16_t* Yb = (bf16_t*)(ws + WS_Y); \
    bf16_t* MISCb = (bf16_t*)(ws + WS_MISC); bf16_t* XCb = (bf16_t*)(ws + WS_XC); bf16_t* Qb = (bf16_t*)(ws + WS_Q); bf16_t* VVb = (bf16_t*)(ws + WS_VV); bf16_t* KRb = (bf16_t*)(ws + WS_KR); \
    bf16_t* V1b = (bf16_t*)(ws + WS_V1); bf16_t* Gb = (bf16_t*)(ws + WS_G); bf16_t* Ob = (bf16_t*)(ws + WS_O); \
    float* SLAB = (float*)(ws + WS_SLAB); float* AGG = (float*)(ws + WS_AGG); const float* CS = (const float*)(ws + WS_ROPE); const float* SN = CS + 2048 * 32; \
    const unsigned char* wb = ws + WS_WB; (void)Hb; (void)Yb; (void)MISCb; (void)XCb; (void)Qb; (void)VVb; (void)KRb; (void)V1b; (void)Gb; (void)Ob; (void)SLAB; (void)AGG; (void)CS; (void)SN; (void)wb;
    if (IN(0)) {
        { PHASE_PTRS
        convert_weights(Fp, la, ws, 0);
        rope_table(Fp, ws);
        norm_rows(Fp, false, la.in[I_X], nullptr, nullptr, nullptr, la.in[I_PRE_G], Hb);
        }
        SEAM(0);
    }
#pragma nounroll
    for (int l = 0; l < DEPTH; ++l) {
        const int pb = 1 + 8 * l;
        if (IN(pb + 0)) {
            { const bool nostore = false; (void)nostore;
            PHASE_PTRS
            SchedA S; S.ord.init(64, 16, Fp.G, bid); S.A = (const char*)Hb; S.B = (const char*)(wb + WB_W1T);
            EpiA E{MISCb, XCb, Yb, SLAB, KRb, CS, SN};
            g8::gemm_stream(Fp.lds, Fp.wave * 64 + lane_id(), 2048u, 2048u, S, E);
            }
            SEAM(pb + 0);
        }
        if (IN(pb + 1)) {
            { const bool nostore = false; (void)nostore;
            PHASE_PTRS
            { SchedZ SZ; SZ.v = Fp.vcu; SZ.A = (const char*)Hb; SZ.B = (const char*)(wb + WB_W1T); EpiA EZ{MISCb, XCb, Yb, SLAB, KRb, CS, SN};
              g8::gemm_stream(Fp.lds, Fp.wave * 64 + lane_id(), 2048u, 2048u, SZ, EZ); }
            SchedQKV S; S.v = Fp.vcu; S.misc = (const char*)MISCb; S.wq = (const char*)(wb + WB_WQT); S.wkv = (const char*)(wb + WB_WKVT);
            EpiQKV E{Qb, Yb, VVb, SLAB, CS, SN};
            g8::gemm_stream(Fp.lds, Fp.wave * 64 + lane_id(), 1536u, 768u, S, E);
            phaseB_lru(Fp, ws, (unsigned*)(ws + WS_CTL), nostore, l, XCb, Yb, AGG);
            }
            SEAM(pb + 1);
        }
        if (IN(pb + 2)) {
            { const bool nostore = false; (void)nostore;
            PHASE_PTRS
            phaseC_att(Fp, nostore, Qb, Yb, VVb, KRb);
            }
            SEAM(pb + 2);
        }
        if (IN(pb + 3)) {
            { const bool nostore = false; (void)nostore;
            PHASE_PTRS
            SchedD S; S.ord.init(64, 24, Fp.G, bid); S.A = (const char*)Hb; S.B = (const char*)(wb + WB_W2T);
            EpiD E{Yb, V1b, Gb, SLAB};
            g8::gemm_stream(Fp.lds, Fp.wave * 64 + lane_id(), 2048u, 2048u, S, E);
            }
            SEAM(pb + 3);
        }
        if (IN(pb + 4)) {
            { const bool nostore = false; (void)nostore;
            PHASE_PTRS
            phaseE(Fp, la, ws, nostore, l, V1b, Yb, SLAB);
            }
            SEAM(pb + 4);
        }
        if (IN(pb + 5)) {
            { const bool nostore = false; (void)nostore;
            PHASE_PTRS
            SchedF S; S.ord.init(64, 4, Fp.G, bid); S.A = (const char*)Yb; S.B = (const char*)(wb + WB_WPT);
            EpiF E{Gb, V1b};
            g8::gemm_stream(Fp.lds, Fp.wave * 64 + lane_id(), (unsigned)(YLD * 2), (unsigned)(YLD * 2), S, E);
            }
            SEAM(pb + 5);
        }
        if (IN(pb + 6)) {
            { const bool nostore = false; (void)nostore;
            PHASE_PTRS
            SchedG1 S; S.v = Fp.vcu; S.A = (const char*)V1b; S.B = (const char*)(wb + WB_WOT);
            const float* xin = (l == 0) ? la.in[I_X] : la.out;
            EpiNorm E{xin, la.out, Hb, la.in[I_POST_G] + l * DM, (l + 1 < DEPTH) ? la.in[I_PRE_G] + (l + 1) * DM : nullptr, SLAB, (unsigned*)(ws + WS_CTL) + CW_NORM + l * 2048};
            g8::gemm_stream<true>(Fp.lds, Fp.wave * 64 + lane_id(), 2048u, 2048u, S, E);
            }
            if (l + 1 < DEPTH) SEAM(pb + 6);
        }
        if (IN(pb + 7) && l + 1 < DEPTH) {
            { const bool nostore = false; (void)nostore;
            PHASE_PTRS
            if (l + 1 < DEPTH) convert_weights(Fp, la, ws, l + 1);
            }
            SEAM(pb + 7);
        }
    }
#undef IN
#undef SEAM
}

#ifndef MK_PROBE
#define MK_PROBE 0
#endif
static int mk_setup(size_t ws_size) {
    static int grid = 0;
    if (grid == 0) {
        if (ws_size < WS_END) { fprintf(stderr, "kernel_launch: workspace too small: %zu < %zu\n", ws_size, (size_t)WS_END); grid = -1; return grid; }
        int dev = 0, cus = 0, per_cu = 0;
        if (hipGetDevice(&dev) != hipSuccess || hipDeviceGetAttribute(&cus, hipDeviceAttributeMultiprocessorCount, dev) != hipSuccess) { grid = -1; return grid; }
        if (hipFuncSetAttribute((const void*)mk_fwd, hipFuncAttributeMaxDynamicSharedMemorySize, LDS_BYTES) != hipSuccess) { fprintf(stderr, "kernel_launch: hipFuncSetAttribute failed\n"); grid = -1; return grid; }
        if (hipOccupancyMaxActiveBlocksPerMultiprocessor(&per_cu, (const void*)mk_fwd, NWAVES * 64, LDS_BYTES) != hipSuccess || per_cu < 1)
            fprintf(stderr, "kernel_launch: occupancy query reports %d blocks/CU\n", per_cu);
        (void)hipGetLastError();
        grid = cus;
        if (grid != 256) fprintf(stderr, "kernel_launch: note: %d CUs (tile schedules assume 256)\n", grid);
    }
    return grid;
}
static void mk_launch(void* const* d_in, void* d_out, void* d_ws, hipStream_t stream, int grid, int lo, int hi) {
    Args a{};
    for (int i = 0; i < N_INPUTS; ++i) a.in[i] = (const float*)d_in[i];
    a.out = (float*)d_out; a.ws = (unsigned char*)d_ws; a.ph_lo = lo; a.ph_hi = hi; a.probe = MK_PROBE; a.pad = 0;
    hipLaunchKernelGGL(mk_fwd, dim3(grid), dim3(NWAVES * 64), LDS_BYTES, stream, a);
}
extern "C" void kernel_launch(void* const* d_in, const int* in_sizes, int n_in, void* d_out, int out_size, void* d_ws, size_t ws_size, hipStream_t stream) {
    const int grid = mk_setup(ws_size); if (grid < 0) return;
    hipMemsetAsync((char*)d_ws + WS_CTL, 0, CTL_ZERO_BYTES, stream);
#if MK_PER_PHASE
    for (int ph = 0; ph < N_PHASES; ++ph) mk_launch(d_in, d_out, d_ws, stream, grid, ph, ph + 1);
#else
    mk_launch(d_in, d_out, d_ws, stream, grid, 0, N_PHASES);
#endif
}
```

```cpp
#define MK_PROBE 0
#include <hip/hip_runtime.h>
#include <cstdio>
#include <cstdint>

#define LAS __attribute__((address_space(3)))
#define GAS __attribute__((address_space(1)))
typedef unsigned short bf16_t;
typedef short bf16x8 __attribute__((ext_vector_type(8)));
typedef short s16x4 __attribute__((ext_vector_type(4)));
typedef float f32x2 __attribute__((ext_vector_type(2)));
typedef float f32x4 __attribute__((ext_vector_type(4)));
typedef float f32x16 __attribute__((ext_vector_type(16)));
typedef unsigned u32x2 __attribute__((ext_vector_type(2)));
typedef unsigned u32x4 __attribute__((ext_vector_type(4)));
typedef __bf16 bf16x2_t __attribute__((ext_vector_type(2)));

__device__ __forceinline__ unsigned pk_bf16(float lo, float hi) { f32x2 v = {lo, hi}; bf16x2_t b = __builtin_convertvector(v, bf16x2_t); return __builtin_bit_cast(unsigned, b); }
__device__ __forceinline__ float bf_lo(unsigned w) { return __uint_as_float(w << 16); }
__device__ __forceinline__ float bf_hi(unsigned w) { return __uint_as_float(w & 0xffff0000u); }
__device__ __forceinline__ float bf1(bf16_t h) { return __uint_as_float(((unsigned)h) << 16); }
__device__ __forceinline__ bf16_t f2bf(float f) { return (bf16_t)(pk_bf16(f, 0.f) & 0xffffu); }
__device__ __forceinline__ float fexp2(float x) { return __builtin_amdgcn_exp2f(x); }
__device__ __forceinline__ float fsigmoid(float x) { return __builtin_amdgcn_rcpf(1.f + fexp2(x * -1.4426950408889634f)); }
__device__ __forceinline__ float fsilu(float x) { return x * __builtin_amdgcn_rcpf(1.f + fexp2(x * -1.4426950408889634f)); }
template <int XM> __device__ __forceinline__ float sx(float v) { return __int_as_float(__builtin_amdgcn_ds_swizzle(__float_as_int(v), (XM << 10) | 0x1f)); }
__device__ __forceinline__ float xsum32(float v) { auto rr = __builtin_amdgcn_permlane32_swap(__float_as_uint(v), __float_as_uint(v), false, false); return __uint_as_float(rr[0]) + __uint_as_float(rr[1]); }
__device__ __forceinline__ float wave_sum(float v) { v += sx<1>(v); v += sx<2>(v); v += sx<4>(v); v += sx<8>(v); v += sx<16>(v); return xsum32(v); }
struct WsBuf { __amdgpu_buffer_rsrc_t r; const unsigned char* base; };
__device__ __forceinline__ WsBuf make_wsbuf(unsigned char* ws) { WsBuf b; b.r = __builtin_amdgcn_make_buffer_rsrc(ws, (short)0, 0x7fffffff, 0x00020000); b.base = ws; return b; }
__device__ __forceinline__ void st16_wt(const WsBuf& b, const void* p, u32x4 v) { __builtin_amdgcn_raw_buffer_store_b128(v, b.r, (unsigned)((const unsigned char*)p - b.base), 0, 16); }
template <bool WT> __device__ __forceinline__ void st16_sel(const WsBuf& b, void* p, u32x4 v) { if (WT) st16_wt(b, p, v); else *(u32x4*)p = v; }
#ifndef WT_QKV
#define WT_QKV 0
#endif
#ifndef WT_F
#define WT_F 0
#endif
#ifndef WT_NORM
#define WT_NORM 0
#endif
#ifndef WT_OUT
#define WT_OUT 0
#endif
#ifndef WT_MIX
#define WT_MIX 0
#endif
#define LDS_WAIT() asm volatile("s_waitcnt lgkmcnt(0)" ::: "memory")
#define VM_WAIT() asm volatile("s_waitcnt vmcnt(0)" ::: "memory")

namespace g8 {
constexpr int BM = 256, BK = 64, HALF = 128, HTB = HALF * BK * 2, STAGE_BYTES = 8 * HTB, NXCD = 8, WGM = 8;
__host__ __device__ __forceinline__ int lds_byte(int r, int c) { const int st = (r >> 4) * 2 + (c >> 5), rr = r & 15, cc = c & 31, ob = rr * 64 + cc * 2; return st * 1024 + (ob ^ (((ob >> 9) & 1) << 5)); }
__host__ __device__ __forceinline__ void stage_rc(int b, int& R, int& C) { const int st = b / 1024, sb = b % 1024, swz = sb ^ (((sb >> 9) & 1) << 5); R = (st >> 1) * 16 + swz / 64; C = (st & 1) * 32 + (swz % 64) / 2; }
__host__ __device__ __forceinline__ int perm32(int rho) { const int n = rho >> 4, i = rho & 15; return 8 * (i >> 2) + 4 * n + (i & 3); }

struct UnitD { const char* A; const char* B; int nt, pm, pn, kind; };
constexpr int KEEP_ACC = 0x100;

struct TileOrder {
    int nM, nN, nwg, G, c;
    __device__ void init(int nM_, int nN_, int G_, int c_) { nM = nM_; nN = nN_; nwg = nM * nN; G = G_; c = c_; }
    __device__ bool tile(int i, int& pm, int& pn) const {
        const long L = (long)i * G + c; if (L >= nwg) return false;
        int wgid = (int)L; { const int q = nwg / NXCD, r = nwg % NXCD, xcd = wgid % NXCD, off = wgid / NXCD; wgid = (xcd < r ? xcd * (q + 1) : r * (q + 1) + (xcd - r) * q) + off; }
        const int nig = WGM * nN, gid = wgid / nig, fm = gid * WGM, gsz = (nM - fm) < WGM ? (nM - fm) : WGM;
        pm = fm + ((wgid % nig) % gsz); pn = (wgid % nig) / gsz; return true;
    }
};

template <bool AFTER_DRAIN = false, class Sched, class Epi>
__device__ __forceinline__ void gemm_stream(LAS unsigned char* lds, int tid_in, const unsigned lda, const unsigned ldb, const Sched& S, const Epi& E) {
    int tid_ = tid_in; asm volatile("" : "+v"(tid_));
    const int tid = tid_, wid = __builtin_amdgcn_readfirstlane(tid >> 6), lane = tid & 63, wr = wid >> 2, wc = wid & 3, fr = lane & 15, fq = lane >> 4;
    unsigned voffA[2], voffB[2];
#pragma unroll
    for (int i = 0; i < 2; ++i) { int R, C; stage_rc(tid * 16 + i * 8192, R, C); const int Rb = (R & ~31) + perm32(R & 31);
        voffA[i] = (unsigned)R * lda + (unsigned)C * 2u; voffB[i] = (unsigned)Rb * ldb + (unsigned)C * 2u; }
    const size_t kstep = (size_t)(BK * 2);
    const size_t hstepA = (size_t)HALF * lda, hstepB = (size_t)HALF * ldb;
    const unsigned ldsw = (unsigned)wid * 1024u;
    const int aoff = lds_byte(wr * 64 + fr, fq * 8), boff = lds_byte(wc * 32 + fr, fq * 8);
#define G8_SA(b, h) (((b) * 2 + (h)) * HTB)
#define G8_SB(b, h) ((4 + (b) * 2 + (h)) * HTB)
#define G8_STAGE(bufoff, gbase, voff) do { _Pragma("unroll") for (int _i = 0; _i < 2; ++_i) \
        __builtin_amdgcn_global_load_lds((const unsigned*)((const char*)(gbase) + (voff)[_i]), (LAS unsigned*)(lds + (bufoff) + ldsw + _i * 8192), 16, 0, 0); } while (0)
#define G8_LDA(dst, b, h) do { _Pragma("unroll") for (int m = 0; m < 4; ++m) _Pragma("unroll") for (int k = 0; k < 2; ++k) dst[m][k] = *(const LAS bf16x8*)(lds + G8_SA(b, h) + aoff + m * 2048 + k * 1024); } while (0)
#define G8_LDB(dst, b, h) do { _Pragma("unroll") for (int n = 0; n < 2; ++n) _Pragma("unroll") for (int k = 0; k < 2; ++k) dst[n][k] = *(const LAS bf16x8*)(lds + G8_SB(b, h) + boff + n * 2048 + k * 1024); } while (0)
#define G8_MMA(ai, bj, At, Bt) do { __builtin_amdgcn_s_setprio(1); _Pragma("unroll") for (int m = 0; m < 4; ++m) _Pragma("unroll") for (int n = 0; n < 2; ++n) _Pragma("unroll") for (int k = 0; k < 2; ++k) \
        acc[ai][bj][m][n] = __builtin_amdgcn_mfma_f32_16x16x32_bf16(Bt[n][k], At[m][k], acc[ai][bj][m][n], 0, 0, 0); __builtin_amdgcn_s_setprio(0); } while (0)
#define G8_WAIT_V(n) asm volatile("s_waitcnt vmcnt(" #n ")" ::: "memory")
#define G8_WAIT_L(n) asm volatile("s_waitcnt lgkmcnt(" #n ")" ::: "memory")
#define G8_BAR __builtin_amdgcn_s_barrier()
#define G8_SCHED __builtin_amdgcn_sched_barrier(0)
    UnitD cur, nxt; int ui = 0;
    if (!S.next(0, cur)) return;
    f32x4 acc[2][2][4][2];
#pragma unroll
    for (int a = 0; a < 2; ++a)
#pragma unroll
        for (int b = 0; b < 2; ++b)
#pragma unroll
            for (int m = 0; m < 4; ++m)
#pragma unroll
                for (int n = 0; n < 2; ++n) acc[a][b][m][n] = (f32x4){0.f, 0.f, 0.f, 0.f};
    bf16x8 At[4][2], B0[2][2], B1[2][2];
    const char* cA = cur.A; const char* cB = cur.B;
    G8_STAGE(G8_SB(0, 0), cB, voffB); G8_STAGE(G8_SB(0, 1), cB + hstepB, voffB); G8_STAGE(G8_SA(0, 0), cA, voffA); G8_STAGE(G8_SA(0, 1), cA + hstepA, voffA);
    if (wr == 1) G8_BAR;
    G8_WAIT_V(2); G8_BAR;
    G8_STAGE(G8_SB(1, 0), cB + kstep, voffB); G8_STAGE(G8_SA(1, 0), cA + kstep, voffA); G8_STAGE(G8_SB(1, 1), cB + hstepB + kstep, voffB);
    G8_WAIT_V(6); G8_BAR;
    for (;;) {
        const bool has_next = S.next(ui + 1, nxt);
        const char* nA = has_next ? nxt.A : cA; const char* nB = has_next ? nxt.B : cB;
        const int nt = cur.nt;
        for (int t = 0; t < nt; t += 2) {
            const bool last = (t == nt - 2);
            const char* a1 = cA + (size_t)(t + 1) * kstep;
            const char* a2 = last ? nA : cA + (size_t)(t + 2) * kstep; const char* b2 = last ? nB : cB + (size_t)(t + 2) * kstep;
            const char* a3 = a2 + kstep; const char* b3 = b2 + kstep;
            G8_LDB(B0, 0, 0); G8_LDB(B1, 0, 1); G8_SCHED; G8_LDA(At, 0, 0); G8_STAGE(G8_SA(1, 1), a1 + hstepA, voffA);
            G8_WAIT_V(8); G8_WAIT_L(0); G8_BAR; G8_MMA(0, 0, At, B0); G8_MMA(0, 1, At, B1); G8_BAR; G8_SCHED;
            G8_LDA(At, 0, 1); G8_STAGE(G8_SB(0, 0), b2, voffB); G8_STAGE(G8_SB(0, 1), b2 + hstepB, voffB); G8_STAGE(G8_SA(0, 0), a2, voffA);
            G8_WAIT_V(8); G8_WAIT_L(0); G8_BAR; G8_MMA(1, 0, At, B0); G8_MMA(1, 1, At, B1); G8_BAR; G8_SCHED;
            G8_LDB(B0, 1, 0); G8_LDB(B1, 1, 1); G8_SCHED; G8_LDA(At, 1, 0); G8_STAGE(G8_SA(0, 1), a2 + hstepA, voffA);
            G8_WAIT_V(8); G8_WAIT_L(0); G8_BAR; G8_MMA(0, 0, At, B0); G8_MMA(0, 1, At, B1); G8_BAR; G8_SCHED;
            G8_LDA(At, 1, 1); G8_STAGE(G8_SB(1, 0), b3, voffB); G8_STAGE(G8_SB(1, 1), b3 + hstepB, voffB); G8_STAGE(G8_SA(1, 0), a3, voffA);
            G8_WAIT_V(8); G8_WAIT_L(0); G8_BAR; G8_MMA(1, 0, At, B0); G8_MMA(1, 1, At, B1); G8_BAR; G8_SCHED;
        }
        if (wr == 0) G8_BAR;
        if constexpr (!AFTER_DRAIN) { UnitD eu = cur; int fr_ = fr, fq_ = fq; asm volatile("" : "+s"(eu.pm), "+s"(eu.pn), "+v"(fr_), "+v"(fq_)); E(acc, eu, wr, wc, fr_, fq_); }
        if (!has_next) break;
        if (!(cur.kind & KEEP_ACC)) {
#pragma unroll
            for (int a = 0; a < 2; ++a)
#pragma unroll
                for (int b = 0; b < 2; ++b)
#pragma unroll
                    for (int m = 0; m < 4; ++m)
#pragma unroll
                        for (int n = 0; n < 2; ++n) acc[a][b][m][n] = (f32x4){0.f, 0.f, 0.f, 0.f};
        }
        cur = nxt; cA = nA; cB = nB; ++ui;
        if (wr == 1) G8_BAR;
    }
    G8_WAIT_V(0);
    G8_BAR;
    if constexpr (AFTER_DRAIN) {
        UnitD eu = cur; int fr_ = fr, fq_ = fq, ln_ = lane; asm volatile("" : "+s"(eu.pm), "+s"(eu.pn), "+v"(fr_), "+v"(fq_), "+v"(ln_)); E.fused(acc, eu, wr, wc, fr_, fq_, lds, wid, ln_); }
#undef G8_SA
#undef G8_SB
#undef G8_STAGE
#undef G8_LDA
#undef G8_LDB
#undef G8_MMA
#undef G8_WAIT_V
#undef G8_WAIT_L
#undef G8_BAR
#undef G8_SCHED
}
}

#define XB_TMO      128
#define XB_XCNT(j)  (256  + 64 * (j))
#define XB_XSUB(j)  (1280 + 64 * (j))
#define XB_XGEN(j)  (2304 + 64 * (j))
#define XB_TOP      3328
#define XB_TOPGEN   3392
#define XCD_BAR_WORDS 3456
#define XB_SPIN_CAP (1u << 18)
__device__ __forceinline__ unsigned xb_ld(unsigned* p)              { return __hip_atomic_load(p, __ATOMIC_RELAXED, __HIP_MEMORY_SCOPE_AGENT); }
__device__ __forceinline__ unsigned xb_add(unsigned* p, unsigned v) { return __hip_atomic_fetch_add(p, v, __ATOMIC_RELAXED, __HIP_MEMORY_SCOPE_AGENT); }
__device__ __forceinline__ unsigned xb_xcc_id() { return (unsigned)__builtin_amdgcn_s_getreg((3 << 11) | 20) & 0xFu; }
#define XB_SPIN(cond, bar) do { unsigned _sp = 0; while (cond) { __builtin_amdgcn_s_sleep(1); \
    if ((++_sp & 255u) == 0u) { if (xb_ld(&(bar)[XB_TMO])) break; if (_sp > XB_SPIN_CAP) { atomicAdd(&(bar)[XB_TMO], 1u); break; } } } } while (0)
struct XcdBarrier { unsigned* bar; unsigned x; volatile LAS unsigned* st; };
__device__ __forceinline__ XcdBarrier xcd_barrier_post(unsigned* bar, volatile LAS unsigned* st) {
    XcdBarrier b; b.bar = bar; b.x = xb_xcc_id(); b.st = st;
    if (threadIdx.x == 0) (void)xb_add(&bar[XB_XCNT(b.x)], 1u);
    return b;
}
__device__ __forceinline__ void xcd_barrier_complete(unsigned* bar, unsigned x, unsigned& nloc, unsigned& nx) {
    const unsigned G = gridDim.x * gridDim.y * gridDim.z;
    unsigned sum, cnt, mine, sp = 0u;
    for (;;) {
        sum = 0u; cnt = 0u; mine = 0u;
#pragma unroll
        for (unsigned j = 0; j < 16; ++j) { const unsigned c = xb_ld(&bar[XB_XCNT(j)]); sum += c; cnt += (c > 0u) ? 1u : 0u; mine = (j == x) ? c : mine; }
        if (sum == G) break;
        __builtin_amdgcn_s_sleep(1);
        if ((++sp & 255u) == 0u) { if (xb_ld(&bar[XB_TMO])) break; if (sp > XB_SPIN_CAP) { atomicAdd(&bar[XB_TMO], 1u); break; } }
    }
    nloc = mine > 0u ? mine : 1u; nx = cnt > 0u ? cnt : 1u;
}
__device__ __forceinline__ void xcd_barrier(const XcdBarrier& b) {
    asm volatile("s_waitcnt vmcnt(0)" ::: "memory");
    __syncthreads();
    if (threadIdx.x == 0) {
        unsigned* bar = b.bar; unsigned bx = b.x; asm volatile("" : "+s"(bar), "+s"(bx));
        __builtin_amdgcn_s_waitcnt(0);
        unsigned nloc = b.st[0], nx = b.st[1];
        if (nloc == 0u) { xcd_barrier_complete(bar, bx, nloc, nx); b.st[0] = nloc; b.st[1] = nx; }
        const unsigned old = xb_add(&bar[XB_XSUB(bx)], 1u);
        const unsigned gen = old / nloc;
        if (old + 1u == (gen + 1u) * nloc) {
            __builtin_amdgcn_fence(__ATOMIC_RELEASE, "agent");
            asm volatile("s_waitcnt vmcnt(0)" ::: "memory");
            const unsigned og = xb_add(&bar[XB_TOP], 1u);
            const unsigned tg = og / nx;
            if (og + 1u == (tg + 1u) * nx) xb_add(&bar[XB_TOPGEN], 1u);
            else XB_SPIN(xb_ld(&bar[XB_TOPGEN]) == tg, bar);
            __builtin_amdgcn_fence(__ATOMIC_ACQUIRE, "agent");
            xb_add(&bar[XB_XGEN(bx)], 1u);
            asm volatile("s_waitcnt vmcnt(0)" ::: "memory");
        } else {
            XB_SPIN(xb_ld(&bar[XB_XGEN(bx)]) == gen, bar);
            __builtin_amdgcn_fence(__ATOMIC_ACQUIRE, "agent");
            asm volatile("s_waitcnt vmcnt(0)" ::: "memory");
        }
    }
    __syncthreads();
}
constexpr int T = 16384, DM = 1024, SEQ = 2048, NBATCH = 8, DEPTH = 2, N_IN = 10432;
constexpr int NWAVES = 8;
constexpr float EPS = 1e-6f;
constexpr size_t MiB = 1u << 20;
constexpr size_t WS_CTL = 0, CTL_ZERO_BYTES = 64 * 1024;
constexpr size_t WS_WB = 1 * MiB;
constexpr size_t WB_W1T = 0;
constexpr size_t WB_W2T = WB_W1T + (size_t)4352 * 1024 * 2;
constexpr size_t WB_WQT = WB_W2T + (size_t)6144 * 1024 * 2;
constexpr size_t WB_WKVT = WB_WQT + (size_t)1536 * 384 * 2;
constexpr size_t WB_WPT = WB_WKVT + (size_t)2048 * 384 * 2;
constexpr size_t WB_WOT = WB_WPT + (size_t)1024 * 3328 * 2;
constexpr size_t WB_END = WB_WOT + (size_t)1024 * 1024 * 2;
static_assert(WB_END <= 32 * MiB, "weights region");
constexpr size_t WS_H = 33 * MiB;
constexpr size_t WS_Y = 65 * MiB;
constexpr int YLD = 3328;
constexpr size_t WS_BIG = 169 * MiB;
constexpr size_t WS_MISC = WS_BIG;
constexpr size_t WS_XC = WS_MISC + 24 * MiB;
constexpr size_t WS_Q = WS_XC + 40 * MiB;
constexpr size_t WS_VV = WS_Q + 48 * MiB;
constexpr size_t WS_KR = WS_VV + 32 * MiB;
constexpr size_t WS_V1 = WS_BIG;
constexpr size_t WS_G = WS_V1 + 32 * MiB;
constexpr size_t WS_O = WS_BIG;
constexpr size_t WS_SMALL = 315 * MiB;
constexpr size_t WS_SLAB = WS_SMALL;
constexpr size_t WS_AGG = WS_SLAB + 1536 * 1024;
constexpr size_t WS_ROPE = WS_AGG + 2560 * 1024;
constexpr size_t WS_LW = WS_ROPE + 512 * 1024;
constexpr size_t WS_GMW = WS_LW + 480 * 1024;
constexpr size_t WS_LCT = WS_GMW + 128 * 1024;
constexpr size_t WS_RINV = WS_LCT + 64 * 1024;
constexpr size_t WS_END = WS_RINV + 128 * 1024;
static_assert(WS_KR + 2 * MiB <= WS_SMALL && WS_G + 96 * MiB <= WS_SMALL && WS_END <= 326 * MiB, "d_ws map");
constexpr int CW_NORM = 12288;
constexpr int CW_BAR = 1024;
static_assert((CW_BAR + XCD_BAR_WORDS) * 4 <= (int)CTL_ZERO_BYTES, "ctl");
constexpr int RING_BYTES = 131072, MISC_OFF = RING_BYTES + 320, LDS_BYTES = 147456;

enum { I_X = 0, I_PRE_G, I_W_IN, I_GM_LN_G, I_GM_LN_B, I_GM_WS, I_GM_BS, I_QN_G, I_W_UQ, I_KVN_G, I_W_UKV, I_CONV_W, I_CONV_B, I_W_A, I_B_A, I_W_X, I_B_X, I_LAM,
       I_W_PA, I_W_PB, I_W_PC, I_W_OUT, I_POST_G, N_INPUTS };
struct Args { const float* in[N_INPUTS]; float* out; unsigned char* ws; int ph_lo, ph_hi, probe, pad; };

struct Frame { LAS unsigned char* lds; int wave, vcu, G; };
__device__ __forceinline__ int lane_id() { int l; asm volatile("v_mbcnt_lo_u32_b32 %0, -1, 0\n\tv_mbcnt_hi_u32_b32 %0, -1, %0" : "=v"(l)); return l; }

__device__ __forceinline__ float softplus_neg(float x) { const float e = __expf(-x);
    const float p = e * (1.f - e * (0.5f - e * (0.33333334f - e * (0.25f - e * (0.2f - e * (0.16666667f - e * (0.14285715f - e * 0.125f)))))));
    return (e < 0.2f) ? p : __logf(1.f + e); }
struct MapW1 { __device__ __forceinline__ int operator()(int j) const {
    if (j < 384) return 3072 + j; if (j < 640) return 3456 + (j - 384); if (j < 704) { const int jj = j - 640, g = jj >> 3, e = jj & 7; return 3712 + (e < 4 ? 4 * g + e : 32 + 4 * g + (e - 4)); } if (j < 768) return -1;
    if (j < 2048) return 4800 + (j - 768); if (j < 3328) return 6080 + (j - 2048); return 3776 + (j - 3328); } };
struct MapW2 { __device__ __forceinline__ int operator()(int j) const {
    if (j < 2048) { const int tl = j >> 8, lc = j & 255; return (lc < 128) ? (128 * tl + lc) : (2048 + 128 * tl + (lc - 128)); }
    if (j < 3072) return 1024 + (j - 2048); return 7360 + (j - 3072); } };
struct MapQ { __device__ __forceinline__ int operator()(int j) const {
    if (j < 1024) { const int hd = j >> 7, d = j & 127; return hd * 192 + d; }
    const int jj = j - 1024, hh = jj >> 6, w = jj & 63, g = w >> 3, e = w & 7; return hh * 192 + (e < 4 ? 128 + 4 * g + e : 160 + 4 * g + (e - 4)); } };
struct MapId { __device__ __forceinline__ int operator()(int j) const { return j; } };

template <class Map>
__device__ __forceinline__ void tr_item(const float* W, int ldw, int nkb  , bf16_t* WT, int ldt, const Map map, const float* kscale, LAS float* scr, int item, int lane) {
    const int kb = item % nkb, nb = item / nkb, k0 = 64 * kb, n0 = 32 * nb;
    const int nn = lane & 31; const int sc = map(n0 + nn);
    float wv[32];
    const float* wp = W + (size_t)(k0 + (lane >> 5)) * ldw + (sc >= 0 ? sc : 0);
#pragma unroll
    for (int i = 0; i < 32; ++i) wv[i] = (sc >= 0) ? wp[(size_t)(2 * i) * ldw] : 0.f;
#pragma unroll
    for (int i = 0; i < 32; ++i) { const int kk = 2 * i + (lane >> 5); float v = wv[i]; if (kscale) v *= kscale[k0 + kk]; scr[kk * 33 + nn] = v; }
    LDS_WAIT(); asm volatile("" ::: "memory");
    const int c = lane & 7;
#pragma unroll
    for (int j = 0; j < 4; ++j) { const int n = (lane >> 3) + 8 * j; const LAS float* s = scr + (8 * c) * 33 + n;
        u32x4 o; o.x = pk_bf16(s[0 * 33], s[1 * 33]); o.y = pk_bf16(s[2 * 33], s[3 * 33]); o.z = pk_bf16(s[4 * 33], s[5 * 33]); o.w = pk_bf16(s[6 * 33], s[7 * 33]);
        *(u32x4*)(WT + (size_t)(n0 + n) * ldt + k0 + 8 * c) = o; }
    LDS_WAIT(); asm volatile("" ::: "memory");
}

__device__ __forceinline__ void convert_weights(const Frame& F, const Args& a, unsigned char* ws, int l) {
    const int lane = lane_id();
    LAS float* scr = (LAS float*)(F.lds + F.wave * 16384);
    const int gw = F.vcu * NWAVES + F.wave, NGW = F.G * NWAVES;
    unsigned char* wb = ws + WS_WB;
    constexpr int I1 = 16 * (4352 / 32), I2 = 16 * (6144 / 32), IQ = 6 * (1536 / 32), IKV = 4 * (2048 / 32), IPA = 16 * 32, IPB = 16 * 32, IPC = 20 * 32, IO = 16 * 32;
    constexpr int NITEMS = I1 + I2 + IQ + IKV + IPA + IPB + IPC + IO;
    const float* w_in = a.in[I_W_IN] + (size_t)l * 1024 * N_IN; const float* pre_g = a.in[I_PRE_G] + l * DM;
    for (int it = gw; it < NITEMS; it += NGW) {
        int r = it;
        if (r < I1) { tr_item(w_in, N_IN, 16, (bf16_t*)(wb + WB_W1T), 1024, MapW1(), pre_g, scr, r, lane); continue; } r -= I1;
        if (r < I2) { tr_item(w_in, N_IN, 16, (bf16_t*)(wb + WB_W2T), 1024, MapW2(), pre_g, scr, r, lane); continue; } r -= I2;
        if (r < IQ) { tr_item(a.in[I_W_UQ] + (size_t)l * 384 * 1536, 1536, 6, (bf16_t*)(wb + WB_WQT), 384, MapQ(), a.in[I_QN_G] + l * 384, scr, r, lane); continue; } r -= IQ;
        if (r < IKV) { tr_item(a.in[I_W_UKV] + (size_t)l * 256 * 2048, 2048, 4, (bf16_t*)(wb + WB_WKVT), 384, MapId(), a.in[I_KVN_G] + l * 256, scr, r, lane); continue; } r -= IKV;
        if (r < IPA) { tr_item(a.in[I_W_PA] + (size_t)l * 1024 * 1024, 1024, 16, (bf16_t*)(wb + WB_WPT), 3328, MapId(), nullptr, scr, r, lane); continue; } r -= IPA;
        if (r < IPB) { tr_item(a.in[I_W_PB] + (size_t)l * 1024 * 1024, 1024, 16, (bf16_t*)(wb + WB_WPT) + 1024, 3328, MapId(), nullptr, scr, r, lane); continue; } r -= IPB;
        if (r < IPC) { tr_item(a.in[I_W_PC] + (size_t)l * 1280 * 1024, 1024, 20, (bf16_t*)(wb + WB_WPT) + 2048, 3328, MapId(), nullptr, scr, r, lane); continue; } r -= IPC;
        tr_item(a.in[I_W_OUT] + (size_t)l * 1024 * 1024, 1024, 16, (bf16_t*)(wb + WB_WOT), 1024, MapId(), nullptr, scr, r, lane);
    }
    const int gt = (F.vcu * NWAVES + F.wave) * 64 + lane, NGT = F.G * NWAVES * 64;
    bf16_t* lwa = (bf16_t*)(ws + WS_LW); bf16_t* lwx = lwa + 16 * 80 * 96;
    const float* w_a = a.in[I_W_A] + (size_t)l * 16 * 80 * 80; const float* w_x = a.in[I_W_X] + (size_t)l * 16 * 80 * 80;
    for (int i = gt; i < 16 * 80 * 96; i += NGT) { const int k = i % 96, j = (i / 96) % 80, blk = i / (96 * 80);
        const float va = (k < 80) ? w_a[((size_t)blk * 80 + k) * 80 + j] : 0.f, vx = (k < 80) ? w_x[((size_t)blk * 80 + k) * 80 + j] : 0.f;
        lwa[i] = f2bf(va); lwx[i] = f2bf(vx); }
    { float* lct = (float*)(ws + WS_LCT); const float* cw = a.in[I_CONV_W] + (size_t)l * 4 * 1280;
      for (int c = gt; c < 1280; c += NGT) { f32x4 v0 = {cw[c], cw[1280 + c], cw[2560 + c], cw[3840 + c]};
          f32x4 v1 = {a.in[I_CONV_B][l * 1280 + c], -1.4426950408889634f * a.in[I_B_A][l * 1280 + c], -1.4426950408889634f * a.in[I_B_X][l * 1280 + c],   -8.f * 1.4426950408889634f * softplus_neg(a.in[I_LAM][l * 1280 + c])};
          *(f32x4*)(lct + c * 8) = v0; *(f32x4*)(lct + c * 8 + 4) = v1; } }
    bf16_t* gmw = (bf16_t*)(ws + WS_GMW); const float* gws = a.in[I_GM_WS] + (size_t)l * 4 * 128 * 128;
    for (int i = gt; i < 4 * 128 * 128; i += NGT) { const int j = i & 127, ii = (i >> 7) & 127; gmw[i] = f2bf(((j >> 6) <= (ii >> 6)) ? gws[i] : 0.f); }
}
__device__ __forceinline__ void rope_table(const Frame& F, unsigned char* ws) {
    const int gt = (F.vcu * NWAVES + F.wave) * 64 + lane_id(), NGT = F.G * NWAVES * 64;
    float* cs = (float*)(ws + WS_ROPE); float* sn = cs + 2048 * 32;
    for (int i = gt; i < 2048 * 32; i += NGT) { const int s = i >> 5, fi = i & 31; const float inv_freq = powf(10000.f, -(float)(2 * fi) / 64.f); const float ang = (float)s * inv_freq;
        cs[i] = cosf(ang); sn[i] = sinf(ang); }
}
__device__ __forceinline__ void norm_rows(const Frame& F, const bool nostore, const float* xin, const bf16_t* o, const float* g_post, float* xout, const float* g_pre, bf16_t* h, float* rinv = nullptr) {
    const int gw = F.vcu * NWAVES + F.wave, NGW = F.G * NWAVES; const int lane = lane_id();
    f32x4 v[4], ov[4], nv[4]; u32x2 nov[4];
    if (gw < T) {
#pragma unroll
        for (int j = 0; j < 4; ++j) { nv[j] = *((const f32x4*)(xin + (size_t)gw * DM) + lane + 64 * j); nov[j] = o ? *((const u32x2*)(o + (size_t)gw * DM) + lane + 64 * j) : (u32x2){0u, 0u}; }
    }
    for (int m = gw; m < T; m += NGW) {
#pragma unroll
        for (int j = 0; j < 4; ++j) { v[j] = nv[j]; ov[j] = (f32x4){bf_lo(nov[j].x), bf_hi(nov[j].x), bf_lo(nov[j].y), bf_hi(nov[j].y)}; }
        const int mn = m + NGW;
        if (mn < T) {
#pragma unroll
            for (int j = 0; j < 4; ++j) { nv[j] = *((const f32x4*)(xin + (size_t)mn * DM) + lane + 64 * j); if (o) nov[j] = *((const u32x2*)(o + (size_t)mn * DM) + lane + 64 * j); }
        }
        if (o) {
            float s = 0.f;
#pragma unroll
            for (int j = 0; j < 4; ++j) s += (ov[j].x * ov[j].x + ov[j].y * ov[j].y) + (ov[j].z * ov[j].z + ov[j].w * ov[j].w);
            const float r = rsqrtf(wave_sum(s) * (1.f / DM) + EPS);
            f32x4* xo = (f32x4*)(xout + (size_t)m * DM) + lane;
#pragma unroll
            for (int j = 0; j < 4; ++j) { const f32x4 gp = *((const f32x4*)g_post + lane + 64 * j); v[j] = v[j] + ov[j] * r * gp; if (!nostore) xo[64 * j] = v[j]; }
        }
        if (g_pre) {
            float s = 0.f;
#pragma unroll
            for (int j = 0; j < 4; ++j) s += (v[j].x * v[j].x + v[j].y * v[j].y) + (v[j].z * v[j].z + v[j].w * v[j].w);
            const float ms = wave_sum(s) * (1.f / DM) + EPS, r = rsqrtf(ms); if (rinv && lane == 0) rinv[m] = ms * r;
            u32x2* ho = (u32x2*)(h + (size_t)m * DM) + lane;
#pragma unroll
            for (int j = 0; j < 4; ++j) { const f32x4 y = v[j] * r; u32x2 w; w.x = pk_bf16(y.x, y.y); w.y = pk_bf16(y.z, y.w); if (!nostore) ho[64 * j] = w; }
        }
    }
}
using g8::UnitD;
constexpr float QSCALE = 0.07216878364870322f * 1.4426950408889634f;

struct SchedA {
    g8::TileOrder ord; const char* A; const char* B;
    __device__ __forceinline__ bool next(int i, UnitD& u) const { int pm, pn; if (!ord.tile(i, pm, pn)) return false;
        u.A = A + (size_t)pm * 256 * 2048; u.B = B + (size_t)pn * 256 * 2048; u.nt = 16; u.pm = pm; u.pn = pn; u.kind = 0; return true; }
};
struct EpiA {
    bf16_t* misc; bf16_t* xc; bf16_t* y; float* slab; bf16_t* kr; const float* cs; const float* sn; WsBuf wsb;
    template <int KIND>
    __device__ __forceinline__ void body(f32x4 (&acc)[2][2][4][2], const UnitD& u, bf16_t* dst, int ld, int wr, int wc, int fr, int fq) const {
        const int pn = u.pn, rowp = wr * 64 + fr, lc = wc * 32 + 8 * fq;
#pragma unroll
        for (int ai = 0; ai < 2; ++ai)
#pragma unroll
            for (int m = 0; m < 4; ++m) { const int rp = rowp + ai * 128 + m * 16; bf16_t* p = dst + ((size_t)u.pm * 256 + rp) * ld + lc;
#pragma unroll
                for (int bj = 0; bj < 2; ++bj) { f32x4 v0 = acc[ai][bj][m][0], v1 = acc[ai][bj][m][1];
                    if (KIND == 0) {
                        if (pn == 2 && bj == 1) { if (wc < 2) { const int g = 4 * wc + fq; const size_t r = (size_t)u.pm * 256 + rp; const int pos = (int)(r & 2047);
                                const f32x4 c4 = *(const f32x4*)(cs + pos * 32 + 4 * g), s4 = *(const f32x4*)(sn + pos * 32 + 4 * g);
                                const f32x4 o1 = v0 * c4 - v1 * s4, o2 = v1 * c4 + v0 * s4; bf16_t* kp = kr + r * 64 + 4 * g;
                                u32x2 w1, w2; w1.x = pk_bf16(o1.x, o1.y); w1.y = pk_bf16(o1.z, o1.w); w2.x = pk_bf16(o2.x, o2.y); w2.y = pk_bf16(o2.z, o2.w);
                                *(u32x2*)kp = w1; *(u32x2*)(kp + 32) = w2; }
                            continue; }
                        float ss = (v0.x * v0.x + v0.y * v0.y) + (v0.z * v0.z + v0.w * v0.w) + (v1.x * v1.x + v1.y * v1.y) + (v1.z * v1.z + v1.w * v1.w);
                        ss += sx<16>(ss); ss = xsum32(ss);
                        if (fq == 0) slab[(((size_t)u.pm * 6 + pn * 2 + bj) * 4 + wc) * 256 + rp] = ss; }
                    if (KIND == 2) { v0.x = fsilu(v0.x); v0.y = fsilu(v0.y); v0.z = fsilu(v0.z); v0.w = fsilu(v0.w); v1.x = fsilu(v1.x); v1.y = fsilu(v1.y); v1.z = fsilu(v1.z); v1.w = fsilu(v1.w); }
                    u32x4 w; w.x = pk_bf16(v0.x, v0.y); w.y = pk_bf16(v0.z, v0.w); w.z = pk_bf16(v1.x, v1.y); w.w = pk_bf16(v1.z, v1.w);
                    st16_wt(wsb, p + bj * 128, w); } }
    }
    __device__ __forceinline__ void operator()(f32x4 (&acc)[2][2][4][2], const UnitD& u, int wr, int wc, int fr, int fq) const {
        const int pn = u.pn;
        if (pn < 3) body<0>(acc, u, misc + 256 * pn, 768, wr, wc, fr, fq);
        else if (pn < 8) body<1>(acc, u, xc + 256 * (pn - 3), 1280, wr, wc, fr, fq);
        else if (pn < 13) body<2>(acc, u, y + 2048 + 256 * (pn - 8), YLD, wr, wc, fr, fq);
        else body<2>(acc, u, y + 1024 + 256 * (pn - 13), YLD, wr, wc, fr, fq);
    }
};

struct SchedZ {
    int v; const char* A; const char* B;
    __device__ __forceinline__ bool next(int i, UnitD& u) const { if (i > 0 || (v & 3) != 0 || v >= 256) return false; const int pm = v >> 2;
        u.A = A + (size_t)pm * 256 * 2048; u.B = B + (size_t)16 * 256 * 2048; u.nt = 16; u.pm = pm; u.pn = 16; u.kind = 0; return true; }
};
struct SchedQKV {
    int v; const char* misc; const char* wq; const char* wkv;
    __device__ __forceinline__ bool next(int i, UnitD& u) const { if (v >= 256) return false; const int role = v & 3, pm = v >> 2; int pn;
        if (role == 0) { if (i > 1) return false; pn = 6 + i; }
        else { if (i > 3) return false; pn = (i < 2) ? (2 * role - 2 + i) : (6 + 2 * role + (i - 2)); }
        u.pm = pm; u.pn = pn; u.kind = 0;
        if (pn < 6) { u.A = misc + (size_t)pm * 256 * 1536; u.B = wq + (size_t)pn * 256 * 768; u.nt = 6; }
        else { u.A = misc + (size_t)pm * 256 * 1536 + 384 * 2; u.B = wkv + (size_t)(pn - 6) * 256 * 768; u.nt = 4; }
        return true; }
};
constexpr int RS_TAB_OFF = RING_BYTES + 2048;
__device__ __forceinline__ void qkv_row_scales(LAS unsigned char* lds, const float* slab, int pm, int tid) {
    if (tid < 256) { const float* sl = slab + (size_t)pm * 6 * 4 * 256 + tid; float p[20];
#pragma unroll
        for (int j = 0; j < 20; ++j) p[j] = sl[(size_t)j * 256];
        float sq = 0.f, sk = 0.f;
#pragma unroll
        for (int j = 0; j < 12; ++j) sq += p[j];
#pragma unroll
        for (int j = 12; j < 20; ++j) sk += p[j];
        LAS float* tab = (LAS float*)(lds + RS_TAB_OFF);
        tab[tid] = rsqrtf(sq * (1.f / 384.f) + EPS) * QSCALE; tab[256 + tid] = rsqrtf(sk * (1.f / 256.f) + EPS); }
    LDS_WAIT(); __syncthreads();
}
struct EpiNull {
    __device__ __forceinline__ void operator()(f32x4 (&acc)[2][2][4][2], const UnitD&, int, int, int, int) const {
#pragma unroll
        for (int a = 0; a < 2; ++a)
#pragma unroll
            for (int b = 0; b < 2; ++b)
#pragma unroll
                for (int m = 0; m < 4; ++m) { asm volatile("" :: "v"(acc[a][b][m][0]), "v"(acc[a][b][m][1])); } }
};
struct EpiQKV {
    bf16_t* q; bf16_t* y; bf16_t* vv; const float* cs; const float* sn; WsBuf wsb;
    template <int KIND>
    __device__ __forceinline__ void body(f32x4 (&acc)[2][2][4][2], const UnitD& u, int wr, int wc, int fr, int fq, const LAS float* tab) const {
        const int pn = u.pn, rowp = wr * 64 + fr, lc = wc * 32 + 8 * fq; constexpr bool isq = KIND < 2;
        float rsv[2][4];
#pragma unroll
        for (int ai = 0; ai < 2; ++ai)
#pragma unroll
            for (int m = 0; m < 4; ++m) rsv[ai][m] = tab[(isq ? 0 : 256) + rowp + ai * 128 + m * 16];
#pragma unroll
        for (int ai = 0; ai < 2; ++ai) {
            f32x4 c4[4], s4[4];
            if (KIND == 1) { const int g = (lc & 63) >> 3;
#pragma unroll
                for (int m = 0; m < 4; ++m) { const int pos = (int)(((size_t)u.pm * 256 + rowp + ai * 128 + m * 16) & 2047);
                    c4[m] = *(const f32x4*)(cs + pos * 32 + 4 * g); s4[m] = *(const f32x4*)(sn + pos * 32 + 4 * g); } }
#pragma unroll
            for (int m = 0; m < 4; ++m) { const int rp = rowp + ai * 128 + m * 16; const size_t r = (size_t)u.pm * 256 + rp;
                const float rs = rsv[ai][m];
#pragma unroll
                for (int bj = 0; bj < 2; ++bj) { f32x4 v0 = acc[ai][bj][m][0] * rs, v1 = acc[ai][bj][m][1] * rs;
                    if (KIND == 0) { const int j0 = 256 * pn + 128 * bj + lc; bf16_t* p = q + r * 1536 + (j0 >> 7) * 192 + (j0 & 127);
                        u32x4 w; w.x = pk_bf16(v0.x, v0.y); w.y = pk_bf16(v0.z, v0.w); w.z = pk_bf16(v1.x, v1.y); w.w = pk_bf16(v1.z, v1.w); st16_sel<WT_QKV>(wsb, p, w); }
                    else if (KIND == 1) { const int jj = 256 * (pn - 4) + 128 * bj + lc, hh = jj >> 6, g = (jj & 63) >> 3;
                        const f32x4 cc = c4[m], ss = s4[m];
                        const f32x4 o1 = v0 * cc - v1 * ss, o2 = v1 * cc + v0 * ss; bf16_t* p = q + r * 1536 + hh * 192 + 128 + 4 * g;
                        u32x2 w1, w2; w1.x = pk_bf16(o1.x, o1.y); w1.y = pk_bf16(o1.z, o1.w); w2.x = pk_bf16(o2.x, o2.y); w2.y = pk_bf16(o2.z, o2.w);
                        *(u32x2*)p = w1; *(u32x2*)(p + 32) = w2; }
                    else { const int hd = pn - 6; bf16_t* p = (bj == 0) ? (y + r * YLD + hd * 128 + lc) : (vv + r * 1024 + hd * 128 + lc);
                        u32x4 w; w.x = pk_bf16(v0.x, v0.y); w.y = pk_bf16(v0.z, v0.w); w.z = pk_bf16(v1.x, v1.y); w.w = pk_bf16(v1.z, v1.w); st16_sel<WT_QKV>(wsb, p, w); } } } }
    }
    LAS unsigned char* lds;
    __device__ __forceinline__ void operator()(f32x4 (&acc)[2][2][4][2], const UnitD& u, int wr, int wc, int fr, int fq) const {
        const LAS float* tab = (const LAS float*)(lds + RS_TAB_OFF);
        if (u.pn < 4) body<0>(acc, u, wr, wc, fr, fq, tab); else if (u.pn < 6) body<1>(acc, u, wr, wc, fr, fq, tab); else body<2>(acc, u, wr, wc, fr, fq, tab);
    }
};

struct SchedD {
    g8::TileOrder ord; const char* A; const char* B;
    __device__ __forceinline__ bool next(int i, UnitD& u) const { int pm, pn; if (!ord.tile(i, pm, pn)) return false;
        u.A = A + (size_t)pm * 256 * 2048; u.B = B + (size_t)pn * 256 * 2048; u.nt = 16; u.pm = pm; u.pn = pn; u.kind = 0; return true; }
};
struct EpiD {
    bf16_t* y; bf16_t* v1; bf16_t* g; float* vslab; WsBuf wsb;
    template <int KIND>
    __device__ __forceinline__ void body(f32x4 (&acc)[2][2][4][2], const UnitD& u, int wr, int wc, int fr, int fq) const {
        const int pn = u.pn, rowp = wr * 64 + fr, lc = wc * 32 + 8 * fq;
#pragma unroll
        for (int ai = 0; ai < 2; ++ai)
#pragma unroll
            for (int m = 0; m < 4; ++m) { const size_t r = (size_t)u.pm * 256 + rowp + ai * 128 + m * 16;
                if (KIND == 0) { const f32x4 u0 = acc[ai][0][m][0], u1 = acc[ai][0][m][1], z0 = acc[ai][1][m][0], z1 = acc[ai][1][m][1];
                    u32x4 w; w.x = pk_bf16(u0.x * fsilu(z0.x), u0.y * fsilu(z0.y)); w.y = pk_bf16(u0.z * fsilu(z0.z), u0.w * fsilu(z0.w));
                    w.z = pk_bf16(u1.x * fsilu(z1.x), u1.y * fsilu(z1.y)); w.w = pk_bf16(u1.z * fsilu(z1.z), u1.w * fsilu(z1.w));
                    st16_wt(wsb, y + r * YLD + 128 * pn + lc, w); }
                else {
#pragma unroll
                    for (int bj = 0; bj < 2; ++bj) { f32x4 v0 = acc[ai][bj][m][0], v1_ = acc[ai][bj][m][1]; bf16_t* p;
                        if (KIND == 1) { p = v1 + r * 1024 + 256 * (pn - 8) + 128 * bj + lc;
                            float s1 = (v0.x + v0.y) + (v0.z + v0.w) + (v1_.x + v1_.y) + (v1_.z + v1_.w);
                            float s2 = (v0.x * v0.x + v0.y * v0.y) + (v0.z * v0.z + v0.w * v0.w) + (v1_.x * v1_.x + v1_.y * v1_.y) + (v1_.z * v1_.z + v1_.w * v1_.w);
                            s1 += sx<16>(s1); s1 = xsum32(s1); s2 += sx<16>(s2); s2 = xsum32(s2);
                            if (fq == 0) *(f32x2*)(vslab + r * 64 + (((pn - 8) * 2 + bj) * 4 + wc) * 2) = (f32x2){s1, s2}; }
                        else { p = g + r * 3072 + 256 * (pn - 12) + 128 * bj + lc;
                            v0.x = fsigmoid(v0.x); v0.y = fsigmoid(v0.y); v0.z = fsigmoid(v0.z); v0.w = fsigmoid(v0.w); v1_.x = fsigmoid(v1_.x); v1_.y = fsigmoid(v1_.y); v1_.z = fsigmoid(v1_.z); v1_.w = fsigmoid(v1_.w); }
                        u32x4 w; w.x = pk_bf16(v0.x, v0.y); w.y = pk_bf16(v0.z, v0.w); w.z = pk_bf16(v1_.x, v1_.y); w.w = pk_bf16(v1_.z, v1_.w); st16_wt(wsb, p, w); } } }
    }
    __device__ __forceinline__ void operator()(f32x4 (&acc)[2][2][4][2], const UnitD& u, int wr, int wc, int fr, int fq) const {
        if (u.pn < 8) body<0>(acc, u, wr, wc, fr, fq); else if (u.pn < 12) body<1>(acc, u, wr, wc, fr, fq); else body<2>(acc, u, wr, wc, fr, fq);
    }
};

struct SchedF {
    g8::TileOrder ord; const char* A; const char* B;
    __device__ __forceinline__ bool next(int i, UnitD& u) const { if (i >= 3) return false; int pm, pn; if (!ord.tile(0, pm, pn)) return false;
        const size_t ko = (i == 0) ? 0 : (i == 1 ? 1024 * 2 : 2048 * 2);
        u.A = A + (size_t)pm * 256 * (YLD * 2) + ko; u.B = B + (size_t)pn * 256 * (YLD * 2) + ko; u.nt = (i == 2) ? 20 : 16; u.pm = pm; u.pn = pn; u.kind = (i < 2) ? (i | g8::KEEP_ACC) : i; return true; }
};
struct EpiF {
    const bf16_t* g; bf16_t* merged; WsBuf wsb;
    template <bool MID>
    __device__ __forceinline__ void ldq(int q, u32x4 (&A)[2][2], u32x4 (&B)[2][2], const UnitD& u, int seg, int rowp, int lc) const {
        const int ai = q >> 1, mh = q & 1;
#pragma unroll
        for (int mm = 0; mm < 2; ++mm) { const size_t r = (size_t)u.pm * 256 + rowp + ai * 128 + (2 * mh + mm) * 16;
#pragma unroll
            for (int bj = 0; bj < 2; ++bj) { const bf16_t* gp = g + r * 3072 + seg * 1024 + 256 * u.pn + 128 * bj + lc; A[mm][bj] = *(const u32x4*)gp; if (MID) B[mm][bj] = *(const u32x4*)(gp + 1024); } }
    }
    template <bool MID>
    __device__ __forceinline__ void cmpq(int q, const u32x4 (&A)[2][2], const u32x4 (&B)[2][2], f32x4 (&acc)[2][2][4][2], const UnitD& u, int rowp, int lc) const {
        const int ai = q >> 1, mh = q & 1;
#pragma unroll
        for (int mm = 0; mm < 2; ++mm) { const int m = 2 * mh + mm; const size_t r = (size_t)u.pm * 256 + rowp + ai * 128 + m * 16;
#pragma unroll
            for (int bj = 0; bj < 2; ++bj) { const u32x4 a = A[mm][bj]; f32x4 f0, f1;
                f0.x = bf_lo(a.x); f0.y = bf_hi(a.x); f0.z = bf_lo(a.y); f0.w = bf_hi(a.y); f1.x = bf_lo(a.z); f1.y = bf_hi(a.z); f1.z = bf_lo(a.w); f1.w = bf_hi(a.w);
                if (MID) { const u32x4 b = B[mm][bj];
                    f0.x *= __builtin_amdgcn_rcpf(bf_lo(b.x)); f0.y *= __builtin_amdgcn_rcpf(bf_hi(b.x)); f0.z *= __builtin_amdgcn_rcpf(bf_lo(b.y)); f0.w *= __builtin_amdgcn_rcpf(bf_hi(b.y));
                    f1.x *= __builtin_amdgcn_rcpf(bf_lo(b.z)); f1.y *= __builtin_amdgcn_rcpf(bf_hi(b.z)); f1.z *= __builtin_amdgcn_rcpf(bf_lo(b.w)); f1.w *= __builtin_amdgcn_rcpf(bf_hi(b.w));
                    acc[ai][bj][m][0] *= f0; acc[ai][bj][m][1] *= f1;
                    asm volatile("" : "+v"(acc[ai][bj][m][0]), "+v"(acc[ai][bj][m][1]) :: "memory"); }
                else { const f32x4 v0 = acc[ai][bj][m][0] * f0, v1 = acc[ai][bj][m][1] * f1;
                    u32x4 w; w.x = pk_bf16(v0.x, v0.y); w.y = pk_bf16(v0.z, v0.w); w.z = pk_bf16(v1.x, v1.y); w.w = pk_bf16(v1.z, v1.w);
                    st16_sel<WT_F>(wsb, merged + r * 1024 + 256 * u.pn + 128 * bj + lc, w); } } }
    }
    template <bool MID>
    __device__ __forceinline__ void body(f32x4 (&acc)[2][2][4][2], const UnitD& u, int seg, int wr, int wc, int fr, int fq) const {
        const int rowp = wr * 64 + fr, lc = wc * 32 + 8 * fq;
        constexpr int DQ = MID ? 2 : 4;
        u32x4 A[DQ][2][2], B[MID ? DQ : 1][2][2];
#pragma unroll
        for (int q = 0; q < DQ; ++q) ldq<MID>(q, A[q], B[MID ? q : 0], u, seg, rowp, lc);
#pragma unroll
        for (int q = 0; q < 4; ++q) { cmpq<MID>(q, A[q % DQ], B[MID ? q % DQ : 0], acc, u, rowp, lc);
            if (q + DQ < 4) ldq<MID>(q + DQ, A[q % DQ], B[MID ? q % DQ : 0], u, seg, rowp, lc); }
    }
    __device__ __forceinline__ void operator()(f32x4 (&acc)[2][2][4][2], const UnitD& u, int wr, int wc, int fr, int fq) const {
        const int seg = u.kind & 3; if (seg < 2) body<true>(acc, u, seg, wr, wc, fr, fq); else body<false>(acc, u, seg, wr, wc, fr, fq);
    }
};

struct SchedG1 {
    int v; const char* A; const char* B;
    __device__ __forceinline__ bool next(int i, UnitD& u) const { if (i > 0 || v >= 256) return false; const int pm = v >> 2, pn = v & 3;
        u.A = A + (size_t)pm * 256 * 2048; u.B = B + (size_t)pn * 256 * 2048; u.nt = 16; u.pm = pm; u.pn = pn; u.kind = 0; return true; }
};
template <bool FIRST, bool NEXT>
struct EpiNorm {
    const float* xin; float* xout; bf16_t* h; const float* g_post;
    const float* rin; float* rout;
    WsBuf wsb, outb;
    float* slots; unsigned* cnt;
    __device__ __forceinline__ void exchange(const f32x4 (&v)[2][2][4][2], int pm, int pn, int wr, int wc, int fr, int fq, LAS unsigned char* lds, int wid, int lane, float* sl, unsigned* cn, float* ro) const {
        LAS float* P = (LAS float*)lds; LAS float* S = (LAS float*)(lds + 4096);
#pragma unroll
        for (int ai = 0; ai < 2; ++ai)
#pragma unroll
            for (int m = 0; m < 4; ++m) { float s = 0.f;
#pragma unroll
                for (int bj = 0; bj < 2; ++bj)
#pragma unroll
                    for (int n = 0; n < 2; ++n) { const f32x4 x = v[ai][bj][m][n]; s += (x.x * x.x + x.y * x.y) + (x.z * x.z + x.w * x.w); }
                s += sx<16>(s); s = xsum32(s);
                if (fq == 0) P[(ai * 128 + wr * 64 + m * 16 + fr) * 4 + wc] = s; }
        asm volatile("s_waitcnt lgkmcnt(0)" ::: "memory"); __builtin_amdgcn_s_barrier(); asm volatile("" ::: "memory");
        const int row = wid * 32 + (lane & 31);
        if (lane < 32) { const f32x4 p4 = *(const LAS f32x4*)(P + row * 4); const float tot = (p4.x + p4.y) + (p4.z + p4.w);
            __hip_atomic_store((unsigned*)sl + ((size_t)pm * 256 + row) * 4 + pn, __float_as_uint(tot), __ATOMIC_RELAXED, __HIP_MEMORY_SCOPE_AGENT); }
        asm volatile("s_waitcnt vmcnt(0)" ::: "memory");
        if (lane == 0) __hip_atomic_fetch_add(cn, 1u, __ATOMIC_RELAXED, __HIP_MEMORY_SCOPE_AGENT);
        if (wid == 0) { for (unsigned sp = 0; sp < (1u << 20); ++sp) { if ((unsigned)__builtin_amdgcn_readfirstlane(__hip_atomic_load(cn, __ATOMIC_RELAXED, __HIP_MEMORY_SCOPE_AGENT)) >= 32u) break; __builtin_amdgcn_s_sleep(2); } }
        asm volatile("s_waitcnt vmcnt(0) lgkmcnt(0)" ::: "memory"); __builtin_amdgcn_s_barrier(); asm volatile("" ::: "memory");
        if (lane < 32) { const unsigned* sp4 = (const unsigned*)sl + ((size_t)pm * 256 + row) * 4; float tot = 0.f;
#pragma unroll
            for (int t = 0; t < 4; ++t) tot += __uint_as_float(__hip_atomic_load(sp4 + t, __ATOMIC_RELAXED, __HIP_MEMORY_SCOPE_AGENT));
            const float ms = tot * (1.f / 1024.f) + EPS, rs = rsqrtf(ms); S[row] = rs; if (ro && pn == 0) ro[(size_t)pm * 256 + row] = ms * rs; }
        asm volatile("s_waitcnt lgkmcnt(0)" ::: "memory"); __builtin_amdgcn_s_barrier(); asm volatile("" ::: "memory");
    }
    __device__ __forceinline__ void fused(f32x4 (&acc)[2][2][4][2], const UnitD& u, int wr, int wc, int fr, int fq, LAS unsigned char* lds, int wid, int lane) const {
        const LAS float* S = (const LAS float*)(lds + 4096);
        const int lc = wc * 32 + 8 * fq, col0 = 256 * u.pn + lc;
        u32x4 xr[4][2][FIRST ? 2 : 1]; float ri[4];
        load_res<0, PRE_M>(xr, ri, u.pm, 0, wr, fr, col0);
        exchange(acc, u.pm, u.pn, wr, wc, fr, fq, lds, wid, lane, slots, cnt + u.pm * 16, nullptr);
        load_res<PRE_M, 4>(xr, ri, u.pm, 0, wr, fr, col0);
        f32x4 gp[2][2];
#pragma unroll
        for (int bj = 0; bj < 2; ++bj) { gp[bj][0] = *(const f32x4*)(g_post + col0 + bj * 128); gp[bj][1] = *(const f32x4*)(g_post + col0 + bj * 128 + 4); }
#pragma unroll
        for (int ai = 0; ai < 2; ++ai) {
            if (ai == 1) {
#pragma unroll
                for (int m = 0; m < 4; ++m)
#pragma unroll
                    for (int bj = 0; bj < 2; ++bj) { asm volatile("" : "+v"(acc[0][bj][m][0]), "+v"(acc[0][bj][m][1]) :: "memory"); }
                load_res<0, 4>(xr, ri, u.pm, 1, wr, fr, col0); }
#pragma unroll
            for (int m = 0; m < 4; ++m) { const int r = ai * 128 + wr * 64 + m * 16 + fr; const float rs = S[r]; const size_t off = ((size_t)u.pm * 256 + r) * 1024 + col0;
#pragma unroll
                for (int bj = 0; bj < 2; ++bj) { f32x4 x0, x1;
                    if (FIRST) { x0 = __builtin_bit_cast(f32x4, xr[m][bj][0]); x1 = __builtin_bit_cast(f32x4, xr[m][bj][FIRST ? 1 : 0]); }
                    else { const u32x4 hb = xr[m][bj][0]; x0 = (f32x4){bf_lo(hb.x), bf_hi(hb.x), bf_lo(hb.y), bf_hi(hb.y)} * ri[m]; x1 = (f32x4){bf_lo(hb.z), bf_hi(hb.z), bf_lo(hb.w), bf_hi(hb.w)} * ri[m]; }
                    const f32x4 y0 = x0 + acc[ai][bj][m][0] * rs * gp[bj][0], y1 = x1 + acc[ai][bj][m][1] * rs * gp[bj][1];
                    acc[ai][bj][m][0] = y0; acc[ai][bj][m][1] = y1;
                    if (!NEXT) { st16_sel<WT_OUT>(outb, xout + off + bj * 128, __builtin_bit_cast(u32x4, y0)); st16_sel<WT_OUT>(outb, xout + off + bj * 128 + 4, __builtin_bit_cast(u32x4, y1)); } } } }
        if (NEXT) {
            exchange(acc, u.pm, u.pn, wr, wc, fr, fq, lds, wid, lane, slots + (size_t)T * 4, cnt + 64 * 16 + u.pm * 16, rout);
#pragma unroll
            for (int ai = 0; ai < 2; ++ai)
#pragma unroll
                for (int m = 0; m < 4; ++m) { const int r = ai * 128 + wr * 64 + m * 16 + fr; const float rs = S[r]; const size_t off = ((size_t)u.pm * 256 + r) * 1024 + col0;
#pragma unroll
                    for (int bj = 0; bj < 2; ++bj) { const f32x4 y0 = acc[ai][bj][m][0] * rs, y1 = acc[ai][bj][m][1] * rs;
                        u32x4 w; w.x = pk_bf16(y0.x, y0.y); w.y = pk_bf16(y0.z, y0.w); w.z = pk_bf16(y1.x, y1.y); w.w = pk_bf16(y1.z, y1.w);
                        st16_sel<WT_NORM>(wsb, h + off + bj * 128, w); } }
        }
    }
    static constexpr int PRE_M = 4;
    template <int M0, int M1>
    __device__ __forceinline__ void load_res(u32x4 (&xr)[4][2][FIRST ? 2 : 1], float (&ri)[4], int pm, int ai, int wr, int fr, int col0) const {
#pragma unroll
        for (int m = M0; m < M1; ++m) { const size_t row = (size_t)pm * 256 + ai * 128 + wr * 64 + m * 16 + fr, off = row * 1024 + col0;
            if (FIRST) { ri[m] = 1.f;
#pragma unroll
                for (int bj = 0; bj < 2; ++bj) { xr[m][bj][0] = *(const u32x4*)(xin + off + bj * 128); xr[m][bj][FIRST ? 1 : 0] = *(const u32x4*)(xin + off + bj * 128 + 4); } }
            else { ri[m] = rin[row];
#pragma unroll
                for (int bj = 0; bj < 2; ++bj) xr[m][bj][0] = *(const u32x4*)(h + off + bj * 128); } }
    }
    __device__ __forceinline__ void operator()(f32x4 (&)[2][2][4][2], const UnitD&, int, int, int, int) const {}
};
typedef float f32x2v __attribute__((ext_vector_type(2)));

constexpr int LRU_HIN_OFF = RING_BYTES + 1024;
template <int PASS>
__device__ __forceinline__ void lru_item(const Frame& F, const Args& a, const unsigned char* ws, const bool nostore, int l, int item, const bf16_t* xcb, bf16_t* y, float* agg) {
    const int b = item >> 5, k = item & 31; const size_t r0 = (size_t)b * SEQ + (size_t)k * 64;
    int lane_ = lane_id(); asm volatile("" : "+v"(lane_));
    const int lane = lane_, cl = lane & 15, kg = lane >> 4;
    LAS unsigned char* xt = F.lds + F.wave * 16384;
    const bf16_t* lwa = (const bf16_t*)(ws + WS_LW); const bf16_t* lwx = lwa + 16 * 80 * 96;
    const float* lct = (const float*)(ws + WS_LCT);
    LAS float* hin_l = (LAS float*)(F.lds + LRU_HIN_OFF);
    if (PASS == 2) {
        for (int c = F.wave * 64 + lane; c < 1280; c += 512) { const float* ag = agg + ((size_t)b * 32 * 1280 + c) * 2; float h = 0.f;
#pragma unroll 8
            for (int j = 0; j < k; ++j) { const f32x2v ab = *(const f32x2v*)(ag + (size_t)j * 2560); h = ab.x * h + ab.y; }
            hin_l[c] = h; }
        LDS_WAIT(); __syncthreads();
    }
#pragma unroll 1
    for (int bi = 0; bi < 2; ++bi) {
        const int blk = 2 * F.wave + bi;
        {
            u32x4 xch[11]; int ln = lane; asm volatile("" : "+v"(ln));
            const bf16_t* xbase = xcb + (r0 - 3) * 1280 + blk * 80;
#pragma unroll
            for (int i = 0; i < 11; ++i) { const int idx = ln + 64 * i; const int row = idx / 10, ch = idx - row * 10; xch[i] = (u32x4){0u, 0u, 0u, 0u};
                if (idx < 670 && !(k == 0 && row < 3)) xch[i] = *(const u32x4*)(xbase + (unsigned)(row * 1280 + ch * 8)); }
#pragma unroll
            for (int i = 0; i < 11; ++i) { const int idx = ln + 64 * i; const int row = idx / 10, ch = idx - row * 10; if (idx < 670) *(LAS u32x4*)(xt + row * 208 + ch * 16) = xch[i]; }
            LAS u32x4* z = (LAS u32x4*)(xt + (lane + 3) * 208 + 160); z[0] = (u32x4){0u, 0u, 0u, 0u}; z[1] = (u32x4){0u, 0u, 0u, 0u};
        }
        LDS_WAIT(); asm volatile("" ::: "memory");
#pragma unroll
        for (int ct = 0; ct < 5; ++ct) { const int c = blk * 80 + 16 * ct + cl; const f32x4 cw = *(const f32x4*)(lct + c * 8); const float cb = lct[c * 8 + 4];
            float xv[4][7];
#pragma unroll
            for (int rt = 0; rt < 4; ++rt)
#pragma unroll
                for (int j = 0; j < 7; ++j) xv[rt][j] = bf1(*(const LAS bf16_t*)(xt + (16 * rt + 4 * kg + j) * 208 + (16 * ct + cl) * 2));
            asm volatile("" ::: "memory");
#pragma unroll
            for (int rt = 0; rt < 4; ++rt)
#pragma unroll
                for (int e = 0; e < 4; ++e) { const float v = cb + cw.x * xv[rt][e] + cw.y * xv[rt][e + 1] + cw.z * xv[rt][e + 2] + cw.w * xv[rt][e + 3];
                    *(LAS bf16_t*)(xt + (16 * rt + 4 * kg + e + 3) * 208 + (16 * ct + cl) * 2) = f2bf(v); }
            asm volatile("" ::: "memory"); }
        LDS_WAIT(); asm volatile("" ::: "memory");
        bf16x8 af[4][3];
#pragma unroll
        for (int rt = 0; rt < 4; ++rt)
#pragma unroll
            for (int ks = 0; ks < 3; ++ks) af[rt][ks] = *(const LAS bf16x8*)(xt + (16 * rt + cl + 3) * 208 + (32 * ks + 8 * kg) * 2);
        bf16x8 wA[2][3], wX[2][3];
#pragma unroll
        for (int ks = 0; ks < 3; ++ks) { const size_t wo = ((size_t)blk * 80 + cl) * 96 + 32 * ks + 8 * kg; wA[0][ks] = *(const bf16x8*)(lwa + wo); wX[0][ks] = *(const bf16x8*)(lwx + wo); }
#pragma unroll
        for (int ct = 0; ct < 5; ++ct) { const int c = blk * 80 + 16 * ct + cl; const int cur = ct & 1;
            if (ct + 1 < 5) {
#pragma unroll
                for (int ks = 0; ks < 3; ++ks) { const size_t wo = ((size_t)blk * 80 + 16 * (ct + 1) + cl) * 96 + 32 * ks + 8 * kg; wA[cur ^ 1][ks] = *(const bf16x8*)(lwa + wo); wX[cur ^ 1][ks] = *(const bf16x8*)(lwx + wo); } }
            const f32x4 c1 = *(const f32x4*)(lct + c * 8 + 4); const float ba_c = c1.y, bx_c = c1.z, sp8 = c1.w;
            f32x4 ra[4], rx[4];
#pragma unroll
            for (int rt = 0; rt < 4; ++rt) { ra[rt] = (f32x4){0.f, 0.f, 0.f, 0.f}; rx[rt] = (f32x4){0.f, 0.f, 0.f, 0.f}; }
#pragma unroll
            for (int ks = 0; ks < 3; ++ks)
#pragma unroll
                for (int rt = 0; rt < 4; ++rt) { ra[rt] = __builtin_amdgcn_mfma_f32_16x16x32_bf16(af[rt][ks], wA[cur][ks], ra[rt], 0, 0, 0); rx[rt] = __builtin_amdgcn_mfma_f32_16x16x32_bf16(af[rt][ks], wX[cur][ks], rx[rt], 0, 0, 0); }
            float hin = (PASS == 2) ? hin_l[c] : 0.f; float totA = 1.f, totB = 0.f;
#pragma unroll
            for (int rt = 0; rt < 4; ++rt) { float av[4], bv[4];
#pragma unroll
                for (int e = 0; e < 4; ++e) { const float r = __builtin_amdgcn_rcpf(1.f + fexp2(fmaf(ra[rt][e], -1.4426950408889634f, ba_c))), ig = __builtin_amdgcn_rcpf(1.f + fexp2(fmaf(rx[rt][e], -1.4426950408889634f, bx_c)));
                    const float aa = fexp2(sp8 * r); const float mult = __builtin_amdgcn_sqrtf(fmaxf(1.f - aa * aa, 0.f));
                    const float xcv = bf1(*(const LAS bf16_t*)(xt + (16 * rt + 4 * kg + e + 3) * 208 + (16 * ct + cl) * 2));
                    av[e] = aa; bv[e] = mult * ig * xcv; }
                float sA = av[0], sB = bv[0];
#pragma unroll
                for (int e = 1; e < 4; ++e) { sB = av[e] * sB + bv[e]; sA *= av[e]; }
                float iA = sA, iB = sB;
                { const float pA = __shfl(iA, lane - 16), pB = __shfl(iB, lane - 16); if (kg >= 1) { iB = iA * pB + iB; iA = iA * pA; } }
                { const float pA = __shfl(iA, lane - 32), pB = __shfl(iB, lane - 32); if (kg >= 2) { iB = iA * pB + iB; iA = iA * pA; } }
                const float tA = __shfl(iA, 48 + cl), tB = __shfl(iB, 48 + cl);
                if (PASS == 1) { totB = tA * totB + tB; totA *= tA; }
                else {
                    float eA = __shfl(iA, lane - 16), eB = __shfl(iB, lane - 16); if (kg == 0) { eA = 1.f; eB = 0.f; }
                    float h = eA * hin + eB;
#pragma unroll
                    for (int e = 0; e < 4; ++e) { h = av[e] * h + bv[e]; *(LAS bf16_t*)(xt + (16 * rt + 4 * kg + e + 3) * 208 + (16 * ct + cl) * 2) = f2bf(h); }
                    hin = tA * hin + tB;
                }
            }
            if (PASS == 1) { if (kg == 0) *(f32x2v*)(agg + (((size_t)b * 32 + k) * 1280 + c) * 2) = (f32x2v){totA, totB}; }
        }
        LDS_WAIT(); asm volatile("" ::: "memory");
        if (PASS == 2) {
            int ln = lane; asm volatile("" : "+v"(ln));
            bf16_t* ybase = y + r0 * YLD + 2048 + blk * 80; u32x4 zc[10];
#pragma unroll
            for (int i = 0; i < 10; ++i) { const int idx = ln + 64 * i; const int row = idx / 10, ch = idx - row * 10; zc[i] = *(const u32x4*)(ybase + (unsigned)(row * YLD + ch * 8)); }
#pragma unroll
            for (int i = 0; i < 10; ++i) { const int idx = ln + 64 * i; const int row = idx / 10, ch = idx - row * 10; const u32x4 hv = *(const LAS u32x4*)(xt + (row + 3) * 208 + ch * 16); u32x4 o;
                o.x = pk_bf16(bf_lo(hv.x) * bf_lo(zc[i].x), bf_hi(hv.x) * bf_hi(zc[i].x)); o.y = pk_bf16(bf_lo(hv.y) * bf_lo(zc[i].y), bf_hi(hv.y) * bf_hi(zc[i].y));
                o.z = pk_bf16(bf_lo(hv.z) * bf_lo(zc[i].z), bf_hi(hv.z) * bf_hi(zc[i].z)); o.w = pk_bf16(bf_lo(hv.w) * bf_lo(zc[i].w), bf_hi(hv.w) * bf_hi(zc[i].w));
                if (!nostore) *(u32x4*)(ybase + (unsigned)(row * YLD + ch * 8)) = o; }
            LDS_WAIT(); asm volatile("" ::: "memory");
        }
    }
    if (PASS == 2) __syncthreads();
}

constexpr int CW_LRUF = 8192;
__device__ __forceinline__ void lru_single(const Frame& F, const WsBuf& wsb, const unsigned char* ws, unsigned* ctl, const bool nostore, int l, int item, const bf16_t* xcb, bf16_t* y, float* agg) {
    const int b = item >> 5, k = item & 31; const size_t r0 = (size_t)b * SEQ + (size_t)k * 64;
    int lane_ = lane_id(); asm volatile("" : "+v"(lane_));
    const int lane = lane_, cl = lane & 15, kg = lane >> 4;
    LAS unsigned char* xt = F.lds + F.wave * 16384;
    const bf16_t* lwa = (const bf16_t*)(ws + WS_LW); const bf16_t* lwx = lwa + 16 * 80 * 96;
    const float* lct = (const float*)(ws + WS_LCT);
    const unsigned epoch = (unsigned)l + 1u;
    unsigned* flags = ctl + CW_LRUF + b * 32 * 16;
    unsigned long long* agg64 = (unsigned long long*)agg;
#pragma unroll 1
    for (int bi = 0; bi < 2; ++bi) {
        const int blk = 2 * F.wave + bi;
        {
            u32x4 xch[11]; int ln = lane; asm volatile("" : "+v"(ln));
            const bf16_t* xbase = xcb + (r0 - 3) * 1280 + blk * 80;
#pragma unroll
            for (int i = 0; i < 11; ++i) { const int idx = ln + 64 * i; const int row = idx / 10, ch = idx - row * 10; xch[i] = (u32x4){0u, 0u, 0u, 0u};
                if (idx < 670 && !(k == 0 && row < 3)) xch[i] = *(const u32x4*)(xbase + (unsigned)(row * 1280 + ch * 8)); }
#pragma unroll
            for (int i = 0; i < 11; ++i) { const int idx = ln + 64 * i; const int row = idx / 10, ch = idx - row * 10; if (idx < 670) *(LAS u32x4*)(xt + row * 208 + ch * 16) = xch[i]; }
            LAS u32x4* z = (LAS u32x4*)(xt + (lane + 3) * 208 + 160); z[0] = (u32x4){0u, 0u, 0u, 0u}; z[1] = (u32x4){0u, 0u, 0u, 0u};
        }
        LDS_WAIT(); asm volatile("" ::: "memory");
#pragma unroll
        for (int ct = 0; ct < 5; ++ct) { const int c = blk * 80 + 16 * ct + cl; const f32x4 cw = *(const f32x4*)(lct + c * 8); const float cb = lct[c * 8 + 4];
            float xv[4][7];
#pragma unroll
            for (int rt = 0; rt < 4; ++rt)
#pragma unroll
                for (int j = 0; j < 7; ++j) xv[rt][j] = bf1(*(const LAS bf16_t*)(xt + (16 * rt + 4 * kg + j) * 208 + (16 * ct + cl) * 2));
            asm volatile("" ::: "memory");
#pragma unroll
            for (int rt = 0; rt < 4; ++rt)
#pragma unroll
                for (int e = 0; e < 4; ++e) { const float v = cb + cw.x * xv[rt][e] + cw.y * xv[rt][e + 1] + cw.z * xv[rt][e + 2] + cw.w * xv[rt][e + 3];
                    *(LAS bf16_t*)(xt + (16 * rt + 4 * kg + e + 3) * 208 + (16 * ct + cl) * 2) = f2bf(v); }
            asm volatile("" ::: "memory"); }
        LDS_WAIT(); asm volatile("" ::: "memory");
        bf16x8 af[4][3];
#pragma unroll
        for (int rt = 0; rt < 4; ++rt)
#pragma unroll
            for (int ks = 0; ks < 3; ++ks) af[rt][ks] = *(const LAS bf16x8*)(xt + (16 * rt + cl + 3) * 208 + (32 * ks + 8 * kg) * 2);
        bf16x8 wA[3], wX[3];
#pragma unroll
        for (int ks = 0; ks < 3; ++ks) { const size_t wo = ((size_t)blk * 80 + cl) * 96 + 32 * ks + 8 * kg; wA[ks] = *(const bf16x8*)(lwa + wo); wX[ks] = *(const bf16x8*)(lwx + wo); }
        unsigned pk[5][4][2];
#pragma unroll
        for (int ct = 0; ct < 5; ++ct) { const int c = blk * 80 + 16 * ct + cl;
            const f32x4 c1 = *(const f32x4*)(lct + c * 8 + 4); const float ba_c = c1.y, bx_c = c1.z, sp8 = c1.w;
            f32x4 ra[4], rx[4];
#pragma unroll
            for (int rt = 0; rt < 4; ++rt) { ra[rt] = (f32x4){0.f, 0.f, 0.f, 0.f}; rx[rt] = (f32x4){0.f, 0.f, 0.f, 0.f}; }
#pragma unroll
            for (int ks = 0; ks < 3; ++ks)
#pragma unroll
                for (int rt = 0; rt < 4; ++rt) { ra[rt] = __builtin_amdgcn_mfma_f32_16x16x32_bf16(af[rt][ks], wA[ks], ra[rt], 0, 0, 0); rx[rt] = __builtin_amdgcn_mfma_f32_16x16x32_bf16(af[rt][ks], wX[ks], rx[rt], 0, 0, 0); }
            if (ct + 1 < 5) {
#pragma unroll
                for (int ks = 0; ks < 3; ++ks) { const size_t wo = ((size_t)blk * 80 + 16 * (ct + 1) + cl) * 96 + 32 * ks + 8 * kg; wA[ks] = *(const bf16x8*)(lwa + wo); wX[ks] = *(const bf16x8*)(lwx + wo); } }
            float av[4][4], bv[4][4], iA[4], iB[4];
#pragma unroll
            for (int rt = 0; rt < 4; ++rt) {
#pragma unroll
                for (int e = 0; e < 4; ++e) { const float r = __builtin_amdgcn_rcpf(1.f + fexp2(fmaf(ra[rt][e], -1.4426950408889634f, ba_c))), ig = __builtin_amdgcn_rcpf(1.f + fexp2(fmaf(rx[rt][e], -1.4426950408889634f, bx_c)));
                    const float aa = fexp2(sp8 * r); const float mult = __builtin_amdgcn_sqrtf(fmaxf(1.f - aa * aa, 0.f));
                    const float xcv = bf1(*(const LAS bf16_t*)(xt + (16 * rt + 4 * kg + e + 3) * 208 + (16 * ct + cl) * 2));
                    av[rt][e] = aa; bv[rt][e] = mult * ig * xcv; }
                float sA = av[rt][0], sB = bv[rt][0];
#pragma unroll
                for (int e = 1; e < 4; ++e) { sB = av[rt][e] * sB + bv[rt][e]; sA *= av[rt][e]; }
                iA[rt] = sA; iB[rt] = sB; }
            { float pA[4], pB[4];
#pragma unroll
              for (int rt = 0; rt < 4; ++rt) { pA[rt] = __shfl(iA[rt], lane - 16); pB[rt] = __shfl(iB[rt], lane - 16); }
#pragma unroll
              for (int rt = 0; rt < 4; ++rt) if (kg >= 1) { iB[rt] = iA[rt] * pB[rt] + iB[rt]; iA[rt] = iA[rt] * pA[rt]; }
#pragma unroll
              for (int rt = 0; rt < 4; ++rt) { pA[rt] = __shfl(iA[rt], lane - 32); pB[rt] = __shfl(iB[rt], lane - 32); }
#pragma unroll
              for (int rt = 0; rt < 4; ++rt) if (kg >= 2) { iB[rt] = iA[rt] * pB[rt] + iB[rt]; iA[rt] = iA[rt] * pA[rt]; } }
            float tA[4], tB[4], eA[4], eB[4];
#pragma unroll
            for (int rt = 0; rt < 4; ++rt) { tA[rt] = __shfl(iA[rt], 48 + cl); tB[rt] = __shfl(iB[rt], 48 + cl); eA[rt] = __shfl(iA[rt], lane - 16); eB[rt] = __shfl(iB[rt], lane - 16); }
            float hl = 0.f, pl = 1.f;
#pragma unroll
            for (int rt = 0; rt < 4; ++rt) { if (kg == 0) { eA[rt] = 1.f; eB[rt] = 0.f; }
                float h = eA[rt] * hl + eB[rt], pp = eA[rt] * pl, P[4];
#pragma unroll
                for (int e = 0; e < 4; ++e) { h = av[rt][e] * h + bv[rt][e]; pp *= av[rt][e]; P[e] = pp;
                    *(LAS bf16_t*)(xt + (16 * rt + 4 * kg + e + 3) * 208 + (16 * ct + cl) * 2) = f2bf(h); }
                pk[ct][rt][0] = pk_bf16(P[0], P[1]); pk[ct][rt][1] = pk_bf16(P[2], P[3]);
                hl = tA[rt] * hl + tB[rt]; pl *= tA[rt];
            }
            if (kg == 0) __hip_atomic_store(agg64 + ((size_t)b * 32 + k) * 1280 + c, ((unsigned long long)__float_as_uint(hl) << 32) | (unsigned long long)__float_as_uint(pl), __ATOMIC_RELAXED, __HIP_MEMORY_SCOPE_AGENT);
        }
        asm volatile("s_waitcnt vmcnt(0)" ::: "memory");
        if (lane == 0) __hip_atomic_store(flags + k * 16 + blk, epoch, __ATOMIC_RELAXED, __HIP_MEMORY_SCOPE_AGENT);
        if (k > 0) {
            for (unsigned spins = 0; spins < (1u << 20); ++spins) {
                const unsigned f = (lane < k) ? __hip_atomic_load(flags + lane * 16 + blk, __ATOMIC_RELAXED, __HIP_MEMORY_SCOPE_AGENT) : epoch;
                if (__all(f == epoch)) break;
                __builtin_amdgcn_s_sleep(2);
            }
            float fa[5], fb[5];
#pragma unroll
            for (int ct = 0; ct < 5; ++ct) { fa[ct] = 1.f; fb[ct] = 0.f; }
            const int j0 = (k * kg) >> 2, j1 = (k * (kg + 1)) >> 2;
            const unsigned long long* ag0 = agg64 + (size_t)b * 32 * 1280 + blk * 80 + cl;
            {
                unsigned long long w[8][5];
#pragma unroll
                for (int jj = 0; jj < 8; ++jj)
#pragma unroll
                    for (int ct = 0; ct < 5; ++ct) w[jj][ct] = (j0 + jj < j1) ? __hip_atomic_load(ag0 + (size_t)(j0 + jj) * 1280 + 16 * ct, __ATOMIC_RELAXED, __HIP_MEMORY_SCOPE_AGENT) : 0x000000003f800000ull;
#pragma unroll
                for (int jj = 0; jj < 8; ++jj)
#pragma unroll
                    for (int ct = 0; ct < 5; ++ct) { const float A = __uint_as_float((unsigned)w[jj][ct]), B = __uint_as_float((unsigned)(w[jj][ct] >> 32)); fb[ct] = A * fb[ct] + B; fa[ct] *= A; } }
#pragma unroll
            for (int ct = 0; ct < 5; ++ct) { float iA = fa[ct], iB = fb[ct];
                { const float pA = __shfl(iA, lane - 16), pB = __shfl(iB, lane - 16); if (kg >= 1) { iB = iA * pB + iB; iA = iA * pA; } }
                { const float pA = __shfl(iA, lane - 32), pB = __shfl(iB, lane - 32); if (kg >= 2) { iB = iA * pB + iB; iA = iA * pA; } }
                const float cin = __shfl(iB, 48 + cl);
#pragma unroll
                for (int rt = 0; rt < 4; ++rt) { const float P[4] = {bf_lo(pk[ct][rt][0]), bf_hi(pk[ct][rt][0]), bf_lo(pk[ct][rt][1]), bf_hi(pk[ct][rt][1])};
#pragma unroll
                    for (int e = 0; e < 4; ++e) { LAS bf16_t* hp = (LAS bf16_t*)(xt + (16 * rt + 4 * kg + e + 3) * 208 + (16 * ct + cl) * 2); *hp = f2bf(bf1(*hp) + P[e] * cin); } } }
        }
        LDS_WAIT(); asm volatile("" ::: "memory");
        {
            int ln = lane; asm volatile("" : "+v"(ln));
            bf16_t* ybase = y + r0 * YLD + 2048 + blk * 80; u32x4 zc[10];
#pragma unroll
            for (int i = 0; i < 10; ++i) { const int idx = ln + 64 * i; const int row = idx / 10, ch = idx - row * 10; zc[i] = *(const u32x4*)(ybase + (unsigned)(row * YLD + ch * 8)); }
#pragma unroll
            for (int i = 0; i < 10; ++i) { const int idx = ln + 64 * i; const int row = idx / 10, ch = idx - row * 10; const u32x4 hv = *(const LAS u32x4*)(xt + (row + 3) * 208 + ch * 16); u32x4 o;
                o.x = pk_bf16(bf_lo(hv.x) * bf_lo(zc[i].x), bf_hi(hv.x) * bf_hi(zc[i].x)); o.y = pk_bf16(bf_lo(hv.y) * bf_lo(zc[i].y), bf_hi(hv.y) * bf_hi(zc[i].y));
                o.z = pk_bf16(bf_lo(hv.z) * bf_lo(zc[i].z), bf_hi(hv.z) * bf_hi(zc[i].z)); o.w = pk_bf16(bf_lo(hv.w) * bf_lo(zc[i].w), bf_hi(hv.w) * bf_hi(zc[i].w));
                if (!nostore) st16_sel<WT_MIX>(wsb, ybase + (unsigned)(row * YLD + ch * 8), o); }
            LDS_WAIT(); asm volatile("" ::: "memory");
        }
    }
}
__device__ __forceinline__ void phaseB_lru(const Frame& F, const WsBuf& wsb, const unsigned char* ws, unsigned* ctl, const bool nostore, int l, const bf16_t* xc, bf16_t* y, float* agg) {
    for (int item = F.vcu; item < NBATCH * 32; item += F.G) lru_single(F, wsb, ws, ctl, nostore, l, item, xc, y, agg);
}

__device__ __forceinline__ void phaseB_extra(const Frame& F, const Args& a, const unsigned char* ws, int l, const bf16_t* misc, bf16_t* kr, const bf16_t* xc, float* agg, const float* cs, const float* sn) {
    for (int item = F.vcu; item < NBATCH * 32; item += F.G) lru_item<1>(F, a, ws, false, l, item, xc, nullptr, agg);
}

namespace att {
constexpr int SHM_V = 64 * 128 * 2, SHM_K = 64 * 192 * 2, OFF_K = 2 * SHM_V, OFF_WS = OFF_K + 2 * SHM_K, LDS_TOTAL = OFF_WS + 8 * 64 * 4;
constexpr float THR = 8.f;
constexpr float NEGBIG = -1e30f;
constexpr int KVBLK_ = 64;
#define ATT_SBAR() __builtin_amdgcn_sched_barrier(0)
__device__ __forceinline__ int crow(int r, int hi) { return (r & 3) + 8 * (r >> 2) + 4 * hi; }
__device__ __forceinline__ int koff(int row, int sub, int chunk) { return sub * 8192 + row * 128 + ((chunk ^ ((row >> 1) & 7)) << 4); }
__device__ __forceinline__ void partialSM(f32x16& p0, f32x16& p1, float& m_reg, float& alpha) {
    float pmax = p0[0];
#pragma unroll
    for (int r = 1; r < 16; ++r) pmax = fmaxf(pmax, p0[r]);
#pragma unroll
    for (int r = 0; r < 16; ++r) pmax = fmaxf(pmax, p1[r]);
    { auto rr = __builtin_amdgcn_permlane32_swap(__float_as_uint(pmax), __float_as_uint(pmax), false, false); pmax = fmaxf(__uint_as_float(rr[0]), __uint_as_float(rr[1])); }
    float mn;
    if (__builtin_expect(__all(pmax - m_reg <= THR), 1)) { mn = m_reg; alpha = 1.f; }
    else { mn = fmaxf(m_reg, pmax); alpha = __builtin_amdgcn_exp2f(m_reg - mn); m_reg = mn; }
#pragma unroll
    for (int r = 0; r < 16; ++r) p0[r] = __builtin_amdgcn_exp2f(p0[r] - mn);
#pragma unroll
    for (int r = 0; r < 16; ++r) p1[r] = p1[r] - mn;
}
__device__ __forceinline__ void finishSM(f32x16& p0, f32x16& p1, float alpha, float& l_reg, bf16x8& pa0, bf16x8& pa1, bf16x8& pa2, bf16x8& pa3) {
#pragma unroll
    for (int r = 0; r < 16; ++r) p1[r] = __builtin_amdgcn_exp2f(p1[r]);
    float ps = 0.f;
#pragma unroll
    for (int r = 0; r < 16; ++r) ps += p0[r];
#pragma unroll
    for (int r = 0; r < 16; ++r) ps += p1[r];
    { auto rr = __builtin_amdgcn_permlane32_swap(__float_as_uint(ps), __float_as_uint(ps), false, false); ps = __uint_as_float(rr[0]) + __uint_as_float(rr[1]); }
    l_reg = l_reg * alpha + ps;
#define ATT_PK4(P, BASE, OUT) do { unsigned a0 = pk_bf16(P[BASE + 0], P[BASE + 1]), a1 = pk_bf16(P[BASE + 2], P[BASE + 3]);   \
    unsigned b0 = pk_bf16(P[BASE + 4], P[BASE + 5]), b1 = pk_bf16(P[BASE + 6], P[BASE + 7]);                              \
    auto r0 = __builtin_amdgcn_permlane32_swap(a0, b0, false, false); auto r1 = __builtin_amdgcn_permlane32_swap(a1, b1, false, false); \
    u32x4 w = {r0[0], r1[0], r0[1], r1[1]}; OUT = __builtin_bit_cast(bf16x8, w); } while (0)
    ATT_PK4(p0, 0, pa0); ATT_PK4(p0, 8, pa1); ATT_PK4(p1, 0, pa2); ATT_PK4(p1, 8, pa3);
#undef ATT_PK4
}
__device__ __forceinline__ void qkt(f32x16& p0, f32x16& p1, const LAS unsigned char* Ks, const bf16x8* qr, int r32, int hi) {
    p0 = f32x16{}; p1 = f32x16{};
#pragma unroll
    for (int d0 = 0; d0 < 12; ++d0) { const int sub = d0 >> 2, chunk = (d0 & 3) * 2 + hi;
        const bf16x8 b0 = *(const LAS bf16x8*)(Ks + koff(r32, sub, chunk));
        const bf16x8 b1 = *(const LAS bf16x8*)(Ks + koff(32 + r32, sub, chunk));
        p0 = __builtin_amdgcn_mfma_f32_32x32x16_bf16(b0, qr[d0], p0, 0, 0, 0);
        p1 = __builtin_amdgcn_mfma_f32_32x32x16_bf16(b1, qr[d0], p1, 0, 0, 0);
        if ((d0 & 3) == 3) ATT_SBAR(); }
}
__device__ __forceinline__ int v_st(int k, int c) { const int kk = (k & ~0xC) | ((k & 4) << 1) | ((k & 8) >> 1); return ((kk >> 3) * 4 + (c >> 5)) * 512 + ((kk & 7) * 32 + (c & 31)) * 2; }
__device__ __forceinline__ int v_rd_base(int lane) { return ((lane & 3) << 3) | (((lane >> 2) & 3) << 6) | (((lane >> 4) & 1) << 5) | (((lane >> 5) & 1) << 8); }
constexpr int v_rd_off(int d0, int ks, int half) { return d0 * 512 + ks * 4096 + half * 2048; }
template <int OFF> __device__ __forceinline__ s16x4 tr_read(int vb) { s16x4 r; asm volatile("ds_read_b64_tr_b16 %0, %1 offset:%2" : "=&v"(r) : "v"(vb), "i"(OFF) : "memory"); return r; }
template <int D0> __device__ __forceinline__ void pv_one(f32x16& od, int vb, bf16x8 pa0, bf16x8 pa1, bf16x8 pa2, bf16x8 pa3) {
    const s16x4 l0 = tr_read<v_rd_off(D0, 0, 0)>(vb), h0 = tr_read<v_rd_off(D0, 0, 1)>(vb), l1 = tr_read<v_rd_off(D0, 1, 0)>(vb), h1 = tr_read<v_rd_off(D0, 1, 1)>(vb);
    const s16x4 l2 = tr_read<v_rd_off(D0, 2, 0)>(vb), h2 = tr_read<v_rd_off(D0, 2, 1)>(vb), l3 = tr_read<v_rd_off(D0, 3, 0)>(vb), h3 = tr_read<v_rd_off(D0, 3, 1)>(vb);
    asm volatile("s_waitcnt lgkmcnt(0)" ::: "memory"); ATT_SBAR();
#define ATT_PK(L, H) (bf16x8){L[0], L[1], L[2], L[3], H[0], H[1], H[2], H[3]}
    od = __builtin_amdgcn_mfma_f32_32x32x16_bf16(pa0, ATT_PK(l0, h0), od, 0, 0, 0);
    od = __builtin_amdgcn_mfma_f32_32x32x16_bf16(pa1, ATT_PK(l1, h1), od, 0, 0, 0);
    od = __builtin_amdgcn_mfma_f32_32x32x16_bf16(pa2, ATT_PK(l2, h2), od, 0, 0, 0);
    od = __builtin_amdgcn_mfma_f32_32x32x16_bf16(pa3, ATT_PK(l3, h3), od, 0, 0, 0);
#undef ATT_PK
}
__device__ __forceinline__ void pv_d0(f32x16* o, int vb, bf16x8 pa0, bf16x8 pa1, bf16x8 pa2, bf16x8 pa3) {
    pv_one<0>(o[0], vb, pa0, pa1, pa2, pa3); pv_one<1>(o[1], vb, pa0, pa1, pa2, pa3); pv_one<2>(o[2], vb, pa0, pa1, pa2, pa3); pv_one<3>(o[3], vb, pa0, pa1, pa2, pa3);
}

__device__ __forceinline__ void unit(const Frame& F, const WsBuf& wsb, const bool nostore, int b, int hd, int qb, const bf16_t* __restrict__ Q, bf16_t* Y, const bf16_t* __restrict__ VV, const bf16_t* __restrict__ KR) {
    int tid_ = F.wave * 64 + lane_id(); asm volatile("" : "+v"(tid_));
    const int tid = tid_, wid = F.wave, lane = tid & 63, r32 = lane & 31, hi = lane >> 5;
    LAS unsigned char* lds = F.lds;
    LAS unsigned char* V_lds = lds; LAS unsigned char* K_lds = lds + OFF_K;
    LAS float* wsf = (LAS float*)(lds + OFF_WS) + wid * 64; LAS float* li_l = wsf; LAS float* al_l = wsf + 32;
    const size_t rowbase = (size_t)b * SEQ; const int q0 = qb * 256; const int qc = 4 * qb + (wid >> 1); const int NT = 4 * qb + 4;
    float m_reg = NEGBIG, l_reg = 0.f; f32x16 o[4] = {}; bf16x8 qr[12];
    { const bf16_t* Qw = Q + (rowbase + q0 + wid * 32 + r32) * 1536 + hd * 192 + hi * 8;
#pragma unroll
      for (int d0 = 0; d0 < 12; ++d0) qr[d0] = *(const bf16x8*)(Qw + d0 * 16); }
    const bf16_t* Kn = Y + rowbase * YLD + hd * 128; const bf16_t* Vh = VV + rowbase * 1024 + hd * 128; const bf16_t* Kr = KR + rowbase * 64;
    const int sr = tid >> 4, sc = (tid & 15) * 8; const int vst0 = v_st(sr, sc), vst1 = v_st(32 + sr, sc);
    const int kst0 = koff(sr, sc >> 6, (sc & 63) >> 3), kst1 = koff(32 + sr, sc >> 6, (sc & 63) >> 3), kst2 = koff(tid >> 3, 2, tid & 7);
    const int vb0 = (int)(uintptr_t)V_lds + v_rd_base(lane);
    bf16x8 vs0, vs1, ks0, ks1, ks2;
#define ATT_SLOAD(k0) do { vs0 = *(const bf16x8*)(Vh + (size_t)((k0) + sr) * 1024 + sc); vs1 = *(const bf16x8*)(Vh + (size_t)((k0) + 32 + sr) * 1024 + sc); \
    ks0 = *(const bf16x8*)(Kn + (size_t)((k0) + sr) * YLD + sc); ks1 = *(const bf16x8*)(Kn + (size_t)((k0) + 32 + sr) * YLD + sc); \
    ks2 = *(const bf16x8*)(Kr + (size_t)((k0) + (tid >> 3)) * 64 + (tid & 7) * 8); } while (0)
#define ATT_SWRITE(bf) do { *(LAS bf16x8*)(V_lds + (bf) * SHM_V + vst0) = vs0; *(LAS bf16x8*)(V_lds + (bf) * SHM_V + vst1) = vs1; \
    *(LAS bf16x8*)(K_lds + (bf) * SHM_K + kst0) = ks0; *(LAS bf16x8*)(K_lds + (bf) * SHM_K + kst1) = ks1; *(LAS bf16x8*)(K_lds + (bf) * SHM_K + kst2) = ks2; } while (0)
#define ATT_RESC(al) do { if (__any((al) < 1.f)) { if (hi == 0) al_l[r32] = (al); asm volatile("s_waitcnt lgkmcnt(0)" ::: "memory"); \
    _Pragma("unroll") for (int d = 0; d < 4; ++d) _Pragma("unroll") for (int r = 0; r < 16; ++r) o[d][r] *= al_l[crow(r, hi)]; } } while (0)
#define ATT_QKT(P0, P1, bf, jt) do { if ((jt) <= qc) qkt(P0, P1, K_lds + (bf) * SHM_K, qr, r32, hi); else { _Pragma("unroll") for (int r = 0; r < 16; ++r) { P0[r] = NEGBIG; P1[r] = NEGBIG; } } } while (0)
    f32x16 pA0, pA1, pB0, pB1; float alA, alB; bf16x8 pa0, pa1, pa2, pa3;
    ATT_SLOAD(0); asm volatile("s_waitcnt vmcnt(0)" ::: "memory"); ATT_SWRITE(0); __syncthreads();
    ATT_SLOAD(KVBLK_); ATT_SBAR();
    ATT_QKT(pA0, pA1, 0, 0); partialSM(pA0, pA1, m_reg, alA);
    asm volatile("s_waitcnt vmcnt(0)" ::: "memory"); ATT_SWRITE(1); __syncthreads();
    for (int j = 1; j + 1 < NT; j += 2) {
        ATT_SBAR(); ATT_SLOAD((j + 1) * KVBLK_); ATT_SBAR();
        ATT_QKT(pB0, pB1, 1, j);
        finishSM(pA0, pA1, alA, l_reg, pa0, pa1, pa2, pa3); ATT_SBAR();
        if (j - 1 <= qc) pv_d0(o, vb0, pa0, pa1, pa2, pa3);
        partialSM(pB0, pB1, m_reg, alB);
        __syncthreads(); asm volatile("s_waitcnt vmcnt(0)" ::: "memory"); ATT_SWRITE(0);
        ATT_RESC(alB); __syncthreads();
        ATT_SBAR(); ATT_SLOAD((j + 2) * KVBLK_); ATT_SBAR();
        ATT_QKT(pA0, pA1, 0, j + 1);
        finishSM(pB0, pB1, alB, l_reg, pa0, pa1, pa2, pa3); ATT_SBAR();
        if (j <= qc) pv_d0(o, vb0 + SHM_V, pa0, pa1, pa2, pa3);
        partialSM(pA0, pA1, m_reg, alA);
        __syncthreads(); asm volatile("s_waitcnt vmcnt(0)" ::: "memory"); ATT_SWRITE(1);
        ATT_RESC(alA); __syncthreads();
    }
    ATT_SBAR(); ATT_QKT(pB0, pB1, 1, NT - 1);
    finishSM(pA0, pA1, alA, l_reg, pa0, pa1, pa2, pa3); ATT_SBAR();
    if (NT - 2 <= qc) pv_d0(o, vb0, pa0, pa1, pa2, pa3);
    partialSM(pB0, pB1, m_reg, alB);
    __syncthreads(); ATT_RESC(alB);
    finishSM(pB0, pB1, alB, l_reg, pa0, pa1, pa2, pa3); ATT_SBAR();
    if (NT - 1 <= qc) pv_d0(o, vb0 + SHM_V, pa0, pa1, pa2, pa3);
    if (hi == 0) li_l[r32] = l_reg; asm volatile("s_waitcnt lgkmcnt(0)" ::: "memory");
    float rli[16];
#pragma unroll
    for (int r = 0; r < 16; ++r) rli[r] = __builtin_amdgcn_rcpf(li_l[crow(r, hi)]);
    __syncthreads();
    int hi2 = hi, r32b = r32, ln = lane; asm volatile("" : "+v"(hi2), "+v"(r32b), "+v"(ln));
    LAS unsigned char* stg = lds + wid * 8704;
#pragma unroll
    for (int r = 0; r < 16; ++r) { const int orow = (r & 3) + 8 * (r >> 2) + 4 * hi2;
#pragma unroll
        for (int d0 = 0; d0 < 4; ++d0) *(LAS bf16_t*)(stg + orow * 272 + (d0 * 32 + r32b) * 2) = f2bf(o[d0][r] * rli[r]); }
    asm volatile("s_waitcnt lgkmcnt(0)" ::: "memory");
    bf16_t* Ow = Y + (rowbase + q0 + wid * 32) * YLD + 1024 + hd * 128;
    u32x4 zb[8];
#pragma unroll
    for (int i = 0; i < 8; ++i) { const int row = i * 4 + (ln >> 4), ch = ln & 15; zb[i] = *(const u32x4*)(Ow + (unsigned)(row * YLD + ch * 8)); }
#pragma unroll
    for (int i = 0; i < 8; ++i) { const int row = i * 4 + (ln >> 4), ch = ln & 15; const u32x4 ov = *(const LAS u32x4*)(stg + row * 272 + ch * 16); u32x4 w;
        w.x = pk_bf16(bf_lo(ov.x) * bf_lo(zb[i].x), bf_hi(ov.x) * bf_hi(zb[i].x)); w.y = pk_bf16(bf_lo(ov.y) * bf_lo(zb[i].y), bf_hi(ov.y) * bf_hi(zb[i].y));
        w.z = pk_bf16(bf_lo(ov.z) * bf_lo(zb[i].z), bf_hi(ov.z) * bf_hi(zb[i].z)); w.w = pk_bf16(bf_lo(ov.w) * bf_lo(zb[i].w), bf_hi(ov.w) * bf_hi(zb[i].w));
        if (!nostore) st16_sel<WT_MIX>(wsb, Ow + (unsigned)(row * YLD + ch * 8), w); }
    asm volatile("s_waitcnt lgkmcnt(0)" ::: "memory");
    __syncthreads();
#undef ATT_SLOAD
#undef ATT_SWRITE
#undef ATT_RESC
#undef ATT_QKT
}
}

__device__ __forceinline__ void phaseC_att(const Frame& F, const WsBuf& wsb, const bool nostore, const bf16_t* q, bf16_t* y, const bf16_t* vv, const bf16_t* kr) {
    for (int v = F.vcu; v < 256; v += F.G) { const int bh = v >> 2, s = v & 3;
        att::unit(F, wsb, nostore, bh >> 3, bh & 7, 7 - s, q, y, vv, kr);
        att::unit(F, wsb, nostore, bh >> 3, bh & 7, s, q, y, vv, kr); }
}
__device__ __forceinline__ void phaseC_lru(const Frame& F, const Args& a, const unsigned char* ws, const bool nostore, int l, bf16_t* y, const bf16_t* xc, const float* agg) {
    for (int item = F.vcu; item < NBATCH * 32; item += F.G) lru_item<2>(F, a, ws, nostore, l, item, xc, y, const_cast<float*>(agg));
}

__device__ __forceinline__ void gmlp_item(const Frame& F, const WsBuf& wsb, const Args& a, const unsigned char* ws, const bool nostore, int l, int item, const bf16_t* v1, bf16_t* y, const float* vslab) {
    const int nb = item >> 2, g = item & 3; const size_t t0 = (size_t)nb * 128;
    int lane_ = lane_id(); asm volatile("" : "+v"(lane_));
    const int lane = lane_, w = F.wave, cl = lane & 15, kg = lane >> 4;
    LAS f32x2v* stat = (LAS f32x2v*)F.lds; LAS unsigned char* vnT = F.lds + 1024;
    { float pv[16];
#pragma unroll
      for (int i = 0; i < 16; ++i) pv[i] = vslab[(t0 + 16 * w + i) * 64 + lane];
#pragma unroll
      for (int i = 0; i < 16; ++i) { float v = pv[i]; v += sx<2>(v); v += sx<4>(v); v += sx<8>(v); v += sx<16>(v); v = xsum32(v);
          const float o = sx<1>(v);
          const float mu = v * (1.f / 1024.f); const float var = fmaxf(o * (1.f / 1024.f) - mu * mu, 0.f);
          if (lane == 0) stat[16 * w + i] = (f32x2v){mu, rsqrtf(var + EPS)}; } }
    LDS_WAIT(); __syncthreads();
    { const f32x2v st0 = stat[2 * lane], st1 = stat[2 * lane + 1];
      const float* lg = a.in[I_GM_LN_G] + l * 1024 + g * 256; const float* lb = a.in[I_GM_LN_B] + l * 1024 + g * 256;
      u32x4 xa[4], xb[4];
#pragma unroll
      for (int i = 0; i < 4; ++i) { const int c8 = 4 * w + i; xa[i] = *(const u32x4*)(v1 + (t0 + 2 * lane) * 1024 + g * 256 + c8 * 8); xb[i] = *(const u32x4*)(v1 + (t0 + 2 * lane + 1) * 1024 + g * 256 + c8 * 8); }
#pragma unroll
      for (int i = 0; i < 4; ++i) { const int c8 = 4 * w + i;
          const f32x4 g0 = *(const f32x4*)(lg + c8 * 8), g1 = *(const f32x4*)(lg + c8 * 8 + 4), b0 = *(const f32x4*)(lb + c8 * 8), b1 = *(const f32x4*)(lb + c8 * 8 + 4);
          const float ga[8] = {g0.x, g0.y, g0.z, g0.w, g1.x, g1.y, g1.z, g1.w}, be[8] = {b0.x, b0.y, b0.z, b0.w, b1.x, b1.y, b1.z, b1.w};
          const unsigned wa[4] = {xa[i].x, xa[i].y, xa[i].z, xa[i].w}, wb[4] = {xb[i].x, xb[i].y, xb[i].z, xb[i].w};
#pragma unroll
          for (int e = 0; e < 8; ++e) {
              const float fa = (e & 1) ? bf_hi(wa[e >> 1]) : bf_lo(wa[e >> 1]), fb = (e & 1) ? bf_hi(wb[e >> 1]) : bf_lo(wb[e >> 1]);
              const float na = (fa - st0.x) * st0.y * ga[e] + be[e], nbv = (fb - st1.x) * st1.y * ga[e] + be[e];
              *(LAS unsigned*)(vnT + (c8 * 8 + e) * 272 + lane * 4) = pk_bf16(na, nbv); } } }
    const bf16_t* gmw = (const bf16_t*)(ws + WS_GMW) + (size_t)g * 128 * 128;
    const float* bs = a.in[I_GM_BS] + l * 512 + g * 128;
    bf16_t* ybase = y + t0 * YLD + g * 256;
    const int tid = w * 64 + lane;
    u32x4 pa[8];
#pragma unroll
    for (int i = 0; i < 8; ++i) { const int idx = tid + 512 * i; pa[i] = *(const u32x4*)(ybase + (unsigned)((idx >> 5) * YLD + (idx & 31) * 8)); }
    float bsv[8];
#pragma unroll
    for (int ct = 0; ct < 8; ++ct) bsv[ct] = bs[16 * ct + cl];
    bf16x8 wf[2][4];
#pragma unroll
    for (int ks = 0; ks < 2; ++ks) wf[0][ks] = *(const bf16x8*)(gmw + (size_t)cl * 128 + 32 * ks + 8 * kg);
    LDS_WAIT(); __syncthreads();
    bf16x8 af[2][4];
#pragma unroll
    for (int r = 0; r < 2; ++r)
#pragma unroll
        for (int ks = 0; ks < 4; ++ks) af[r][ks] = *(const LAS bf16x8*)(vnT + (16 * (2 * w + r) + cl) * 272 + (32 * ks + 8 * kg) * 2);
    LDS_WAIT(); __syncthreads();
    LAS unsigned char* stg = vnT;
#pragma unroll
    for (int ct = 0; ct < 8; ++ct) { const int cur = ct & 1;
        if (ct + 1 < 8) {
#pragma unroll
            for (int ks = 0; ks < 4; ++ks) if (ks < ((ct + 1 < 4) ? 2 : 4)) wf[cur ^ 1][ks] = *(const bf16x8*)(gmw + (size_t)(16 * (ct + 1) + cl) * 128 + 32 * ks + 8 * kg); }
        f32x4 acc[2] = {(f32x4){0.f, 0.f, 0.f, 0.f}, (f32x4){0.f, 0.f, 0.f, 0.f}};
#pragma unroll
        for (int ks = 0; ks < 4; ++ks) if (ks < ((ct < 4) ? 2 : 4)) {
            acc[0] = __builtin_amdgcn_mfma_f32_16x16x32_bf16(af[0][ks], wf[cur][ks], acc[0], 0, 0, 0); acc[1] = __builtin_amdgcn_mfma_f32_16x16x32_bf16(af[1][ks], wf[cur][ks], acc[1], 0, 0, 0); }
#pragma unroll
        for (int r = 0; r < 2; ++r) { u32x2 o; o.x = pk_bf16(acc[r][0] + bsv[ct], acc[r][1] + bsv[ct]); o.y = pk_bf16(acc[r][2] + bsv[ct], acc[r][3] + bsv[ct]);
            *(LAS u32x2*)(stg + (16 * ct + cl) * 528 + (16 * (2 * w + r) + 4 * kg) * 2) = o; }
    }
    LDS_WAIT(); __syncthreads();
#pragma unroll
    for (int i = 0; i < 8; ++i) { const int idx = tid + 512 * i; const u32x4 sv = *(const LAS u32x4*)(stg + (idx >> 5) * 528 + (idx & 31) * 16); u32x4 o;
        o.x = pk_bf16(bf_lo(pa[i].x) * bf_lo(sv.x), bf_hi(pa[i].x) * bf_hi(sv.x)); o.y = pk_bf16(bf_lo(pa[i].y) * bf_lo(sv.y), bf_hi(pa[i].y) * bf_hi(sv.y));
        o.z = pk_bf16(bf_lo(pa[i].z) * bf_lo(sv.z), bf_hi(pa[i].z) * bf_hi(sv.z)); o.w = pk_bf16(bf_lo(pa[i].w) * bf_lo(sv.w), bf_hi(pa[i].w) * bf_hi(sv.w));
        if (!nostore) st16_sel<WT_MIX>(wsb, ybase + (unsigned)((idx >> 5) * YLD + (idx & 31) * 8), o); }
    LDS_WAIT(); __syncthreads();
}
__device__ __forceinline__ void phaseE(const Frame& F, const WsBuf& wsb, const Args& a, const unsigned char* ws, const bool nostore, int l, const bf16_t* v1, bf16_t* y, const float* vslab) {
    for (int item = F.vcu; item < 512; item += F.G) gmlp_item(F, wsb, a, ws, nostore, l, item, v1, y, vslab);
}
constexpr int N_PHASES = 1 + 8 * DEPTH;
#ifndef MK_PER_PHASE
#define MK_PER_PHASE 0
#endif
#ifndef MK_MAX_PHASE
#define MK_MAX_PHASE N_PHASES
#endif

__global__ void __launch_bounds__(NWAVES * 64, 2) mk_fwd(Args args) {
    extern __shared__ __attribute__((aligned(16))) unsigned char lds_raw[];
    Frame F;
    F.lds = (LAS unsigned char*)lds_raw;
    F.wave = __builtin_amdgcn_readfirstlane((int)threadIdx.x >> 6);
    F.G = gridDim.x; { const int bx = blockIdx.x; F.vcu = (F.G % 8 == 0) ? (bx % 8) * (F.G / 8) + bx / 8 : bx; }
    volatile LAS unsigned* MISCW = (volatile LAS unsigned*)(F.lds + MISC_OFF);
    for (int u = threadIdx.x; u < (LDS_BYTES - RING_BYTES) / 4; u += NWAVES * 64) ((LAS unsigned*)(F.lds + RING_BYTES))[u] = 0u;
    __syncthreads();
    unsigned* ctl = (unsigned*)(args.ws + WS_CTL);
#if MK_PER_PHASE
    const int lo = args.ph_lo, hi = args.ph_hi;
    const bool multi = (hi - lo) > 1;
#else
    constexpr int lo = 0, hi = N_PHASES;
    constexpr bool multi = true;
#endif
    XcdBarrier bar; bar.bar = ctl + CW_BAR; bar.x = 0; bar.st = nullptr;
    if (multi) bar = xcd_barrier_post(ctl + CW_BAR, MISCW + 8);
#define IN(k) (lo <= (k) && (k) < hi)
#ifndef MK_TSP
#define MK_TSP 0
#endif
#ifndef MK_TSM
#define MK_TSM 1
#endif
#define TS_BEGIN(k) do { if (MK_TSP == (k) + 1 && threadIdx.x == 0) MISCW[16] = (unsigned)__builtin_amdgcn_s_memrealtime(); } while (0)
#define TS_END(k) do { if (MK_TSP == (k) + 1 && threadIdx.x == 0) MISCW[17] = (unsigned)__builtin_amdgcn_s_memrealtime(); } while (0)
#define SEAM(k) do { if (IN((k) + 1)) xcd_barrier(bar); } while (0)
#define xcd_barrier_if(c, b) do { if (c) xcd_barrier(b); } while (0)

typedef const __attribute__((address_space(4))) Args* KArgP;
#if defined(__HIP_DEVICE_COMPILE__)
#define AS_GLOBAL(p) __builtin_assume(!__builtin_amdgcn_is_shared((const __attribute__((address_space(0))) void*)(p)) && !__builtin_amdgcn_is_private((const __attribute__((address_space(0))) void*)(p)))
#else
#define AS_GLOBAL(p) ((void)0)
#endif
#define PHASE_PTRS \
    KArgP kp = (KArgP)__builtin_amdgcn_kernarg_segment_ptr(); asm volatile("" : "+s"(kp)); Args la; \
    _Pragma("unroll") for (int i_ = 0; i_ < N_INPUTS; ++i_) { la.in[i_] = kp->in[i_]; AS_GLOBAL(la.in[i_]); } la.out = kp->out; AS_GLOBAL(la.out); la.ph_lo = 0; la.ph_hi = 0; \
    unsigned char* ws = kp->ws; AS_GLOBAL(ws); la.ws = ws; Frame Fp = F; int bid = (int)blockIdx.x; asm volatile("" : "+s"(Fp.wave), "+s"(Fp.vcu), "+s"(Fp.G), "+s"(bid)); (void)bid; \
    bf16_t* Hb = (bf16_t*)(ws + WS_H); bf16_t* Yb = (bf16_t*)(ws + WS_Y); \
    bf16_t* MISCb = (bf16_t*)(ws + WS_MISC); bf16_t* XCb = (bf16_t*)(ws + WS_XC); bf16_t* Qb = (bf16_t*)(ws + WS_Q); bf16_t* VVb = (bf16_t*)(ws + WS_VV); bf16_t* KRb = (bf16_t*)(ws + WS_KR); \
    bf16_t* V1b = (bf16_t*)(ws + WS_V1); bf16_t* Gb = (bf16_t*)(ws + WS_G); bf16_t* Ob = (bf16_t*)(ws + WS_O); \
    float* SLAB = (float*)(ws + WS_SLAB); float* AGG = (float*)(ws + WS_AGG); const float* CS = (const float*)(ws + WS_ROPE); const float* SN = CS + 2048 * 32; \
    const unsigned char* wb = ws + WS_WB; (void)Hb; (void)Yb; (void)MISCb; (void)XCb; (void)Qb; (void)VVb; (void)KRb; (void)V1b; (void)Gb; (void)Ob; (void)SLAB; (void)AGG; (void)CS; (void)SN; (void)wb;
    TS_BEGIN(0);
    if (IN(0)) {
        { PHASE_PTRS
        convert_weights(Fp, la, ws, 0);
        rope_table(Fp, ws);
        norm_rows(Fp, false, la.in[I_X], nullptr, nullptr, nullptr, la.in[I_PRE_G], Hb, (float*)(ws + WS_RINV) + T);
        }
        SEAM(0);
    }
    TS_END(0);
#pragma nounroll
    for (int l = 0; l < DEPTH; ++l) {
        const int pb = 1 + 8 * l;
        TS_BEGIN(pb + 0);
        if (IN(pb + 0)) {
            { const bool nostore = false; (void)nostore;
            PHASE_PTRS
            SchedA S; S.ord.init(64, 16, Fp.G, bid); S.A = (const char*)Hb; S.B = (const char*)(wb + WB_W1T);
            EpiA E{MISCb, XCb, Yb, SLAB, KRb, CS, SN, make_wsbuf(ws)};
            g8::gemm_stream(Fp.lds, Fp.wave * 64 + lane_id(), 2048u, 2048u, S, E);
            }
            SEAM(pb + 0);
        }
        TS_END(pb + 0);
        TS_BEGIN(pb + 1);
        if (IN(pb + 1)) {
            { const bool nostore = false; (void)nostore;
            PHASE_PTRS
            const int gemm_first = (Fp.vcu >> 5) & 1;
#pragma unroll 1
            for (int step = 0; step < 2; ++step) {
                int which = step ^ gemm_first; asm volatile("" : "+s"(which));
                if (which == 0) phaseB_lru(Fp, make_wsbuf(ws), ws, (unsigned*)(ws + WS_CTL), nostore, l, XCb, Yb, AGG);
                else {
                    { SchedZ SZ; SZ.v = Fp.vcu; SZ.A = (const char*)Hb; SZ.B = (const char*)(wb + WB_W1T); EpiA EZ{MISCb, XCb, Yb, SLAB, KRb, CS, SN, make_wsbuf(ws)};
                      g8::gemm_stream(Fp.lds, Fp.wave * 64 + lane_id(), 2048u, 2048u, SZ, EZ); }
                    SchedQKV S; S.v = Fp.vcu; S.misc = (const char*)MISCb; S.wq = (const char*)(wb + WB_WQT); S.wkv = (const char*)(wb + WB_WKVT);
                    qkv_row_scales(Fp.lds, SLAB, Fp.vcu >> 2, Fp.wave * 64 + lane_id());
                    EpiQKV E{Qb, Yb, VVb, CS, SN, make_wsbuf(ws), Fp.lds};
                    g8::gemm_stream(Fp.lds, Fp.wave * 64 + lane_id(), 1536u, 768u, S, E);
                }
                __syncthreads();
            }
            }
            SEAM(pb + 1);
        }
        TS_END(pb + 1);
        TS_BEGIN(pb + 2);
        if (IN(pb + 2)) {
            { const bool nostore = false; (void)nostore;
            PHASE_PTRS
            phaseC_att(Fp, make_wsbuf(ws), nostore, Qb, Yb, VVb, KRb);
            }
            SEAM(pb + 2);
        }
        TS_END(pb + 2);
        TS_BEGIN(pb + 3);
        if (IN(pb + 3)) {
            { const bool nostore = false; (void)nostore;
            PHASE_PTRS
            SchedD S; S.ord.init(64, 24, Fp.G, bid); S.A = (const char*)Hb; S.B = (const char*)(wb + WB_W2T);
            EpiD E{Yb, V1b, Gb, SLAB, make_wsbuf(ws)};
            g8::gemm_stream(Fp.lds, Fp.wave * 64 + lane_id(), 2048u, 2048u, S, E);
            }
            SEAM(pb + 3);
        }
        TS_END(pb + 3);
        TS_BEGIN(pb + 4);
        if (IN(pb + 4)) {
            { const bool nostore = false; (void)nostore;
            PHASE_PTRS
            phaseE(Fp, make_wsbuf(ws), la, ws, nostore, l, V1b, Yb, SLAB);
            }
            SEAM(pb + 4);
        }
        TS_END(pb + 4);
        TS_BEGIN(pb + 5);
        if (IN(pb + 5)) {
            { const bool nostore = false; (void)nostore;
            PHASE_PTRS
            SchedF S; S.ord.init(64, 4, Fp.G, bid); S.A = (const char*)Yb; S.B = (const char*)(wb + WB_WPT);
            EpiF E{Gb, V1b, make_wsbuf(ws)};
            g8::gemm_stream(Fp.lds, Fp.wave * 64 + lane_id(), (unsigned)(YLD * 2), (unsigned)(YLD * 2), S, E);
            }
            SEAM(pb + 5);
        }
        TS_END(pb + 5);
        TS_BEGIN(pb + 6);
        if (IN(pb + 6)) {
            { const bool nostore = false; (void)nostore;
            PHASE_PTRS
            SchedG1 S; S.v = Fp.vcu; S.A = (const char*)V1b; S.B = (const char*)(wb + WB_WOT);
            float* RINV = (float*)(ws + WS_RINV); float* rin = RINV + (size_t)((l + 1) & 1) * T; float* rout = RINV + (size_t)(l & 1) * T;
            unsigned* ncnt = (unsigned*)(ws + WS_CTL) + CW_NORM + l * 2048;
            static_assert(DEPTH == 2, "phase G is instantiated for (first, has next) and (later, last)");
            if (l == 0) { EpiNorm<false, true> E{nullptr, la.out, Hb, la.in[I_POST_G] + l * DM, rin, rout, make_wsbuf(ws), make_wsbuf((unsigned char*)la.out), SLAB, ncnt};
                g8::gemm_stream<true>(Fp.lds, Fp.wave * 64 + lane_id(), 2048u, 2048u, S, E); }
            else { EpiNorm<false, false> E{nullptr, la.out, Hb, la.in[I_POST_G] + l * DM, rin, rout, make_wsbuf(ws), make_wsbuf((unsigned char*)la.out), SLAB, ncnt};
                g8::gemm_stream<true>(Fp.lds, Fp.wave * 64 + lane_id(), 2048u, 2048u, S, E); }
            }
            if (l + 1 < DEPTH) SEAM(pb + 6);
        }
        TS_END(pb + 6);
        TS_BEGIN(pb + 7);
        if (IN(pb + 7) && l + 1 < DEPTH) {
            { const bool nostore = false; (void)nostore;
            PHASE_PTRS
            if (l + 1 < DEPTH) convert_weights(Fp, la, ws, l + 1);
            }
            SEAM(pb + 7);
        }
        TS_END(pb + 7);
    }
    if (MK_TSP && blockIdx.x == 0 && threadIdx.x == 0) { const unsigned long long d = (unsigned long long)MK_TSM * (unsigned long long)(MISCW[17] - MISCW[16]), t = __builtin_amdgcn_s_memrealtime(); while (__builtin_amdgcn_s_memrealtime() - t < d) __builtin_amdgcn_s_sleep(8); }
#undef IN
#undef SEAM
}

#ifndef MK_PROBE
#define MK_PROBE 0
#endif
static int mk_setup(size_t ws_size) {
    static int grid = 0;
    if (grid == 0) {
        if (ws_size < WS_END) { fprintf(stderr, "kernel_launch: workspace too small: %zu < %zu\n", ws_size, (size_t)WS_END); grid = -1; return grid; }
        int dev = 0, cus = 0, per_cu = 0;
        if (hipGetDevice(&dev) != hipSuccess || hipDeviceGetAttribute(&cus, hipDeviceAttributeMultiprocessorCount, dev) != hipSuccess) { grid = -1; return grid; }
        if (hipFuncSetAttribute((const void*)mk_fwd, hipFuncAttributeMaxDynamicSharedMemorySize, LDS_BYTES) != hipSuccess) { fprintf(stderr, "kernel_launch: hipFuncSetAttribute failed\n"); grid = -1; return grid; }
        if (hipOccupancyMaxActiveBlocksPerMultiprocessor(&per_cu, (const void*)mk_fwd, NWAVES * 64, LDS_BYTES) != hipSuccess || per_cu < 1)
            fprintf(stderr, "kernel_launch: occupancy query reports %d blocks/CU\n", per_cu);
        (void)hipGetLastError();
        grid = cus;
        if (grid != 256) fprintf(stderr, "kernel_launch: note: %d CUs (tile schedules assume 256)\n", grid);
    }
    return grid;
}
static void mk_launch(void* const* d_in, void* d_out, void* d_ws, hipStream_t stream, int grid, int lo, int hi) {
    Args a{};
    for (int i = 0; i < N_INPUTS; ++i) a.in[i] = (const float*)d_in[i];
    a.out = (float*)d_out; a.ws = (unsigned char*)d_ws; a.ph_lo = lo; a.ph_hi = hi; a.probe = MK_PROBE; a.pad = 0;
    hipLaunchKernelGGL(mk_fwd, dim3(grid), dim3(NWAVES * 64), LDS_BYTES, stream, a);
}
extern "C" void kernel_launch(void* const* d_in, const int* in_sizes, int n_in, void* d_out, int out_size, void* d_ws, size_t ws_size, hipStream_t stream) {
    const int grid = mk_setup(ws_size); if (grid < 0) return;
    hipMemsetAsync((char*)d_ws + WS_CTL, 0, CTL_ZERO_BYTES, stream);
#if MK_PER_PHASE
    for (int ph = 0; ph < N_PHASES; ++ph) mk_launch(d_in, d_out, d_ws, stream, grid, ph, ph + 1);
#else
    mk_launch(d_in, d_out, d_ws, stream, grid, 0, N_PHASES);
#endif
}
```

```cpp
#define MK_PROBE 0
#include <hip/hip_runtime.h>
#include <cstdio>
#include <cstdint>

#define LAS __attribute__((address_space(3)))
#define GAS __attribute__((address_space(1)))
typedef unsigned short bf16_t;
typedef short bf16x8 __attribute__((ext_vector_type(8)));
typedef short s16x4 __attribute__((ext_vector_type(4)));
typedef float f32x2 __attribute__((ext_vector_type(2)));
typedef float f32x4 __attribute__((ext_vector_type(4)));
typedef float f32x16 __attribute__((ext_vector_type(16)));
typedef unsigned u32x2 __attribute__((ext_vector_type(2)));
typedef unsigned u32x4 __attribute__((ext_vector_type(4)));
typedef __bf16 bf16x2_t __attribute__((ext_vector_type(2)));

__device__ __forceinline__ unsigned pk_bf16(float lo, float hi) { f32x2 v = {lo, hi}; bf16x2_t b = __builtin_convertvector(v, bf16x2_t); return __builtin_bit_cast(unsigned, b); }
__device__ __forceinline__ float bf_lo(unsigned w) { return __uint_as_float(w << 16); }
__device__ __forceinline__ float bf_hi(unsigned w) { return __uint_as_float(w & 0xffff0000u); }
__device__ __forceinline__ float bf1(bf16_t h) { return __uint_as_float(((unsigned)h) << 16); }
__device__ __forceinline__ bf16_t f2bf(float f) { return (bf16_t)(pk_bf16(f, 0.f) & 0xffffu); }
__device__ __forceinline__ float fexp2(float x) { return __builtin_amdgcn_exp2f(x); }
__device__ __forceinline__ float fsigmoid(float x) { return __builtin_amdgcn_rcpf(1.f + fexp2(x * -1.4426950408889634f)); }
__device__ __forceinline__ float fsilu(float x) { return x * __builtin_amdgcn_rcpf(1.f + fexp2(x * -1.4426950408889634f)); }
template <int XM> __device__ __forceinline__ float sx(float v) { return __int_as_float(__builtin_amdgcn_ds_swizzle(__float_as_int(v), (XM << 10) | 0x1f)); }
__device__ __forceinline__ float xsum32(float v) { auto rr = __builtin_amdgcn_permlane32_swap(__float_as_uint(v), __float_as_uint(v), false, false); return __uint_as_float(rr[0]) + __uint_as_float(rr[1]); }
__device__ __forceinline__ float wave_sum(float v) { v += sx<1>(v); v += sx<2>(v); v += sx<4>(v); v += sx<8>(v); v += sx<16>(v); return xsum32(v); }
struct WsBuf { __amdgpu_buffer_rsrc_t r; const unsigned char* base; };
__device__ __forceinline__ WsBuf make_wsbuf(unsigned char* ws) { WsBuf b; b.r = __builtin_amdgcn_make_buffer_rsrc(ws, (short)0, 0x7fffffff, 0x00020000); b.base = ws; return b; }
__device__ __forceinline__ void st16_wt(const WsBuf& b, const void* p, u32x4 v) { __builtin_amdgcn_raw_buffer_store_b128(v, b.r, (unsigned)((const unsigned char*)p - b.base), 0, 16); }
template <bool WT> __device__ __forceinline__ void st16_sel(const WsBuf& b, void* p, u32x4 v) { if (WT) st16_wt(b, p, v); else *(u32x4*)p = v; }
#ifndef WT_QKV
#define WT_QKV 0
#endif
#ifndef WT_F
#define WT_F 0
#endif
#ifndef WT_NORM
#define WT_NORM 0
#endif
#ifndef WT_OUT
#define WT_OUT 0
#endif
#ifndef WT_MIX
#define WT_MIX 0
#endif
#define LDS_WAIT() asm volatile("s_waitcnt lgkmcnt(0)" ::: "memory")
#define VM_WAIT() asm volatile("s_waitcnt vmcnt(0)" ::: "memory")

namespace g8 {
constexpr int BM = 256, BK = 64, HALF = 128, HTB = HALF * BK * 2, STAGE_BYTES = 8 * HTB, NXCD = 8, WGM = 8;
__host__ __device__ __forceinline__ int lds_byte(int r, int c) { const int st = (r >> 4) * 2 + (c >> 5), rr = r & 15, cc = c & 31, ob = rr * 64 + cc * 2; return st * 1024 + (ob ^ (((ob >> 9) & 1) << 5)); }
__host__ __device__ __forceinline__ void stage_rc(int b, int& R, int& C) { const int st = b / 1024, sb = b % 1024, swz = sb ^ (((sb >> 9) & 1) << 5); R = (st >> 1) * 16 + swz / 64; C = (st & 1) * 32 + (swz % 64) / 2; }
__host__ __device__ __forceinline__ int perm32(int rho) { const int n = rho >> 4, i = rho & 15; return 8 * (i >> 2) + 4 * n + (i & 3); }

struct UnitD { const char* A; const char* B; int nt, pm, pn, kind; };
constexpr int KEEP_ACC = 0x100;

struct TileOrder {
    int nM, nN, nwg, G, c;
    __device__ void init(int nM_, int nN_, int G_, int c_) { nM = nM_; nN = nN_; nwg = nM * nN; G = G_; c = c_; }
    __device__ bool tile(int i, int& pm, int& pn) const {
        const long L = (long)i * G + c; if (L >= nwg) return false;
        int wgid = (int)L; { const int q = nwg / NXCD, r = nwg % NXCD, xcd = wgid % NXCD, off = wgid / NXCD; wgid = (xcd < r ? xcd * (q + 1) : r * (q + 1) + (xcd - r) * q) + off; }
        const int nig = WGM * nN, gid = wgid / nig, fm = gid * WGM, gsz = (nM - fm) < WGM ? (nM - fm) : WGM;
        pm = fm + ((wgid % nig) % gsz); pn = (wgid % nig) / gsz; return true;
    }
};

template <bool AFTER_DRAIN = false, class Sched, class Epi>
__device__ __forceinline__ void gemm_stream(LAS unsigned char* lds, int tid_in, const unsigned lda, const unsigned ldb, const Sched& S, const Epi& E) {
    int tid_ = tid_in; asm volatile("" : "+v"(tid_));
    const int tid = tid_, wid = __builtin_amdgcn_readfirstlane(tid >> 6), lane = tid & 63, wr = wid >> 2, wc = wid & 3, fr = lane & 15, fq = lane >> 4;
    unsigned voffA[2], voffB[2];
#pragma unroll
    for (int i = 0; i < 2; ++i) { int R, C; stage_rc(tid * 16 + i * 8192, R, C); const int Rb = (R & ~31) + perm32(R & 31);
        voffA[i] = (unsigned)R * lda + (unsigned)C * 2u; voffB[i] = (unsigned)Rb * ldb + (unsigned)C * 2u; }
    const size_t kstep = (size_t)(BK * 2);
    const size_t hstepA = (size_t)HALF * lda, hstepB = (size_t)HALF * ldb;
    const unsigned ldsw = (unsigned)wid * 1024u;
    const int aoff = lds_byte(wr * 64 + fr, fq * 8), boff = lds_byte(wc * 32 + fr, fq * 8);
#define G8_SA(b, h) (((b) * 2 + (h)) * HTB)
#define G8_SB(b, h) ((4 + (b) * 2 + (h)) * HTB)
#define G8_STAGE(bufoff, gbase, voff) do { _Pragma("unroll") for (int _i = 0; _i < 2; ++_i) \
        __builtin_amdgcn_global_load_lds((const unsigned*)((const char*)(gbase) + (voff)[_i]), (LAS unsigned*)(lds + (bufoff) + ldsw + _i * 8192), 16, 0, 0); } while (0)
#define G8_LDA(dst, b, h) do { _Pragma("unroll") for (int m = 0; m < 4; ++m) _Pragma("unroll") for (int k = 0; k < 2; ++k) dst[m][k] = *(const LAS bf16x8*)(lds + G8_SA(b, h) + aoff + m * 2048 + k * 1024); } while (0)
#define G8_LDB(dst, b, h) do { _Pragma("unroll") for (int n = 0; n < 2; ++n) _Pragma("unroll") for (int k = 0; k < 2; ++k) dst[n][k] = *(const LAS bf16x8*)(lds + G8_SB(b, h) + boff + n * 2048 + k * 1024); } while (0)
#define G8_MMA(ai, bj, At, Bt) do { __builtin_amdgcn_s_setprio(1); _Pragma("unroll") for (int m = 0; m < 4; ++m) _Pragma("unroll") for (int n = 0; n < 2; ++n) _Pragma("unroll") for (int k = 0; k < 2; ++k) \
        acc[ai][bj][m][n] = __builtin_amdgcn_mfma_f32_16x16x32_bf16(Bt[n][k], At[m][k], acc[ai][bj][m][n], 0, 0, 0); __builtin_amdgcn_s_setprio(0); } while (0)
#define G8_WAIT_V(n) asm volatile("s_waitcnt vmcnt(" #n ")" ::: "memory")
#define G8_WAIT_L(n) asm volatile("s_waitcnt lgkmcnt(" #n ")" ::: "memory")
#define G8_BAR __builtin_amdgcn_s_barrier()
#define G8_SCHED __builtin_amdgcn_sched_barrier(0)
    UnitD cur, nxt; int ui = 0;
    if (!S.next(0, cur)) return;
    f32x4 acc[2][2][4][2];
#pragma unroll
    for (int a = 0; a < 2; ++a)
#pragma unroll
        for (int b = 0; b < 2; ++b)
#pragma unroll
            for (int m = 0; m < 4; ++m)
#pragma unroll
                for (int n = 0; n < 2; ++n) acc[a][b][m][n] = (f32x4){0.f, 0.f, 0.f, 0.f};
    bf16x8 At[4][2], B0[2][2], B1[2][2];
    const char* cA = cur.A; const char* cB = cur.B;
    G8_STAGE(G8_SB(0, 0), cB, voffB); G8_STAGE(G8_SB(0, 1), cB + hstepB, voffB); G8_STAGE(G8_SA(0, 0), cA, voffA); G8_STAGE(G8_SA(0, 1), cA + hstepA, voffA);
    if (wr == 1) G8_BAR;
    G8_WAIT_V(2); G8_BAR;
    G8_STAGE(G8_SB(1, 0), cB + kstep, voffB); G8_STAGE(G8_SA(1, 0), cA + kstep, voffA); G8_STAGE(G8_SB(1, 1), cB + hstepB + kstep, voffB);
    G8_WAIT_V(6); G8_BAR;
    for (;;) {
        const bool has_next = S.next(ui + 1, nxt);
        const char* nA = has_next ? nxt.A : cA; const char* nB = has_next ? nxt.B : cB;
        const int nt = cur.nt;
        for (int t = 0; t < nt; t += 2) {
            const bool last = (t == nt - 2);
            const char* a1 = cA + (size_t)(t + 1) * kstep;
            const char* a2 = last ? nA : cA + (size_t)(t + 2) * kstep; const char* b2 = last ? nB : cB + (size_t)(t + 2) * kstep;
            const char* a3 = a2 + kstep; const char* b3 = b2 + kstep;
            G8_LDB(B0, 0, 0); G8_LDB(B1, 0, 1); G8_SCHED; G8_LDA(At, 0, 0); G8_STAGE(G8_SA(1, 1), a1 + hstepA, voffA);
            G8_WAIT_V(8); G8_WAIT_L(0); G8_BAR; G8_MMA(0, 0, At, B0); G8_MMA(0, 1, At, B1); G8_BAR; G8_SCHED;
            G8_LDA(At, 0, 1); G8_STAGE(G8_SB(0, 0), b2, voffB); G8_STAGE(G8_SB(0, 1), b2 + hstepB, voffB); G8_STAGE(G8_SA(0, 0), a2, voffA);
            G8_WAIT_V(8); G8_WAIT_L(0); G8_BAR; G8_MMA(1, 0, At, B0); G8_MMA(1, 1, At, B1); G8_BAR; G8_SCHED;
            G8_LDB(B0, 1, 0); G8_LDB(B1, 1, 1); G8_SCHED; G8_LDA(At, 1, 0); G8_STAGE(G8_SA(0, 1), a2 + hstepA, voffA);
            G8_WAIT_V(8); G8_WAIT_L(0); G8_BAR; G8_MMA(0, 0, At, B0); G8_MMA(0, 1, At, B1); G8_BAR; G8_SCHED;
            G8_LDA(At, 1, 1); G8_STAGE(G8_SB(1, 0), b3, voffB); G8_STAGE(G8_SB(1, 1), b3 + hstepB, voffB); G8_STAGE(G8_SA(1, 0), a3, voffA);
            G8_WAIT_V(8); G8_WAIT_L(0); G8_BAR; G8_MMA(1, 0, At, B0); G8_MMA(1, 1, At, B1); G8_BAR; G8_SCHED;
        }
        if (wr == 0) G8_BAR;
        if constexpr (!AFTER_DRAIN) { UnitD eu = cur; int fr_ = fr, fq_ = fq; asm volatile("" : "+s"(eu.pm), "+s"(eu.pn), "+v"(fr_), "+v"(fq_)); E(acc, eu, wr, wc, fr_, fq_); }
        if (!has_next) break;
        if (!(cur.kind & KEEP_ACC)) {
#pragma unroll
            for (int a = 0; a < 2; ++a)
#pragma unroll
                for (int b = 0; b < 2; ++b)
#pragma unroll
                    for (int m = 0; m < 4; ++m)
#pragma unroll
                        for (int n = 0; n < 2; ++n) acc[a][b][m][n] = (f32x4){0.f, 0.f, 0.f, 0.f};
        }
        cur = nxt; cA = nA; cB = nB; ++ui;
        if (wr == 1) G8_BAR;
    }
    G8_WAIT_V(0);
    G8_BAR;
    if constexpr (AFTER_DRAIN) {
        UnitD eu = cur; int fr_ = fr, fq_ = fq, ln_ = lane; asm volatile("" : "+s"(eu.pm), "+s"(eu.pn), "+v"(fr_), "+v"(fq_), "+v"(ln_)); E.fused(acc, eu, wr, wc, fr_, fq_, lds, wid, ln_); }
#undef G8_SA
#undef G8_SB
#undef G8_STAGE
#undef G8_LDA
#undef G8_LDB
#undef G8_MMA
#undef G8_WAIT_V
#undef G8_WAIT_L
#undef G8_BAR
#undef G8_SCHED
}
}

#define XB_TMO      128
#define XB_XCNT(j)  (256  + 64 * (j))
#define XB_XSUB(j)  (1280 + 64 * (j))
#define XB_XGEN(j)  (2304 + 64 * (j))
#define XB_TOP      3328
#define XB_TOPGEN   3392
#define XCD_BAR_WORDS 3456
#define XB_SPIN_CAP (1u << 18)
__device__ __forceinline__ unsigned xb_ld(unsigned* p)              { return __hip_atomic_load(p, __ATOMIC_RELAXED, __HIP_MEMORY_SCOPE_AGENT); }
__device__ __forceinline__ unsigned xb_add(unsigned* p, unsigned v) { return __hip_atomic_fetch_add(p, v, __ATOMIC_RELAXED, __HIP_MEMORY_SCOPE_AGENT); }
__device__ __forceinline__ unsigned xb_xcc_id() { return (unsigned)__builtin_amdgcn_s_getreg((3 << 11) | 20) & 0xFu; }
#define XB_SPIN(cond, bar) do { unsigned _sp = 0; while (cond) { __builtin_amdgcn_s_sleep(1); \
    if ((++_sp & 255u) == 0u) { if (xb_ld(&(bar)[XB_TMO])) break; if (_sp > XB_SPIN_CAP) { atomicAdd(&(bar)[XB_TMO], 1u); break; } } } } while (0)
struct XcdBarrier { unsigned* bar; unsigned x; volatile LAS unsigned* st; };
__device__ __forceinline__ XcdBarrier xcd_barrier_post(unsigned* bar, volatile LAS unsigned* st) {
    XcdBarrier b; b.bar = bar; b.x = xb_xcc_id(); b.st = st;
    if (threadIdx.x == 0) (void)xb_add(&bar[XB_XCNT(b.x)], 1u);
    return b;
}
__device__ __forceinline__ void xcd_barrier_complete(unsigned* bar, unsigned x, unsigned& nloc, unsigned& nx) {
    const unsigned G = gridDim.x * gridDim.y * gridDim.z;
    unsigned sum, cnt, mine, sp = 0u;
    for (;;) {
        sum = 0u; cnt = 0u; mine = 0u;
#pragma unroll
        for (unsigned j = 0; j < 16; ++j) { const unsigned c = xb_ld(&bar[XB_XCNT(j)]); sum += c; cnt += (c > 0u) ? 1u : 0u; mine = (j == x) ? c : mine; }
        if (sum == G) break;
        __builtin_amdgcn_s_sleep(1);
        if ((++sp & 255u) == 0u) { if (xb_ld(&bar[XB_TMO])) break; if (sp > XB_SPIN_CAP) { atomicAdd(&bar[XB_TMO], 1u); break; } }
    }
    nloc = mine > 0u ? mine : 1u; nx = cnt > 0u ? cnt : 1u;
}
__device__ __forceinline__ void xcd_barrier(const XcdBarrier& b) {
    asm volatile("s_waitcnt vmcnt(0)" ::: "memory");
    __syncthreads();
    if (threadIdx.x == 0) {
        unsigned* bar = b.bar; unsigned bx = b.x; asm volatile("" : "+s"(bar), "+s"(bx));
        __builtin_amdgcn_s_waitcnt(0);
        unsigned nloc = b.st[0], nx = b.st[1];
        if (nloc == 0u) { xcd_barrier_complete(bar, bx, nloc, nx); b.st[0] = nloc; b.st[1] = nx; }
        const unsigned old = xb_add(&bar[XB_XSUB(bx)], 1u);
        const unsigned gen = old / nloc;
        if (old + 1u == (gen + 1u) * nloc) {
            __builtin_amdgcn_fence(__ATOMIC_RELEASE, "agent");
            asm volatile("s_waitcnt vmcnt(0)" ::: "memory");
            const unsigned og = xb_add(&bar[XB_TOP], 1u);
            const unsigned tg = og / nx;
            if (og + 1u == (tg + 1u) * nx) xb_add(&bar[XB_TOPGEN], 1u);
            else XB_SPIN(xb_ld(&bar[XB_TOPGEN]) == tg, bar);
            __builtin_amdgcn_fence(__ATOMIC_ACQUIRE, "agent");
            xb_add(&bar[XB_XGEN(bx)], 1u);
            asm volatile("s_waitcnt vmcnt(0)" ::: "memory");
        } else {
            XB_SPIN(xb_ld(&bar[XB_XGEN(bx)]) == gen, bar);
            __builtin_amdgcn_fence(__ATOMIC_ACQUIRE, "agent");
            asm volatile("s_waitcnt vmcnt(0)" ::: "memory");
        }
    }
    __syncthreads();
}
constexpr int T = 16384, DM = 1024, SEQ = 2048, NBATCH = 8, DEPTH = 2, N_IN = 10432;
constexpr int NWAVES = 8;
constexpr float EPS = 1e-6f;
constexpr size_t MiB = 1u << 20;
constexpr size_t WS_CTL = 0, CTL_ZERO_BYTES = 64 * 1024;
constexpr size_t WS_WB = 1 * MiB;
constexpr size_t WB_W1T = 0;
constexpr size_t WB_W2T = WB_W1T + (size_t)4352 * 1024 * 2;
constexpr size_t WB_WQT = WB_W2T + (size_t)6144 * 1024 * 2;
constexpr size_t WB_WKVT = WB_WQT + (size_t)1536 * 384 * 2;
constexpr size_t WB_WPT = WB_WKVT + (size_t)2048 * 384 * 2;
constexpr size_t WB_WOT = WB_WPT + (size_t)1024 * 3328 * 2;
constexpr size_t WB_END = WB_WOT + (size_t)1024 * 1024 * 2;
static_assert(WB_END <= 32 * MiB, "weights region");
constexpr size_t WS_H = 33 * MiB;
constexpr size_t WS_Y = 65 * MiB;
constexpr int YLD = 3328;
constexpr size_t WS_BIG = 169 * MiB;
constexpr size_t WS_MISC = WS_BIG;
constexpr size_t WS_XC = WS_MISC + 24 * MiB;
constexpr size_t WS_Q = WS_XC + 40 * MiB;
constexpr size_t WS_VV = WS_Q + 48 * MiB;
constexpr size_t WS_KR = WS_VV + 32 * MiB;
constexpr size_t WS_V1 = WS_BIG;
constexpr size_t WS_G = WS_V1 + 32 * MiB;
constexpr size_t WS_O = WS_BIG;
constexpr size_t WS_SMALL = 315 * MiB;
constexpr size_t WS_SLAB = WS_SMALL;
constexpr size_t WS_AGG = WS_SLAB + 1536 * 1024;
constexpr size_t WS_ROPE = WS_AGG + 2560 * 1024;
constexpr size_t WS_LW = WS_ROPE + 512 * 1024;
constexpr size_t WS_GMW = WS_LW + 480 * 1024;
constexpr size_t WS_LCT = WS_GMW + 128 * 1024;
constexpr size_t WS_RINV = WS_LCT + 64 * 1024;
constexpr size_t WS_END = WS_RINV + 128 * 1024;
static_assert(WS_KR + 2 * MiB <= WS_SMALL && WS_G + 96 * MiB <= WS_SMALL && WS_END <= 326 * MiB, "d_ws map");
constexpr int CW_NORM = 12288;
constexpr int CW_BAR = 1024;
static_assert((CW_BAR + XCD_BAR_WORDS) * 4 <= (int)CTL_ZERO_BYTES, "ctl");
constexpr int RING_BYTES = 131072, MISC_OFF = RING_BYTES + 320, LDS_BYTES = 147456;

enum { I_X = 0, I_PRE_G, I_W_IN, I_GM_LN_G, I_GM_LN_B, I_GM_WS, I_GM_BS, I_QN_G, I_W_UQ, I_KVN_G, I_W_UKV, I_CONV_W, I_CONV_B, I_W_A, I_B_A, I_W_X, I_B_X, I_LAM,
       I_W_PA, I_W_PB, I_W_PC, I_W_OUT, I_POST_G, N_INPUTS };
struct Args { const float* in[N_INPUTS]; float* out; unsigned char* ws; int ph_lo, ph_hi, probe, pad; };

struct Frame { LAS unsigned char* lds; int wave, vcu, G; };
__device__ __forceinline__ int lane_id() { int l; asm volatile("v_mbcnt_lo_u32_b32 %0, -1, 0\n\tv_mbcnt_hi_u32_b32 %0, -1, %0" : "=v"(l)); return l; }

__device__ __forceinline__ float softplus_neg(float x) { const float e = __expf(-x);
    const float p = e * (1.f - e * (0.5f - e * (0.33333334f - e * (0.25f - e * (0.2f - e * (0.16666667f - e * (0.14285715f - e * 0.125f)))))));
    return (e < 0.2f) ? p : __logf(1.f + e); }
struct MapW1 { __device__ __forceinline__ int operator()(int j) const {
    if (j < 384) return 3072 + j; if (j < 640) return 3456 + (j - 384); if (j < 704) { const int jj = j - 640, g = jj >> 3, e = jj & 7; return 3712 + (e < 4 ? 4 * g + e : 32 + 4 * g + (e - 4)); } if (j < 768) return -1;
    if (j < 2048) return 4800 + (j - 768); if (j < 3328) return 6080 + (j - 2048); return 3776 + (j - 3328); } };
struct MapW2 { __device__ __forceinline__ int operator()(int j) const {
    if (j < 2048) { const int tl = j >> 8, lc = j & 255; return (lc < 128) ? (128 * tl + lc) : (2048 + 128 * tl + (lc - 128)); }
    if (j < 3072) return 1024 + (j - 2048); return 7360 + (j - 3072); } };
struct MapQ { __device__ __forceinline__ int operator()(int j) const {
    if (j < 1024) { const int hd = j >> 7, d = j & 127; return hd * 192 + d; }
    const int jj = j - 1024, hh = jj >> 6, w = jj & 63, g = w >> 3, e = w & 7; return hh * 192 + (e < 4 ? 128 + 4 * g + e : 160 + 4 * g + (e - 4)); } };
struct MapId { __device__ __forceinline__ int operator()(int j) const { return j; } };

template <class Map>
__device__ __forceinline__ void tr_item(const float* W, int ldw, int nkb  , bf16_t* WT, int ldt, const Map map, const float* kscale, LAS float* scr, int item, int lane) {
    const int kb = item % nkb, nb = item / nkb, k0 = 32 * kb, n0 = 64 * nb;
    const int sc = map(n0 + lane);
    float wv[32];
    const float* wp = W + (size_t)k0 * ldw + (sc >= 0 ? sc : 0);
#pragma unroll
    for (int i = 0; i < 32; ++i) wv[i] = (sc >= 0) ? wp[(size_t)i * ldw] : 0.f;
#pragma unroll
    for (int i = 0; i < 32; ++i) { float v = wv[i]; if (kscale) v *= kscale[k0 + i]; scr[i * 65 + lane] = v; }
    LDS_WAIT(); asm volatile("" ::: "memory");
    const int c = lane & 3;
#pragma unroll
    for (int j = 0; j < 4; ++j) { const int n = (lane >> 2) + 16 * j; const LAS float* s = scr + (8 * c) * 65 + n;
        u32x4 o; o.x = pk_bf16(s[0 * 65], s[1 * 65]); o.y = pk_bf16(s[2 * 65], s[3 * 65]); o.z = pk_bf16(s[4 * 65], s[5 * 65]); o.w = pk_bf16(s[6 * 65], s[7 * 65]);
        *(u32x4*)(WT + (size_t)(n0 + n) * ldt + k0 + 8 * c) = o; }
    LDS_WAIT(); asm volatile("" ::: "memory");
}

__device__ __forceinline__ void convert_weights(const Frame& F, const Args& a, unsigned char* ws, int l) {
    const int lane = lane_id();
    LAS float* scr = (LAS float*)(F.lds + F.wave * 16384);
    const int gw = F.vcu * NWAVES + F.wave, NGW = F.G * NWAVES;
    unsigned char* wb = ws + WS_WB;
    constexpr int I1 = 32 * (4352 / 64), I2 = 32 * (6144 / 64), IQ = 12 * (1536 / 64), IKV = 8 * (2048 / 64), IPA = 32 * 16, IPB = 32 * 16, IPC = 40 * 16, IO = 32 * 16;
    constexpr int NITEMS = I1 + I2 + IQ + IKV + IPA + IPB + IPC + IO;
    const float* w_in = a.in[I_W_IN] + (size_t)l * 1024 * N_IN; const float* pre_g = a.in[I_PRE_G] + l * DM;
    for (int it = gw; it < NITEMS; it += NGW) {
        int r = it;
        if (r < I1) { tr_item(w_in, N_IN, 32, (bf16_t*)(wb + WB_W1T), 1024, MapW1(), pre_g, scr, r, lane); continue; } r -= I1;
        if (r < I2) { tr_item(w_in, N_IN, 32, (bf16_t*)(wb + WB_W2T), 1024, MapW2(), pre_g, scr, r, lane); continue; } r -= I2;
        if (r < IQ) { tr_item(a.in[I_W_UQ] + (size_t)l * 384 * 1536, 1536, 12, (bf16_t*)(wb + WB_WQT), 384, MapQ(), a.in[I_QN_G] + l * 384, scr, r, lane); continue; } r -= IQ;
        if (r < IKV) { tr_item(a.in[I_W_UKV] + (size_t)l * 256 * 2048, 2048, 8, (bf16_t*)(wb + WB_WKVT), 384, MapId(), a.in[I_KVN_G] + l * 256, scr, r, lane); continue; } r -= IKV;
        if (r < IPA) { tr_item(a.in[I_W_PA] + (size_t)l * 1024 * 1024, 1024, 32, (bf16_t*)(wb + WB_WPT), 3328, MapId(), nullptr, scr, r, lane); continue; } r -= IPA;
        if (r < IPB) { tr_item(a.in[I_W_PB] + (size_t)l * 1024 * 1024, 1024, 32, (bf16_t*)(wb + WB_WPT) + 1024, 3328, MapId(), nullptr, scr, r, lane); continue; } r -= IPB;
        if (r < IPC) { tr_item(a.in[I_W_PC] + (size_t)l * 1280 * 1024, 1024, 40, (bf16_t*)(wb + WB_WPT) + 2048, 3328, MapId(), nullptr, scr, r, lane); continue; } r -= IPC;
        tr_item(a.in[I_W_OUT] + (size_t)l * 1024 * 1024, 1024, 32, (bf16_t*)(wb + WB_WOT), 1024, MapId(), nullptr, scr, r, lane);
    }
    const int gt = (F.vcu * NWAVES + F.wave) * 64 + lane, NGT = F.G * NWAVES * 64;
    bf16_t* lwa = (bf16_t*)(ws + WS_LW); bf16_t* lwx = lwa + 16 * 80 * 96;
    const float* w_a = a.in[I_W_A] + (size_t)l * 16 * 80 * 80; const float* w_x = a.in[I_W_X] + (size_t)l * 16 * 80 * 80;
    for (int i = gt; i < 16 * 80 * 96; i += NGT) { const int k = i % 96, j = (i / 96) % 80, blk = i / (96 * 80);
        const float va = (k < 80) ? w_a[((size_t)blk * 80 + k) * 80 + j] : 0.f, vx = (k < 80) ? w_x[((size_t)blk * 80 + k) * 80 + j] : 0.f;
        lwa[i] = f2bf(va); lwx[i] = f2bf(vx); }
    { float* lct = (float*)(ws + WS_LCT); const float* cw = a.in[I_CONV_W] + (size_t)l * 4 * 1280;
      for (int c = gt; c < 1280; c += NGT) { f32x4 v0 = {cw[c], cw[1280 + c], cw[2560 + c], cw[3840 + c]};
          f32x4 v1 = {a.in[I_CONV_B][l * 1280 + c], -1.4426950408889634f * a.in[I_B_A][l * 1280 + c], -1.4426950408889634f * a.in[I_B_X][l * 1280 + c],   -8.f * 1.4426950408889634f * softplus_neg(a.in[I_LAM][l * 1280 + c])};
          *(f32x4*)(lct + c * 8) = v0; *(f32x4*)(lct + c * 8 + 4) = v1; } }
    bf16_t* gmw = (bf16_t*)(ws + WS_GMW); const float* gws = a.in[I_GM_WS] + (size_t)l * 4 * 128 * 128;
    for (int i = gt; i < 4 * 128 * 128; i += NGT) { const int j = i & 127, ii = (i >> 7) & 127; gmw[i] = f2bf(((j >> 6) <= (ii >> 6)) ? gws[i] : 0.f); }
}
__device__ __forceinline__ void rope_table(const Frame& F, unsigned char* ws) {
    const int gt = (F.vcu * NWAVES + F.wave) * 64 + lane_id(), NGT = F.G * NWAVES * 64;
    float* cs = (float*)(ws + WS_ROPE); float* sn = cs + 2048 * 32;
    for (int i = gt; i < 2048 * 32; i += NGT) { const int s = i >> 5, fi = i & 31; const float inv_freq = powf(10000.f, -(float)(2 * fi) / 64.f); const float ang = (float)s * inv_freq;
        cs[i] = cosf(ang); sn[i] = sinf(ang); }
}
__device__ __forceinline__ void norm_rows(const Frame& F, const bool nostore, const float* xin, const bf16_t* o, const float* g_post, float* xout, const float* g_pre, bf16_t* h, float* rinv = nullptr) {
    const int gw = F.vcu * NWAVES + F.wave, NGW = F.G * NWAVES; const int lane = lane_id();
    f32x4 v[4], ov[4], nv[4]; u32x2 nov[4];
    if (gw < T) {
#pragma unroll
        for (int j = 0; j < 4; ++j) { nv[j] = *((const f32x4*)(xin + (size_t)gw * DM) + lane + 64 * j); nov[j] = o ? *((const u32x2*)(o + (size_t)gw * DM) + lane + 64 * j) : (u32x2){0u, 0u}; }
    }
    for (int m = gw; m < T; m += NGW) {
#pragma unroll
        for (int j = 0; j < 4; ++j) { v[j] = nv[j]; ov[j] = (f32x4){bf_lo(nov[j].x), bf_hi(nov[j].x), bf_lo(nov[j].y), bf_hi(nov[j].y)}; }
        const int mn = m + NGW;
        if (mn < T) {
#pragma unroll
            for (int j = 0; j < 4; ++j) { nv[j] = *((const f32x4*)(xin + (size_t)mn * DM) + lane + 64 * j); if (o) nov[j] = *((const u32x2*)(o + (size_t)mn * DM) + lane + 64 * j); }
        }
        if (o) {
            float s = 0.f;
#pragma unroll
            for (int j = 0; j < 4; ++j) s += (ov[j].x * ov[j].x + ov[j].y * ov[j].y) + (ov[j].z * ov[j].z + ov[j].w * ov[j].w);
            const float r = rsqrtf(wave_sum(s) * (1.f / DM) + EPS);
            f32x4* xo = (f32x4*)(xout + (size_t)m * DM) + lane;
#pragma unroll
            for (int j = 0; j < 4; ++j) { const f32x4 gp = *((const f32x4*)g_post + lane + 64 * j); v[j] = v[j] + ov[j] * r * gp; if (!nostore) xo[64 * j] = v[j]; }
        }
        if (g_pre) {
            float s = 0.f;
#pragma unroll
            for (int j = 0; j < 4; ++j) s += (v[j].x * v[j].x + v[j].y * v[j].y) + (v[j].z * v[j].z + v[j].w * v[j].w);
            const float ms = wave_sum(s) * (1.f / DM) + EPS, r = rsqrtf(ms); if (rinv && lane == 0) rinv[m] = ms * r;
            u32x2* ho = (u32x2*)(h + (size_t)m * DM) + lane;
#pragma unroll
            for (int j = 0; j < 4; ++j) { const f32x4 y = v[j] * r; u32x2 w; w.x = pk_bf16(y.x, y.y); w.y = pk_bf16(y.z, y.w); if (!nostore) ho[64 * j] = w; }
        }
    }
}
using g8::UnitD;
constexpr float QSCALE = 0.07216878364870322f * 1.4426950408889634f;

struct SchedA {
    g8::TileOrder ord; const char* A; const char* B;
    __device__ __forceinline__ bool next(int i, UnitD& u) const { int pm, pn; if (!ord.tile(i, pm, pn)) return false;
        u.A = A + (size_t)pm * 256 * 2048; u.B = B + (size_t)pn * 256 * 2048; u.nt = 16; u.pm = pm; u.pn = pn; u.kind = 0; return true; }
};
struct EpiA {
    bf16_t* misc; bf16_t* xc; bf16_t* y; float* slab; bf16_t* kr; const float* cs; const float* sn; WsBuf wsb;
    template <int KIND>
    __device__ __forceinline__ void body(f32x4 (&acc)[2][2][4][2], const UnitD& u, bf16_t* dst, int ld, int wr, int wc, int fr, int fq) const {
        const int pn = u.pn, rowp = wr * 64 + fr, lc = wc * 32 + 8 * fq;
#pragma unroll
        for (int ai = 0; ai < 2; ++ai)
#pragma unroll
            for (int m = 0; m < 4; ++m) { const int rp = rowp + ai * 128 + m * 16; bf16_t* p = dst + ((size_t)u.pm * 256 + rp) * ld + lc;
#pragma unroll
                for (int bj = 0; bj < 2; ++bj) { f32x4 v0 = acc[ai][bj][m][0], v1 = acc[ai][bj][m][1];
                    if (KIND == 0) {
                        if (pn == 2 && bj == 1) { if (wc < 2) { const int g = 4 * wc + fq; const size_t r = (size_t)u.pm * 256 + rp; const int pos = (int)(r & 2047);
                                const f32x4 c4 = *(const f32x4*)(cs + pos * 32 + 4 * g), s4 = *(const f32x4*)(sn + pos * 32 + 4 * g);
                                const f32x4 o1 = v0 * c4 - v1 * s4, o2 = v1 * c4 + v0 * s4; bf16_t* kp = kr + r * 64 + 4 * g;
                                u32x2 w1, w2; w1.x = pk_bf16(o1.x, o1.y); w1.y = pk_bf16(o1.z, o1.w); w2.x = pk_bf16(o2.x, o2.y); w2.y = pk_bf16(o2.z, o2.w);
                                *(u32x2*)kp = w1; *(u32x2*)(kp + 32) = w2; }
                            continue; }
                        float ss = (v0.x * v0.x + v0.y * v0.y) + (v0.z * v0.z + v0.w * v0.w) + (v1.x * v1.x + v1.y * v1.y) + (v1.z * v1.z + v1.w * v1.w);
                        ss += sx<16>(ss); ss = xsum32(ss);
                        if (fq == 0) slab[(((size_t)u.pm * 6 + pn * 2 + bj) * 4 + wc) * 256 + rp] = ss; }
                    if (KIND == 2) { v0.x = fsilu(v0.x); v0.y = fsilu(v0.y); v0.z = fsilu(v0.z); v0.w = fsilu(v0.w); v1.x = fsilu(v1.x); v1.y = fsilu(v1.y); v1.z = fsilu(v1.z); v1.w = fsilu(v1.w); }
                    u32x4 w; w.x = pk_bf16(v0.x, v0.y); w.y = pk_bf16(v0.z, v0.w); w.z = pk_bf16(v1.x, v1.y); w.w = pk_bf16(v1.z, v1.w);
                    st16_wt(wsb, p + bj * 128, w); } }
    }
    __device__ __forceinline__ void operator()(f32x4 (&acc)[2][2][4][2], const UnitD& u, int wr, int wc, int fr, int fq) const {
        const int pn = u.pn;
        if (pn < 3) body<0>(acc, u, misc + 256 * pn, 768, wr, wc, fr, fq);
        else if (pn < 8) body<1>(acc, u, xc + 256 * (pn - 3), 1280, wr, wc, fr, fq);
        else if (pn < 13) body<2>(acc, u, y + 2048 + 256 * (pn - 8), YLD, wr, wc, fr, fq);
        else body<2>(acc, u, y + 1024 + 256 * (pn - 13), YLD, wr, wc, fr, fq);
    }
};

struct SchedZ {
    int v; const char* A; const char* B;
    __device__ __forceinline__ bool next(int i, UnitD& u) const { if (i > 0 || (v & 3) != 0 || v >= 256) return false; const int pm = v >> 2;
        u.A = A + (size_t)pm * 256 * 2048; u.B = B + (size_t)16 * 256 * 2048; u.nt = 16; u.pm = pm; u.pn = 16; u.kind = 0; return true; }
};
struct SchedQKV {
    int v; const char* misc; const char* wq; const char* wkv;
    __device__ __forceinline__ bool next(int i, UnitD& u) const { if (v >= 256) return false; const int role = v & 3, pm = v >> 2; int pn;
        if (role == 0) { if (i > 1) return false; pn = 6 + i; }
        else { if (i > 3) return false; pn = (i < 2) ? (2 * role - 2 + i) : (6 + 2 * role + (i - 2)); }
        u.pm = pm; u.pn = pn; u.kind = 0;
        if (pn < 6) { u.A = misc + (size_t)pm * 256 * 1536; u.B = wq + (size_t)pn * 256 * 768; u.nt = 6; }
        else { u.A = misc + (size_t)pm * 256 * 1536 + 384 * 2; u.B = wkv + (size_t)(pn - 6) * 256 * 768; u.nt = 4; }
        return true; }
};
constexpr int RS_TAB_OFF = RING_BYTES + 2048;
__device__ __forceinline__ void qkv_row_scales(LAS unsigned char* lds, const float* slab, int pm, int tid) {
    if (tid < 256) { const float* sl = slab + (size_t)pm * 6 * 4 * 256 + tid; float p[20];
#pragma unroll
        for (int j = 0; j < 20; ++j) p[j] = sl[(size_t)j * 256];
        float sq = 0.f, sk = 0.f;
#pragma unroll
        for (int j = 0; j < 12; ++j) sq += p[j];
#pragma unroll
        for (int j = 12; j < 20; ++j) sk += p[j];
        LAS float* tab = (LAS float*)(lds + RS_TAB_OFF);
        tab[tid] = rsqrtf(sq * (1.f / 384.f) + EPS) * QSCALE; tab[256 + tid] = rsqrtf(sk * (1.f / 256.f) + EPS); }
    LDS_WAIT(); __syncthreads();
}
struct EpiNull {
    __device__ __forceinline__ void operator()(f32x4 (&acc)[2][2][4][2], const UnitD&, int, int, int, int) const {
#pragma unroll
        for (int a = 0; a < 2; ++a)
#pragma unroll
            for (int b = 0; b < 2; ++b)
#pragma unroll
                for (int m = 0; m < 4; ++m) { asm volatile("" :: "v"(acc[a][b][m][0]), "v"(acc[a][b][m][1])); } }
};
struct EpiQKV {
    bf16_t* q; bf16_t* y; bf16_t* vv; const float* cs; const float* sn; WsBuf wsb;
    template <int KIND>
    __device__ __forceinline__ void body(f32x4 (&acc)[2][2][4][2], const UnitD& u, int wr, int wc, int fr, int fq, const LAS float* tab) const {
        const int pn = u.pn, rowp = wr * 64 + fr, lc = wc * 32 + 8 * fq; constexpr bool isq = KIND < 2;
        float rsv[2][4];
#pragma unroll
        for (int ai = 0; ai < 2; ++ai)
#pragma unroll
            for (int m = 0; m < 4; ++m) rsv[ai][m] = tab[(isq ? 0 : 256) + rowp + ai * 128 + m * 16];
#pragma unroll
        for (int ai = 0; ai < 2; ++ai) {
            f32x4 c4[4], s4[4];
            if (KIND == 1) { const int g = (lc & 63) >> 3;
#pragma unroll
                for (int m = 0; m < 4; ++m) { const int pos = (int)(((size_t)u.pm * 256 + rowp + ai * 128 + m * 16) & 2047);
                    c4[m] = *(const f32x4*)(cs + pos * 32 + 4 * g); s4[m] = *(const f32x4*)(sn + pos * 32 + 4 * g); } }
#pragma unroll
            for (int m = 0; m < 4; ++m) { const int rp = rowp + ai * 128 + m * 16; const size_t r = (size_t)u.pm * 256 + rp;
                const float rs = rsv[ai][m];
#pragma unroll
                for (int bj = 0; bj < 2; ++bj) { f32x4 v0 = acc[ai][bj][m][0] * rs, v1 = acc[ai][bj][m][1] * rs;
                    if (KIND == 0) { const int j0 = 256 * pn + 128 * bj + lc; bf16_t* p = q + r * 1536 + (j0 >> 7) * 192 + (j0 & 127);
                        u32x4 w; w.x = pk_bf16(v0.x, v0.y); w.y = pk_bf16(v0.z, v0.w); w.z = pk_bf16(v1.x, v1.y); w.w = pk_bf16(v1.z, v1.w); st16_sel<WT_QKV>(wsb, p, w); }
                    else if (KIND == 1) { const int jj = 256 * (pn - 4) + 128 * bj + lc, hh = jj >> 6, g = (jj & 63) >> 3;
                        const f32x4 cc = c4[m], ss = s4[m];
                        const f32x4 o1 = v0 * cc - v1 * ss, o2 = v1 * cc + v0 * ss; bf16_t* p = q + r * 1536 + hh * 192 + 128 + 4 * g;
                        u32x2 w1, w2; w1.x = pk_bf16(o1.x, o1.y); w1.y = pk_bf16(o1.z, o1.w); w2.x = pk_bf16(o2.x, o2.y); w2.y = pk_bf16(o2.z, o2.w);
                        *(u32x2*)p = w1; *(u32x2*)(p + 32) = w2; }
                    else { const int hd = pn - 6; bf16_t* p = (bj == 0) ? (y + r * YLD + hd * 128 + lc) : (vv + r * 1024 + hd * 128 + lc);
                        u32x4 w; w.x = pk_bf16(v0.x, v0.y); w.y = pk_bf16(v0.z, v0.w); w.z = pk_bf16(v1.x, v1.y); w.w = pk_bf16(v1.z, v1.w); st16_sel<WT_QKV>(wsb, p, w); } } } }
    }
    LAS unsigned char* lds;
    __device__ __forceinline__ void operator()(f32x4 (&acc)[2][2][4][2], const UnitD& u, int wr, int wc, int fr, int fq) const {
        const LAS float* tab = (const LAS float*)(lds + RS_TAB_OFF);
        if (u.pn < 4) body<0>(acc, u, wr, wc, fr, fq, tab); else if (u.pn < 6) body<1>(acc, u, wr, wc, fr, fq, tab); else body<2>(acc, u, wr, wc, fr, fq, tab);
    }
};

struct SchedD {
    g8::TileOrder ord; const char* A; const char* B;
    __device__ __forceinline__ bool next(int i, UnitD& u) const { int pm, pn; if (!ord.tile(i, pm, pn)) return false;
        u.A = A + (size_t)pm * 256 * 2048; u.B = B + (size_t)pn * 256 * 2048; u.nt = 16; u.pm = pm; u.pn = pn; u.kind = 0; return true; }
};
struct EpiD {
    bf16_t* y; bf16_t* v1; bf16_t* g; float* vslab; WsBuf wsb;
    template <int KIND>
    __device__ __forceinline__ void body(f32x4 (&acc)[2][2][4][2], const UnitD& u, int wr, int wc, int fr, int fq) const {
        const int pn = u.pn, rowp = wr * 64 + fr, lc = wc * 32 + 8 * fq;
#pragma unroll
        for (int ai = 0; ai < 2; ++ai)
#pragma unroll
            for (int m = 0; m < 4; ++m) { const size_t r = (size_t)u.pm * 256 + rowp + ai * 128 + m * 16;
                if (KIND == 0) { const f32x4 u0 = acc[ai][0][m][0], u1 = acc[ai][0][m][1], z0 = acc[ai][1][m][0], z1 = acc[ai][1][m][1];
                    u32x4 w; w.x = pk_bf16(u0.x * fsilu(z0.x), u0.y * fsilu(z0.y)); w.y = pk_bf16(u0.z * fsilu(z0.z), u0.w * fsilu(z0.w));
                    w.z = pk_bf16(u1.x * fsilu(z1.x), u1.y * fsilu(z1.y)); w.w = pk_bf16(u1.z * fsilu(z1.z), u1.w * fsilu(z1.w));
                    st16_wt(wsb, y + r * YLD + 128 * pn + lc, w); }
                else {
#pragma unroll
                    for (int bj = 0; bj < 2; ++bj) { f32x4 v0 = acc[ai][bj][m][0], v1_ = acc[ai][bj][m][1]; bf16_t* p;
                        if (KIND == 1) { p = v1 + r * 1024 + 256 * (pn - 8) + 128 * bj + lc;
                            float s1 = (v0.x + v0.y) + (v0.z + v0.w) + (v1_.x + v1_.y) + (v1_.z + v1_.w);
                            float s2 = (v0.x * v0.x + v0.y * v0.y) + (v0.z * v0.z + v0.w * v0.w) + (v1_.x * v1_.x + v1_.y * v1_.y) + (v1_.z * v1_.z + v1_.w * v1_.w);
                            s1 += sx<16>(s1); s1 = xsum32(s1); s2 += sx<16>(s2); s2 = xsum32(s2);
                            if (fq == 0) *(f32x2*)(vslab + r * 64 + (((pn - 8) * 2 + bj) * 4 + wc) * 2) = (f32x2){s1, s2}; }
                        else { p = g + r * 3072 + 256 * (pn - 12) + 128 * bj + lc;
                            v0.x = fsigmoid(v0.x); v0.y = fsigmoid(v0.y); v0.z = fsigmoid(v0.z); v0.w = fsigmoid(v0.w); v1_.x = fsigmoid(v1_.x); v1_.y = fsigmoid(v1_.y); v1_.z = fsigmoid(v1_.z); v1_.w = fsigmoid(v1_.w); }
                        u32x4 w; w.x = pk_bf16(v0.x, v0.y); w.y = pk_bf16(v0.z, v0.w); w.z = pk_bf16(v1_.x, v1_.y); w.w = pk_bf16(v1_.z, v1_.w); st16_wt(wsb, p, w); } } }
    }
    __device__ __forceinline__ void operator()(f32x4 (&acc)[2][2][4][2], const UnitD& u, int wr, int wc, int fr, int fq) const {
        if (u.pn < 8) body<0>(acc, u, wr, wc, fr, fq); else if (u.pn < 12) body<1>(acc, u, wr, wc, fr, fq); else body<2>(acc, u, wr, wc, fr, fq);
    }
};

struct SchedF {
    g8::TileOrder ord; const char* A; const char* B;
    __device__ __forceinline__ bool next(int i, UnitD& u) const { if (i >= 3) return false; int pm, pn; if (!ord.tile(0, pm, pn)) return false;
        const size_t ko = (i == 0) ? 0 : (i == 1 ? 1024 * 2 : 2048 * 2);
        u.A = A + (size_t)pm * 256 * (YLD * 2) + ko; u.B = B + (size_t)pn * 256 * (YLD * 2) + ko; u.nt = (i == 2) ? 20 : 16; u.pm = pm; u.pn = pn; u.kind = (i < 2) ? (i | g8::KEEP_ACC) : i; return true; }
};
struct EpiF {
    const bf16_t* g; bf16_t* merged; WsBuf wsb;
    template <bool MID>
    __device__ __forceinline__ void ldq(int q, u32x4 (&A)[2][2], u32x4 (&B)[2][2], const UnitD& u, int seg, int rowp, int lc) const {
        const int ai = q >> 1, mh = q & 1;
#pragma unroll
        for (int mm = 0; mm < 2; ++mm) { const size_t r = (size_t)u.pm * 256 + rowp + ai * 128 + (2 * mh + mm) * 16;
#pragma unroll
            for (int bj = 0; bj < 2; ++bj) { const bf16_t* gp = g + r * 3072 + seg * 1024 + 256 * u.pn + 128 * bj + lc; A[mm][bj] = *(const u32x4*)gp; if (MID) B[mm][bj] = *(const u32x4*)(gp + 1024); } }
    }
    template <bool MID>
    __device__ __forceinline__ void cmpq(int q, const u32x4 (&A)[2][2], const u32x4 (&B)[2][2], f32x4 (&acc)[2][2][4][2], const UnitD& u, int rowp, int lc) const {
        const int ai = q >> 1, mh = q & 1;
#pragma unroll
        for (int mm = 0; mm < 2; ++mm) { const int m = 2 * mh + mm; const size_t r = (size_t)u.pm * 256 + rowp + ai * 128 + m * 16;
#pragma unroll
            for (int bj = 0; bj < 2; ++bj) { const u32x4 a = A[mm][bj]; f32x4 f0, f1;
                f0.x = bf_lo(a.x); f0.y = bf_hi(a.x); f0.z = bf_lo(a.y); f0.w = bf_hi(a.y); f1.x = bf_lo(a.z); f1.y = bf_hi(a.z); f1.z = bf_lo(a.w); f1.w = bf_hi(a.w);
                if (MID) { const u32x4 b = B[mm][bj];
                    f0.x *= __builtin_amdgcn_rcpf(bf_lo(b.x)); f0.y *= __builtin_amdgcn_rcpf(bf_hi(b.x)); f0.z *= __builtin_amdgcn_rcpf(bf_lo(b.y)); f0.w *= __builtin_amdgcn_rcpf(bf_hi(b.y));
                    f1.x *= __builtin_amdgcn_rcpf(bf_lo(b.z)); f1.y *= __builtin_amdgcn_rcpf(bf_hi(b.z)); f1.z *= __builtin_amdgcn_rcpf(bf_lo(b.w)); f1.w *= __builtin_amdgcn_rcpf(bf_hi(b.w));
                    acc[ai][bj][m][0] *= f0; acc[ai][bj][m][1] *= f1;
                    asm volatile("" : "+v"(acc[ai][bj][m][0]), "+v"(acc[ai][bj][m][1]) :: "memory"); }
                else { const f32x4 v0 = acc[ai][bj][m][0] * f0, v1 = acc[ai][bj][m][1] * f1;
                    u32x4 w; w.x = pk_bf16(v0.x, v0.y); w.y = pk_bf16(v0.z, v0.w); w.z = pk_bf16(v1.x, v1.y); w.w = pk_bf16(v1.z, v1.w);
                    st16_sel<WT_F>(wsb, merged + r * 1024 + 256 * u.pn + 128 * bj + lc, w); } } }
    }
    template <bool MID>
    __device__ __forceinline__ void body(f32x4 (&acc)[2][2][4][2], const UnitD& u, int seg, int wr, int wc, int fr, int fq) const {
        const int rowp = wr * 64 + fr, lc = wc * 32 + 8 * fq;
        constexpr int DQ = MID ? 2 : 4;
        u32x4 A[DQ][2][2], B[MID ? DQ : 1][2][2];
#pragma unroll
        for (int q = 0; q < DQ; ++q) ldq<MID>(q, A[q], B[MID ? q : 0], u, seg, rowp, lc);
#pragma unroll
        for (int q = 0; q < 4; ++q) { cmpq<MID>(q, A[q % DQ], B[MID ? q % DQ : 0], acc, u, rowp, lc);
            if (q + DQ < 4) ldq<MID>(q + DQ, A[q % DQ], B[MID ? q % DQ : 0], u, seg, rowp, lc); }
    }
    __device__ __forceinline__ void operator()(f32x4 (&acc)[2][2][4][2], const UnitD& u, int wr, int wc, int fr, int fq) const {
        const int seg = u.kind & 3; if (seg < 2) body<true>(acc, u, seg, wr, wc, fr, fq); else body<false>(acc, u, seg, wr, wc, fr, fq);
    }
};

struct SchedG1 {
    int v; const char* A; const char* B;
    __device__ __forceinline__ bool next(int i, UnitD& u) const { if (i > 0 || v >= 256) return false; const int pm = v >> 2, pn = v & 3;
        u.A = A + (size_t)pm * 256 * 2048; u.B = B + (size_t)pn * 256 * 2048; u.nt = 16; u.pm = pm; u.pn = pn; u.kind = 0; return true; }
};
template <bool FIRST, bool NEXT>
struct EpiNorm {
    const float* xin; float* xout; bf16_t* h; const float* g_post;
    const float* rin; float* rout;
    WsBuf wsb, outb;
    float* slots; unsigned* cnt;
    __device__ __forceinline__ void exchange(const f32x4 (&v)[2][2][4][2], int pm, int pn, int wr, int wc, int fr, int fq, LAS unsigned char* lds, int wid, int lane, float* sl, unsigned* cn, float* ro) const {
        LAS float* P = (LAS float*)lds; LAS float* S = (LAS float*)(lds + 4096);
#pragma unroll
        for (int ai = 0; ai < 2; ++ai)
#pragma unroll
            for (int m = 0; m < 4; ++m) { float s = 0.f;
#pragma unroll
                for (int bj = 0; bj < 2; ++bj)
#pragma unroll
                    for (int n = 0; n < 2; ++n) { const f32x4 x = v[ai][bj][m][n]; s += (x.x * x.x + x.y * x.y) + (x.z * x.z + x.w * x.w); }
                s += sx<16>(s); s = xsum32(s);
                if (fq == 0) P[(ai * 128 + wr * 64 + m * 16 + fr) * 4 + wc] = s; }
        asm volatile("s_waitcnt lgkmcnt(0)" ::: "memory"); __builtin_amdgcn_s_barrier(); asm volatile("" ::: "memory");
        const int row = wid * 32 + (lane & 31);
        if (lane < 32) { const f32x4 p4 = *(const LAS f32x4*)(P + row * 4); const float tot = (p4.x + p4.y) + (p4.z + p4.w);
            __hip_atomic_store((unsigned*)sl + ((size_t)pm * 256 + row) * 4 + pn, __float_as_uint(tot), __ATOMIC_RELAXED, __HIP_MEMORY_SCOPE_AGENT); }
        asm volatile("s_waitcnt vmcnt(0)" ::: "memory");
        if (lane == 0) __hip_atomic_fetch_add(cn, 1u, __ATOMIC_RELAXED, __HIP_MEMORY_SCOPE_AGENT);
        if (wid == 0) { for (unsigned sp = 0; sp < (1u << 20); ++sp) { if ((unsigned)__builtin_amdgcn_readfirstlane(__hip_atomic_load(cn, __ATOMIC_RELAXED, __HIP_MEMORY_SCOPE_AGENT)) >= 32u) break; __builtin_amdgcn_s_sleep(2); } }
        asm volatile("s_waitcnt vmcnt(0) lgkmcnt(0)" ::: "memory"); __builtin_amdgcn_s_barrier(); asm volatile("" ::: "memory");
        if (lane < 32) { const unsigned* sp4 = (const unsigned*)sl + ((size_t)pm * 256 + row) * 4; float tot = 0.f;
#pragma unroll
            for (int t = 0; t < 4; ++t) tot += __uint_as_float(__hip_atomic_load(sp4 + t, __ATOMIC_RELAXED, __HIP_MEMORY_SCOPE_AGENT));
            const float ms = tot * (1.f / 1024.f) + EPS, rs = rsqrtf(ms); S[row] = rs; if (ro && pn == 0) ro[(size_t)pm * 256 + row] = ms * rs; }
        asm volatile("s_waitcnt lgkmcnt(0)" ::: "memory"); __builtin_amdgcn_s_barrier(); asm volatile("" ::: "memory");
    }
    __device__ __forceinline__ void fused(f32x4 (&acc)[2][2][4][2], const UnitD& u, int wr, int wc, int fr, int fq, LAS unsigned char* lds, int wid, int lane) const {
        const LAS float* S = (const LAS float*)(lds + 4096);
        const int lc = wc * 32 + 8 * fq, col0 = 256 * u.pn + lc;
        u32x4 xr[4][2][FIRST ? 2 : 1]; float ri[4];
        load_res<0, PRE_M>(xr, ri, u.pm, 0, wr, fr, col0);
        exchange(acc, u.pm, u.pn, wr, wc, fr, fq, lds, wid, lane, slots, cnt + u.pm * 16, nullptr);
        load_res<PRE_M, 4>(xr, ri, u.pm, 0, wr, fr, col0);
        f32x4 gp[2][2];
#pragma unroll
        for (int bj = 0; bj < 2; ++bj) { gp[bj][0] = *(const f32x4*)(g_post + col0 + bj * 128); gp[bj][1] = *(const f32x4*)(g_post + col0 + bj * 128 + 4); }
#pragma unroll
        for (int ai = 0; ai < 2; ++ai) {
            if (ai == 1) {
#pragma unroll
                for (int m = 0; m < 4; ++m)
#pragma unroll
                    for (int bj = 0; bj < 2; ++bj) { asm volatile("" : "+v"(acc[0][bj][m][0]), "+v"(acc[0][bj][m][1]) :: "memory"); }
                load_res<0, 4>(xr, ri, u.pm, 1, wr, fr, col0); }
#pragma unroll
            for (int m = 0; m < 4; ++m) { const int r = ai * 128 + wr * 64 + m * 16 + fr; const float rs = S[r]; const size_t off = ((size_t)u.pm * 256 + r) * 1024 + col0;
#pragma unroll
                for (int bj = 0; bj < 2; ++bj) { f32x4 x0, x1;
                    if (FIRST) { x0 = __builtin_bit_cast(f32x4, xr[m][bj][0]); x1 = __builtin_bit_cast(f32x4, xr[m][bj][FIRST ? 1 : 0]); }
                    else { const u32x4 hb = xr[m][bj][0]; x0 = (f32x4){bf_lo(hb.x), bf_hi(hb.x), bf_lo(hb.y), bf_hi(hb.y)} * ri[m]; x1 = (f32x4){bf_lo(hb.z), bf_hi(hb.z), bf_lo(hb.w), bf_hi(hb.w)} * ri[m]; }
                    const f32x4 y0 = x0 + acc[ai][bj][m][0] * rs * gp[bj][0], y1 = x1 + acc[ai][bj][m][1] * rs * gp[bj][1];
                    acc[ai][bj][m][0] = y0; acc[ai][bj][m][1] = y1;
                    if (!NEXT) { st16_sel<WT_OUT>(outb, xout + off + bj * 128, __builtin_bit_cast(u32x4, y0)); st16_sel<WT_OUT>(outb, xout + off + bj * 128 + 4, __builtin_bit_cast(u32x4, y1)); } } } }
        if (NEXT) {
            exchange(acc, u.pm, u.pn, wr, wc, fr, fq, lds, wid, lane, slots + (size_t)T * 4, cnt + 64 * 16 + u.pm * 16, rout);
#pragma unroll
            for (int ai = 0; ai < 2; ++ai)
#pragma unroll
                for (int m = 0; m < 4; ++m) { const int r = ai * 128 + wr * 64 + m * 16 + fr; const float rs = S[r]; const size_t off = ((size_t)u.pm * 256 + r) * 1024 + col0;
#pragma unroll
                    for (int bj = 0; bj < 2; ++bj) { const f32x4 y0 = acc[ai][bj][m][0] * rs, y1 = acc[ai][bj][m][1] * rs;
                        u32x4 w; w.x = pk_bf16(y0.x, y0.y); w.y = pk_bf16(y0.z, y0.w); w.z = pk_bf16(y1.x, y1.y); w.w = pk_bf16(y1.z, y1.w);
                        st16_sel<WT_NORM>(wsb, h + off + bj * 128, w); } }
        }
    }
    static constexpr int PRE_M = 4;
    template <int M0, int M1>
    __device__ __forceinline__ void load_res(u32x4 (&xr)[4][2][FIRST ? 2 : 1], float (&ri)[4], int pm, int ai, int wr, int fr, int col0) const {
#pragma unroll
        for (int m = M0; m < M1; ++m) { const size_t row = (size_t)pm * 256 + ai * 128 + wr * 64 + m * 16 + fr, off = row * 1024 + col0;
            if (FIRST) { ri[m] = 1.f;
#pragma unroll
                for (int bj = 0; bj < 2; ++bj) { xr[m][bj][0] = *(const u32x4*)(xin + off + bj * 128); xr[m][bj][FIRST ? 1 : 0] = *(const u32x4*)(xin + off + bj * 128 + 4); } }
            else { ri[m] = rin[row];
#pragma unroll
                for (int bj = 0; bj < 2; ++bj) xr[m][bj][0] = *(const u32x4*)(h + off + bj * 128); } }
    }
    __device__ __forceinline__ void operator()(f32x4 (&)[2][2][4][2], const UnitD&, int, int, int, int) const {}
};
typedef float f32x2v __attribute__((ext_vector_type(2)));

constexpr int LRU_HIN_OFF = RING_BYTES + 1024;
template <int PASS>
__device__ __forceinline__ void lru_item(const Frame& F, const Args& a, const unsigned char* ws, const bool nostore, int l, int item, const bf16_t* xcb, bf16_t* y, float* agg) {
    const int b = item >> 5, k = item & 31; const size_t r0 = (size_t)b * SEQ + (size_t)k * 64;
    int lane_ = lane_id(); asm volatile("" : "+v"(lane_));
    const int lane = lane_, cl = lane & 15, kg = lane >> 4;
    LAS unsigned char* xt = F.lds + F.wave * 16384;
    const bf16_t* lwa = (const bf16_t*)(ws + WS_LW); const bf16_t* lwx = lwa + 16 * 80 * 96;
    const float* lct = (const float*)(ws + WS_LCT);
    LAS float* hin_l = (LAS float*)(F.lds + LRU_HIN_OFF);
    if (PASS == 2) {
        for (int c = F.wave * 64 + lane; c < 1280; c += 512) { const float* ag = agg + ((size_t)b * 32 * 1280 + c) * 2; float h = 0.f;
#pragma unroll 8
            for (int j = 0; j < k; ++j) { const f32x2v ab = *(const f32x2v*)(ag + (size_t)j * 2560); h = ab.x * h + ab.y; }
            hin_l[c] = h; }
        LDS_WAIT(); __syncthreads();
    }
#pragma unroll 1
    for (int bi = 0; bi < 2; ++bi) {
        const int blk = 2 * F.wave + bi;
        {
            u32x4 xch[11]; int ln = lane; asm volatile("" : "+v"(ln));
            const bf16_t* xbase = xcb + (r0 - 3) * 1280 + blk * 80;
#pragma unroll
            for (int i = 0; i < 11; ++i) { const int idx = ln + 64 * i; const int row = idx / 10, ch = idx - row * 10; xch[i] = (u32x4){0u, 0u, 0u, 0u};
                if (idx < 670 && !(k == 0 && row < 3)) xch[i] = *(const u32x4*)(xbase + (unsigned)(row * 1280 + ch * 8)); }
#pragma unroll
            for (int i = 0; i < 11; ++i) { const int idx = ln + 64 * i; const int row = idx / 10, ch = idx - row * 10; if (idx < 670) *(LAS u32x4*)(xt + row * 208 + ch * 16) = xch[i]; }
            LAS u32x4* z = (LAS u32x4*)(xt + (lane + 3) * 208 + 160); z[0] = (u32x4){0u, 0u, 0u, 0u}; z[1] = (u32x4){0u, 0u, 0u, 0u};
        }
        LDS_WAIT(); asm volatile("" ::: "memory");
#pragma unroll
        for (int ct = 0; ct < 5; ++ct) { const int c = blk * 80 + 16 * ct + cl; const f32x4 cw = *(const f32x4*)(lct + c * 8); const float cb = lct[c * 8 + 4];
            float xv[4][7];
#pragma unroll
            for (int rt = 0; rt < 4; ++rt)
#pragma unroll
                for (int j = 0; j < 7; ++j) xv[rt][j] = bf1(*(const LAS bf16_t*)(xt + (16 * rt + 4 * kg + j) * 208 + (16 * ct + cl) * 2));
            asm volatile("" ::: "memory");
#pragma unroll
            for (int rt = 0; rt < 4; ++rt)
#pragma unroll
                for (int e = 0; e < 4; ++e) { const float v = cb + cw.x * xv[rt][e] + cw.y * xv[rt][e + 1] + cw.z * xv[rt][e + 2] + cw.w * xv[rt][e + 3];
                    *(LAS bf16_t*)(xt + (16 * rt + 4 * kg + e + 3) * 208 + (16 * ct + cl) * 2) = f2bf(v); }
            asm volatile("" ::: "memory"); }
        LDS_WAIT(); asm volatile("" ::: "memory");
        bf16x8 af[4][3];
#pragma unroll
        for (int rt = 0; rt < 4; ++rt)
#pragma unroll
            for (int ks = 0; ks < 3; ++ks) af[rt][ks] = *(const LAS bf16x8*)(xt + (16 * rt + cl + 3) * 208 + (32 * ks + 8 * kg) * 2);
        bf16x8 wA[2][3], wX[2][3];
#pragma unroll
        for (int ks = 0; ks < 3; ++ks) { const size_t wo = ((size_t)blk * 80 + cl) * 96 + 32 * ks + 8 * kg; wA[0][ks] = *(const bf16x8*)(lwa + wo); wX[0][ks] = *(const bf16x8*)(lwx + wo); }
#pragma unroll
        for (int ct = 0; ct < 5; ++ct) { const int c = blk * 80 + 16 * ct + cl; const int cur = ct & 1;
            if (ct + 1 < 5) {
#pragma unroll
                for (int ks = 0; ks < 3; ++ks) { const size_t wo = ((size_t)blk * 80 + 16 * (ct + 1) + cl) * 96 + 32 * ks + 8 * kg; wA[cur ^ 1][ks] = *(const bf16x8*)(lwa + wo); wX[cur ^ 1][ks] = *(const bf16x8*)(lwx + wo); } }
            const f32x4 c1 = *(const f32x4*)(lct + c * 8 + 4); const float ba_c = c1.y, bx_c = c1.z, sp8 = c1.w;
            f32x4 ra[4], rx[4];
#pragma unroll
            for (int rt = 0; rt < 4; ++rt) { ra[rt] = (f32x4){0.f, 0.f, 0.f, 0.f}; rx[rt] = (f32x4){0.f, 0.f, 0.f, 0.f}; }
#pragma unroll
            for (int ks = 0; ks < 3; ++ks)
#pragma unroll
                for (int rt = 0; rt < 4; ++rt) { ra[rt] = __builtin_amdgcn_mfma_f32_16x16x32_bf16(af[rt][ks], wA[cur][ks], ra[rt], 0, 0, 0); rx[rt] = __builtin_amdgcn_mfma_f32_16x16x32_bf16(af[rt][ks], wX[cur][ks], rx[rt], 0, 0, 0); }
            float hin = (PASS == 2) ? hin_l[c] : 0.f; float totA = 1.f, totB = 0.f;
#pragma unroll
            for (int rt = 0; rt < 4; ++rt) { float av[4], bv[4];
#pragma unroll
                for (int e = 0; e < 4; ++e) { const float r = __builtin_amdgcn_rcpf(1.f + fexp2(fmaf(ra[rt][e], -1.4426950408889634f, ba_c))), ig = __builtin_amdgcn_rcpf(1.f + fexp2(fmaf(rx[rt][e], -1.4426950408889634f, bx_c)));
                    const float aa = fexp2(sp8 * r); const float mult = __builtin_amdgcn_sqrtf(fmaxf(1.f - aa * aa, 0.f));
                    const float xcv = bf1(*(const LAS bf16_t*)(xt + (16 * rt + 4 * kg + e + 3) * 208 + (16 * ct + cl) * 2));
                    av[e] = aa; bv[e] = mult * ig * xcv; }
                float sA = av[0], sB = bv[0];
#pragma unroll
                for (int e = 1; e < 4; ++e) { sB = av[e] * sB + bv[e]; sA *= av[e]; }
                float iA = sA, iB = sB;
                { const float pA = __shfl(iA, lane - 16), pB = __shfl(iB, lane - 16); if (kg >= 1) { iB = iA * pB + iB; iA = iA * pA; } }
                { const float pA = __shfl(iA, lane - 32), pB = __shfl(iB, lane - 32); if (kg >= 2) { iB = iA * pB + iB; iA = iA * pA; } }
                const float tA = __shfl(iA, 48 + cl), tB = __shfl(iB, 48 + cl);
                if (PASS == 1) { totB = tA * totB + tB; totA *= tA; }
                else {
                    float eA = __shfl(iA, lane - 16), eB = __shfl(iB, lane - 16); if (kg == 0) { eA = 1.f; eB = 0.f; }
                    float h = eA * hin + eB;
#pragma unroll
                    for (int e = 0; e < 4; ++e) { h = av[e] * h + bv[e]; *(LAS bf16_t*)(xt + (16 * rt + 4 * kg + e + 3) * 208 + (16 * ct + cl) * 2) = f2bf(h); }
                    hin = tA * hin + tB;
                }
            }
            if (PASS == 1) { if (kg == 0) *(f32x2v*)(agg + (((size_t)b * 32 + k) * 1280 + c) * 2) = (f32x2v){totA, totB}; }
        }
        LDS_WAIT(); asm volatile("" ::: "memory");
        if (PASS == 2) {
            int ln = lane; asm volatile("" : "+v"(ln));
            bf16_t* ybase = y + r0 * YLD + 2048 + blk * 80; u32x4 zc[10];
#pragma unroll
            for (int i = 0; i < 10; ++i) { const int idx = ln + 64 * i; const int row = idx / 10, ch = idx - row * 10; zc[i] = *(const u32x4*)(ybase + (unsigned)(row * YLD + ch * 8)); }
#pragma unroll
            for (int i = 0; i < 10; ++i) { const int idx = ln + 64 * i; const int row = idx / 10, ch = idx - row * 10; const u32x4 hv = *(const LAS u32x4*)(xt + (row + 3) * 208 + ch * 16); u32x4 o;
                o.x = pk_bf16(bf_lo(hv.x) * bf_lo(zc[i].x), bf_hi(hv.x) * bf_hi(zc[i].x)); o.y = pk_bf16(bf_lo(hv.y) * bf_lo(zc[i].y), bf_hi(hv.y) * bf_hi(zc[i].y));
                o.z = pk_bf16(bf_lo(hv.z) * bf_lo(zc[i].z), bf_hi(hv.z) * bf_hi(zc[i].z)); o.w = pk_bf16(bf_lo(hv.w) * bf_lo(zc[i].w), bf_hi(hv.w) * bf_hi(zc[i].w));
                if (!nostore) *(u32x4*)(ybase + (unsigned)(row * YLD + ch * 8)) = o; }
            LDS_WAIT(); asm volatile("" ::: "memory");
        }
    }
    if (PASS == 2) __syncthreads();
}

constexpr int CW_LRUF = 8192;
__device__ __forceinline__ void lru_single(const Frame& F, const WsBuf& wsb, const unsigned char* ws, unsigned* ctl, const bool nostore, int l, int item, const bf16_t* xcb, bf16_t* y, float* agg) {
    const int b = item >> 5, k = item & 31; const size_t r0 = (size_t)b * SEQ + (size_t)k * 64;
    int lane_ = lane_id(); asm volatile("" : "+v"(lane_));
    const int lane = lane_, cl = lane & 15, kg = lane >> 4;
    LAS unsigned char* xt = F.lds + F.wave * 16384;
    const bf16_t* lwa = (const bf16_t*)(ws + WS_LW); const bf16_t* lwx = lwa + 16 * 80 * 96;
    const float* lct = (const float*)(ws + WS_LCT);
    const unsigned epoch = (unsigned)l + 1u;
    unsigned* flags = ctl + CW_LRUF + b * 32 * 16;
    unsigned long long* agg64 = (unsigned long long*)agg;
#pragma unroll 1
    for (int bi = 0; bi < 2; ++bi) {
        const int blk = 2 * F.wave + bi;
        {
            u32x4 xch[11]; int ln = lane; asm volatile("" : "+v"(ln));
            const bf16_t* xbase = xcb + (r0 - 3) * 1280 + blk * 80;
#pragma unroll
            for (int i = 0; i < 11; ++i) { const int idx = ln + 64 * i; const int row = idx / 10, ch = idx - row * 10; xch[i] = (u32x4){0u, 0u, 0u, 0u};
                if (idx < 670 && !(k == 0 && row < 3)) xch[i] = *(const u32x4*)(xbase + (unsigned)(row * 1280 + ch * 8)); }
#pragma unroll
            for (int i = 0; i < 11; ++i) { const int idx = ln + 64 * i; const int row = idx / 10, ch = idx - row * 10; if (idx < 670) *(LAS u32x4*)(xt + row * 208 + ch * 16) = xch[i]; }
            LAS u32x4* z = (LAS u32x4*)(xt + (lane + 3) * 208 + 160); z[0] = (u32x4){0u, 0u, 0u, 0u}; z[1] = (u32x4){0u, 0u, 0u, 0u};
        }
        LDS_WAIT(); asm volatile("" ::: "memory");
#pragma unroll
        for (int ct = 0; ct < 5; ++ct) { const int c = blk * 80 + 16 * ct + cl; const f32x4 cw = *(const f32x4*)(lct + c * 8); const float cb = lct[c * 8 + 4];
            float xv[4][7];
#pragma unroll
            for (int rt = 0; rt < 4; ++rt)
#pragma unroll
                for (int j = 0; j < 7; ++j) xv[rt][j] = bf1(*(const LAS bf16_t*)(xt + (16 * rt + 4 * kg + j) * 208 + (16 * ct + cl) * 2));
            asm volatile("" ::: "memory");
#pragma unroll
            for (int rt = 0; rt < 4; ++rt)
#pragma unroll
                for (int e = 0; e < 4; ++e) { const float v = cb + cw.x * xv[rt][e] + cw.y * xv[rt][e + 1] + cw.z * xv[rt][e + 2] + cw.w * xv[rt][e + 3];
                    *(LAS bf16_t*)(xt + (16 * rt + 4 * kg + e + 3) * 208 + (16 * ct + cl) * 2) = f2bf(v); }
            asm volatile("" ::: "memory"); }
        LDS_WAIT(); asm volatile("" ::: "memory");
        bf16x8 af[4][3];
#pragma unroll
        for (int rt = 0; rt < 4; ++rt)
#pragma unroll
            for (int ks = 0; ks < 3; ++ks) af[rt][ks] = *(const LAS bf16x8*)(xt + (16 * rt + cl + 3) * 208 + (32 * ks + 8 * kg) * 2);
        bf16x8 wA[3], wX[3];
#pragma unroll
        for (int ks = 0; ks < 3; ++ks) { const size_t wo = ((size_t)blk * 80 + cl) * 96 + 32 * ks + 8 * kg; wA[ks] = *(const bf16x8*)(lwa + wo); wX[ks] = *(const bf16x8*)(lwx + wo); }
        unsigned pk[5][4][2];
#pragma unroll
        for (int ct = 0; ct < 5; ++ct) { const int c = blk * 80 + 16 * ct + cl;
            const f32x4 c1 = *(const f32x4*)(lct + c * 8 + 4); const float ba_c = c1.y, bx_c = c1.z, sp8 = c1.w;
            f32x4 ra[4], rx[4];
#pragma unroll
            for (int rt = 0; rt < 4; ++rt) { ra[rt] = (f32x4){0.f, 0.f, 0.f, 0.f}; rx[rt] = (f32x4){0.f, 0.f, 0.f, 0.f}; }
#pragma unroll
            for (int ks = 0; ks < 3; ++ks)
#pragma unroll
                for (int rt = 0; rt < 4; ++rt) { ra[rt] = __builtin_amdgcn_mfma_f32_16x16x32_bf16(af[rt][ks], wA[ks], ra[rt], 0, 0, 0); rx[rt] = __builtin_amdgcn_mfma_f32_16x16x32_bf16(af[rt][ks], wX[ks], rx[rt], 0, 0, 0); }
            if (ct + 1 < 5) {
#pragma unroll
                for (int ks = 0; ks < 3; ++ks) { const size_t wo = ((size_t)blk * 80 + 16 * (ct + 1) + cl) * 96 + 32 * ks + 8 * kg; wA[ks] = *(const bf16x8*)(lwa + wo); wX[ks] = *(const bf16x8*)(lwx + wo); } }
            float av[4][4], bv[4][4], iA[4], iB[4];
#pragma unroll
            for (int rt = 0; rt < 4; ++rt) {
#pragma unroll
                for (int e = 0; e < 4; ++e) { const float r = __builtin_amdgcn_rcpf(1.f + fexp2(fmaf(ra[rt][e], -1.4426950408889634f, ba_c))), ig = __builtin_amdgcn_rcpf(1.f + fexp2(fmaf(rx[rt][e], -1.4426950408889634f, bx_c)));
                    const float aa = fexp2(sp8 * r); const float mult = __builtin_amdgcn_sqrtf(fmaxf(1.f - aa * aa, 0.f));
                    const float xcv = bf1(*(const LAS bf16_t*)(xt + (16 * rt + 4 * kg + e + 3) * 208 + (16 * ct + cl) * 2));
                    av[rt][e] = aa; bv[rt][e] = mult * ig * xcv; }
                float sA = av[rt][0], sB = bv[rt][0];
#pragma unroll
                for (int e = 1; e < 4; ++e) { sB = av[rt][e] * sB + bv[rt][e]; sA *= av[rt][e]; }
                iA[rt] = sA; iB[rt] = sB; }
            { float pA[4], pB[4];
#pragma unroll
              for (int rt = 0; rt < 4; ++rt) { pA[rt] = __shfl(iA[rt], lane - 16); pB[rt] = __shfl(iB[rt], lane - 16); }
#pragma unroll
              for (int rt = 0; rt < 4; ++rt) if (kg >= 1) { iB[rt] = iA[rt] * pB[rt] + iB[rt]; iA[rt] = iA[rt] * pA[rt]; }
#pragma unroll
              for (int rt = 0; rt < 4; ++rt) { pA[rt] = __shfl(iA[rt], lane - 32); pB[rt] = __shfl(iB[rt], lane - 32); }
#pragma unroll
              for (int rt = 0; rt < 4; ++rt) if (kg >= 2) { iB[rt] = iA[rt] * pB[rt] + iB[rt]; iA[rt] = iA[rt] * pA[rt]; } }
            float tA[4], tB[4], eA[4], eB[4];
#pragma unroll
            for (int rt = 0; rt < 4; ++rt) { tA[rt] = __shfl(iA[rt], 48 + cl); tB[rt] = __shfl(iB[rt], 48 + cl); eA[rt] = __shfl(iA[rt], lane - 16); eB[rt] = __shfl(iB[rt], lane - 16); }
            float hl = 0.f, pl = 1.f;
#pragma unroll
            for (int rt = 0; rt < 4; ++rt) { if (kg == 0) { eA[rt] = 1.f; eB[rt] = 0.f; }
                float h = eA[rt] * hl + eB[rt], pp = eA[rt] * pl, P[4];
#pragma unroll
                for (int e = 0; e < 4; ++e) { h = av[rt][e] * h + bv[rt][e]; pp *= av[rt][e]; P[e] = pp;
                    *(LAS bf16_t*)(xt + (16 * rt + 4 * kg + e + 3) * 208 + (16 * ct + cl) * 2) = f2bf(h); }
                pk[ct][rt][0] = pk_bf16(P[0], P[1]); pk[ct][rt][1] = pk_bf16(P[2], P[3]);
                hl = tA[rt] * hl + tB[rt]; pl *= tA[rt];
            }
            if (kg == 0) __hip_atomic_store(agg64 + ((size_t)b * 32 + k) * 1280 + c, ((unsigned long long)__float_as_uint(hl) << 32) | (unsigned long long)__float_as_uint(pl), __ATOMIC_RELAXED, __HIP_MEMORY_SCOPE_AGENT);
        }
        asm volatile("s_waitcnt vmcnt(0)" ::: "memory");
        if (lane == 0) __hip_atomic_store(flags + k * 16 + blk, epoch, __ATOMIC_RELAXED, __HIP_MEMORY_SCOPE_AGENT);
        if (k > 0) {
            for (unsigned spins = 0; spins < (1u << 20); ++spins) {
                const unsigned f = (lane < k) ? __hip_atomic_load(flags + lane * 16 + blk, __ATOMIC_RELAXED, __HIP_MEMORY_SCOPE_AGENT) : epoch;
                if (__all(f == epoch)) break;
                __builtin_amdgcn_s_sleep(2);
            }
            float fa[5], fb[5];
#pragma unroll
            for (int ct = 0; ct < 5; ++ct) { fa[ct] = 1.f; fb[ct] = 0.f; }
            const int j0 = (k * kg) >> 2, j1 = (k * (kg + 1)) >> 2;
            const unsigned long long* ag0 = agg64 + (size_t)b * 32 * 1280 + blk * 80 + cl;
            {
                unsigned long long w[8][5];
#pragma unroll
                for (int jj = 0; jj < 8; ++jj)
#pragma unroll
                    for (int ct = 0; ct < 5; ++ct) w[jj][ct] = (j0 + jj < j1) ? __hip_atomic_load(ag0 + (size_t)(j0 + jj) * 1280 + 16 * ct, __ATOMIC_RELAXED, __HIP_MEMORY_SCOPE_AGENT) : 0x000000003f800000ull;
#pragma unroll
                for (int jj = 0; jj < 8; ++jj)
#pragma unroll
                    for (int ct = 0; ct < 5; ++ct) { const float A = __uint_as_float((unsigned)w[jj][ct]), B = __uint_as_float((unsigned)(w[jj][ct] >> 32)); fb[ct] = A * fb[ct] + B; fa[ct] *= A; } }
#pragma unroll
            for (int ct = 0; ct < 5; ++ct) { float iA = fa[ct], iB = fb[ct];
                { const float pA = __shfl(iA, lane - 16), pB = __shfl(iB, lane - 16); if (kg >= 1) { iB = iA * pB + iB; iA = iA * pA; } }
                { const float pA = __shfl(iA, lane - 32), pB = __shfl(iB, lane - 32); if (kg >= 2) { iB = iA * pB + iB; iA = iA * pA; } }
                const float cin = __shfl(iB, 48 + cl);
#pragma unroll
                for (int rt = 0; rt < 4; ++rt) { const float P[4] = {bf_lo(pk[ct][rt][0]), bf_hi(pk[ct][rt][0]), bf_lo(pk[ct][rt][1]), bf_hi(pk[ct][rt][1])};
#pragma unroll
                    for (int e = 0; e < 4; ++e) { LAS bf16_t* hp = (LAS bf16_t*)(xt + (16 * rt + 4 * kg + e + 3) * 208 + (16 * ct + cl) * 2); *hp = f2bf(bf1(*hp) + P[e] * cin); } } }
        }
        LDS_WAIT(); asm volatile("" ::: "memory");
        {
            int ln = lane; asm volatile("" : "+v"(ln));
            bf16_t* ybase = y + r0 * YLD + 2048 + blk * 80; u32x4 zc[10];
#pragma unroll
            for (int i = 0; i < 10; ++i) { const int idx = ln + 64 * i; const int row = idx / 10, ch = idx - row * 10; zc[i] = *(const u32x4*)(ybase + (unsigned)(row * YLD + ch * 8)); }
#pragma unroll
            for (int i = 0; i < 10; ++i) { const int idx = ln + 64 * i; const int row = idx / 10, ch = idx - row * 10; const u32x4 hv = *(const LAS u32x4*)(xt + (row + 3) * 208 + ch * 16); u32x4 o;
                o.x = pk_bf16(bf_lo(hv.x) * bf_lo(zc[i].x), bf_hi(hv.x) * bf_hi(zc[i].x)); o.y = pk_bf16(bf_lo(hv.y) * bf_lo(zc[i].y), bf_hi(hv.y) * bf_hi(zc[i].y));
                o.z = pk_bf16(bf_lo(hv.z) * bf_lo(zc[i].z), bf_hi(hv.z) * bf_hi(zc[i].z)); o.w = pk_bf16(bf_lo(hv.w) * bf_lo(zc[i].w), bf_hi(hv.w) * bf_hi(zc[i].w));
                if (!nostore) st16_sel<WT_MIX>(wsb, ybase + (unsigned)(row * YLD + ch * 8), o); }
            LDS_WAIT(); asm volatile("" ::: "memory");
        }
    }
}
__device__ __forceinline__ void phaseB_lru(const Frame& F, const WsBuf& wsb, const unsigned char* ws, unsigned* ctl, const bool nostore, int l, const bf16_t* xc, bf16_t* y, float* agg) {
    for (int item = F.vcu; item < NBATCH * 32; item += F.G) lru_single(F, wsb, ws, ctl, nostore, l, item, xc, y, agg);
}

__device__ __forceinline__ void phaseB_extra(const Frame& F, const Args& a, const unsigned char* ws, int l, const bf16_t* misc, bf16_t* kr, const bf16_t* xc, float* agg, const float* cs, const float* sn) {
    for (int item = F.vcu; item < NBATCH * 32; item += F.G) lru_item<1>(F, a, ws, false, l, item, xc, nullptr, agg);
}

namespace att {
constexpr int SHM_V = 64 * 128 * 2, SHM_K = 64 * 192 * 2, OFF_K = 2 * SHM_V, OFF_WS = OFF_K + 2 * SHM_K, LDS_TOTAL = OFF_WS + 8 * 64 * 4;
constexpr float THR = 8.f;
constexpr float NEGBIG = -1e30f;
constexpr int KVBLK_ = 64;
#define ATT_SBAR() __builtin_amdgcn_sched_barrier(0)
__device__ __forceinline__ int crow(int r, int hi) { return (r & 3) + 8 * (r >> 2) + 4 * hi; }
__device__ __forceinline__ int koff(int row, int sub, int chunk) { return sub * 8192 + row * 128 + ((chunk ^ ((row >> 1) & 7)) << 4); }
__device__ __forceinline__ void partialSM(f32x16& p0, f32x16& p1, float& m_reg, float& alpha) {
    float pmax = p0[0];
#pragma unroll
    for (int r = 1; r < 16; ++r) pmax = fmaxf(pmax, p0[r]);
#pragma unroll
    for (int r = 0; r < 16; ++r) pmax = fmaxf(pmax, p1[r]);
    { auto rr = __builtin_amdgcn_permlane32_swap(__float_as_uint(pmax), __float_as_uint(pmax), false, false); pmax = fmaxf(__uint_as_float(rr[0]), __uint_as_float(rr[1])); }
    float mn;
    if (__builtin_expect(__all(pmax - m_reg <= THR), 1)) { mn = m_reg; alpha = 1.f; }
    else { mn = fmaxf(m_reg, pmax); alpha = __builtin_amdgcn_exp2f(m_reg - mn); m_reg = mn; }
#pragma unroll
    for (int r = 0; r < 16; ++r) p0[r] = __builtin_amdgcn_exp2f(p0[r] - mn);
#pragma unroll
    for (int r = 0; r < 16; ++r) p1[r] = p1[r] - mn;
}
__device__ __forceinline__ void finishSM(f32x16& p0, f32x16& p1, float alpha, float& l_reg, bf16x8& pa0, bf16x8& pa1, bf16x8& pa2, bf16x8& pa3) {
#pragma unroll
    for (int r = 0; r < 16; ++r) p1[r] = __builtin_amdgcn_exp2f(p1[r]);
    float ps = 0.f;
#pragma unroll
    for (int r = 0; r < 16; ++r) ps += p0[r];
#pragma unroll
    for (int r = 0; r < 16; ++r) ps += p1[r];
    { auto rr = __builtin_amdgcn_permlane32_swap(__float_as_uint(ps), __float_as_uint(ps), false, false); ps = __uint_as_float(rr[0]) + __uint_as_float(rr[1]); }
    l_reg = l_reg * alpha + ps;
#define ATT_PK4(P, BASE, OUT) do { unsigned a0 = pk_bf16(P[BASE + 0], P[BASE + 1]), a1 = pk_bf16(P[BASE + 2], P[BASE + 3]);   \
    unsigned b0 = pk_bf16(P[BASE + 4], P[BASE + 5]), b1 = pk_bf16(P[BASE + 6], P[BASE + 7]);                              \
    auto r0 = __builtin_amdgcn_permlane32_swap(a0, b0, false, false); auto r1 = __builtin_amdgcn_permlane32_swap(a1, b1, false, false); \
    u32x4 w = {r0[0], r1[0], r0[1], r1[1]}; OUT = __builtin_bit_cast(bf16x8, w); } while (0)
    ATT_PK4(p0, 0, pa0); ATT_PK4(p0, 8, pa1); ATT_PK4(p1, 0, pa2); ATT_PK4(p1, 8, pa3);
#undef ATT_PK4
}
__device__ __forceinline__ void qkt(f32x16& p0, f32x16& p1, const LAS unsigned char* Ks, const bf16x8* qr, int r32, int hi) {
    p0 = f32x16{}; p1 = f32x16{};
#pragma unroll
    for (int d0 = 0; d0 < 12; ++d0) { const int sub = d0 >> 2, chunk = (d0 & 3) * 2 + hi;
        const bf16x8 b0 = *(const LAS bf16x8*)(Ks + koff(r32, sub, chunk));
        const bf16x8 b1 = *(const LAS bf16x8*)(Ks + koff(32 + r32, sub, chunk));
        p0 = __builtin_amdgcn_mfma_f32_32x32x16_bf16(b0, qr[d0], p0, 0, 0, 0);
        p1 = __builtin_amdgcn_mfma_f32_32x32x16_bf16(b1, qr[d0], p1, 0, 0, 0);
        if ((d0 & 3) == 3) ATT_SBAR(); }
}
__device__ __forceinline__ int v_st(int k, int c) { const int kk = (k & ~0xC) | ((k & 4) << 1) | ((k & 8) >> 1); return ((kk >> 3) * 4 + (c >> 5)) * 512 + ((kk & 7) * 32 + (c & 31)) * 2; }
__device__ __forceinline__ int v_rd_base(int lane) { return ((lane & 3) << 3) | (((lane >> 2) & 3) << 6) | (((lane >> 4) & 1) << 5) | (((lane >> 5) & 1) << 8); }
constexpr int v_rd_off(int d0, int ks, int half) { return d0 * 512 + ks * 4096 + half * 2048; }
template <int OFF> __device__ __forceinline__ s16x4 tr_read(int vb) { s16x4 r; asm volatile("ds_read_b64_tr_b16 %0, %1 offset:%2" : "=&v"(r) : "v"(vb), "i"(OFF) : "memory"); return r; }
template <int D0> __device__ __forceinline__ void pv_one(f32x16& od, int vb, bf16x8 pa0, bf16x8 pa1, bf16x8 pa2, bf16x8 pa3) {
    const s16x4 l0 = tr_read<v_rd_off(D0, 0, 0)>(vb), h0 = tr_read<v_rd_off(D0, 0, 1)>(vb), l1 = tr_read<v_rd_off(D0, 1, 0)>(vb), h1 = tr_read<v_rd_off(D0, 1, 1)>(vb);
    const s16x4 l2 = tr_read<v_rd_off(D0, 2, 0)>(vb), h2 = tr_read<v_rd_off(D0, 2, 1)>(vb), l3 = tr_read<v_rd_off(D0, 3, 0)>(vb), h3 = tr_read<v_rd_off(D0, 3, 1)>(vb);
    asm volatile("s_waitcnt lgkmcnt(0)" ::: "memory"); ATT_SBAR();
#define ATT_PK(L, H) (bf16x8){L[0], L[1], L[2], L[3], H[0], H[1], H[2], H[3]}
    od = __builtin_amdgcn_mfma_f32_32x32x16_bf16(pa0, ATT_PK(l0, h0), od, 0, 0, 0);
    od = __builtin_amdgcn_mfma_f32_32x32x16_bf16(pa1, ATT_PK(l1, h1), od, 0, 0, 0);
    od = __builtin_amdgcn_mfma_f32_32x32x16_bf16(pa2, ATT_PK(l2, h2), od, 0, 0, 0);
    od = __builtin_amdgcn_mfma_f32_32x32x16_bf16(pa3, ATT_PK(l3, h3), od, 0, 0, 0);
#undef ATT_PK
}
__device__ __forceinline__ void pv_d0(f32x16* o, int vb, bf16x8 pa0, bf16x8 pa1, bf16x8 pa2, bf16x8 pa3) {
    pv_one<0>(o[0], vb, pa0, pa1, pa2, pa3); pv_one<1>(o[1], vb, pa0, pa1, pa2, pa3); pv_one<2>(o[2], vb, pa0, pa1, pa2, pa3); pv_one<3>(o[3], vb, pa0, pa1, pa2, pa3);
}

__device__ __forceinline__ void unit(const Frame& F, const WsBuf& wsb, const bool nostore, int b, int hd, int qb, const bf16_t* __restrict__ Q, bf16_t* Y, const bf16_t* __restrict__ VV, const bf16_t* __restrict__ KR) {
    int tid_ = F.wave * 64 + lane_id(); asm volatile("" : "+v"(tid_));
    const int tid = tid_, wid = F.wave, lane = tid & 63, r32 = lane & 31, hi = lane >> 5;
    LAS unsigned char* lds = F.lds;
    LAS unsigned char* V_lds = lds; LAS unsigned char* K_lds = lds + OFF_K;
    LAS float* wsf = (LAS float*)(lds + OFF_WS) + wid * 64; LAS float* li_l = wsf; LAS float* al_l = wsf + 32;
    const size_t rowbase = (size_t)b * SEQ; const int q0 = qb * 256; const int qc = 4 * qb + (wid >> 1); const int NT = 4 * qb + 4;
    float m_reg = NEGBIG, l_reg = 0.f; f32x16 o[4] = {}; bf16x8 qr[12];
    { const bf16_t* Qw = Q + (rowbase + q0 + wid * 32 + r32) * 1536 + hd * 192 + hi * 8;
#pragma unroll
      for (int d0 = 0; d0 < 12; ++d0) qr[d0] = *(const bf16x8*)(Qw + d0 * 16); }
    const bf16_t* Kn = Y + rowbase * YLD + hd * 128; const bf16_t* Vh = VV + rowbase * 1024 + hd * 128; const bf16_t* Kr = KR + rowbase * 64;
    const int sr = tid >> 4, sc = (tid & 15) * 8; const int vst0 = v_st(sr, sc), vst1 = v_st(32 + sr, sc);
    const int kst0 = koff(sr, sc >> 6, (sc & 63) >> 3), kst1 = koff(32 + sr, sc >> 6, (sc & 63) >> 3), kst2 = koff(tid >> 3, 2, tid & 7);
    const int vb0 = (int)(uintptr_t)V_lds + v_rd_base(lane);
    bf16x8 vs0, vs1, ks0, ks1, ks2;
#define ATT_SLOAD(k0) do { vs0 = *(const bf16x8*)(Vh + (size_t)((k0) + sr) * 1024 + sc); vs1 = *(const bf16x8*)(Vh + (size_t)((k0) + 32 + sr) * 1024 + sc); \
    ks0 = *(const bf16x8*)(Kn + (size_t)((k0) + sr) * YLD + sc); ks1 = *(const bf16x8*)(Kn + (size_t)((k0) + 32 + sr) * YLD + sc); \
    ks2 = *(const bf16x8*)(Kr + (size_t)((k0) + (tid >> 3)) * 64 + (tid & 7) * 8); } while (0)
#define ATT_SWRITE(bf) do { *(LAS bf16x8*)(V_lds + (bf) * SHM_V + vst0) = vs0; *(LAS bf16x8*)(V_lds + (bf) * SHM_V + vst1) = vs1; \
    *(LAS bf16x8*)(K_lds + (bf) * SHM_K + kst0) = ks0; *(LAS bf16x8*)(K_lds + (bf) * SHM_K + kst1) = ks1; *(LAS bf16x8*)(K_lds + (bf) * SHM_K + kst2) = ks2; } while (0)
#define ATT_RESC(al) do { if (__any((al) < 1.f)) { if (hi == 0) al_l[r32] = (al); asm volatile("s_waitcnt lgkmcnt(0)" ::: "memory"); \
    _Pragma("unroll") for (int d = 0; d < 4; ++d) _Pragma("unroll") for (int r = 0; r < 16; ++r) o[d][r] *= al_l[crow(r, hi)]; } } while (0)
#define ATT_QKT(P0, P1, bf, jt) do { if ((jt) <= qc) qkt(P0, P1, K_lds + (bf) * SHM_K, qr, r32, hi); else { _Pragma("unroll") for (int r = 0; r < 16; ++r) { P0[r] = NEGBIG; P1[r] = NEGBIG; } } } while (0)
    f32x16 pA0, pA1, pB0, pB1; float alA, alB; bf16x8 pa0, pa1, pa2, pa3;
    ATT_SLOAD(0); asm volatile("s_waitcnt vmcnt(0)" ::: "memory"); ATT_SWRITE(0); __syncthreads();
    ATT_SLOAD(KVBLK_); ATT_SBAR();
    ATT_QKT(pA0, pA1, 0, 0); partialSM(pA0, pA1, m_reg, alA);
    asm volatile("s_waitcnt vmcnt(0)" ::: "memory"); ATT_SWRITE(1); __syncthreads();
    for (int j = 1; j + 1 < NT; j += 2) {
        ATT_SBAR(); ATT_SLOAD((j + 1) * KVBLK_); ATT_SBAR();
        ATT_QKT(pB0, pB1, 1, j);
        finishSM(pA0, pA1, alA, l_reg, pa0, pa1, pa2, pa3); ATT_SBAR();
        if (j - 1 <= qc) pv_d0(o, vb0, pa0, pa1, pa2, pa3);
        partialSM(pB0, pB1, m_reg, alB);
        __syncthreads(); asm volatile("s_waitcnt vmcnt(0)" ::: "memory"); ATT_SWRITE(0);
        ATT_RESC(alB); __syncthreads();
        ATT_SBAR(); ATT_SLOAD((j + 2) * KVBLK_); ATT_SBAR();
        ATT_QKT(pA0, pA1, 0, j + 1);
        finishSM(pB0, pB1, alB, l_reg, pa0, pa1, pa2, pa3); ATT_SBAR();
        if (j <= qc) pv_d0(o, vb0 + SHM_V, pa0, pa1, pa2, pa3);
        partialSM(pA0, pA1, m_reg, alA);
        __syncthreads(); asm volatile("s_waitcnt vmcnt(0)" ::: "memory"); ATT_SWRITE(1);
        ATT_RESC(alA); __syncthreads();
    }
    ATT_SBAR(); ATT_QKT(pB0, pB1, 1, NT - 1);
    finishSM(pA0, pA1, alA, l_reg, pa0, pa1, pa2, pa3); ATT_SBAR();
    if (NT - 2 <= qc) pv_d0(o, vb0, pa0, pa1, pa2, pa3);
    partialSM(pB0, pB1, m_reg, alB);
    __syncthreads(); ATT_RESC(alB);
    finishSM(pB0, pB1, alB, l_reg, pa0, pa1, pa2, pa3); ATT_SBAR();
    if (NT - 1 <= qc) pv_d0(o, vb0 + SHM_V, pa0, pa1, pa2, pa3);
    if (hi == 0) li_l[r32] = l_reg; asm volatile("s_waitcnt lgkmcnt(0)" ::: "memory");
    float rli[16];
#pragma unroll
    for (int r = 0; r < 16; ++r) rli[r] = __builtin_amdgcn_rcpf(li_l[crow(r, hi)]);
    __syncthreads();
    int hi2 = hi, r32b = r32, ln = lane; asm volatile("" : "+v"(hi2), "+v"(r32b), "+v"(ln));
    LAS unsigned char* stg = lds + wid * 8704;
#pragma unroll
    for (int r = 0; r < 16; ++r) { const int orow = (r & 3) + 8 * (r >> 2) + 4 * hi2;
#pragma unroll
        for (int d0 = 0; d0 < 4; ++d0) *(LAS bf16_t*)(stg + orow * 272 + (d0 * 32 + r32b) * 2) = f2bf(o[d0][r] * rli[r]); }
    asm volatile("s_waitcnt lgkmcnt(0)" ::: "memory");
    bf16_t* Ow = Y + (rowbase + q0 + wid * 32) * YLD + 1024 + hd * 128;
    u32x4 zb[8];
#pragma unroll
    for (int i = 0; i < 8; ++i) { const int row = i * 4 + (ln >> 4), ch = ln & 15; zb[i] = *(const u32x4*)(Ow + (unsigned)(row * YLD + ch * 8)); }
#pragma unroll
    for (int i = 0; i < 8; ++i) { const int row = i * 4 + (ln >> 4), ch = ln & 15; const u32x4 ov = *(const LAS u32x4*)(stg + row * 272 + ch * 16); u32x4 w;
        w.x = pk_bf16(bf_lo(ov.x) * bf_lo(zb[i].x), bf_hi(ov.x) * bf_hi(zb[i].x)); w.y = pk_bf16(bf_lo(ov.y) * bf_lo(zb[i].y), bf_hi(ov.y) * bf_hi(zb[i].y));
        w.z = pk_bf16(bf_lo(ov.z) * bf_lo(zb[i].z), bf_hi(ov.z) * bf_hi(zb[i].z)); w.w = pk_bf16(bf_lo(ov.w) * bf_lo(zb[i].w), bf_hi(ov.w) * bf_hi(zb[i].w));
        if (!nostore) st16_sel<WT_MIX>(wsb, Ow + (unsigned)(row * YLD + ch * 8), w); }
    asm volatile("s_waitcnt lgkmcnt(0)" ::: "memory");
    __syncthreads();
#undef ATT_SLOAD
#undef ATT_SWRITE
#undef ATT_RESC
#undef ATT_QKT
}
}

__device__ __forceinline__ void phaseC_att(const Frame& F, const WsBuf& wsb, const bool nostore, const bf16_t* q, bf16_t* y, const bf16_t* vv, const bf16_t* kr) {
    for (int v = F.vcu; v < 256; v += F.G) { const int bh = v >> 2, s = v & 3;
        att::unit(F, wsb, nostore, bh >> 3, bh & 7, 7 - s, q, y, vv, kr);
        att::unit(F, wsb, nostore, bh >> 3, bh & 7, s, q, y, vv, kr); }
}
__device__ __forceinline__ void phaseC_lru(const Frame& F, const Args& a, const unsigned char* ws, const bool nostore, int l, bf16_t* y, const bf16_t* xc, const float* agg) {
    for (int item = F.vcu; item < NBATCH * 32; item += F.G) lru_item<2>(F, a, ws, nostore, l, item, xc, y, const_cast<float*>(agg));
}

__device__ __forceinline__ void gmlp_item(const Frame& F, const WsBuf& wsb, const Args& a, const unsigned char* ws, const bool nostore, int l, int item, const bf16_t* v1, bf16_t* y, const float* vslab) {
    const int nb = item >> 2, g = item & 3; const size_t t0 = (size_t)nb * 128;
    int lane_ = lane_id(); asm volatile("" : "+v"(lane_));
    const int lane = lane_, w = F.wave, cl = lane & 15, kg = lane >> 4;
    LAS f32x2v* stat = (LAS f32x2v*)F.lds; LAS unsigned char* vnT = F.lds + 1024;
    { float pv[16];
#pragma unroll
      for (int i = 0; i < 16; ++i) pv[i] = vslab[(t0 + 16 * w + i) * 64 + lane];
#pragma unroll
      for (int i = 0; i < 16; ++i) { float v = pv[i]; v += sx<2>(v); v += sx<4>(v); v += sx<8>(v); v += sx<16>(v); v = xsum32(v);
          const float o = sx<1>(v);
          const float mu = v * (1.f / 1024.f); const float var = fmaxf(o * (1.f / 1024.f) - mu * mu, 0.f);
          if (lane == 0) stat[16 * w + i] = (f32x2v){mu, rsqrtf(var + EPS)}; } }
    LDS_WAIT(); __syncthreads();
    { const f32x2v st0 = stat[2 * lane], st1 = stat[2 * lane + 1];
      const float* lg = a.in[I_GM_LN_G] + l * 1024 + g * 256; const float* lb = a.in[I_GM_LN_B] + l * 1024 + g * 256;
      u32x4 xa[4], xb[4];
#pragma unroll
      for (int i = 0; i < 4; ++i) { const int c8 = 4 * w + i; xa[i] = *(const u32x4*)(v1 + (t0 + 2 * lane) * 1024 + g * 256 + c8 * 8); xb[i] = *(const u32x4*)(v1 + (t0 + 2 * lane + 1) * 1024 + g * 256 + c8 * 8); }
#pragma unroll
      for (int i = 0; i < 4; ++i) { const int c8 = 4 * w + i;
          const f32x4 g0 = *(const f32x4*)(lg + c8 * 8), g1 = *(const f32x4*)(lg + c8 * 8 + 4), b0 = *(const f32x4*)(lb + c8 * 8), b1 = *(const f32x4*)(lb + c8 * 8 + 4);
          const float ga[8] = {g0.x, g0.y, g0.z, g0.w, g1.x, g1.y, g1.z, g1.w}, be[8] = {b0.x, b0.y, b0.z, b0.w, b1.x, b1.y, b1.z, b1.w};
          const unsigned wa[4] = {xa[i].x, xa[i].y, xa[i].z, xa[i].w}, wb[4] = {xb[i].x, xb[i].y, xb[i].z, xb[i].w};
#pragma unroll
          for (int e = 0; e < 8; ++e) {
              const float fa = (e & 1) ? bf_hi(wa[e >> 1]) : bf_lo(wa[e >> 1]), fb = (e & 1) ? bf_hi(wb[e >> 1]) : bf_lo(wb[e >> 1]);
              const float na = (fa - st0.x) * st0.y * ga[e] + be[e], nbv = (fb - st1.x) * st1.y * ga[e] + be[e];
              *(LAS unsigned*)(vnT + (c8 * 8 + e) * 272 + lane * 4) = pk_bf16(na, nbv); } } }
    const bf16_t* gmw = (const bf16_t*)(ws + WS_GMW) + (size_t)g * 128 * 128;
    const float* bs = a.in[I_GM_BS] + l * 512 + g * 128;
    bf16_t* ybase = y + t0 * YLD + g * 256;
    const int tid = w * 64 + lane;
    u32x4 pa[8];
#pragma unroll
    for (int i = 0; i < 8; ++i) { const int idx = tid + 512 * i; pa[i] = *(const u32x4*)(ybase + (unsigned)((idx >> 5) * YLD + (idx & 31) * 8)); }
    float bsv[8];
#pragma unroll
    for (int ct = 0; ct < 8; ++ct) bsv[ct] = bs[16 * ct + cl];
    bf16x8 wf[2][4];
#pragma unroll
    for (int ks = 0; ks < 2; ++ks) wf[0][ks] = *(const bf16x8*)(gmw + (size_t)cl * 128 + 32 * ks + 8 * kg);
    LDS_WAIT(); __syncthreads();
    bf16x8 af[2][4];
#pragma unroll
    for (int r = 0; r < 2; ++r)
#pragma unroll
        for (int ks = 0; ks < 4; ++ks) af[r][ks] = *(const LAS bf16x8*)(vnT + (16 * (2 * w + r) + cl) * 272 + (32 * ks + 8 * kg) * 2);
    LDS_WAIT(); __syncthreads();
    LAS unsigned char* stg = vnT;
#pragma unroll
    for (int ct = 0; ct < 8; ++ct) { const int cur = ct & 1;
        if (ct + 1 < 8) {
#pragma unroll
            for (int ks = 0; ks < 4; ++ks) if (ks < ((ct + 1 < 4) ? 2 : 4)) wf[cur ^ 1][ks] = *(const bf16x8*)(gmw + (size_t)(16 * (ct + 1) + cl) * 128 + 32 * ks + 8 * kg); }
        f32x4 acc[2] = {(f32x4){0.f, 0.f, 0.f, 0.f}, (f32x4){0.f, 0.f, 0.f, 0.f}};
#pragma unroll
        for (int ks = 0; ks < 4; ++ks) if (ks < ((ct < 4) ? 2 : 4)) {
            acc[0] = __builtin_amdgcn_mfma_f32_16x16x32_bf16(af[0][ks], wf[cur][ks], acc[0], 0, 0, 0); acc[1] = __builtin_amdgcn_mfma_f32_16x16x32_bf16(af[1][ks], wf[cur][ks], acc[1], 0, 0, 0); }
#pragma unroll
        for (int r = 0; r < 2; ++r) { u32x2 o; o.x = pk_bf16(acc[r][0] + bsv[ct], acc[r][1] + bsv[ct]); o.y = pk_bf16(acc[r][2] + bsv[ct], acc[r][3] + bsv[ct]);
            *(LAS u32x2*)(stg + (16 * ct + cl) * 528 + (16 * (2 * w + r) + 4 * kg) * 2) = o; }
    }
    LDS_WAIT(); __syncthreads();
#pragma unroll
    for (int i = 0; i < 8; ++i) { const int idx = tid + 512 * i; const u32x4 sv = *(const LAS u32x4*)(stg + (idx >> 5) * 528 + (idx & 31) * 16); u32x4 o;
        o.x = pk_bf16(bf_lo(pa[i].x) * bf_lo(sv.x), bf_hi(pa[i].x) * bf_hi(sv.x)); o.y = pk_bf16(bf_lo(pa[i].y) * bf_lo(sv.y), bf_hi(pa[i].y) * bf_hi(sv.y));
        o.z = pk_bf16(bf_lo(pa[i].z) * bf_lo(sv.z), bf_hi(pa[i].z) * bf_hi(sv.z)); o.w = pk_bf16(bf_lo(pa[i].w) * bf_lo(sv.w), bf_hi(pa[i].w) * bf_hi(sv.w));
        if (!nostore) st16_sel<WT_MIX>(wsb, ybase + (unsigned)((idx >> 5) * YLD + (idx & 31) * 8), o); }
    LDS_WAIT(); __syncthreads();
}
__device__ __forceinline__ void phaseE(const Frame& F, const WsBuf& wsb, const Args& a, const unsigned char* ws, const bool nostore, int l, const bf16_t* v1, bf16_t* y, const float* vslab) {
    for (int item = F.vcu; item < 512; item += F.G) gmlp_item(F, wsb, a, ws, nostore, l, item, v1, y, vslab);
}
constexpr int N_PHASES = 1 + 8 * DEPTH;
#ifndef MK_PER_PHASE
#define MK_PER_PHASE 0
#endif
#ifndef MK_MAX_PHASE
#define MK_MAX_PHASE N_PHASES
#endif

__global__ void __launch_bounds__(NWAVES * 64, 2) mk_fwd(Args args) {
    extern __shared__ __attribute__((aligned(16))) unsigned char lds_raw[];
    Frame F;
    F.lds = (LAS unsigned char*)lds_raw;
    F.wave = __builtin_amdgcn_readfirstlane((int)threadIdx.x >> 6);
    F.G = gridDim.x; { const int bx = blockIdx.x; F.vcu = (F.G % 8 == 0) ? (bx % 8) * (F.G / 8) + bx / 8 : bx; }
    volatile LAS unsigned* MISCW = (volatile LAS unsigned*)(F.lds + MISC_OFF);
    for (int u = threadIdx.x; u < (LDS_BYTES - RING_BYTES) / 4; u += NWAVES * 64) ((LAS unsigned*)(F.lds + RING_BYTES))[u] = 0u;
    __syncthreads();
    unsigned* ctl = (unsigned*)(args.ws + WS_CTL);
#if MK_PER_PHASE
    const int lo = args.ph_lo, hi = args.ph_hi;
    const bool multi = (hi - lo) > 1;
#else
    constexpr int lo = 0, hi = N_PHASES;
    constexpr bool multi = true;
#endif
    XcdBarrier bar; bar.bar = ctl + CW_BAR; bar.x = 0; bar.st = nullptr;
    if (multi) bar = xcd_barrier_post(ctl + CW_BAR, MISCW + 8);
#define IN(k) (lo <= (k) && (k) < hi)
#ifndef MK_TSP
#define MK_TSP 0
#endif
#ifndef MK_TSM
#define MK_TSM 1
#endif
#define TS_BEGIN(k) do { if (MK_TSP == (k) + 1 && threadIdx.x == 0) MISCW[16] = (unsigned)__builtin_amdgcn_s_memrealtime(); } while (0)
#define TS_END(k) do { if (MK_TSP == (k) + 1 && threadIdx.x == 0) MISCW[17] = (unsigned)__builtin_amdgcn_s_memrealtime(); } while (0)
#define SEAM(k) do { if (IN((k) + 1)) xcd_barrier(bar); } while (0)
#define xcd_barrier_if(c, b) do { if (c) xcd_barrier(b); } while (0)

typedef const __attribute__((address_space(4))) Args* KArgP;
#if defined(__HIP_DEVICE_COMPILE__)
#define AS_GLOBAL(p) __builtin_assume(!__builtin_amdgcn_is_shared((const __attribute__((address_space(0))) void*)(p)) && !__builtin_amdgcn_is_private((const __attribute__((address_space(0))) void*)(p)))
#else
#define AS_GLOBAL(p) ((void)0)
#endif
#define PHASE_PTRS \
    KArgP kp = (KArgP)__builtin_amdgcn_kernarg_segment_ptr(); asm volatile("" : "+s"(kp)); Args la; \
    _Pragma("unroll") for (int i_ = 0; i_ < N_INPUTS; ++i_) { la.in[i_] = kp->in[i_]; AS_GLOBAL(la.in[i_]); } la.out = kp->out; AS_GLOBAL(la.out); la.ph_lo = 0; la.ph_hi = 0; \
    unsigned char* ws = kp->ws; AS_GLOBAL(ws); la.ws = ws; Frame Fp = F; int bid = (int)blockIdx.x; asm volatile("" : "+s"(Fp.wave), "+s"(Fp.vcu), "+s"(Fp.G), "+s"(bid)); (void)bid; \
    bf16_t* Hb = (bf16_t*)(ws + WS_H); bf16_t* Yb = (bf16_t*)(ws + WS_Y); \
    bf16_t* MISCb = (bf16_t*)(ws + WS_MISC); bf16_t* XCb = (bf16_t*)(ws + WS_XC); bf16_t* Qb = (bf16_t*)(ws + WS_Q); bf16_t* VVb = (bf16_t*)(ws + WS_VV); bf16_t* KRb = (bf16_t*)(ws + WS_KR); \
    bf16_t* V1b = (bf16_t*)(ws + WS_V1); bf16_t* Gb = (bf16_t*)(ws + WS_G); bf16_t* Ob = (bf16_t*)(ws + WS_O); \
    float* SLAB = (float*)(ws + WS_SLAB); float* AGG = (float*)(ws + WS_AGG); const float* CS = (const float*)(ws + WS_ROPE); const float* SN = CS + 2048 * 32; \
    const unsigned char* wb = ws + WS_WB; (void)Hb; (void)Yb; (void)MISCb; (void)XCb; (void)Qb; (void)VVb; (void)KRb; (void)V1b; (void)Gb; (void)Ob; (void)SLAB; (void)AGG; (void)CS; (void)SN; (void)wb;
    TS_BEGIN(0);
    if (IN(0)) {
        { PHASE_PTRS
        convert_weights(Fp, la, ws, 0);
        rope_table(Fp, ws);
        norm_rows(Fp, false, la.in[I_X], nullptr, nullptr, nullptr, la.in[I_PRE_G], Hb, (float*)(ws + WS_RINV) + T);
        }
        SEAM(0);
    }
    TS_END(0);
#pragma nounroll
    for (int l = 0; l < DEPTH; ++l) {
        const int pb = 1 + 8 * l;
        TS_BEGIN(pb + 0);
        if (IN(pb + 0)) {
            { const bool nostore = false; (void)nostore;
            PHASE_PTRS
            SchedA S; S.ord.init(64, 16, Fp.G, bid); S.A = (const char*)Hb; S.B = (const char*)(wb + WB_W1T);
            EpiA E{MISCb, XCb, Yb, SLAB, KRb, CS, SN, make_wsbuf(ws)};
            g8::gemm_stream(Fp.lds, Fp.wave * 64 + lane_id(), 2048u, 2048u, S, E);
            }
            SEAM(pb + 0);
        }
        TS_END(pb + 0);
        TS_BEGIN(pb + 1);
        if (IN(pb + 1)) {
            { const bool nostore = false; (void)nostore;
            PHASE_PTRS
            phaseB_lru(Fp, make_wsbuf(ws), ws, (unsigned*)(ws + WS_CTL), nostore, l, XCb, Yb, AGG);
            __syncthreads();
            { SchedZ SZ; SZ.v = Fp.vcu; SZ.A = (const char*)Hb; SZ.B = (const char*)(wb + WB_W1T); EpiA EZ{MISCb, XCb, Yb, SLAB, KRb, CS, SN, make_wsbuf(ws)};
              g8::gemm_stream(Fp.lds, Fp.wave * 64 + lane_id(), 2048u, 2048u, SZ, EZ); }
            SchedQKV S; S.v = Fp.vcu; S.misc = (const char*)MISCb; S.wq = (const char*)(wb + WB_WQT); S.wkv = (const char*)(wb + WB_WKVT);
            qkv_row_scales(Fp.lds, SLAB, Fp.vcu >> 2, Fp.wave * 64 + lane_id());
            EpiQKV E{Qb, Yb, VVb, CS, SN, make_wsbuf(ws), Fp.lds};
            g8::gemm_stream(Fp.lds, Fp.wave * 64 + lane_id(), 1536u, 768u, S, E);
#ifdef MK_B2X
            { SchedZ SZ; SZ.v = Fp.vcu; SZ.A = (const char*)Hb; SZ.B = (const char*)(wb + WB_W1T); EpiA EZ{MISCb, XCb, Yb, SLAB, KRb, CS, SN, make_wsbuf(ws)};
              g8::gemm_stream(Fp.lds, Fp.wave * 64 + lane_id(), 2048u, 2048u, SZ, EZ); }
            g8::gemm_stream(Fp.lds, Fp.wave * 64 + lane_id(), 1536u, 768u, S, E);
#endif
#ifdef MK_BQ2X
            g8::gemm_stream(Fp.lds, Fp.wave * 64 + lane_id(), 1536u, 768u, S, E);
#endif
#ifdef MK_BQNULL
            { EpiNull EN; g8::gemm_stream(Fp.lds, Fp.wave * 64 + lane_id(), 1536u, 768u, S, EN); }
#endif
#ifdef MK_BZ2X
            { SchedZ SZ; SZ.v = Fp.vcu; SZ.A = (const char*)Hb; SZ.B = (const char*)(wb + WB_W1T); EpiA EZ{MISCb, XCb, Yb, SLAB, KRb, CS, SN, make_wsbuf(ws)};
              g8::gemm_stream(Fp.lds, Fp.wave * 64 + lane_id(), 2048u, 2048u, SZ, EZ); }
#endif
            }
            SEAM(pb + 1);
        }
        TS_END(pb + 1);
        TS_BEGIN(pb + 2);
        if (IN(pb + 2)) {
            { const bool nostore = false; (void)nostore;
            PHASE_PTRS
            phaseC_att(Fp, make_wsbuf(ws), nostore, Qb, Yb, VVb, KRb);
            }
            SEAM(pb + 2);
        }
        TS_END(pb + 2);
        TS_BEGIN(pb + 3);
        if (IN(pb + 3)) {
            { const bool nostore = false; (void)nostore;
            PHASE_PTRS
            SchedD S; S.ord.init(64, 24, Fp.G, bid); S.A = (const char*)Hb; S.B = (const char*)(wb + WB_W2T);
            EpiD E{Yb, V1b, Gb, SLAB, make_wsbuf(ws)};
            g8::gemm_stream(Fp.lds, Fp.wave * 64 + lane_id(), 2048u, 2048u, S, E);
            }
            SEAM(pb + 3);
        }
        TS_END(pb + 3);
        TS_BEGIN(pb + 4);
        if (IN(pb + 4)) {
            { const bool nostore = false; (void)nostore;
            PHASE_PTRS
            phaseE(Fp, make_wsbuf(ws), la, ws, nostore, l, V1b, Yb, SLAB);
            }
            SEAM(pb + 4);
        }
        TS_END(pb + 4);
        TS_BEGIN(pb + 5);
        if (IN(pb + 5)) {
            { const bool nostore = false; (void)nostore;
            PHASE_PTRS
            SchedF S; S.ord.init(64, 4, Fp.G, bid); S.A = (const char*)Yb; S.B = (const char*)(wb + WB_WPT);
            EpiF E{Gb, V1b, make_wsbuf(ws)};
            g8::gemm_stream(Fp.lds, Fp.wave * 64 + lane_id(), (unsigned)(YLD * 2), (unsigned)(YLD * 2), S, E);
            }
            SEAM(pb + 5);
        }
        TS_END(pb + 5);
        TS_BEGIN(pb + 6);
        if (IN(pb + 6)) {
            { const bool nostore = false; (void)nostore;
            PHASE_PTRS
            SchedG1 S; S.v = Fp.vcu; S.A = (const char*)V1b; S.B = (const char*)(wb + WB_WOT);
            float* RINV = (float*)(ws + WS_RINV); float* rin = RINV + (size_t)((l + 1) & 1) * T; float* rout = RINV + (size_t)(l & 1) * T;
            unsigned* ncnt = (unsigned*)(ws + WS_CTL) + CW_NORM + l * 2048;
            static_assert(DEPTH == 2, "phase G is instantiated for (first, has next) and (later, last)");
            if (l == 0) { EpiNorm<false, true> E{nullptr, la.out, Hb, la.in[I_POST_G] + l * DM, rin, rout, make_wsbuf(ws), make_wsbuf((unsigned char*)la.out), SLAB, ncnt};
                g8::gemm_stream<true>(Fp.lds, Fp.wave * 64 + lane_id(), 2048u, 2048u, S, E); }
            else { EpiNorm<false, false> E{nullptr, la.out, Hb, la.in[I_POST_G] + l * DM, rin, rout, make_wsbuf(ws), make_wsbuf((unsigned char*)la.out), SLAB, ncnt};
                g8::gemm_stream<true>(Fp.lds, Fp.wave * 64 + lane_id(), 2048u, 2048u, S, E); }
            }
            if (l + 1 < DEPTH) SEAM(pb + 6);
        }
        TS_END(pb + 6);
        TS_BEGIN(pb + 7);
        if (IN(pb + 7) && l + 1 < DEPTH) {
            { const bool nostore = false; (void)nostore;
            PHASE_PTRS
            if (l + 1 < DEPTH) convert_weights(Fp, la, ws, l + 1);
            }
            SEAM(pb + 7);
        }
        TS_END(pb + 7);
    }
    if (MK_TSP && blockIdx.x == 0 && threadIdx.x == 0) { const unsigned long long d = (unsigned long long)MK_TSM * (unsigned long long)(MISCW[17] - MISCW[16]), t = __builtin_amdgcn_s_memrealtime(); while (__builtin_amdgcn_s_memrealtime() - t < d) __builtin_amdgcn_s_sleep(8); }
#undef IN
#undef SEAM
}

#ifndef MK_PROBE
#define MK_PROBE 0
#endif
static int mk_setup(size_t ws_size) {
    static int grid = 0;
    if (grid == 0) {
        if (ws_size < WS_END) { fprintf(stderr, "kernel_launch: workspace too small: %zu < %zu\n", ws_size, (size_t)WS_END); grid = -1; return grid; }
        int dev = 0, cus = 0, per_cu = 0;
        if (hipGetDevice(&dev) != hipSuccess || hipDeviceGetAttribute(&cus, hipDeviceAttributeMultiprocessorCount, dev) != hipSuccess) { grid = -1; return grid; }
        if (hipFuncSetAttribute((const void*)mk_fwd, hipFuncAttributeMaxDynamicSharedMemorySize, LDS_BYTES) != hipSuccess) { fprintf(stderr, "kernel_launch: hipFuncSetAttribute failed\n"); grid = -1; return grid; }
        if (hipOccupancyMaxActiveBlocksPerMultiprocessor(&per_cu, (const void*)mk_fwd, NWAVES * 64, LDS_BYTES) != hipSuccess || per_cu < 1)
            fprintf(stderr, "kernel_launch: occupancy query reports %d blocks/CU\n", per_cu);
        (void)hipGetLastError();
        grid = cus;
        if (grid != 256) fprintf(stderr, "kernel_launch: note: %d CUs (tile schedules assume 256)\n", grid);
    }
    return grid;
}
static void mk_launch(void* const* d_in, void* d_out, void* d_ws, hipStream_t stream, int grid, int lo, int hi) {
    Args a{};
    for (int i = 0; i < N_INPUTS; ++i) a.in[i] = (const float*)d_in[i];
    a.out = (float*)d_out; a.ws = (unsigned char*)d_ws; a.ph_lo = lo; a.ph_hi = hi; a.probe = MK_PROBE; a.pad = 0;
    hipLaunchKernelGGL(mk_fwd, dim3(grid), dim3(NWAVES * 64), LDS_BYTES, stream, a);
}
extern "C" void kernel_launch(void* const* d_in, const int* in_sizes, int n_in, void* d_out, int out_size, void* d_ws, size_t ws_size, hipStream_t stream) {
    const int grid = mk_setup(ws_size); if (grid < 0) return;
    hipMemsetAsync((char*)d_ws + WS_CTL, 0, CTL_ZERO_BYTES, stream);
#if MK_PER_PHASE
    for (int ph = 0; ph < N_PHASES; ++ph) mk_launch(d_in, d_out, d_ws, stream, grid, ph, ph + 1);
#else
    mk_launch(d_in, d_out, d_ws, stream, grid, 0, N_PHASES);
#endif
}
```
